# Optimizing an MI355X kernel written in HIP

```python
import math
import jax, jax.numpy as jnp
from jax import lax
import numpy as np

D_MODEL = 1024
BATCH = 2
SEQ = 8192
DEPTH = 2

GRID_W = 64
CTX_LEN = 256

DN_HEADS = 4
DN_DK = 128
DN_DV = 256
DN_QKW = DN_HEADS * DN_DK
DN_VW = DN_HEADS * DN_DV
DN_CONV_CH = 2 * DN_QKW + DN_VW
CONV_W = 5
RET_HEADS = 4
RET_DK = 128
RET_DV = 256
RET_QKW = RET_HEADS * RET_DK
RET_VW = RET_HEADS * RET_DV
ROPE_BASE = 10000.0
HG_HEADS = 8
HG_DK = 128
HG_DV = 128
HG_KW = HG_HEADS * HG_DK
HG_VW = HG_HEADS * HG_DV

N_BRANCH = 3
BRANCH_W = 1024
CHUNK = 64
HG_CHUNK = 32
NORM_EPS = 1e-6

SPLIT_SIZES = (DN_CONV_CH, DN_VW, 2 * DN_HEADS, 2 * DN_HEADS,
               RET_QKW, RET_QKW, RET_VW, RET_VW,
               HG_KW, 2 * HG_KW, HG_VW, HG_VW,
               N_BRANCH * D_MODEL)
IN_WIDTH = sum(SPLIT_SIZES)

kernel_name = "hybrid_deltanet_retention_hgrn2_block"


def rms_norm(x, w):
    xf = x.astype(jnp.float32)
    y = xf * lax.rsqrt(jnp.mean(xf * xf, axis=-1, keepdims=True) + NORM_EPS)
    return (y * w.astype(jnp.float32)).astype(x.dtype)


def l2norm(x):
    return x * lax.rsqrt(jnp.sum(x * x, axis=-1, keepdims=True) + NORM_EPS)


def short_conv(x, w):
    pad = CONV_W // 2
    return lax.conv_general_dilated(x, w[:, None, :].astype(x.dtype), window_strides=(1,),
                                    padding=[(pad, pad)], dimension_numbers=('NWC', 'WIO', 'NWC'),
                                    feature_group_count=x.shape[-1])


def axial_rotary(x, row, col):
    half = x.shape[-1] // 2
    inv = ROPE_BASE ** (-jnp.arange(0, half, 2, dtype=jnp.float32) / half)
    ang = jnp.concatenate([row[:, None] * inv, col[:, None] * inv], axis=-1)[:, None, :]
    cos, sin = jnp.cos(ang), jnp.sin(ang)
    x1, x2 = x[..., 0::2], x[..., 1::2]
    return jnp.stack([x1 * cos - x2 * sin, x1 * sin + x2 * cos], axis=-1).reshape(x.shape)


def _heads(t, n_heads):
    B, T, _ = t.shape
    return t.reshape(B, T, n_heads, -1).transpose(0, 2, 1, 3)


def _chunks(t, c):
    B, H, T = t.shape[:3]
    return jnp.moveaxis(t.reshape(B, H, T // c, c, *t.shape[3:]), 2, 0)


def _unchunk(o):
    n, B, H, c, d = o.shape
    return jnp.moveaxis(o, 0, 2).reshape(B, H, n * c, d)


def gated_delta_scan(q, k, v, g, beta, s0):
    dk = q.shape[-1]
    qc, kc, vc, gc, bc = [_chunks(t, CHUNK) for t in (q, k, v, g, beta)]
    gcum = jnp.cumsum(gc, axis=-1)
    idx = jnp.arange(CHUNK)
    tril = idx[:, None] >= idx[None, :]
    strict = idx[:, None] > idx[None, :]
    dec = jnp.exp(jnp.where(tril, gcum[..., :, None] - gcum[..., None, :], -jnp.inf))
    kb = kc * bc[..., None]
    lower = jnp.where(strict, jnp.einsum('nbhid,nbhjd->nbhij', kb, kc) * dec, 0.0)
    a_mat = lower + jnp.eye(CHUNK, dtype=lower.dtype)
    rhs = jnp.concatenate([kb * jnp.exp(gcum)[..., None], vc * bc[..., None]], axis=-1)
    sol = lax.linalg.triangular_solve(a_mat, rhs, left_side=True, lower=True)
    w, u = sol[..., :dk], sol[..., dk:]
    attn = jnp.einsum('nbhid,nbhjd->nbhij', qc, kc) * dec
    qd = qc * jnp.exp(gcum)[..., None]
    kd = kc * jnp.exp(gcum[..., -1:] - gcum)[..., None]
    gl = jnp.exp(gcum[..., -1])

    def step(S, inp):
        wi, ui, ai, qi, ki, gi = inp
        vn = ui - jnp.einsum('bhid,bhdv->bhiv', wi, S)
        o = jnp.einsum('bhid,bhdv->bhiv', qi, S) + jnp.einsum('bhij,bhjv->bhiv', ai, vn)
        S = S * gi[..., None, None] + jnp.einsum('bhjd,bhjv->bhdv', ki, vn)
        return S, o

    S, o = lax.scan(step, s0, (w, u, attn, qd, kd, gl))
    return _unchunk(o), S


def retention_scan(q, k, v, g, s0):
    qc, kc, vc, gc = [_chunks(t, CHUNK) for t in (q, k, v, g)]
    gcum = jnp.cumsum(gc, axis=-1)
    idx = jnp.arange(CHUNK)
    tril = idx[:, None] >= idx[None, :]

    def step(S, inp):
        qi, ki, vi, gi = inp
        dec = jnp.exp(jnp.where(tril, gi[..., :, None] - gi[..., None, :], -jnp.inf))
        attn = jnp.einsum('bhid,bhjd->bhij', qi, ki) * dec
        o = (jnp.einsum('bhij,bhjv->bhiv', attn, vi)
             + jnp.einsum('bhid,bhdv->bhiv', qi * jnp.exp(gi)[..., None], S))
        S = (S * jnp.exp(gi[..., -1])[..., None, None]
             + jnp.einsum('bhjd,bhjv->bhdv', ki * jnp.exp(gi[..., -1:] - gi)[..., None], vi))
        return S, o

    S, o = lax.scan(step, s0, (qc, kc, vc, gcum))
    return _unchunk(o), S


def hgrn2_scan(q, k, v, g, s0):
    qc, kc, vc, gc = [_chunks(t, HG_CHUNK) for t in (q, k, v, g)]
    gcum = jnp.cumsum(gc, axis=-2)
    idx = jnp.arange(HG_CHUNK)
    tril = (idx[:, None] >= idx[None, :])[:, :, None]

    def step(S, inp):
        qi, ki, vi, gi = inp
        rel = jnp.exp(jnp.where(tril, gi[..., :, None, :] - gi[..., None, :, :], -jnp.inf))
        attn = jnp.einsum('bhid,bhjd,bhijd->bhij', qi, ki, rel)
        o = (jnp.einsum('bhij,bhjv->bhiv', attn, vi)
             + jnp.einsum('bhid,bhdv->bhiv', qi * jnp.exp(gi), S))
        S = (S * jnp.exp(gi[..., -1, :])[..., :, None]
             + jnp.einsum('bhjd,bhjv->bhdv', ki * jnp.exp(gi[..., -1:, :] - gi), vi))
        return S, o

    S, o = lax.scan(step, s0, (qc, kc, vc, gcum))
    return _unchunk(o), S


def bidirectional(scan_fn, ctx_args, lat_args, s0):
    flip = lambda t: jnp.flip(t, axis=2)
    (cf, cb), (lf, lb) = ctx_args, lat_args
    o_cf, s_f = scan_fn(*cf, s0)
    o_cb, s_b = scan_fn(*map(flip, cb), s0)
    o_lf, _ = scan_fn(*lf, s_f)
    o_lb, _ = scan_fn(*map(flip, lb), s_b)
    return o_cf + flip(o_cb), o_lf + flip(o_lb)


def mixer_inputs(h, w_in, conv_w, dn_a_log, dn_dt_bias, ret_log_gamma, hg_lower, rot):
    f32 = jnp.float32
    B, T, _ = h.shape
    p = jnp.einsum('btd,de->bte', h, w_in)
    bounds = np.cumsum(SPLIT_SIZES)[:-1].tolist()
    (dn_qkv, dn_gate, dn_a, dn_b, r_q, r_k, r_v, r_gate,
     hg_q, hg_f, hg_i, hg_gate, merge) = jnp.split(p, bounds, axis=-1)

    qkv = jax.nn.silu(short_conv(dn_qkv, conv_w)).astype(f32)
    q, k, v = jnp.split(qkv, [DN_QKW, 2 * DN_QKW], axis=-1)
    q = l2norm(_heads(q, DN_HEADS)) * DN_DK ** -0.5
    k = l2norm(_heads(k, DN_HEADS))
    v = _heads(v, DN_HEADS)
    a = dn_a.astype(f32).reshape(B, T, 2, DN_HEADS).transpose(2, 0, 3, 1)
    b = dn_b.astype(f32).reshape(B, T, 2, DN_HEADS).transpose(2, 0, 3, 1)
    g = (-jnp.exp(dn_a_log.astype(f32))[:, None, :, None]
         * jax.nn.softplus(a + dn_dt_bias.astype(f32)[:, None, :, None]))
    beta = jax.nn.sigmoid(b)
    dn = tuple((q, k, v, g[d], beta[d]) for d in range(2))

    rq = r_q.astype(f32).reshape(B, T, RET_HEADS, RET_DK)
    rk = r_k.astype(f32).reshape(B, T, RET_HEADS, RET_DK)
    if rot is not None:
        rq, rk = axial_rotary(rq, *rot), axial_rotary(rk, *rot)
    rq = rq.transpose(0, 2, 1, 3)
    rk = rk.transpose(0, 2, 1, 3) * RET_DK ** -0.5
    rv = _heads(r_v, RET_HEADS).astype(f32)
    lam = jnp.broadcast_to(ret_log_gamma[:, None, :, None], (2, B, RET_HEADS, T))
    ret = tuple((rq, rk, rv, lam[d]) for d in range(2))

    hq = jax.nn.silu(_heads(hg_q, HG_HEADS).astype(f32))
    hi = _heads(hg_i, HG_HEADS).astype(f32)
    f = jax.nn.sigmoid(hg_f.astype(f32).reshape(B, T, 2, HG_KW))
    f = hg_lower + (1.0 - hg_lower) * f
    f = f.reshape(B, T, 2, HG_HEADS, HG_DK).transpose(2, 0, 3, 1, 4)
    hg = tuple((hq, 1.0 - f[d], hi, jnp.log(f[d])) for d in range(2))

    return dn, ret, hg, (dn_gate, r_gate, hg_gate), merge


def branch_out(o, gate, norm_w):
    B, H, T, dv = o.shape
    o = rms_norm(o.transpose(0, 2, 1, 3), norm_w).reshape(B, T, H * dv)
    return o.astype(gate.dtype) * jax.nn.silu(gate)


def merge_branches(branches, merge, w_branch, w_out):
    B, T, _ = merge.shape
    gates = jax.nn.sigmoid(merge.reshape(B, T, N_BRANCH, D_MODEL))
    y = jnp.einsum('btw,wd->btd', branches[0], w_branch[0]) * gates[:, :, 0]
    for i in range(1, N_BRANCH):
        y = y + jnp.einsum('btw,wd->btd', branches[i], w_branch[i]) * gates[:, :, i]
    return jnp.einsum('btd,de->bte', y, w_out)


def setup_inputs(seed: int = 0) -> dict:
    key = jax.random.key(seed)
    ks = jax.random.split(key, 20)
    f32 = jnp.float32
    nrm = lambda k, shape, s: jax.random.normal(k, shape, f32) * s
    x = nrm(ks[0], (BATCH, SEQ, D_MODEL), 1.0)
    c = nrm(ks[1], (BATCH, D_MODEL), 1.0)
    ctx = nrm(ks[2], (BATCH, CTX_LEN, D_MODEL), 1.0)
    c_ctx = nrm(ks[3], (D_MODEL,), 1.0)
    norm_w = 1.0 + nrm(ks[4], (DEPTH, D_MODEL), 0.02)
    ada_w = nrm(ks[5], (DEPTH, D_MODEL, 3 * D_MODEL), 0.5 * D_MODEL ** -0.5)
    ada_b = nrm(ks[6], (DEPTH, 3 * D_MODEL), 0.02)
    w_in = nrm(ks[7], (DEPTH, D_MODEL, IN_WIDTH), D_MODEL ** -0.5)
    dn_conv = nrm(ks[8], (DEPTH, CONV_W, DN_CONV_CH), CONV_W ** -0.5)
    dn_a_log = jnp.log(jax.random.uniform(ks[9], (DEPTH, 2, DN_HEADS), f32, 1.0, 16.0))
    dt = jnp.exp(jax.random.uniform(ks[10], (DEPTH, 2, DN_HEADS), f32, math.log(1e-3), math.log(1e-1)))
    dn_dt_bias = dt + jnp.log(-jnp.expm1(-dt))
    dn_norm_w = 1.0 + nrm(ks[11], (DEPTH, DN_DV), 0.02)
    gamma_logit = jnp.log(2.0 ** (5.0 + jnp.arange(RET_HEADS, dtype=f32)) - 1.0)
    ret_decay = gamma_logit + nrm(ks[12], (DEPTH, 2, RET_HEADS), 0.01)
    ret_norm_w = 1.0 + nrm(ks[13], (DEPTH, RET_DV), 0.02)
    hg_lb = nrm(ks[14], (DEPTH, 2, HG_KW), 0.1)
    hg_norm_w = 1.0 + nrm(ks[15], (DEPTH, HG_DV), 0.02)
    w_branch = nrm(ks[16], (DEPTH, N_BRANCH, BRANCH_W, D_MODEL), BRANCH_W ** -0.5)
    w_out = nrm(ks[17], (DEPTH, D_MODEL, D_MODEL), D_MODEL ** -0.5)
    final_norm_w = 1.0 + nrm(ks[18], (D_MODEL,), 0.02)
    return {"x": x, "c": c, "ctx": ctx, "c_ctx": c_ctx, "norm_w": norm_w, "ada_w": ada_w,
            "ada_b": ada_b, "w_in": w_in, "dn_conv": dn_conv, "dn_a_log": dn_a_log,
            "dn_dt_bias": dn_dt_bias, "dn_norm_w": dn_norm_w, "ret_decay": ret_decay,
            "ret_norm_w": ret_norm_w, "hg_lb": hg_lb, "hg_norm_w": hg_norm_w,
            "w_branch": w_branch, "w_out": w_out, "final_norm_w": final_norm_w}


def reference(x, c, ctx, c_ctx, norm_w, ada_w, ada_b, w_in, dn_conv, dn_a_log, dn_dt_bias, dn_norm_w,
              ret_decay, ret_norm_w, hg_lb, hg_norm_w, w_branch, w_out, final_norm_w):
    f32 = jnp.float32
    B, n_tok, _ = x.shape
    rows = n_tok // GRID_W
    row = jnp.repeat(jnp.arange(rows, dtype=f32), GRID_W)
    col = jnp.tile(jnp.arange(GRID_W, dtype=f32), rows)
    lb_sm = jax.nn.softmax(hg_lb.astype(f32), axis=0)
    lower = jnp.cumsum(lb_sm, axis=0) - lb_sm[0:1]
    silu_c = jax.nn.silu(c)
    silu_cc = jax.nn.silu(c_ctx)

    for l in range(DEPTH):
        last = l == DEPTH - 1
        sh, sc, gt = jnp.split(silu_c @ ada_w[l] + ada_b[l], 3, axis=-1)
        sh_c, sc_c, gt_c = jnp.split(silu_cc @ ada_w[l] + ada_b[l], 3, axis=-1)
        h = rms_norm(x, norm_w[l]) * (1.0 + sc[:, None]) + sh[:, None]
        hc = rms_norm(ctx, norm_w[l]) * (1.0 + sc_c) + sh_c
        log_gamma = jax.nn.log_sigmoid(ret_decay[l].astype(f32))
        lat_in = mixer_inputs(h, w_in[l], dn_conv[l], dn_a_log[l], dn_dt_bias[l], log_gamma, lower[l],
                              (row, col))
        ctx_in = mixer_inputs(hc, w_in[l], dn_conv[l], dn_a_log[l], dn_dt_bias[l], log_gamma, lower[l],
                              None)
        mixers = ((gated_delta_scan, (DN_HEADS, DN_DK, DN_DV), dn_norm_w[l]),
                  (retention_scan, (RET_HEADS, RET_DK, RET_DV), ret_norm_w[l]),
                  (hgrn2_scan, (HG_HEADS, HG_DK, HG_DV), hg_norm_w[l]))
        o_ctx, o_lat = [], []
        for i, (fn, sdim, _) in enumerate(mixers):
            oc, ol = bidirectional(fn, ctx_in[i], lat_in[i], jnp.zeros((B,) + sdim, f32))
            o_ctx.append(oc)
            o_lat.append(ol)
        lat_br = [branch_out(o, g, m[2]) for o, g, m in zip(o_lat, lat_in[3], mixers)]
        x = x + gt[:, None, :] * merge_branches(lat_br, lat_in[4], w_branch[l], w_out[l]).astype(x.dtype)
        if not last:
            ctx_br = [branch_out(o, g, m[2]) for o, g, m in zip(o_ctx, ctx_in[3], mixers)]
            ctx = ctx + gt_c * merge_branches(ctx_br, ctx_in[4], w_branch[l], w_out[l]).astype(ctx.dtype)

    return rms_norm(x, final_norm_w)
```

```cpp
#include <hip/hip_runtime.h>
#include <hip/hip_cooperative_groups.h>
#include <cstdio>
namespace cg = cooperative_groups;

#ifndef ONE_LAUNCH
#define ONE_LAUNCH 1
#endif
#ifndef ONLY_Q
#define ONLY_Q -1
#endif
#define QSEL(n) (ONLY_Q < 0 || ONLY_Q == (n))

typedef unsigned short u16;
using bf16x8 = __attribute__((ext_vector_type(8))) short;
using bf16x4 = __attribute__((ext_vector_type(4))) short;
using f32x4 = __attribute__((ext_vector_type(4))) float;
#define DI __device__ __forceinline__

constexpr int T_LAT = 16384, T_ALL = 16896, NCH = 264;
constexpr int WROWS = 18448;
constexpr int W_BR = 14352, W_OUT = 17424;
constexpr size_t al(size_t x) { return (x + 255) & ~(size_t)255; }
constexpr size_t SZ_WT = (size_t)WROWS * 1024 * 2;
constexpr size_t SZ_TOK1K = (size_t)T_ALL * 1024 * 2;
constexpr size_t OFF_WT = 0;
constexpr size_t OFF_H = OFF_WT + al(SZ_WT);
constexpr size_t OFF_MOD = OFF_H + al(SZ_TOK1K);
constexpr size_t OFF_ROT = OFF_MOD + al(2 * 3 * 3072 * 4);
constexpr size_t OFF_GB = OFF_ROT + al(128 * 32 * 2 * 4);
constexpr size_t OFF_CTX1 = OFF_GB + al((size_t)T_ALL * 16 * 4);
constexpr size_t OFF_HALO = OFF_CTX1 + al(512 * 1024 * 4);
constexpr size_t OFF_DNSC = OFF_HALO + al((size_t)NCH * 4 * 2048 * 2);
constexpr size_t OFF_HGDEC = OFF_DNSC + al((size_t)NCH * 4 * 2 * 192 * 4);
constexpr size_t OFF_A = OFF_HGDEC + al((size_t)NCH * 8 * 2 * 128 * 4);
constexpr size_t OFF_B = OFF_A + 4 * SZ_TOK1K;
constexpr size_t OFF_C = OFF_B + SZ_TOK1K;
constexpr size_t OFF_D = OFF_C + SZ_TOK1K;
constexpr size_t OFF_E = OFF_D + 2 * SZ_TOK1K;
constexpr size_t WS_TOTAL = OFF_E + 3 * SZ_TOK1K;
static_assert(WS_TOTAL <= 470286336ull, "workspace too large");

constexpr int SMEM_BYTES = 72960;

struct Params {
  const float *x, *c, *ctx, *c_ctx, *norm_w, *ada_w, *ada_b, *w_in, *dn_conv, *dn_a_log, *dn_dt_bias, *dn_norm_w,
      *ret_decay, *ret_norm_w, *hg_lb, *hg_norm_w, *w_branch, *w_out, *final_norm_w;
  float* out;
  char* ws;
  int ph_lo, ph_hi;
};

DI int laneid_v() { int t; asm volatile("v_mbcnt_lo_u32_b32 %0, -1, 0\n\tv_mbcnt_hi_u32_b32 %0, -1, %0" : "=v"(t)); return t; }
#define tidx() (WV * 64 + laneid_v())
DI u16 f2bf(float f) { unsigned u = __float_as_uint(f); u += 0x7fffu + ((u >> 16) & 1u); return (u16)(u >> 16); }
DI float bf2f(u16 h) { return __uint_as_float(((unsigned)h) << 16); }
DI unsigned pack2(float a, float b) { return (unsigned)f2bf(a) | ((unsigned)f2bf(b) << 16); }
DI float sigm(float x) { return 1.f / (1.f + __expf(-x)); }
DI float silu(float x) { return x / (1.f + __expf(-x)); }
DI float wsum(float v) {
#pragma unroll
  for (int o = 32; o > 0; o >>= 1) v += __shfl_xor(v, o, 64);
  return v;
}
DI f32x4 mfma16(bf16x8 a, bf16x8 b, f32x4 c) { return __builtin_amdgcn_mfma_f32_16x16x32_bf16(a, b, c, 0, 0, 0); }
DI bf16x8 pack8(f32x4 lo, f32x4 hi) {
  bf16x8 r;
  r[0] = (short)f2bf(lo[0]); r[1] = (short)f2bf(lo[1]); r[2] = (short)f2bf(lo[2]); r[3] = (short)f2bf(lo[3]);
  r[4] = (short)f2bf(hi[0]); r[5] = (short)f2bf(hi[1]); r[6] = (short)f2bf(hi[2]); r[7] = (short)f2bf(hi[3]);
  return r;
}
DI bf16x8 ld_perm(const char* rowp, int c0) {
  bf16x4 lo = *(const bf16x4*)(rowp + c0 * 2);
  bf16x4 hi = *(const bf16x4*)(rowp + c0 * 2 + 32);
  bf16x8 r;
  r[0] = lo[0]; r[1] = lo[1]; r[2] = lo[2]; r[3] = lo[3]; r[4] = hi[0]; r[5] = hi[1]; r[6] = hi[2]; r[7] = hi[3];
  return r;
}

DI int swz(int row, int ch) { return row * 128 + ((ch ^ (row & 7)) << 4); }

DI void gemm_kloop(const u16* __restrict__ A, const u16* __restrict__ W, f32x4 (&acc)[4][4], char* smem, const int WV) {
  const int tid = tidx(), lane = tid & 63, wid = tid >> 6, wn = wid >> 1, wt = wid & 1;
  const int fr = lane & 15, fq = lane >> 4;
  uint4 ra[4], rw[4];
  const int lrow = tid >> 3, lch = tid & 7;
  const u16* Ap = A + (size_t)lrow * 1024 + lch * 8;
  const u16* Wp = W + (size_t)lrow * 1024 + lch * 8;
#pragma unroll
  for (int i = 0; i < 4; i++) {
    ra[i] = *(const uint4*)(Ap + (size_t)i * 32 * 1024);
    rw[i] = *(const uint4*)(Wp + (size_t)i * 32 * 1024);
  }
#pragma unroll
  for (int i = 0; i < 4; i++) {
    *(uint4*)(smem + swz(lrow + i * 32, lch)) = rw[i];
    *(uint4*)(smem + 16384 + swz(lrow + i * 32, lch)) = ra[i];
  }
  __syncthreads();
  for (int kt = 0; kt < 16; kt++) {
    if (kt < 15) {
#pragma unroll
      for (int i = 0; i < 4; i++) {
        ra[i] = *(const uint4*)(Ap + (size_t)i * 32 * 1024 + (kt + 1) * 64);
        rw[i] = *(const uint4*)(Wp + (size_t)i * 32 * 1024 + (kt + 1) * 64);
      }
    }
    const char* sW = smem + (kt & 1) * 32768;
    const char* sA = sW + 16384;
#pragma unroll
    for (int ks = 0; ks < 2; ks++) {
      bf16x8 fw[4], fa[4];
#pragma unroll
      for (int i = 0; i < 4; i++) {
        fw[i] = *(const bf16x8*)(sW + swz(wn * 64 + i * 16 + fr, ks * 4 + fq));
        fa[i] = *(const bf16x8*)(sA + swz(wt * 64 + i * 16 + fr, ks * 4 + fq));
      }
#pragma unroll
      for (int ni = 0; ni < 4; ni++)
#pragma unroll
        for (int ti = 0; ti < 4; ti++) acc[ni][ti] = mfma16(fw[ni], fa[ti], acc[ni][ti]);
    }
    if (kt < 15) {
      char* dW = smem + ((kt + 1) & 1) * 32768;
#pragma unroll
      for (int i = 0; i < 4; i++) {
        *(uint4*)(dW + swz(lrow + i * 32, lch)) = rw[i];
        *(uint4*)(dW + 16384 + swz(lrow + i * 32, lch)) = ra[i];
      }
    }
    __syncthreads();
  }
}

enum { EPI_HG = 0, EPI_DNRET = 1, EPI_GATE = 2, EPI_OUT = 3 };

template <int EPI>
DI void gemm_tile(const Params& p, int l, int rt, int nti, char* smem) {
  const int WV = p.ph_hi;
  const int tid = tidx(), lane = tid & 63, wid = tid >> 6, wn = wid >> 1, wt = wid & 1;
  const int fr = lane & 15, fq = lane >> 4;
  const int row0 = rt * 128;
  const u16* WT = (const u16*)(p.ws + OFF_WT);
  const u16* A;
  int wrow, n0, mixer = 0;
  if (EPI == EPI_HG) { A = (const u16*)(p.ws + OFF_H); n0 = nti * 128; wrow = 6160 + n0; }
  else if (EPI == EPI_DNRET) { A = (const u16*)(p.ws + OFF_H); mixer = nti >> 4; n0 = (nti & 15) * 128; wrow = (mixer ? 3088 : 0) + n0; }
  else if (EPI == EPI_GATE) { A = (const u16*)(p.ws + OFF_H); mixer = nti >> 3; n0 = (nti & 7) * 128; wrow = (mixer == 0 ? 2048 : (mixer == 1 ? 5136 : 10256)) + n0; }
  else { A = (const u16*)(p.ws + OFF_B); n0 = nti * 128; wrow = W_OUT + n0; }
  f32x4 acc[4][4];
#pragma unroll
  for (int i = 0; i < 4; i++)
#pragma unroll
    for (int j = 0; j < 4; j++) acc[i][j] = f32x4{0.f, 0.f, 0.f, 0.f};
  gemm_kloop(A + (size_t)row0 * 1024, WT + (size_t)wrow * 1024, acc, smem, WV);

  const float* ROT = (const float*)(p.ws + OFF_ROT);
  const float* MOD = (const float*)(p.ws + OFF_MOD);
#pragma unroll
  for (int ti = 0; ti < 4; ti++) {
    const int token = row0 + wt * 64 + ti * 16 + fr;
#pragma unroll
    for (int ni = 0; ni < 4; ni++) {
      const int nl = n0 + wn * 64 + ni * 16 + fq * 4;
      f32x4 v = acc[ni][ti];
      if (EPI == EPI_HG) {
        if (nl < 1024) { v[0] = silu(v[0]); v[1] = silu(v[1]); v[2] = silu(v[2]); v[3] = silu(v[3]); }
        u16* dst = (u16*)(p.ws + OFF_A) + (size_t)token * 4096 + nl;
        *(uint2*)dst = uint2{pack2(v[0], v[1]), pack2(v[2], v[3])};
      } else if (EPI == EPI_DNRET) {
        if (mixer == 0) {
          uint2 pk = uint2{pack2(v[0], v[1]), pack2(v[2], v[3])};
          u16* dst = (u16*)(p.ws + OFF_A) + (size_t)token * 2048 + nl;
          *(uint2*)dst = pk;
          const int tm = token & 63;
          if (tm < 2 || tm >= 62) {
            const int slot = tm < 2 ? tm : tm - 60;
            u16* hd = (u16*)(p.ws + OFF_HALO) + ((size_t)(token >> 6) * 4 + slot) * 2048 + nl;
            *(uint2*)hd = pk;
          }
        } else {
          if (nl < 1024) {
            if (token < T_LAT) {
              const int t = token & 8191, ri = t >> 6, ci = t & 63;
              const int d = nl & 127;
#pragma unroll
              for (int pp = 0; pp < 2; pp++) {
                const int pidx = (d >> 1) + pp;
                const float* rp = pidx < 32 ? ROT + (ri * 32 + pidx) * 2 : ROT + (ci * 32 + (pidx - 32)) * 2;
                const float cs = rp[0], sn = rp[1];
                const float x1 = v[2 * pp], x2 = v[2 * pp + 1];
                v[2 * pp] = x1 * cs - x2 * sn;
                v[2 * pp + 1] = x1 * sn + x2 * cs;
              }
            }
            if (nl >= 512) { const float s = 0.08838834764831845f; v[0] *= s; v[1] *= s; v[2] *= s; v[3] *= s; }
          }
          u16* dst = (u16*)(p.ws + OFF_A + 2 * SZ_TOK1K) + (size_t)token * 2048 + nl;
          *(uint2*)dst = uint2{pack2(v[0], v[1]), pack2(v[2], v[3])};
        }
      } else if (EPI == EPI_GATE) {
        char* base = mixer == 0 ? p.ws + OFF_E : (mixer == 1 ? p.ws + OFF_E + SZ_TOK1K : p.ws + OFF_D);
        u16* dst = (u16*)base + (size_t)token * 1024 + nl;
        uint2 on = *(const uint2*)dst;
        float o0 = bf2f((u16)(on.x & 0xffff)), o1 = bf2f((u16)(on.x >> 16)), o2 = bf2f((u16)(on.y & 0xffff)), o3 = bf2f((u16)(on.y >> 16));
        *(uint2*)dst = uint2{pack2(o0 * silu(v[0]), o1 * silu(v[1])), pack2(o2 * silu(v[2]), o3 * silu(v[3]))};
      } else {
        const int vec = token < T_LAT ? (token >> 13) : 2;
        const f32x4 gt = *(const f32x4*)(MOD + ((size_t)l * 3 + vec) * 3072 + 2048 + nl);
        const float* src;
        float* dst;
        if (token < T_LAT) {
          src = (l == 0 ? p.x : (const float*)p.out) + (size_t)token * 1024 + nl;
          dst = p.out + (size_t)token * 1024 + nl;
        } else {
          src = p.ctx + (size_t)(token - T_LAT) * 1024 + nl;
          dst = (float*)(p.ws + OFF_CTX1) + (size_t)(token - T_LAT) * 1024 + nl;
        }
        f32x4 xi = *(const f32x4*)src;
        f32x4 r;
        r[0] = xi[0] + gt[0] * v[0]; r[1] = xi[1] + gt[1] * v[1]; r[2] = xi[2] + gt[2] * v[2]; r[3] = xi[3] + gt[3] * v[3];
        *(f32x4*)dst = r;
      }
    }
  }
}

DI void merge_tile(const Params& p, int rt, int nti, char* smem) {
  const int WV = p.ph_hi;
  const int tid = tidx(), lane = tid & 63, wid = tid >> 6, wn = wid >> 1, wt = wid & 1;
  const int fr = lane & 15, fq = lane >> 4;
  const int row0 = rt * 128, n0 = nti * 128;
  const u16* WT = (const u16*)(p.ws + OFF_WT);
  const u16* H = (const u16*)(p.ws + OFF_H) + (size_t)row0 * 1024;
  uint2 y[4][4];
#pragma unroll
  for (int i = 0; i < 4; i++)
#pragma unroll
    for (int j = 0; j < 4; j++) y[i][j] = uint2{0u, 0u};
  for (int m = 0; m < 3; m++) {
    uint2 sg[4][4];
    {
      f32x4 acc[4][4];
#pragma unroll
      for (int i = 0; i < 4; i++)
#pragma unroll
        for (int j = 0; j < 4; j++) acc[i][j] = f32x4{0.f, 0.f, 0.f, 0.f};
      gemm_kloop(H, WT + (size_t)(11280 + m * 1024 + n0) * 1024, acc, smem, WV);
#pragma unroll
      for (int i = 0; i < 4; i++)
#pragma unroll
        for (int j = 0; j < 4; j++)
          sg[i][j] = uint2{pack2(sigm(acc[i][j][0]), sigm(acc[i][j][1])), pack2(sigm(acc[i][j][2]), sigm(acc[i][j][3]))};
    }
    {
      const char* base = m == 0 ? p.ws + OFF_E : (m == 1 ? p.ws + OFF_E + SZ_TOK1K : p.ws + OFF_D);
      f32x4 acc[4][4];
#pragma unroll
      for (int i = 0; i < 4; i++)
#pragma unroll
        for (int j = 0; j < 4; j++) acc[i][j] = f32x4{0.f, 0.f, 0.f, 0.f};
      gemm_kloop((const u16*)base + (size_t)row0 * 1024, WT + (size_t)(W_BR + m * 1024 + n0) * 1024, acc, smem, WV);
#pragma unroll
      for (int i = 0; i < 4; i++)
#pragma unroll
        for (int j = 0; j < 4; j++) {
          const float y0 = bf2f((u16)(y[i][j].x & 0xffff)) + acc[i][j][0] * bf2f((u16)(sg[i][j].x & 0xffff));
          const float y1 = bf2f((u16)(y[i][j].x >> 16)) + acc[i][j][1] * bf2f((u16)(sg[i][j].x >> 16));
          const float y2 = bf2f((u16)(y[i][j].y & 0xffff)) + acc[i][j][2] * bf2f((u16)(sg[i][j].y & 0xffff));
          const float y3 = bf2f((u16)(y[i][j].y >> 16)) + acc[i][j][3] * bf2f((u16)(sg[i][j].y >> 16));
          y[i][j] = uint2{pack2(y0, y1), pack2(y2, y3)};
        }
    }
  }
  u16* Y = (u16*)(p.ws + OFF_B);
#pragma unroll
  for (int ti = 0; ti < 4; ti++) {
    const int token = row0 + wt * 64 + ti * 16 + fr;
#pragma unroll
    for (int ni = 0; ni < 4; ni++) {
      const int nl = n0 + wn * 64 + ni * 16 + fq * 4;
      *(uint2*)(Y + (size_t)token * 1024 + nl) = y[ni][ti];
    }
  }
}

DI void wconv_tile(const float* __restrict__ src, int N, int kt, int ntile, u16* __restrict__ dst, char* smem, const int WV) {
  float* s = (float*)smem;
  const int tid = tidx();
  const int k0 = kt * 64, n0 = ntile * 64;
#pragma unroll
  for (int i = 0; i < 4; i++) {
    const int r = (tid >> 4) + i * 16, c4 = (tid & 15) * 4;
    if (n0 + c4 < N) {
      f32x4 v = *(const f32x4*)(src + (size_t)(k0 + r) * N + n0 + c4);
      s[r * 65 + c4] = v[0]; s[r * 65 + c4 + 1] = v[1]; s[r * 65 + c4 + 2] = v[2]; s[r * 65 + c4 + 3] = v[3];
    }
  }
  __syncthreads();
#pragma unroll
  for (int i = 0; i < 2; i++) {
    const int id = tid + i * 256, n = id >> 3, kc = (id & 7) * 8;
    if (n0 + n < N) {
      uint4 o;
      o.x = pack2(s[(kc + 0) * 65 + n], s[(kc + 1) * 65 + n]);
      o.y = pack2(s[(kc + 2) * 65 + n], s[(kc + 3) * 65 + n]);
      o.z = pack2(s[(kc + 4) * 65 + n], s[(kc + 5) * 65 + n]);
      o.w = pack2(s[(kc + 6) * 65 + n], s[(kc + 7) * 65 + n]);
      *(uint4*)(dst + (size_t)(n0 + n) * 1024 + k0 + kc) = o;
    }
  }
  __syncthreads();
}
constexpr int WCONV_UNITS = 16 * 225 + 3 * 256 + 256;
DI void wconv_unit(const Params& p, int l, int u, char* smem) {
  const int WV = p.ph_hi;
  u16* WT = (u16*)(p.ws + OFF_WT);
  if (u < 16 * 225) wconv_tile(p.w_in + (size_t)l * 1024 * 14352, 14352, u / 225, u % 225, WT, smem, WV);
  else if (u < 16 * 225 + 768) {
    const int v = u - 16 * 225, m = v >> 8, r = v & 255;
    wconv_tile(p.w_branch + ((size_t)l * 3 + m) * 1024 * 1024, 1024, r >> 4, r & 15, WT + (size_t)(W_BR + m * 1024) * 1024, smem, WV);
  } else {
    const int r = u - 16 * 225 - 768;
    wconv_tile(p.w_out + (size_t)l * 1024 * 1024, 1024, r >> 4, r & 15, WT + (size_t)W_OUT * 1024, smem, WV);
  }
}

DI void adaln_unit(const Params& p, int u, char* smem) {
  const int WV = p.ph_hi;
  const int l = u / 48, ng = u % 48;
  const int tid = tidx(), lane = tid & 63, w = tid >> 6;
  const int n = ng * 64 + lane;
  const float* W = p.ada_w + (size_t)l * 1024 * 3072;
  float a0 = 0.f, a1 = 0.f, a2 = 0.f;
  for (int k = w * 256; k < w * 256 + 256; k++) {
    const float wv = W[(size_t)k * 3072 + n];
    a0 += silu(p.c[k]) * wv; a1 += silu(p.c[1024 + k]) * wv; a2 += silu(p.c_ctx[k]) * wv;
  }
  float* red = (float*)smem;
  red[(w * 3 + 0) * 64 + lane] = a0; red[(w * 3 + 1) * 64 + lane] = a1; red[(w * 3 + 2) * 64 + lane] = a2;
  __syncthreads();
  if (tid < 192) {
    const int vec = tid >> 6, ln = tid & 63;
    float s = red[(0 * 3 + vec) * 64 + ln] + red[(1 * 3 + vec) * 64 + ln] + red[(2 * 3 + vec) * 64 + ln] + red[(3 * 3 + vec) * 64 + ln];
    const int nn = ng * 64 + ln;
    ((float*)(p.ws + OFF_MOD))[((size_t)l * 3 + vec) * 3072 + nn] = s + p.ada_b[(size_t)l * 3072 + nn];
  }
  __syncthreads();
}

DI void phase_pro(const Params& p, char* smem) {
  const int WV = p.ph_hi;
  const int total = 96 + 16 + WCONV_UNITS;
  for (int u = blockIdx.x; u < total; u += gridDim.x) {
    if (u < 96) adaln_unit(p, u, smem);
    else if (u < 112) {
      const int id = (u - 96) * 256 + tidx();
      const int pos = id >> 5, m = id & 31;
      const float inv = powf(10000.f, -(float)(2 * m) / 64.f);
      float s, c;
      sincosf((float)pos * inv, &s, &c);
      float* ROT = (float*)(p.ws + OFF_ROT);
      ROT[id * 2] = c; ROT[id * 2 + 1] = s;
    } else wconv_unit(p, 0, u - 112, smem);
  }
}

DI void phase_norm(const Params& p, int l, char* smem) {
  const int WV = p.ph_hi;
  const int tid = tidx(), lane = tid & 63, w = tid >> 6;
  float* sW = (float*)smem;
  const float* win = p.w_in + (size_t)l * 1024 * 14352;
  for (int i = tid; i < 16 * 1024; i += 256) {
    const int k = i >> 4, cc = i & 15;
    sW[cc * 1024 + k] = win[(size_t)k * 14352 + 3072 + cc];
  }
  __syncthreads();
  const float* MOD = (const float*)(p.ws + OFF_MOD);
  const float* nw = p.norm_w + (size_t)l * 1024;
  u16* H = (u16*)(p.ws + OFF_H);
  float* GB = (float*)(p.ws + OFF_GB);
  for (int row = blockIdx.x * 4 + w; row < T_ALL; row += gridDim.x * 4) {
    const float* xr;
    int vec;
    if (row < T_LAT) { xr = (l == 0 ? p.x : (const float*)p.out) + (size_t)row * 1024; vec = row >> 13; }
    else { xr = (l == 0 ? p.ctx : (const float*)(p.ws + OFF_CTX1)) + (size_t)(row - T_LAT) * 1024; vec = 2; }
    const float* md = MOD + ((size_t)l * 3 + vec) * 3072;
    f32x4 xv[4];
    float ss = 0.f;
#pragma unroll
    for (int i = 0; i < 4; i++) {
      xv[i] = *(const f32x4*)(xr + i * 256 + lane * 4);
      ss += xv[i][0] * xv[i][0] + xv[i][1] * xv[i][1] + xv[i][2] * xv[i][2] + xv[i][3] * xv[i][3];
    }
    ss = wsum(ss);
    const float rstd = rsqrtf(ss * (1.f / 1024.f) + 1e-6f);
    float ab[16];
#pragma unroll
    for (int cc = 0; cc < 16; cc++) ab[cc] = 0.f;
#pragma unroll
    for (int i = 0; i < 4; i++) {
      const int k = i * 256 + lane * 4;
      const f32x4 wv = *(const f32x4*)(nw + k);
      const f32x4 sh = *(const f32x4*)(md + k);
      const f32x4 sc = *(const f32x4*)(md + 1024 + k);
      f32x4 h;
#pragma unroll
      for (int j = 0; j < 4; j++) h[j] = xv[i][j] * rstd * wv[j] * (1.f + sc[j]) + sh[j];
      *(uint2*)(H + (size_t)row * 1024 + k) = uint2{pack2(h[0], h[1]), pack2(h[2], h[3])};
      asm volatile("" ::: "memory");
#pragma unroll
      for (int cc = 0; cc < 16; cc++) {
        const f32x4 ww = *(const f32x4*)(sW + cc * 1024 + k);
        ab[cc] += h[0] * ww[0] + h[1] * ww[1] + h[2] * ww[2] + h[3] * ww[3];
      }
    }
#pragma unroll
    for (int cc = 0; cc < 16; cc++) ab[cc] = wsum(ab[cc]);
    if (lane < 16) {
      float v = 0.f;
#pragma unroll
      for (int cc = 0; cc < 16; cc++) if (lane == cc) v = ab[cc];
      float r;
      if (lane < 8) {
        const float A = __expf(p.dn_a_log[l * 8 + lane]);
        const float z = v + p.dn_dt_bias[l * 8 + lane];
        const float sp = z > 20.f ? z : log1pf(__expf(z));
        r = -A * sp;
      } else r = sigm(v);
      GB[(size_t)row * 16 + lane] = r;
    }
  }
  __syncthreads();
}

DI void xyT(const char* sX, const char* sY, int it, f32x4 (&acc)[4], const int WV) {
  const int lane = tidx() & 63, fr = lane & 15, fq = lane >> 4;
#pragma unroll
  for (int j = 0; j < 4; j++) acc[j] = f32x4{0.f, 0.f, 0.f, 0.f};
#pragma unroll
  for (int ks = 0; ks < 4; ks++) {
    const bf16x8 a = *(const bf16x8*)(sX + (it * 16 + fr) * 272 + (ks * 32 + fq * 8) * 2);
#pragma unroll
    for (int jt = 0; jt < 4; jt++) {
      const bf16x8 b = *(const bf16x8*)(sY + (jt * 16 + fr) * 272 + (ks * 32 + fq * 8) * 2);
      acc[jt] = mfma16(a, b, acc[jt]);
    }
  }
}

DI void dn_prep_unit(const Params& p, int l, int c, int h, char* smem) {
  const int WV = p.ph_hi;
  const int tid = tidx(), lane = tid & 63, w = tid >> 6;
  u16* QKV = (u16*)(p.ws + OFF_A);
  const u16* HALO = (const u16*)(p.ws + OFF_HALO);
  char* sQ = smem;
  char* sK = smem + 17408;
  float* sKK = (float*)(smem + 34816);
  float* sQK = (float*)(smem + 34816 + 16384);
  float* sGC = (float*)(smem + 34816 + 32768);
  float* sBT = sGC + 128;
  const int row0 = c * 64;
  {
    const int u = tid * 2;
    const int gcol = u < 128 ? h * 128 + u : (u < 256 ? 512 + h * 128 + (u - 128) : 1024 + h * 256 + (u - 256));
    bool first, last;
    if (c < 256) { first = (c & 127) == 0; last = (c & 127) == 127; }
    else { first = ((c - 256) & 3) == 0; last = ((c - 256) & 3) == 3; }
    const float* cw = p.dn_conv + (size_t)l * 5 * 2048 + gcol;
    float cw0[5], cw1[5];
#pragma unroll
    for (int j = 0; j < 5; j++) { cw0[j] = cw[j * 2048]; cw1[j] = cw[j * 2048 + 1]; }
    auto load_ext = [&](int e) -> unsigned {
      if (e < 2) return first ? 0u : *(const unsigned*)(HALO + ((size_t)(c - 1) * 4 + 2 + e) * 2048 + gcol);
      if (e >= 66) return last ? 0u : *(const unsigned*)(HALO + ((size_t)(c + 1) * 4 + (e - 66)) * 2048 + gcol);
      return *(const unsigned*)(QKV + (size_t)(row0 + e - 2) * 2048 + gcol);
    };
    unsigned cat[12];
#pragma unroll
    for (int i = 0; i < 4; i++) cat[i] = load_ext(i);
    for (int tb = 0; tb < 8; tb++) {
#pragma unroll
      for (int i = 0; i < 8; i++) cat[4 + i] = load_ext(4 + tb * 8 + i);
#pragma unroll
      for (int i = 0; i < 8; i++) {
        const int t = tb * 8 + i;
        float y0 = 0.f, y1 = 0.f;
#pragma unroll
        for (int j = 0; j < 5; j++) {
          y0 += cw0[j] * bf2f((u16)(cat[i + j] & 0xffff));
          y1 += cw1[j] * bf2f((u16)(cat[i + j] >> 16));
        }
        y0 = silu(y0); y1 = silu(y1);
        if (w < 2) {
          const float ss = wsum(y0 * y0 + y1 * y1);
          float rs = rsqrtf(ss + 1e-6f);
          if (w == 0) rs *= 0.08838834764831845f;
          y0 *= rs; y1 *= rs;
          const unsigned pk = pack2(y0, y1);
          *(unsigned*)((w == 0 ? sQ : sK) + t * 272 + (u & 127) * 2) = pk;
          *(unsigned*)(QKV + (size_t)(row0 + t) * 2048 + gcol) = pk;
        } else {
          *(unsigned*)(QKV + (size_t)(row0 + t) * 2048 + gcol) = pack2(y0, y1);
        }
      }
#pragma unroll
      for (int i = 0; i < 4; i++) cat[i] = cat[8 + i];
    }
  }
  if (w < 2) {
    const float* GB = (const float*)(p.ws + OFF_GB);
    const float g = GB[(size_t)(row0 + lane) * 16 + w * 4 + h];
    const float bt = GB[(size_t)(row0 + lane) * 16 + 8 + w * 4 + h];
    float s = g;
    if (w == 0) {
#pragma unroll
      for (int o = 1; o < 64; o <<= 1) { const float t = __shfl_up(s, o, 64); if (lane >= o) s += t; }
    } else {
#pragma unroll
      for (int o = 1; o < 64; o <<= 1) { const float t = __shfl_down(s, o, 64); if (lane + o < 64) s += t; }
    }
    const float gl = __shfl(s, w == 0 ? 63 : 0, 64);
    sGC[w * 64 + lane] = s;
    sBT[w * 64 + lane] = bt;
    float* SC = (float*)(p.ws + OFF_DNSC) + ((size_t)(c * 4 + h) * 2 + w) * 192;
    SC[lane] = __expf(s);
    SC[64 + lane] = __expf(gl - s);
    if (lane == 0) SC[128] = __expf(gl);
  }
  __syncthreads();
  {
    const int fr = lane & 15, fq = lane >> 4;
    f32x4 acc[4];
    xyT(sK, sK, w, acc, WV);
#pragma unroll
    for (int jt = 0; jt < 4; jt++)
#pragma unroll
      for (int j = 0; j < 4; j++) sKK[(w * 16 + fq * 4 + j) * 64 + jt * 16 + fr] = acc[jt][j];
    xyT(sQ, sK, w, acc, WV);
#pragma unroll
    for (int jt = 0; jt < 4; jt++)
#pragma unroll
      for (int j = 0; j < 4; j++) sQK[(w * 16 + fq * 4 + j) * 64 + jt * 16 + fr] = acc[jt][j];
  }
  __syncthreads();
  u16* AUX = (u16*)(p.ws + OFF_B) + (size_t)(c * 4 + h) * 4 * 4096;
#pragma unroll 2
  for (int e = 0; e < 32; e++) {
    const int id = tid + e * 256, dir = id >> 12, i = (id >> 6) & 63, j = id & 63;
    const bool valid = dir == 0 ? (j <= i) : (j >= i);
    float v = 0.f;
    if (valid) v = sQK[i * 64 + j] * __expf(sGC[dir * 64 + i] - sGC[dir * 64 + j]);
    AUX[(size_t)(dir * 2 + 1) * 4096 + i * 64 + j] = f2bf(v);
  }
  __syncthreads();
  float* sL0 = sQK;
  float* sL1 = (float*)smem;
#pragma unroll 2
  for (int e = 0; e < 32; e++) {
    const int id = tid + e * 256, dir = id >> 12, ip = (id >> 6) & 63, jp = id & 63;
    const int i = dir ? 63 - ip : ip, j = dir ? 63 - jp : jp;
    float v = 0.f;
    if (jp < ip) v = sBT[dir * 64 + i] * sKK[i * 64 + j] * __expf(sGC[dir * 64 + i] - sGC[dir * 64 + j]);
    (dir ? sL1 : sL0)[ip * 64 + jp] = v;
  }
  __syncthreads();
  if (w < 2) {
    const float* L = w ? sL1 : sL0;
    float* Xs = w ? (float*)(smem + 16384) : sKK;
    const int cn = w ? 63 - lane : lane;
    const float bc = sBT[w * 64 + cn];
    for (int ip = 0; ip < 64; ip++) {
      float a0 = (ip == lane) ? bc : 0.f, a1 = 0.f, a2 = 0.f, a3 = 0.f;
      int jp = 0;
      for (; jp + 4 <= ip; jp += 4) {
        const f32x4 l4 = *(const f32x4*)(L + ip * 64 + jp);
        a0 -= l4[0] * Xs[(jp + 0) * 64 + lane];
        a1 -= l4[1] * Xs[(jp + 1) * 64 + lane];
        a2 -= l4[2] * Xs[(jp + 2) * 64 + lane];
        a3 -= l4[3] * Xs[(jp + 3) * 64 + lane];
      }
      for (; jp < ip; jp++) a0 -= L[ip * 64 + jp] * Xs[jp * 64 + lane];
      const float a = (a0 + a1) + (a2 + a3);
      Xs[ip * 64 + lane] = a;
      const int i = w ? 63 - ip : ip;
      AUX[(size_t)(w * 2 + 0) * 4096 + i * 64 + cn] = f2bf(a);
    }
  }
  __syncthreads();
}

DI void ret_prep_unit(const Params& p, int l, int c, int h, char* smem) {
  const int WV = p.ph_hi;
  const int tid = tidx(), lane = tid & 63, w = tid >> 6;
  const u16* QKV = (const u16*)(p.ws + OFF_A + 2 * SZ_TOK1K);
  char* sQ = smem;
  char* sK = smem + 17408;
  const int row0 = c * 64;
#pragma unroll
  for (int i = 0; i < 4; i++) {
    const int id = tid + i * 256, r = id >> 4, ch = id & 15;
    *(uint4*)(sQ + r * 272 + ch * 16) = *(const uint4*)(QKV + (size_t)(row0 + r) * 2048 + h * 128 + ch * 8);
    *(uint4*)(sK + r * 272 + ch * 16) = *(const uint4*)(QKV + (size_t)(row0 + r) * 2048 + 512 + h * 128 + ch * 8);
  }
  __syncthreads();
  f32x4 acc[4];
  xyT(sQ, sK, w, acc, WV);
  const int fr = lane & 15, fq = lane >> 4;
  u16* AUX = (u16*)(p.ws + OFF_C) + (size_t)(c * 4 + h) * 2 * 4096;
#pragma unroll
  for (int dir = 0; dir < 2; dir++) {
    const float rd = p.ret_decay[l * 8 + dir * 4 + h];
    const float lam = fminf(rd, 0.f) - log1pf(__expf(-fabsf(rd)));
#pragma unroll
    for (int jt = 0; jt < 4; jt++)
#pragma unroll
      for (int j = 0; j < 4; j++) {
        const int i = w * 16 + fq * 4 + j, jj = jt * 16 + fr;
        const int dd = dir == 0 ? i - jj : jj - i;
        const float v = dd >= 0 ? acc[jt][j] * __expf(lam * (float)dd) : 0.f;
        AUX[(size_t)dir * 4096 + i * 64 + jj] = f2bf(v);
      }
  }
  __syncthreads();
}

DI void hg_prep_unit(const Params& p, int l, int c, int h, char* smem) {
  const int WV = p.ph_hi;
  const int tid = tidx();
  u16* QFI = (u16*)(p.ws + OFF_A);
  u16* HGX = (u16*)(p.ws + OFF_B);
  float* sG = (float*)smem;
  u16* sQ = (u16*)(smem + 32768);
  u16* sK = (u16*)(smem + 49152);
  float* sTot = (float*)(smem + 65536);
  const int row0 = c * 64;
#pragma unroll
  for (int i = 0; i < 4; i++) {
    const int id = tid + i * 256, r = id >> 4, ch = id & 15;
    const uint4 v = *(const uint4*)(QFI + (size_t)(row0 + r) * 4096 + h * 128 + ch * 8);
    const unsigned vv[4] = {v.x, v.y, v.z, v.w};
#pragma unroll
    for (int e = 0; e < 4; e++) {
      sQ[(ch * 8 + e * 2) * 64 + r] = (u16)(vv[e] & 0xffff);
      sQ[(ch * 8 + e * 2 + 1) * 64 + r] = (u16)(vv[e] >> 16);
    }
  }
  __syncthreads();
  const int half = tid >> 7, d = tid & 127;
  for (int dir = 1; dir >= 0; dir--) {
    float lo = 0.f;
    if (l == 1) {
      const float b0 = p.hg_lb[dir * 1024 + h * 128 + d], b1 = p.hg_lb[2048 + dir * 1024 + h * 128 + d];
      lo = sigm(b1 - b0);
    }
    float run = 0.f;
    {
      const u16* xs = QFI + (size_t)row0 * 4096 + 1024 + dir * 1024 + h * 128 + d;
      float xv[32];
#pragma unroll
      for (int i = 0; i < 32; i++) xv[i] = bf2f(xs[(size_t)(half * 32 + i) * 4096]);
#pragma unroll
      for (int i = 0; i < 32; i++) {
        const int ii = dir == 0 ? i : 31 - i;
        const int t = half * 32 + ii;
        const float x = xv[ii];
        const float sg = sigm(x);
        const float f = lo + (1.f - lo) * sg;
        const float omf = (1.f - lo) * (1.f - sg);
        run += __log2f(f);
        sG[d * 64 + t] = run;
        sK[d * 64 + t] = f2bf(omf);
      }
      sTot[half * 128 + d] = run;
    }
    __syncthreads();
    {
      const float t0 = sTot[d], t1 = sTot[128 + d];
      const float gtot = t0 + t1;
      const float add = dir == 0 ? (half == 1 ? t0 : 0.f) : (half == 0 ? t1 : 0.f);
      u16* qdst = dir == 0 ? QFI + (size_t)row0 * 4096 + h * 128 + d : HGX + (size_t)row0 * 1024 + h * 128 + d;
      const size_t qp = dir == 0 ? 4096 : 1024;
      u16* kdst = QFI + (size_t)row0 * 4096 + 1024 + dir * 1024 + h * 128 + d;
#pragma unroll 8
      for (int i = 0; i < 32; i++) {
        const int t = half * 32 + i;
        const float G = sG[d * 64 + t] + add;
        sG[d * 64 + t] = G;
        qdst[(size_t)t * qp] = f2bf(bf2f(sQ[d * 64 + t]) * exp2f(G));
        kdst[(size_t)t * 4096] = f2bf(bf2f(sK[d * 64 + t]) * exp2f(gtot - G));
      }
      if (half == 0) ((float*)(p.ws + OFF_HGDEC))[((size_t)(c * 8 + h) * 2 + dir) * 128 + d] = exp2f(gtot);
    }
    __syncthreads();
    {
      const int bi = tid >> 4, bj = tid & 15;
      const bool act = dir == 0 ? (bj <= bi) : (bj >= bi);
      if (act) {
        float acc[4][4];
#pragma unroll
        for (int a = 0; a < 4; a++)
#pragma unroll
          for (int b = 0; b < 4; b++) acc[a][b] = 0.f;
        for (int dd = 0; dd < 128; dd++) {
          const f32x4 Gi = *(const f32x4*)(sG + dd * 64 + bi * 4);
          const f32x4 Gj = *(const f32x4*)(sG + dd * 64 + bj * 4);
          const uint2 qi = *(const uint2*)(sQ + dd * 64 + bi * 4);
          const uint2 kj = *(const uint2*)(sK + dd * 64 + bj * 4);
          const float q4[4] = {bf2f((u16)(qi.x & 0xffff)), bf2f((u16)(qi.x >> 16)), bf2f((u16)(qi.y & 0xffff)), bf2f((u16)(qi.y >> 16))};
          const float k4[4] = {bf2f((u16)(kj.x & 0xffff)), bf2f((u16)(kj.x >> 16)), bf2f((u16)(kj.y & 0xffff)), bf2f((u16)(kj.y >> 16))};
#pragma unroll
          for (int a = 0; a < 4; a++)
#pragma unroll
            for (int b = 0; b < 4; b++) acc[a][b] += q4[a] * k4[b] * exp2f(fminf(Gi[a] - Gj[b], 0.f));
        }
        u16* AUX = (u16*)(p.ws + OFF_C) + ((size_t)(c * 8 + h) * 2 + dir) * 4096;
#pragma unroll
        for (int a = 0; a < 4; a++) {
          const int i = bi * 4 + a;
          float o[4];
#pragma unroll
          for (int b = 0; b < 4; b++) {
            const int j = bj * 4 + b;
            const bool valid = dir == 0 ? (j <= i) : (j >= i);
            o[b] = valid ? acc[a][b] : 0.f;
          }
          *(uint2*)(AUX + i * 64 + bj * 4) = uint2{pack2(o[0], o[1]), pack2(o[2], o[3])};
        }
      } else {
        u16* AUX = (u16*)(p.ws + OFF_C) + ((size_t)(c * 8 + h) * 2 + dir) * 4096;
#pragma unroll
        for (int a = 0; a < 4; a++) *(uint2*)(AUX + (bi * 4 + a) * 64 + bj * 4) = uint2{0u, 0u};
      }
    }
    __syncthreads();
  }
}

struct ScanDesc {
  const u16 *q, *k, *v;
  int qp, kp, vp;
  const u16* aux;
  size_t aux_cs;
  int attn_off, ainv_off;
  u16* o;
  int mixer, b, dir;
  const float* sc;
  size_t sc_cs;
  float lam;
};

template <int MIXER>
DI void scan_unit(const ScanDesc& s, char* smem, const int WV) {
  const int tid = tidx(), lane = tid & 63, w = tid >> 6;
  const int fr = lane & 15, fq = lane >> 4;
  char* sQm = smem;
  char* sKm = smem + 17408;
  char* sKT = smem + 34816;
  char* sAT = smem + 53248;
  char* sAI = smem + 62464;
  float* sSC = (float*)(smem + 71680);
  f32x4 S[8];
#pragma unroll
  for (int i = 0; i < 8; i++) S[i] = f32x4{0.f, 0.f, 0.f, 0.f};
  for (int step = 0; step < 132; step++) {
    int c;
    if (s.dir == 0) c = step < 4 ? 256 + 4 * s.b + step : 128 * s.b + (step - 4);
    else c = step < 4 ? 256 + 4 * s.b + (3 - step) : 128 * s.b + (131 - step);
    const int row0 = c * 64;
    const u16* qbase = s.q + (size_t)row0 * s.qp;
    const u16* kbase = s.k + (size_t)row0 * s.kp;
    const u16* vbase = s.v + (size_t)row0 * s.vp;
#pragma unroll
    for (int i = 0; i < 4; i++) {
      const int id = tid + i * 256, r = id >> 4, ch = id & 15;
      *(uint4*)(sQm + r * 272 + ch * 16) = *(const uint4*)(qbase + (unsigned)(r * s.qp + ch * 8));
      const uint4 kv = *(const uint4*)(kbase + (unsigned)(r * s.kp + ch * 8));
      *(uint4*)(sKm + r * 272 + ch * 16) = kv;
      const unsigned vv[4] = {kv.x, kv.y, kv.z, kv.w};
#pragma unroll
      for (int e = 0; e < 4; e++) {
        *(u16*)(sKT + (ch * 8 + e * 2) * 144 + r * 2) = (u16)(vv[e] & 0xffff);
        *(u16*)(sKT + (ch * 8 + e * 2 + 1) * 144 + r * 2) = (u16)(vv[e] >> 16);
      }
    }
#pragma unroll
    for (int i = 0; i < 2; i++) {
      const int id = tid + i * 256, r = id >> 3, ch = id & 7;
      const u16* ab = s.aux + (size_t)c * s.aux_cs;
      *(uint4*)(sAT + r * 144 + ch * 16) = *(const uint4*)(ab + s.attn_off + (unsigned)(r * 64 + ch * 8));
      if (MIXER == 0) *(uint4*)(sAI + r * 144 + ch * 16) = *(const uint4*)(ab + s.ainv_off + (unsigned)(r * 64 + ch * 8));
    }
    float egl = 1.f;
    if (MIXER == 0) {
      const float* sc = s.sc + (size_t)c * s.sc_cs;
      if (tid < 128) sSC[tid] = sc[tid];
      egl = sc[128];
    } else if (MIXER == 1) {
      if (tid < 64) {
        const float e1 = s.dir == 0 ? (float)(tid + 1) : (float)(64 - tid);
        sSC[tid] = __expf(s.lam * e1);
        sSC[64 + tid] = __expf(s.lam * (64.f - e1));
      }
      egl = __expf(s.lam * 64.f);
    } else {
      if (tid < 128) sSC[tid] = s.sc[(size_t)c * s.sc_cs + tid];
    }
    f32x4 V[4];
#pragma unroll
    for (int mt = 0; mt < 4; mt++)
#pragma unroll
      for (int j = 0; j < 4; j++) V[mt][j] = bf2f(vbase[(unsigned)((mt * 16 + fq * 4 + j) * s.vp + w * 16 + fr)]);
    __syncthreads();
    bf16x8 Sb[4];
#pragma unroll
    for (int ks = 0; ks < 4; ks++) Sb[ks] = pack8(S[2 * ks], S[2 * ks + 1]);
    f32x4 vn[4];
    if (MIXER == 0) {
      f32x4 P[4];
#pragma unroll
      for (int mt = 0; mt < 4; mt++) {
        P[mt] = f32x4{0.f, 0.f, 0.f, 0.f};
#pragma unroll
        for (int ks = 0; ks < 4; ks++) P[mt] = mfma16(ld_perm(sKm + (mt * 16 + fr) * 272, ks * 32 + fq * 4), Sb[ks], P[mt]);
      }
#pragma unroll
      for (int mt = 0; mt < 4; mt++)
#pragma unroll
        for (int j = 0; j < 4; j++) P[mt][j] = V[mt][j] - sSC[mt * 16 + fq * 4 + j] * P[mt][j];
      bf16x8 rb[2];
#pragma unroll
      for (int ks = 0; ks < 2; ks++) rb[ks] = pack8(P[2 * ks], P[2 * ks + 1]);
#pragma unroll
      for (int mt = 0; mt < 4; mt++) {
        vn[mt] = f32x4{0.f, 0.f, 0.f, 0.f};
#pragma unroll
        for (int ks = 0; ks < 2; ks++) vn[mt] = mfma16(ld_perm(sAI + (mt * 16 + fr) * 144, ks * 32 + fq * 4), rb[ks], vn[mt]);
      }
    } else {
#pragma unroll
      for (int mt = 0; mt < 4; mt++) vn[mt] = V[mt];
    }
    bf16x8 vb[2];
#pragma unroll
    for (int ks = 0; ks < 2; ks++) vb[ks] = pack8(vn[2 * ks], vn[2 * ks + 1]);
    u16* obase = s.o + (size_t)row0 * 1024;
#pragma unroll
    for (int mt = 0; mt < 4; mt++) {
      f32x4 o0 = f32x4{0.f, 0.f, 0.f, 0.f};
#pragma unroll
      for (int ks = 0; ks < 4; ks++) o0 = mfma16(ld_perm(sQm + (mt * 16 + fr) * 272, ks * 32 + fq * 4), Sb[ks], o0);
      if (MIXER != 2) {
#pragma unroll
        for (int j = 0; j < 4; j++) o0[j] *= sSC[mt * 16 + fq * 4 + j];
      }
#pragma unroll
      for (int ks = 0; ks < 2; ks++) o0 = mfma16(ld_perm(sAT + (mt * 16 + fr) * 144, ks * 32 + fq * 4), vb[ks], o0);
#pragma unroll
      for (int j = 0; j < 4; j++) obase[(unsigned)((mt * 16 + fq * 4 + j) * 1024 + w * 16 + fr)] = f2bf(o0[j]);
    }
    if (MIXER != 2) {
#pragma unroll
      for (int mt = 0; mt < 4; mt++)
#pragma unroll
        for (int j = 0; j < 4; j++) vn[mt][j] *= sSC[64 + mt * 16 + fq * 4 + j];
#pragma unroll
      for (int ks = 0; ks < 2; ks++) vb[ks] = pack8(vn[2 * ks], vn[2 * ks + 1]);
    }
#pragma unroll
    for (int mt = 0; mt < 8; mt++) {
      if (MIXER == 2) {
#pragma unroll
        for (int j = 0; j < 4; j++) S[mt][j] *= sSC[mt * 16 + fq * 4 + j];
      } else {
#pragma unroll
        for (int j = 0; j < 4; j++) S[mt][j] *= egl;
      }
#pragma unroll
      for (int ks = 0; ks < 2; ks++) S[mt] = mfma16(ld_perm(sKT + (mt * 16 + fr) * 144, ks * 32 + fq * 4), vb[ks], S[mt]);
    }
    __syncthreads();
  }
}

DI void scan_phase_hg(const Params& p, char* smem) {
  const int WV = p.ph_hi;
  for (int u = blockIdx.x; u < 64; u += gridDim.x) {
    const int dir = u & 1, vg = (u >> 1) & 1, h = (u >> 2) & 7, b = u >> 5;
    ScanDesc s;
    s.q = dir == 0 ? (const u16*)(p.ws + OFF_A) + h * 128 : (const u16*)(p.ws + OFF_B) + h * 128;
    s.qp = dir == 0 ? 4096 : 1024;
    s.k = (const u16*)(p.ws + OFF_A) + 1024 + dir * 1024 + h * 128; s.kp = 4096;
    s.v = (const u16*)(p.ws + OFF_A) + 3072 + h * 128 + vg * 64; s.vp = 4096;
    s.aux = (const u16*)(p.ws + OFF_C) + (size_t)(h * 2 + dir) * 4096; s.aux_cs = 8 * 2 * 4096; s.attn_off = 0; s.ainv_off = 0;
    s.o = (u16*)(p.ws + OFF_D + (dir ? SZ_TOK1K : 0)) + h * 128 + vg * 64;
    s.mixer = 2; s.b = b; s.dir = dir;
    s.sc = (const float*)(p.ws + OFF_HGDEC) + (size_t)(h * 2 + dir) * 128; s.sc_cs = 8 * 2 * 128; s.lam = 0.f;
    scan_unit<2>(s, smem, WV);
  }
}
DI void scan_phase_dnret(const Params& p, int l, char* smem) {
  const int WV = p.ph_hi;
  for (int u = blockIdx.x; u < 128; u += gridDim.x) {
    const int mixer = u & 1, dir = (u >> 1) & 1, vg = (u >> 2) & 3, h = (u >> 4) & 3, b = u >> 6;
    ScanDesc s;
    const u16* base = (const u16*)(p.ws + OFF_A + (mixer ? 2 * SZ_TOK1K : 0));
    s.q = base + h * 128; s.k = base + 512 + h * 128; s.v = base + 1024 + h * 256 + vg * 64;
    s.qp = s.kp = s.vp = 2048;
    s.mixer = mixer; s.b = b; s.dir = dir;
    if (mixer == 0) {
      s.aux = (const u16*)(p.ws + OFF_B) + (size_t)(h * 2 + dir) * 2 * 4096; s.aux_cs = 4 * 4 * 4096; s.ainv_off = 0; s.attn_off = 4096;
      s.sc = (const float*)(p.ws + OFF_DNSC) + (size_t)(h * 2 + dir) * 192; s.sc_cs = 4 * 2 * 192; s.lam = 0.f;
      s.o = (u16*)(dir == 0 ? p.ws + OFF_E : p.ws + OFF_D + SZ_TOK1K) + h * 256 + vg * 64;
      scan_unit<0>(s, smem, WV);
    } else {
      s.aux = (const u16*)(p.ws + OFF_C) + (size_t)(h * 2 + dir) * 4096; s.aux_cs = 4 * 2 * 4096; s.attn_off = 0; s.ainv_off = 0;
      const float rd = p.ret_decay[l * 8 + dir * 4 + h];
      s.lam = fminf(rd, 0.f) - log1pf(__expf(-fabsf(rd)));
      s.sc = nullptr; s.sc_cs = 0;
      s.o = (u16*)(p.ws + OFF_E + (dir == 0 ? SZ_TOK1K : 2 * SZ_TOK1K)) + h * 256 + vg * 64;
      scan_unit<1>(s, smem, WV);
    }
  }
}

DI void onorm_rows(u16* of, const u16* ob, const float* nw, int dv, int unit, int nunits_stride, const int WV) {
  const int lane = tidx() & 63, w = tidx() >> 6;
  for (int row = unit * 4 + w; row < T_ALL; row += nunits_stride * 4) {
    u16* pf = of + (size_t)row * 1024 + lane * 16;
    const u16* pb = ob + (size_t)row * 1024 + lane * 16;
    float v[16];
#pragma unroll
    for (int hv = 0; hv < 2; hv++) {
      const uint4 a = *(const uint4*)(pf + hv * 8), b = *(const uint4*)(pb + hv * 8);
      const unsigned aa[4] = {a.x, a.y, a.z, a.w}, bb[4] = {b.x, b.y, b.z, b.w};
#pragma unroll
      for (int e = 0; e < 4; e++) {
        v[hv * 8 + e * 2] = bf2f((u16)(aa[e] & 0xffff)) + bf2f((u16)(bb[e] & 0xffff));
        v[hv * 8 + e * 2 + 1] = bf2f((u16)(aa[e] >> 16)) + bf2f((u16)(bb[e] >> 16));
      }
    }
    float ss = 0.f;
#pragma unroll
    for (int e = 0; e < 16; e++) ss += v[e] * v[e];
    const int nl = dv / 16;
    for (int o = 1; o < nl; o <<= 1) ss += __shfl_xor(ss, o, 64);
    const float rstd = rsqrtf(ss / (float)dv + 1e-6f);
    const int dcol = (lane * 16) % dv;
    unsigned o8[8];
#pragma unroll
    for (int e = 0; e < 8; e++) o8[e] = pack2(v[2 * e] * rstd * nw[dcol + 2 * e], v[2 * e + 1] * rstd * nw[dcol + 2 * e + 1]);
    *(uint4*)pf = uint4{o8[0], o8[1], o8[2], o8[3]};
    *(uint4*)(pf + 8) = uint4{o8[4], o8[5], o8[6], o8[7]};
  }
}

DI void final_norm(const Params& p) {
  const int WV = p.ph_hi;
  const int lane = tidx() & 63, w = tidx() >> 6;
  for (int row = blockIdx.x * 4 + w; row < T_LAT; row += gridDim.x * 4) {
    float* xr = p.out + (size_t)row * 1024;
    f32x4 xv[4];
    float ss = 0.f;
#pragma unroll
    for (int i = 0; i < 4; i++) {
      xv[i] = *(const f32x4*)(xr + i * 256 + lane * 4);
      ss += xv[i][0] * xv[i][0] + xv[i][1] * xv[i][1] + xv[i][2] * xv[i][2] + xv[i][3] * xv[i][3];
    }
    ss = wsum(ss);
    const float rstd = rsqrtf(ss * (1.f / 1024.f) + 1e-6f);
#pragma unroll
    for (int i = 0; i < 4; i++) {
      const f32x4 wv = *(const f32x4*)(p.final_norm_w + i * 256 + lane * 4);
      f32x4 r;
#pragma unroll
      for (int j = 0; j < 4; j++) r[j] = xv[i][j] * rstd * wv[j];
      *(f32x4*)(xr + i * 256 + lane * 4) = r;
    }
  }
}

DI void run_phase(const Params& p, int ph, char* smem) {
  const int WV = p.ph_hi;
  const int G = gridDim.x, B = blockIdx.x;
  if (ph == 0) { if (QSEL(11)) phase_pro(p, smem); return; }
  if (ph == 23) { if (QSEL(12)) final_norm(p); return; }
  const int l = (ph - 1) / 11, q = (ph - 1) % 11;
  const bool last = l == 1;
  switch (q) {
    case 0: if (!QSEL(0)) break;
      if (l == 1) for (int u = B; u < WCONV_UNITS; u += G) wconv_unit(p, 1, u, smem);
      phase_norm(p, l, smem);
      break;
    case 1: if (!QSEL(1)) break;
      for (int t = B; t < 132 * 32; t += G) gemm_tile<EPI_HG>(p, l, t % 132, t / 132, smem);
      break;
    case 2: if (!QSEL(2)) break;
      for (int u = B; u < NCH * 8; u += G) hg_prep_unit(p, l, u >> 3, u & 7, smem);
      break;
    case 3: if (!QSEL(3)) break; scan_phase_hg(p, smem); break;
    case 4: if (!QSEL(4)) break;
      for (int t = B; t < 132 * 32; t += G) gemm_tile<EPI_DNRET>(p, l, t % 132, t / 132, smem);
      onorm_rows((u16*)(p.ws + OFF_D), (const u16*)(p.ws + OFF_D + SZ_TOK1K), p.hg_norm_w + l * 128, 128, B, G, WV);
      break;
    case 5: if (!QSEL(5)) break;
      for (int u = B; u < NCH * 8; u += G) {
        if (u < NCH * 4) dn_prep_unit(p, l, u >> 2, u & 3, smem);
        else ret_prep_unit(p, l, (u - NCH * 4) >> 2, u & 3, smem);
      }
      break;
    case 6: if (!QSEL(6)) break; scan_phase_dnret(p, l, smem); break;
    case 7: if (!QSEL(7)) break;
      onorm_rows((u16*)(p.ws + OFF_E), (const u16*)(p.ws + OFF_D + SZ_TOK1K), p.dn_norm_w + l * 256, 256, B, G, WV);
      onorm_rows((u16*)(p.ws + OFF_E + SZ_TOK1K), (const u16*)(p.ws + OFF_E + 2 * SZ_TOK1K), p.ret_norm_w + l * 256, 256, B, G, WV);
      break;
    case 8: if (!QSEL(8)) break; {
      const int nrt = last ? 128 : 132;
      for (int t = B; t < nrt * 24; t += G) gemm_tile<EPI_GATE>(p, l, t % nrt, t / nrt, smem);
    } break;
    case 9: if (!QSEL(9)) break; {
      const int nrt = last ? 128 : 132;
      for (int t = B; t < nrt * 8; t += G) merge_tile(p, t % nrt, t / nrt, smem);
    } break;
    case 10: if (!QSEL(10)) break; {
      const int nrt = last ? 128 : 132;
      for (int t = B; t < nrt * 8; t += G) gemm_tile<EPI_OUT>(p, l, t % nrt, t / nrt, smem);
    } break;
  }
}

__global__ void __launch_bounds__(256, 2) mk(Params p) {
  extern __shared__ __attribute__((aligned(16))) char smem[];
  p.ph_hi = __builtin_amdgcn_readfirstlane((int)__builtin_amdgcn_workitem_id_x() >> 6);
#if ONE_LAUNCH
  cg::grid_group grid = cg::this_grid();
#define PH(n) run_phase(p, n, smem); grid.sync();
  PH(0) PH(1) PH(2) PH(3) PH(4) PH(5) PH(6) PH(7) PH(8) PH(9) PH(10) PH(11)
  PH(12) PH(13) PH(14) PH(15) PH(16) PH(17) PH(18) PH(19) PH(20) PH(21) PH(22)
  run_phase(p, 23, smem);
#else
  run_phase(p, p.ph_lo, smem);
#endif
}

extern "C" void kernel_launch(void* const* d_in, const int* in_sizes, int n_in, void* d_out,
                              int out_size, void* d_ws, size_t ws_size, hipStream_t stream) {
  static int grid_blocks = 0;
  if (!grid_blocks) {
    int dev = 0, cus = 0, per_cu = 0;
    (void)hipGetDevice(&dev);
    (void)hipDeviceGetAttribute(&cus, hipDeviceAttributeMultiprocessorCount, dev);
    (void)hipFuncSetAttribute((const void*)mk, hipFuncAttributeMaxDynamicSharedMemorySize, SMEM_BYTES);
    (void)hipOccupancyMaxActiveBlocksPerMultiprocessor(&per_cu, mk, 256, SMEM_BYTES);
    if (per_cu > 2) per_cu = 2;
    if (per_cu < 1) per_cu = 1;
    grid_blocks = cus * per_cu;
  }
  Params p{};
  const float** f = (const float**)&p;
  for (int i = 0; i < 19; i++) f[i] = (const float*)d_in[i];
  p.out = (float*)d_out;
  p.ws = (char*)d_ws;
#if ONE_LAUNCH
  p.ph_lo = 0; p.ph_hi = 24;
  void* args[] = {&p};
  (void)hipLaunchCooperativeKernel((void*)mk, dim3(grid_blocks), dim3(256), args, SMEM_BYTES, stream);
#else
  for (int ph = 0; ph < 24; ph++) {
    p.ph_lo = ph; p.ph_hi = ph + 1;
    void* args[] = {&p};
    (void)hipLaunchCooperativeKernel((void*)mk, dim3(grid_blocks), dim3(256), args, SMEM_BYTES, stream);
  }
#endif
}
```

```cpp
#include <hip/hip_runtime.h>
#include <hip/hip_cooperative_groups.h>
#include <cstdio>
namespace cg = cooperative_groups;

#ifndef ONE_LAUNCH
#define ONE_LAUNCH 1
#endif
#ifndef ONLY_Q
#define ONLY_Q -1
#endif
#define QSEL(n) (ONLY_Q < 0 || ONLY_Q == (n))

typedef unsigned short u16;
using bf16x8 = __attribute__((ext_vector_type(8))) short;
using bf16x4 = __attribute__((ext_vector_type(4))) short;
using f32x4 = __attribute__((ext_vector_type(4))) float;
#define DI __device__ __forceinline__

constexpr int T_LAT = 16384, T_ALL = 16896, NCH = 264;
constexpr int WROWS = 18448;
constexpr int W_BR = 14352, W_OUT = 17424;
constexpr size_t al(size_t x) { return (x + 255) & ~(size_t)255; }
constexpr size_t SZ_WT = (size_t)WROWS * 1024 * 2;
constexpr size_t SZ_TOK1K = (size_t)T_ALL * 1024 * 2;
constexpr size_t OFF_WT = 0;
constexpr size_t OFF_H = OFF_WT + al(SZ_WT);
constexpr size_t OFF_MOD = OFF_H + al(SZ_TOK1K);
constexpr size_t OFF_ROT = OFF_MOD + al(2 * 3 * 3072 * 4);
constexpr size_t OFF_GB = OFF_ROT + al(128 * 32 * 2 * 4);
constexpr size_t OFF_CTX1 = OFF_GB + al((size_t)T_ALL * 16 * 4);
constexpr size_t OFF_HALO = OFF_CTX1 + al(512 * 1024 * 4);
constexpr size_t OFF_DNSC = OFF_HALO + al((size_t)NCH * 4 * 2048 * 2);
constexpr size_t OFF_HGDEC = OFF_DNSC + al((size_t)NCH * 4 * 2 * 192 * 4);
constexpr size_t OFF_BAR = OFF_HGDEC + al((size_t)NCH * 8 * 2 * 128 * 4);
constexpr size_t OFF_A = OFF_BAR + 4096;
constexpr size_t OFF_B = OFF_A + 4 * SZ_TOK1K;
constexpr size_t OFF_C = OFF_B + SZ_TOK1K;
constexpr size_t OFF_D = OFF_C + SZ_TOK1K;
constexpr size_t OFF_E = OFF_D + 2 * SZ_TOK1K;
constexpr size_t WS_TOTAL = OFF_E + 3 * SZ_TOK1K;
static_assert(WS_TOTAL <= 470286336ull, "workspace too large");

constexpr int SMEM_BYTES = 72960;

struct Params {
  const float *x, *c, *ctx, *c_ctx, *norm_w, *ada_w, *ada_b, *w_in, *dn_conv, *dn_a_log, *dn_dt_bias, *dn_norm_w,
      *ret_decay, *ret_norm_w, *hg_lb, *hg_norm_w, *w_branch, *w_out, *final_norm_w;
  float* out;
  char* ws;
  int ph_lo, ph_hi;
};

DI int laneid_v() { int t; asm volatile("v_mbcnt_lo_u32_b32 %0, -1, 0\n\tv_mbcnt_hi_u32_b32 %0, -1, %0" : "=v"(t)); return t; }
#define tidx() (WV * 64 + laneid_v())
DI u16 f2bf(float f) { unsigned u = __float_as_uint(f); u += 0x7fffu + ((u >> 16) & 1u); return (u16)(u >> 16); }
DI float bf2f(u16 h) { return __uint_as_float(((unsigned)h) << 16); }
DI unsigned pack2(float a, float b) { return (unsigned)f2bf(a) | ((unsigned)f2bf(b) << 16); }
DI float sigm(float x) { return 1.f / (1.f + __expf(-x)); }
DI float silu(float x) { return x / (1.f + __expf(-x)); }
DI float wsum(float v) {
#pragma unroll
  for (int o = 32; o > 0; o >>= 1) v += __shfl_xor(v, o, 64);
  return v;
}
DI f32x4 mfma16(bf16x8 a, bf16x8 b, f32x4 c) { return __builtin_amdgcn_mfma_f32_16x16x32_bf16(a, b, c, 0, 0, 0); }
DI bf16x8 pack8(f32x4 lo, f32x4 hi) {
  bf16x8 r;
  r[0] = (short)f2bf(lo[0]); r[1] = (short)f2bf(lo[1]); r[2] = (short)f2bf(lo[2]); r[3] = (short)f2bf(lo[3]);
  r[4] = (short)f2bf(hi[0]); r[5] = (short)f2bf(hi[1]); r[6] = (short)f2bf(hi[2]); r[7] = (short)f2bf(hi[3]);
  return r;
}
DI bf16x8 ld_perm(const char* rowp, int c0) {
  bf16x4 lo = *(const bf16x4*)(rowp + c0 * 2);
  bf16x4 hi = *(const bf16x4*)(rowp + c0 * 2 + 32);
  bf16x8 r;
  r[0] = lo[0]; r[1] = lo[1]; r[2] = lo[2]; r[3] = lo[3]; r[4] = hi[0]; r[5] = hi[1]; r[6] = hi[2]; r[7] = hi[3];
  return r;
}

DI int swz(int row, int ch) { return row * 128 + ((ch ^ (row & 7)) << 4); }

DI void gemm_kloop(const u16* __restrict__ A, const u16* __restrict__ W, f32x4 (&acc)[4][4], char* smem, const int WV) {
  const int tid = tidx(), lane = tid & 63, wid = tid >> 6, wn = wid >> 1, wt = wid & 1;
  const int fr = lane & 15, fq = lane >> 4;
  uint4 ra[4], rw[4];
  const int lrow = tid >> 3, lch = tid & 7;
  const u16* Ap = A + (size_t)lrow * 1024 + lch * 8;
  const u16* Wp = W + (size_t)lrow * 1024 + lch * 8;
#pragma unroll
  for (int i = 0; i < 4; i++) {
    ra[i] = *(const uint4*)(Ap + (size_t)i * 32 * 1024);
    rw[i] = *(const uint4*)(Wp + (size_t)i * 32 * 1024);
  }
#pragma unroll
  for (int i = 0; i < 4; i++) {
    *(uint4*)(smem + swz(lrow + i * 32, lch)) = rw[i];
    *(uint4*)(smem + 16384 + swz(lrow + i * 32, lch)) = ra[i];
  }
  __syncthreads();
  for (int kt = 0; kt < 16; kt++) {
    if (kt < 15) {
#pragma unroll
      for (int i = 0; i < 4; i++) {
        ra[i] = *(const uint4*)(Ap + (size_t)i * 32 * 1024 + (kt + 1) * 64);
        rw[i] = *(const uint4*)(Wp + (size_t)i * 32 * 1024 + (kt + 1) * 64);
      }
    }
    const char* sW = smem + (kt & 1) * 32768;
    const char* sA = sW + 16384;
#pragma unroll
    for (int ks = 0; ks < 2; ks++) {
      bf16x8 fw[4], fa[4];
#pragma unroll
      for (int i = 0; i < 4; i++) {
        fw[i] = *(const bf16x8*)(sW + swz(wn * 64 + i * 16 + fr, ks * 4 + fq));
        fa[i] = *(const bf16x8*)(sA + swz(wt * 64 + i * 16 + fr, ks * 4 + fq));
      }
#pragma unroll
      for (int ni = 0; ni < 4; ni++)
#pragma unroll
        for (int ti = 0; ti < 4; ti++) acc[ni][ti] = mfma16(fw[ni], fa[ti], acc[ni][ti]);
    }
    if (kt < 15) {
      char* dW = smem + ((kt + 1) & 1) * 32768;
#pragma unroll
      for (int i = 0; i < 4; i++) {
        *(uint4*)(dW + swz(lrow + i * 32, lch)) = rw[i];
        *(uint4*)(dW + 16384 + swz(lrow + i * 32, lch)) = ra[i];
      }
    }
    __syncthreads();
  }
}

enum { EPI_HG = 0, EPI_DNRET = 1, EPI_GATE = 2, EPI_OUT = 3 };

template <int EPI>
DI void gemm_tile(const Params& p, int l, int rt, int nti, char* smem) {
  const int WV = p.ph_hi;
  const int tid = tidx(), lane = tid & 63, wid = tid >> 6, wn = wid >> 1, wt = wid & 1;
  const int fr = lane & 15, fq = lane >> 4;
  const int row0 = rt * 128;
  const u16* WT = (const u16*)(p.ws + OFF_WT);
  const u16* A;
  int wrow, n0, mixer = 0;
  if (EPI == EPI_HG) { A = (const u16*)(p.ws + OFF_H); n0 = nti * 128; wrow = 6160 + n0; }
  else if (EPI == EPI_DNRET) { A = (const u16*)(p.ws + OFF_H); mixer = nti >> 4; n0 = (nti & 15) * 128; wrow = (mixer ? 3088 : 0) + n0; }
  else if (EPI == EPI_GATE) { A = (const u16*)(p.ws + OFF_H); mixer = nti >> 3; n0 = (nti & 7) * 128; wrow = (mixer == 0 ? 2048 : (mixer == 1 ? 5136 : 10256)) + n0; }
  else { A = (const u16*)(p.ws + OFF_B); n0 = nti * 128; wrow = W_OUT + n0; }
  f32x4 acc[4][4];
#pragma unroll
  for (int i = 0; i < 4; i++)
#pragma unroll
    for (int j = 0; j < 4; j++) acc[i][j] = f32x4{0.f, 0.f, 0.f, 0.f};
  gemm_kloop(A + (size_t)row0 * 1024, WT + (size_t)wrow * 1024, acc, smem, WV);

  const float* ROT = (const float*)(p.ws + OFF_ROT);
  const float* MOD = (const float*)(p.ws + OFF_MOD);
#pragma unroll
  for (int ti = 0; ti < 4; ti++) {
    const int token = row0 + wt * 64 + ti * 16 + fr;
#pragma unroll
    for (int ni = 0; ni < 4; ni++) {
      const int nl = n0 + wn * 64 + ni * 16 + fq * 4;
      f32x4 v = acc[ni][ti];
      if (EPI == EPI_HG) {
        if (nl < 1024) { v[0] = silu(v[0]); v[1] = silu(v[1]); v[2] = silu(v[2]); v[3] = silu(v[3]); }
        u16* dst = (u16*)(p.ws + OFF_A) + (size_t)token * 4096 + nl;
        *(uint2*)dst = uint2{pack2(v[0], v[1]), pack2(v[2], v[3])};
      } else if (EPI == EPI_DNRET) {
        if (mixer == 0) {
          uint2 pk = uint2{pack2(v[0], v[1]), pack2(v[2], v[3])};
          u16* dst = (u16*)(p.ws + OFF_A) + (size_t)token * 2048 + nl;
          *(uint2*)dst = pk;
          const int tm = token & 63;
          if (tm < 2 || tm >= 62) {
            const int slot = tm < 2 ? tm : tm - 60;
            u16* hd = (u16*)(p.ws + OFF_HALO) + ((size_t)(token >> 6) * 4 + slot) * 2048 + nl;
            *(uint2*)hd = pk;
          }
        } else {
          if (nl < 1024) {
            if (token < T_LAT) {
              const int t = token & 8191, ri = t >> 6, ci = t & 63;
              const int d = nl & 127;
#pragma unroll
              for (int pp = 0; pp < 2; pp++) {
                const int pidx = (d >> 1) + pp;
                const float* rp = pidx < 32 ? ROT + (ri * 32 + pidx) * 2 : ROT + (ci * 32 + (pidx - 32)) * 2;
                const float cs = rp[0], sn = rp[1];
                const float x1 = v[2 * pp], x2 = v[2 * pp + 1];
                v[2 * pp] = x1 * cs - x2 * sn;
                v[2 * pp + 1] = x1 * sn + x2 * cs;
              }
            }
            if (nl >= 512) { const float s = 0.08838834764831845f; v[0] *= s; v[1] *= s; v[2] *= s; v[3] *= s; }
          }
          u16* dst = (u16*)(p.ws + OFF_A + 2 * SZ_TOK1K) + (size_t)token * 2048 + nl;
          *(uint2*)dst = uint2{pack2(v[0], v[1]), pack2(v[2], v[3])};
        }
      } else if (EPI == EPI_GATE) {
        char* base = mixer == 0 ? p.ws + OFF_E : (mixer == 1 ? p.ws + OFF_E + SZ_TOK1K : p.ws + OFF_D);
        u16* dst = (u16*)base + (size_t)token * 1024 + nl;
        uint2 on = *(const uint2*)dst;
        float o0 = bf2f((u16)(on.x & 0xffff)), o1 = bf2f((u16)(on.x >> 16)), o2 = bf2f((u16)(on.y & 0xffff)), o3 = bf2f((u16)(on.y >> 16));
        *(uint2*)dst = uint2{pack2(o0 * silu(v[0]), o1 * silu(v[1])), pack2(o2 * silu(v[2]), o3 * silu(v[3]))};
      } else {
        const int vec = token < T_LAT ? (token >> 13) : 2;
        const f32x4 gt = *(const f32x4*)(MOD + ((size_t)l * 3 + vec) * 3072 + 2048 + nl);
        const float* src;
        float* dst;
        if (token < T_LAT) {
          src = (l == 0 ? p.x : (const float*)p.out) + (size_t)token * 1024 + nl;
          dst = p.out + (size_t)token * 1024 + nl;
        } else {
          src = p.ctx + (size_t)(token - T_LAT) * 1024 + nl;
          dst = (float*)(p.ws + OFF_CTX1) + (size_t)(token - T_LAT) * 1024 + nl;
        }
        f32x4 xi = *(const f32x4*)src;
        f32x4 r;
        r[0] = xi[0] + gt[0] * v[0]; r[1] = xi[1] + gt[1] * v[1]; r[2] = xi[2] + gt[2] * v[2]; r[3] = xi[3] + gt[3] * v[3];
        *(f32x4*)dst = r;
      }
    }
  }
}

DI void merge_tile(const Params& p, int rt, int nti, char* smem) {
  const int WV = p.ph_hi;
  const int tid = tidx(), lane = tid & 63, wid = tid >> 6, wn = wid >> 1, wt = wid & 1;
  const int fr = lane & 15, fq = lane >> 4;
  const int row0 = rt * 128, n0 = nti * 128;
  const u16* WT = (const u16*)(p.ws + OFF_WT);
  const u16* H = (const u16*)(p.ws + OFF_H) + (size_t)row0 * 1024;
  uint2 y[4][4];
#pragma unroll
  for (int i = 0; i < 4; i++)
#pragma unroll
    for (int j = 0; j < 4; j++) y[i][j] = uint2{0u, 0u};
  for (int m = 0; m < 3; m++) {
    uint2 sg[4][4];
    {
      f32x4 acc[4][4];
#pragma unroll
      for (int i = 0; i < 4; i++)
#pragma unroll
        for (int j = 0; j < 4; j++) acc[i][j] = f32x4{0.f, 0.f, 0.f, 0.f};
      gemm_kloop(H, WT + (size_t)(11280 + m * 1024 + n0) * 1024, acc, smem, WV);
#pragma unroll
      for (int i = 0; i < 4; i++)
#pragma unroll
        for (int j = 0; j < 4; j++)
          sg[i][j] = uint2{pack2(sigm(acc[i][j][0]), sigm(acc[i][j][1])), pack2(sigm(acc[i][j][2]), sigm(acc[i][j][3]))};
    }
    {
      const char* base = m == 0 ? p.ws + OFF_E : (m == 1 ? p.ws + OFF_E + SZ_TOK1K : p.ws + OFF_D);
      f32x4 acc[4][4];
#pragma unroll
      for (int i = 0; i < 4; i++)
#pragma unroll
        for (int j = 0; j < 4; j++) acc[i][j] = f32x4{0.f, 0.f, 0.f, 0.f};
      gemm_kloop((const u16*)base + (size_t)row0 * 1024, WT + (size_t)(W_BR + m * 1024 + n0) * 1024, acc, smem, WV);
#pragma unroll
      for (int i = 0; i < 4; i++)
#pragma unroll
        for (int j = 0; j < 4; j++) {
          const float y0 = bf2f((u16)(y[i][j].x & 0xffff)) + acc[i][j][0] * bf2f((u16)(sg[i][j].x & 0xffff));
          const float y1 = bf2f((u16)(y[i][j].x >> 16)) + acc[i][j][1] * bf2f((u16)(sg[i][j].x >> 16));
          const float y2 = bf2f((u16)(y[i][j].y & 0xffff)) + acc[i][j][2] * bf2f((u16)(sg[i][j].y & 0xffff));
          const float y3 = bf2f((u16)(y[i][j].y >> 16)) + acc[i][j][3] * bf2f((u16)(sg[i][j].y >> 16));
          y[i][j] = uint2{pack2(y0, y1), pack2(y2, y3)};
        }
    }
  }
  u16* Y = (u16*)(p.ws + OFF_B);
#pragma unroll
  for (int ti = 0; ti < 4; ti++) {
    const int token = row0 + wt * 64 + ti * 16 + fr;
#pragma unroll
    for (int ni = 0; ni < 4; ni++) {
      const int nl = n0 + wn * 64 + ni * 16 + fq * 4;
      *(uint2*)(Y + (size_t)token * 1024 + nl) = y[ni][ti];
    }
  }
}

DI void wconv_tile(const float* __restrict__ src, int N, int kt, int ntile, u16* __restrict__ dst, char* smem, const int WV) {
  float* s = (float*)smem;
  const int tid = tidx();
  const int k0 = kt * 64, n0 = ntile * 64;
#pragma unroll
  for (int i = 0; i < 4; i++) {
    const int r = (tid >> 4) + i * 16, c4 = (tid & 15) * 4;
    if (n0 + c4 < N) {
      f32x4 v = *(const f32x4*)(src + (size_t)(k0 + r) * N + n0 + c4);
      s[r * 65 + c4] = v[0]; s[r * 65 + c4 + 1] = v[1]; s[r * 65 + c4 + 2] = v[2]; s[r * 65 + c4 + 3] = v[3];
    }
  }
  __syncthreads();
#pragma unroll
  for (int i = 0; i < 2; i++) {
    const int id = tid + i * 256, n = id >> 3, kc = (id & 7) * 8;
    if (n0 + n < N) {
      uint4 o;
      o.x = pack2(s[(kc + 0) * 65 + n], s[(kc + 1) * 65 + n]);
      o.y = pack2(s[(kc + 2) * 65 + n], s[(kc + 3) * 65 + n]);
      o.z = pack2(s[(kc + 4) * 65 + n], s[(kc + 5) * 65 + n]);
      o.w = pack2(s[(kc + 6) * 65 + n], s[(kc + 7) * 65 + n]);
      *(uint4*)(dst + (size_t)(n0 + n) * 1024 + k0 + kc) = o;
    }
  }
  __syncthreads();
}
constexpr int WCONV_UNITS = 16 * 225 + 3 * 256 + 256;
DI void wconv_unit(const Params& p, int l, int u, char* smem) {
  const int WV = p.ph_hi;
  u16* WT = (u16*)(p.ws + OFF_WT);
  if (u < 16 * 225) wconv_tile(p.w_in + (size_t)l * 1024 * 14352, 14352, u / 225, u % 225, WT, smem, WV);
  else if (u < 16 * 225 + 768) {
    const int v = u - 16 * 225, m = v >> 8, r = v & 255;
    wconv_tile(p.w_branch + ((size_t)l * 3 + m) * 1024 * 1024, 1024, r >> 4, r & 15, WT + (size_t)(W_BR + m * 1024) * 1024, smem, WV);
  } else {
    const int r = u - 16 * 225 - 768;
    wconv_tile(p.w_out + (size_t)l * 1024 * 1024, 1024, r >> 4, r & 15, WT + (size_t)W_OUT * 1024, smem, WV);
  }
}

DI void adaln_unit(const Params& p, int u, char* smem) {
  const int WV = p.ph_hi;
  const int l = u / 48, ng = u % 48;
  const int tid = tidx(), lane = tid & 63, w = tid >> 6;
  const int n = ng * 64 + lane;
  const float* W = p.ada_w + (size_t)l * 1024 * 3072;
  float a0 = 0.f, a1 = 0.f, a2 = 0.f;
  for (int k = w * 256; k < w * 256 + 256; k++) {
    const float wv = W[(size_t)k * 3072 + n];
    a0 += silu(p.c[k]) * wv; a1 += silu(p.c[1024 + k]) * wv; a2 += silu(p.c_ctx[k]) * wv;
  }
  float* red = (float*)smem;
  red[(w * 3 + 0) * 64 + lane] = a0; red[(w * 3 + 1) * 64 + lane] = a1; red[(w * 3 + 2) * 64 + lane] = a2;
  __syncthreads();
  if (tid < 192) {
    const int vec = tid >> 6, ln = tid & 63;
    float s = red[(0 * 3 + vec) * 64 + ln] + red[(1 * 3 + vec) * 64 + ln] + red[(2 * 3 + vec) * 64 + ln] + red[(3 * 3 + vec) * 64 + ln];
    const int nn = ng * 64 + ln;
    ((float*)(p.ws + OFF_MOD))[((size_t)l * 3 + vec) * 3072 + nn] = s + p.ada_b[(size_t)l * 3072 + nn];
  }
  __syncthreads();
}

DI void phase_pro(const Params& p, char* smem) {
  const int WV = p.ph_hi;
  const int total = 96 + 16 + WCONV_UNITS;
  for (int u = blockIdx.x; u < total; u += gridDim.x) {
    if (u < 96) adaln_unit(p, u, smem);
    else if (u < 112) {
      const int id = (u - 96) * 256 + tidx();
      const int pos = id >> 5, m = id & 31;
      const float inv = powf(10000.f, -(float)(2 * m) / 64.f);
      float s, c;
      sincosf((float)pos * inv, &s, &c);
      float* ROT = (float*)(p.ws + OFF_ROT);
      ROT[id * 2] = c; ROT[id * 2 + 1] = s;
    } else wconv_unit(p, 0, u - 112, smem);
  }
}

DI void phase_norm(const Params& p, int l, char* smem) {
  const int WV = p.ph_hi;
  const int tid = tidx(), lane = tid & 63, w = tid >> 6;
  float* sW = (float*)smem;
  const float* win = p.w_in + (size_t)l * 1024 * 14352;
  for (int i = tid; i < 16 * 1024; i += 256) {
    const int k = i >> 4, cc = i & 15;
    sW[cc * 1024 + k] = win[(size_t)k * 14352 + 3072 + cc];
  }
  __syncthreads();
  const float* MOD = (const float*)(p.ws + OFF_MOD);
  const float* nw = p.norm_w + (size_t)l * 1024;
  u16* H = (u16*)(p.ws + OFF_H);
  float* GB = (float*)(p.ws + OFF_GB);
  for (int row = blockIdx.x * 4 + w; row < T_ALL; row += gridDim.x * 4) {
    const float* xr;
    int vec;
    if (row < T_LAT) { xr = (l == 0 ? p.x : (const float*)p.out) + (size_t)row * 1024; vec = row >> 13; }
    else { xr = (l == 0 ? p.ctx : (const float*)(p.ws + OFF_CTX1)) + (size_t)(row - T_LAT) * 1024; vec = 2; }
    const float* md = MOD + ((size_t)l * 3 + vec) * 3072;
    f32x4 xv[4];
    float ss = 0.f;
#pragma unroll
    for (int i = 0; i < 4; i++) {
      xv[i] = *(const f32x4*)(xr + i * 256 + lane * 4);
      ss += xv[i][0] * xv[i][0] + xv[i][1] * xv[i][1] + xv[i][2] * xv[i][2] + xv[i][3] * xv[i][3];
    }
    ss = wsum(ss);
    const float rstd = rsqrtf(ss * (1.f / 1024.f) + 1e-6f);
    float ab[16];
#pragma unroll
    for (int cc = 0; cc < 16; cc++) ab[cc] = 0.f;
#pragma unroll
    for (int i = 0; i < 4; i++) {
      const int k = i * 256 + lane * 4;
      const f32x4 wv = *(const f32x4*)(nw + k);
      const f32x4 sh = *(const f32x4*)(md + k);
      const f32x4 sc = *(const f32x4*)(md + 1024 + k);
      f32x4 h;
#pragma unroll
      for (int j = 0; j < 4; j++) h[j] = xv[i][j] * rstd * wv[j] * (1.f + sc[j]) + sh[j];
      *(uint2*)(H + (size_t)row * 1024 + k) = uint2{pack2(h[0], h[1]), pack2(h[2], h[3])};
      asm volatile("" ::: "memory");
#pragma unroll
      for (int cc = 0; cc < 16; cc++) {
        const f32x4 ww = *(const f32x4*)(sW + cc * 1024 + k);
        ab[cc] += h[0] * ww[0] + h[1] * ww[1] + h[2] * ww[2] + h[3] * ww[3];
      }
    }
#pragma unroll
    for (int cc = 0; cc < 16; cc++) ab[cc] = wsum(ab[cc]);
    if (lane < 16) {
      float v = 0.f;
#pragma unroll
      for (int cc = 0; cc < 16; cc++) if (lane == cc) v = ab[cc];
      float r;
      if (lane < 8) {
        const float A = __expf(p.dn_a_log[l * 8 + lane]);
        const float z = v + p.dn_dt_bias[l * 8 + lane];
        const float sp = z > 20.f ? z : log1pf(__expf(z));
        r = -A * sp;
      } else r = sigm(v);
      GB[(size_t)row * 16 + lane] = r;
    }
  }
  __syncthreads();
}

DI void xyT(const char* sX, const char* sY, int it, f32x4 (&acc)[4], const int WV) {
  const int lane = tidx() & 63, fr = lane & 15, fq = lane >> 4;
#pragma unroll
  for (int j = 0; j < 4; j++) acc[j] = f32x4{0.f, 0.f, 0.f, 0.f};
#pragma unroll
  for (int ks = 0; ks < 4; ks++) {
    const bf16x8 a = *(const bf16x8*)(sX + (it * 16 + fr) * 272 + (ks * 32 + fq * 8) * 2);
#pragma unroll
    for (int jt = 0; jt < 4; jt++) {
      const bf16x8 b = *(const bf16x8*)(sY + (jt * 16 + fr) * 272 + (ks * 32 + fq * 8) * 2);
      acc[jt] = mfma16(a, b, acc[jt]);
    }
  }
}

DI void dn_prep_unit(const Params& p, int l, int c, int h, char* smem) {
  const int WV = p.ph_hi;
  const int tid = tidx(), lane = tid & 63, w = tid >> 6;
  u16* QKV = (u16*)(p.ws + OFF_A);
  const u16* HALO = (const u16*)(p.ws + OFF_HALO);
  char* sQ = smem;
  char* sK = smem + 17408;
  float* sKK = (float*)(smem + 34816);
  float* sQK = (float*)(smem + 34816 + 16384);
  float* sGC = (float*)(smem + 34816 + 32768);
  float* sBT = sGC + 128;
  const int row0 = c * 64;
  {
    const int u = tid * 2;
    const int gcol = u < 128 ? h * 128 + u : (u < 256 ? 512 + h * 128 + (u - 128) : 1024 + h * 256 + (u - 256));
    bool first, last;
    if (c < 256) { first = (c & 127) == 0; last = (c & 127) == 127; }
    else { first = ((c - 256) & 3) == 0; last = ((c - 256) & 3) == 3; }
    const float* cw = p.dn_conv + (size_t)l * 5 * 2048 + gcol;
    float cw0[5], cw1[5];
#pragma unroll
    for (int j = 0; j < 5; j++) { cw0[j] = cw[j * 2048]; cw1[j] = cw[j * 2048 + 1]; }
    auto load_ext = [&](int e) -> unsigned {
      if (e < 2) return first ? 0u : *(const unsigned*)(HALO + ((size_t)(c - 1) * 4 + 2 + e) * 2048 + gcol);
      if (e >= 66) return last ? 0u : *(const unsigned*)(HALO + ((size_t)(c + 1) * 4 + (e - 66)) * 2048 + gcol);
      return *(const unsigned*)(QKV + (size_t)(row0 + e - 2) * 2048 + gcol);
    };
    unsigned cat[12];
#pragma unroll
    for (int i = 0; i < 4; i++) cat[i] = load_ext(i);
    for (int tb = 0; tb < 8; tb++) {
#pragma unroll
      for (int i = 0; i < 8; i++) cat[4 + i] = load_ext(4 + tb * 8 + i);
#pragma unroll
      for (int i = 0; i < 8; i++) {
        const int t = tb * 8 + i;
        float y0 = 0.f, y1 = 0.f;
#pragma unroll
        for (int j = 0; j < 5; j++) {
          y0 += cw0[j] * bf2f((u16)(cat[i + j] & 0xffff));
          y1 += cw1[j] * bf2f((u16)(cat[i + j] >> 16));
        }
        y0 = silu(y0); y1 = silu(y1);
        if (w < 2) {
          const float ss = wsum(y0 * y0 + y1 * y1);
          float rs = rsqrtf(ss + 1e-6f);
          if (w == 0) rs *= 0.08838834764831845f;
          y0 *= rs; y1 *= rs;
          const unsigned pk = pack2(y0, y1);
          *(unsigned*)((w == 0 ? sQ : sK) + t * 272 + (u & 127) * 2) = pk;
          *(unsigned*)(QKV + (size_t)(row0 + t) * 2048 + gcol) = pk;
        } else {
          *(unsigned*)(QKV + (size_t)(row0 + t) * 2048 + gcol) = pack2(y0, y1);
        }
      }
#pragma unroll
      for (int i = 0; i < 4; i++) cat[i] = cat[8 + i];
    }
  }
  if (w < 2) {
    const float* GB = (const float*)(p.ws + OFF_GB);
    const float g = GB[(size_t)(row0 + lane) * 16 + w * 4 + h];
    const float bt = GB[(size_t)(row0 + lane) * 16 + 8 + w * 4 + h];
    float s = g;
    if (w == 0) {
#pragma unroll
      for (int o = 1; o < 64; o <<= 1) { const float t = __shfl_up(s, o, 64); if (lane >= o) s += t; }
    } else {
#pragma unroll
      for (int o = 1; o < 64; o <<= 1) { const float t = __shfl_down(s, o, 64); if (lane + o < 64) s += t; }
    }
    const float gl = __shfl(s, w == 0 ? 63 : 0, 64);
    sGC[w * 64 + lane] = s;
    sBT[w * 64 + lane] = bt;
    float* SC = (float*)(p.ws + OFF_DNSC) + ((size_t)(c * 4 + h) * 2 + w) * 192;
    SC[lane] = __expf(s);
    SC[64 + lane] = __expf(gl - s);
    if (lane == 0) SC[128] = __expf(gl);
  }
  __syncthreads();
  {
    const int fr = lane & 15, fq = lane >> 4;
    f32x4 acc[4];
    xyT(sK, sK, w, acc, WV);
#pragma unroll
    for (int jt = 0; jt < 4; jt++)
#pragma unroll
      for (int j = 0; j < 4; j++) sKK[(w * 16 + fq * 4 + j) * 64 + jt * 16 + fr] = acc[jt][j];
    xyT(sQ, sK, w, acc, WV);
#pragma unroll
    for (int jt = 0; jt < 4; jt++)
#pragma unroll
      for (int j = 0; j < 4; j++) sQK[(w * 16 + fq * 4 + j) * 64 + jt * 16 + fr] = acc[jt][j];
  }
  __syncthreads();
  u16* AUX = (u16*)(p.ws + OFF_B) + (size_t)(c * 4 + h) * 4 * 4096;
#pragma unroll 2
  for (int e = 0; e < 32; e++) {
    const int id = tid + e * 256, dir = id >> 12, i = (id >> 6) & 63, j = id & 63;
    const bool valid = dir == 0 ? (j <= i) : (j >= i);
    float v = 0.f;
    if (valid) v = sQK[i * 64 + j] * __expf(sGC[dir * 64 + i] - sGC[dir * 64 + j]);
    AUX[(size_t)(dir * 2 + 1) * 4096 + i * 64 + j] = f2bf(v);
  }
  __syncthreads();
  float* sL0 = sQK;
  float* sL1 = (float*)smem;
#pragma unroll 2
  for (int e = 0; e < 32; e++) {
    const int id = tid + e * 256, dir = id >> 12, ip = (id >> 6) & 63, jp = id & 63;
    const int i = dir ? 63 - ip : ip, j = dir ? 63 - jp : jp;
    float v = 0.f;
    if (jp < ip) v = sBT[dir * 64 + i] * sKK[i * 64 + j] * __expf(sGC[dir * 64 + i] - sGC[dir * 64 + j]);
    (dir ? sL1 : sL0)[ip * 64 + jp] = v;
  }
  __syncthreads();
  if (w < 2) {
    const float* L = w ? sL1 : sL0;
    float* Xs = w ? (float*)(smem + 16384) : sKK;
    const int cn = w ? 63 - lane : lane;
    const float bc = sBT[w * 64 + cn];
    for (int ip = 0; ip < 64; ip++) {
      float a0 = (ip == lane) ? bc : 0.f, a1 = 0.f, a2 = 0.f, a3 = 0.f;
      int jp = 0;
      for (; jp + 4 <= ip; jp += 4) {
        const f32x4 l4 = *(const f32x4*)(L + ip * 64 + jp);
        a0 -= l4[0] * Xs[(jp + 0) * 64 + lane];
        a1 -= l4[1] * Xs[(jp + 1) * 64 + lane];
        a2 -= l4[2] * Xs[(jp + 2) * 64 + lane];
        a3 -= l4[3] * Xs[(jp + 3) * 64 + lane];
      }
      for (; jp < ip; jp++) a0 -= L[ip * 64 + jp] * Xs[jp * 64 + lane];
      const float a = (a0 + a1) + (a2 + a3);
      Xs[ip * 64 + lane] = a;
      const int i = w ? 63 - ip : ip;
      AUX[(size_t)(w * 2 + 0) * 4096 + i * 64 + cn] = f2bf(a);
    }
  }
  __syncthreads();
}

DI void ret_prep_unit(const Params& p, int l, int c, int h, char* smem) {
  const int WV = p.ph_hi;
  const int tid = tidx(), lane = tid & 63, w = tid >> 6;
  const u16* QKV = (const u16*)(p.ws + OFF_A + 2 * SZ_TOK1K);
  char* sQ = smem;
  char* sK = smem + 17408;
  const int row0 = c * 64;
#pragma unroll
  for (int i = 0; i < 4; i++) {
    const int id = tid + i * 256, r = id >> 4, ch = id & 15;
    *(uint4*)(sQ + r * 272 + ch * 16) = *(const uint4*)(QKV + (size_t)(row0 + r) * 2048 + h * 128 + ch * 8);
    *(uint4*)(sK + r * 272 + ch * 16) = *(const uint4*)(QKV + (size_t)(row0 + r) * 2048 + 512 + h * 128 + ch * 8);
  }
  __syncthreads();
  f32x4 acc[4];
  xyT(sQ, sK, w, acc, WV);
  const int fr = lane & 15, fq = lane >> 4;
  u16* AUX = (u16*)(p.ws + OFF_C) + (size_t)(c * 4 + h) * 2 * 4096;
#pragma unroll
  for (int dir = 0; dir < 2; dir++) {
    const float rd = p.ret_decay[l * 8 + dir * 4 + h];
    const float lam = fminf(rd, 0.f) - log1pf(__expf(-fabsf(rd)));
#pragma unroll
    for (int jt = 0; jt < 4; jt++)
#pragma unroll
      for (int j = 0; j < 4; j++) {
        const int i = w * 16 + fq * 4 + j, jj = jt * 16 + fr;
        const int dd = dir == 0 ? i - jj : jj - i;
        const float v = dd >= 0 ? acc[jt][j] * __expf(lam * (float)dd) : 0.f;
        AUX[(size_t)dir * 4096 + i * 64 + jj] = f2bf(v);
      }
  }
  __syncthreads();
}

DI void hg_prep_unit(const Params& p, int l, int c, int h, char* smem) {
  const int WV = p.ph_hi;
  const int tid = tidx();
  u16* QFI = (u16*)(p.ws + OFF_A);
  u16* HGX = (u16*)(p.ws + OFF_B);
  float* sG = (float*)smem;
  u16* sQ = (u16*)(smem + 32768);
  u16* sK = (u16*)(smem + 49152);
  float* sTot = (float*)(smem + 65536);
  const int row0 = c * 64;
#pragma unroll
  for (int i = 0; i < 4; i++) {
    const int id = tid + i * 256, r = id >> 4, ch = id & 15;
    const uint4 v = *(const uint4*)(QFI + (size_t)(row0 + r) * 4096 + h * 128 + ch * 8);
    const unsigned vv[4] = {v.x, v.y, v.z, v.w};
#pragma unroll
    for (int e = 0; e < 4; e++) {
      sQ[(ch * 8 + e * 2) * 64 + r] = (u16)(vv[e] & 0xffff);
      sQ[(ch * 8 + e * 2 + 1) * 64 + r] = (u16)(vv[e] >> 16);
    }
  }
  __syncthreads();
  const int half = tid >> 7, d = tid & 127;
  for (int dir = 1; dir >= 0; dir--) {
    float lo = 0.f;
    if (l == 1) {
      const float b0 = p.hg_lb[dir * 1024 + h * 128 + d], b1 = p.hg_lb[2048 + dir * 1024 + h * 128 + d];
      lo = sigm(b1 - b0);
    }
    float run = 0.f;
    {
      const u16* xs = QFI + (size_t)row0 * 4096 + 1024 + dir * 1024 + h * 128 + d;
      float xv[32];
#pragma unroll
      for (int i = 0; i < 32; i++) xv[i] = bf2f(xs[(size_t)(half * 32 + i) * 4096]);
#pragma unroll
      for (int i = 0; i < 32; i++) {
        const int ii = dir == 0 ? i : 31 - i;
        const int t = half * 32 + ii;
        const float x = xv[ii];
        const float sg = sigm(x);
        const float f = lo + (1.f - lo) * sg;
        const float omf = (1.f - lo) * (1.f - sg);
        run += __log2f(f);
        sG[d * 64 + t] = run;
        sK[d * 64 + t] = f2bf(omf);
      }
      sTot[half * 128 + d] = run;
    }
    __syncthreads();
    {
      const float t0 = sTot[d], t1 = sTot[128 + d];
      const float gtot = t0 + t1;
      const float add = dir == 0 ? (half == 1 ? t0 : 0.f) : (half == 0 ? t1 : 0.f);
      u16* qdst = dir == 0 ? QFI + (size_t)row0 * 4096 + h * 128 + d : HGX + (size_t)row0 * 1024 + h * 128 + d;
      const size_t qp = dir == 0 ? 4096 : 1024;
      u16* kdst = QFI + (size_t)row0 * 4096 + 1024 + dir * 1024 + h * 128 + d;
#pragma unroll 8
      for (int i = 0; i < 32; i++) {
        const int t = half * 32 + i;
        const float G = sG[d * 64 + t] + add;
        sG[d * 64 + t] = G;
        qdst[(size_t)t * qp] = f2bf(bf2f(sQ[d * 64 + t]) * exp2f(G));
        kdst[(size_t)t * 4096] = f2bf(bf2f(sK[d * 64 + t]) * exp2f(gtot - G));
      }
      if (half == 0) ((float*)(p.ws + OFF_HGDEC))[((size_t)(c * 8 + h) * 2 + dir) * 128 + d] = exp2f(gtot);
    }
    __syncthreads();
    {
      const int bi = tid >> 4, bj = tid & 15;
      const bool act = dir == 0 ? (bj <= bi) : (bj >= bi);
      if (act) {
        float acc[4][4];
#pragma unroll
        for (int a = 0; a < 4; a++)
#pragma unroll
          for (int b = 0; b < 4; b++) acc[a][b] = 0.f;
        for (int dd = 0; dd < 128; dd++) {
          const f32x4 Gi = *(const f32x4*)(sG + dd * 64 + bi * 4);
          const f32x4 Gj = *(const f32x4*)(sG + dd * 64 + bj * 4);
          const uint2 qi = *(const uint2*)(sQ + dd * 64 + bi * 4);
          const uint2 kj = *(const uint2*)(sK + dd * 64 + bj * 4);
          const float q4[4] = {bf2f((u16)(qi.x & 0xffff)), bf2f((u16)(qi.x >> 16)), bf2f((u16)(qi.y & 0xffff)), bf2f((u16)(qi.y >> 16))};
          const float k4[4] = {bf2f((u16)(kj.x & 0xffff)), bf2f((u16)(kj.x >> 16)), bf2f((u16)(kj.y & 0xffff)), bf2f((u16)(kj.y >> 16))};
#pragma unroll
          for (int a = 0; a < 4; a++)
#pragma unroll
            for (int b = 0; b < 4; b++) acc[a][b] += q4[a] * k4[b] * exp2f(fminf(Gi[a] - Gj[b], 0.f));
        }
        u16* AUX = (u16*)(p.ws + OFF_C) + ((size_t)(c * 8 + h) * 2 + dir) * 4096;
#pragma unroll
        for (int a = 0; a < 4; a++) {
          const int i = bi * 4 + a;
          float o[4];
#pragma unroll
          for (int b = 0; b < 4; b++) {
            const int j = bj * 4 + b;
            const bool valid = dir == 0 ? (j <= i) : (j >= i);
            o[b] = valid ? acc[a][b] : 0.f;
          }
          *(uint2*)(AUX + i * 64 + bj * 4) = uint2{pack2(o[0], o[1]), pack2(o[2], o[3])};
        }
      } else {
        u16* AUX = (u16*)(p.ws + OFF_C) + ((size_t)(c * 8 + h) * 2 + dir) * 4096;
#pragma unroll
        for (int a = 0; a < 4; a++) *(uint2*)(AUX + (bi * 4 + a) * 64 + bj * 4) = uint2{0u, 0u};
      }
    }
    __syncthreads();
  }
}

struct ScanDesc {
  const u16 *q, *k, *v;
  int qp, kp, vp;
  const u16* aux;
  size_t aux_cs;
  int attn_off, ainv_off;
  u16* o;
  int mixer, b, dir;
  const float* sc;
  size_t sc_cs;
  float lam;
};

template <int MIXER>
DI void scan_unit(const ScanDesc& s, char* smem, const int WV) {
  const int tid = tidx(), lane = tid & 63, w = tid >> 6;
  const int fr = lane & 15, fq = lane >> 4;
  char* sQm = smem;
  char* sKm = smem + 17408;
  char* sKT = smem + 34816;
  char* sAT = smem + 53248;
  char* sAI = smem + 62464;
  float* sSC = (float*)(smem + 71680);
  f32x4 S[8];
#pragma unroll
  for (int i = 0; i < 8; i++) S[i] = f32x4{0.f, 0.f, 0.f, 0.f};
  for (int step = 0; step < 132; step++) {
    int c;
    if (s.dir == 0) c = step < 4 ? 256 + 4 * s.b + step : 128 * s.b + (step - 4);
    else c = step < 4 ? 256 + 4 * s.b + (3 - step) : 128 * s.b + (131 - step);
    const int row0 = c * 64;
    const u16* qbase = s.q + (size_t)row0 * s.qp;
    const u16* kbase = s.k + (size_t)row0 * s.kp;
    const u16* vbase = s.v + (size_t)row0 * s.vp;
#pragma unroll
    for (int i = 0; i < 4; i++) {
      const int id = tid + i * 256, r = id >> 4, ch = id & 15;
      *(uint4*)(sQm + r * 272 + ch * 16) = *(const uint4*)(qbase + (unsigned)(r * s.qp + ch * 8));
      const uint4 kv = *(const uint4*)(kbase + (unsigned)(r * s.kp + ch * 8));
      *(uint4*)(sKm + r * 272 + ch * 16) = kv;
      const unsigned vv[4] = {kv.x, kv.y, kv.z, kv.w};
#pragma unroll
      for (int e = 0; e < 4; e++) {
        *(u16*)(sKT + (ch * 8 + e * 2) * 144 + r * 2) = (u16)(vv[e] & 0xffff);
        *(u16*)(sKT + (ch * 8 + e * 2 + 1) * 144 + r * 2) = (u16)(vv[e] >> 16);
      }
    }
#pragma unroll
    for (int i = 0; i < 2; i++) {
      const int id = tid + i * 256, r = id >> 3, ch = id & 7;
      const u16* ab = s.aux + (size_t)c * s.aux_cs;
      *(uint4*)(sAT + r * 144 + ch * 16) = *(const uint4*)(ab + s.attn_off + (unsigned)(r * 64 + ch * 8));
      if (MIXER == 0) *(uint4*)(sAI + r * 144 + ch * 16) = *(const uint4*)(ab + s.ainv_off + (unsigned)(r * 64 + ch * 8));
    }
    float egl = 1.f;
    if (MIXER == 0) {
      const float* sc = s.sc + (size_t)c * s.sc_cs;
      if (tid < 128) sSC[tid] = sc[tid];
      egl = sc[128];
    } else if (MIXER == 1) {
      if (tid < 64) {
        const float e1 = s.dir == 0 ? (float)(tid + 1) : (float)(64 - tid);
        sSC[tid] = __expf(s.lam * e1);
        sSC[64 + tid] = __expf(s.lam * (64.f - e1));
      }
      egl = __expf(s.lam * 64.f);
    } else {
      if (tid < 128) sSC[tid] = s.sc[(size_t)c * s.sc_cs + tid];
    }
    f32x4 V[4];
#pragma unroll
    for (int mt = 0; mt < 4; mt++)
#pragma unroll
      for (int j = 0; j < 4; j++) V[mt][j] = bf2f(vbase[(unsigned)((mt * 16 + fq * 4 + j) * s.vp + w * 16 + fr)]);
    __syncthreads();
    bf16x8 Sb[4];
#pragma unroll
    for (int ks = 0; ks < 4; ks++) Sb[ks] = pack8(S[2 * ks], S[2 * ks + 1]);
    f32x4 vn[4];
    if (MIXER == 0) {
      f32x4 P[4];
#pragma unroll
      for (int mt = 0; mt < 4; mt++) {
        P[mt] = f32x4{0.f, 0.f, 0.f, 0.f};
#pragma unroll
        for (int ks = 0; ks < 4; ks++) P[mt] = mfma16(ld_perm(sKm + (mt * 16 + fr) * 272, ks * 32 + fq * 4), Sb[ks], P[mt]);
      }
#pragma unroll
      for (int mt = 0; mt < 4; mt++)
#pragma unroll
        for (int j = 0; j < 4; j++) P[mt][j] = V[mt][j] - sSC[mt * 16 + fq * 4 + j] * P[mt][j];
      bf16x8 rb[2];
#pragma unroll
      for (int ks = 0; ks < 2; ks++) rb[ks] = pack8(P[2 * ks], P[2 * ks + 1]);
#pragma unroll
      for (int mt = 0; mt < 4; mt++) {
        vn[mt] = f32x4{0.f, 0.f, 0.f, 0.f};
#pragma unroll
        for (int ks = 0; ks < 2; ks++) vn[mt] = mfma16(ld_perm(sAI + (mt * 16 + fr) * 144, ks * 32 + fq * 4), rb[ks], vn[mt]);
      }
    } else {
#pragma unroll
      for (int mt = 0; mt < 4; mt++) vn[mt] = V[mt];
    }
    bf16x8 vb[2];
#pragma unroll
    for (int ks = 0; ks < 2; ks++) vb[ks] = pack8(vn[2 * ks], vn[2 * ks + 1]);
    u16* obase = s.o + (size_t)row0 * 1024;
#pragma unroll
    for (int mt = 0; mt < 4; mt++) {
      f32x4 o0 = f32x4{0.f, 0.f, 0.f, 0.f};
#pragma unroll
      for (int ks = 0; ks < 4; ks++) o0 = mfma16(ld_perm(sQm + (mt * 16 + fr) * 272, ks * 32 + fq * 4), Sb[ks], o0);
      if (MIXER != 2) {
#pragma unroll
        for (int j = 0; j < 4; j++) o0[j] *= sSC[mt * 16 + fq * 4 + j];
      }
#pragma unroll
      for (int ks = 0; ks < 2; ks++) o0 = mfma16(ld_perm(sAT + (mt * 16 + fr) * 144, ks * 32 + fq * 4), vb[ks], o0);
#pragma unroll
      for (int j = 0; j < 4; j++) obase[(unsigned)((mt * 16 + fq * 4 + j) * 1024 + w * 16 + fr)] = f2bf(o0[j]);
    }
    if (MIXER != 2) {
#pragma unroll
      for (int mt = 0; mt < 4; mt++)
#pragma unroll
        for (int j = 0; j < 4; j++) vn[mt][j] *= sSC[64 + mt * 16 + fq * 4 + j];
#pragma unroll
      for (int ks = 0; ks < 2; ks++) vb[ks] = pack8(vn[2 * ks], vn[2 * ks + 1]);
    }
#pragma unroll
    for (int mt = 0; mt < 8; mt++) {
      if (MIXER == 2) {
#pragma unroll
        for (int j = 0; j < 4; j++) S[mt][j] *= sSC[mt * 16 + fq * 4 + j];
      } else {
#pragma unroll
        for (int j = 0; j < 4; j++) S[mt][j] *= egl;
      }
#pragma unroll
      for (int ks = 0; ks < 2; ks++) S[mt] = mfma16(ld_perm(sKT + (mt * 16 + fr) * 144, ks * 32 + fq * 4), vb[ks], S[mt]);
    }
    __syncthreads();
  }
}

DI void scan_phase_hg(const Params& p, char* smem) {
  const int WV = p.ph_hi;
  for (int u = blockIdx.x; u < 64; u += gridDim.x) {
    const int dir = u & 1, vg = (u >> 1) & 1, h = (u >> 2) & 7, b = u >> 5;
    ScanDesc s;
    s.q = dir == 0 ? (const u16*)(p.ws + OFF_A) + h * 128 : (const u16*)(p.ws + OFF_B) + h * 128;
    s.qp = dir == 0 ? 4096 : 1024;
    s.k = (const u16*)(p.ws + OFF_A) + 1024 + dir * 1024 + h * 128; s.kp = 4096;
    s.v = (const u16*)(p.ws + OFF_A) + 3072 + h * 128 + vg * 64; s.vp = 4096;
    s.aux = (const u16*)(p.ws + OFF_C) + (size_t)(h * 2 + dir) * 4096; s.aux_cs = 8 * 2 * 4096; s.attn_off = 0; s.ainv_off = 0;
    s.o = (u16*)(p.ws + OFF_D + (dir ? SZ_TOK1K : 0)) + h * 128 + vg * 64;
    s.mixer = 2; s.b = b; s.dir = dir;
    s.sc = (const float*)(p.ws + OFF_HGDEC) + (size_t)(h * 2 + dir) * 128; s.sc_cs = 8 * 2 * 128; s.lam = 0.f;
    scan_unit<2>(s, smem, WV);
  }
}
DI void scan_phase_dnret(const Params& p, int l, char* smem) {
  const int WV = p.ph_hi;
  for (int u = blockIdx.x; u < 128; u += gridDim.x) {
    const int mixer = u & 1, dir = (u >> 1) & 1, vg = (u >> 2) & 3, h = (u >> 4) & 3, b = u >> 6;
    ScanDesc s;
    const u16* base = (const u16*)(p.ws + OFF_A + (mixer ? 2 * SZ_TOK1K : 0));
    s.q = base + h * 128; s.k = base + 512 + h * 128; s.v = base + 1024 + h * 256 + vg * 64;
    s.qp = s.kp = s.vp = 2048;
    s.mixer = mixer; s.b = b; s.dir = dir;
    if (mixer == 0) {
      s.aux = (const u16*)(p.ws + OFF_B) + (size_t)(h * 2 + dir) * 2 * 4096; s.aux_cs = 4 * 4 * 4096; s.ainv_off = 0; s.attn_off = 4096;
      s.sc = (const float*)(p.ws + OFF_DNSC) + (size_t)(h * 2 + dir) * 192; s.sc_cs = 4 * 2 * 192; s.lam = 0.f;
      s.o = (u16*)(dir == 0 ? p.ws + OFF_E : p.ws + OFF_D + SZ_TOK1K) + h * 256 + vg * 64;
      scan_unit<0>(s, smem, WV);
    } else {
      s.aux = (const u16*)(p.ws + OFF_C) + (size_t)(h * 2 + dir) * 4096; s.aux_cs = 4 * 2 * 4096; s.attn_off = 0; s.ainv_off = 0;
      const float rd = p.ret_decay[l * 8 + dir * 4 + h];
      s.lam = fminf(rd, 0.f) - log1pf(__expf(-fabsf(rd)));
      s.sc = nullptr; s.sc_cs = 0;
      s.o = (u16*)(p.ws + OFF_E + (dir == 0 ? SZ_TOK1K : 2 * SZ_TOK1K)) + h * 256 + vg * 64;
      scan_unit<1>(s, smem, WV);
    }
  }
}

DI void onorm_rows(u16* of, const u16* ob, const float* nw, int dv, int unit, int nunits_stride, const int WV) {
  const int lane = tidx() & 63, w = tidx() >> 6;
  for (int row = unit * 4 + w; row < T_ALL; row += nunits_stride * 4) {
    u16* pf = of + (size_t)row * 1024 + lane * 16;
    const u16* pb = ob + (size_t)row * 1024 + lane * 16;
    float v[16];
#pragma unroll
    for (int hv = 0; hv < 2; hv++) {
      const uint4 a = *(const uint4*)(pf + hv * 8), b = *(const uint4*)(pb + hv * 8);
      const unsigned aa[4] = {a.x, a.y, a.z, a.w}, bb[4] = {b.x, b.y, b.z, b.w};
#pragma unroll
      for (int e = 0; e < 4; e++) {
        v[hv * 8 + e * 2] = bf2f((u16)(aa[e] & 0xffff)) + bf2f((u16)(bb[e] & 0xffff));
        v[hv * 8 + e * 2 + 1] = bf2f((u16)(aa[e] >> 16)) + bf2f((u16)(bb[e] >> 16));
      }
    }
    float ss = 0.f;
#pragma unroll
    for (int e = 0; e < 16; e++) ss += v[e] * v[e];
    const int nl = dv / 16;
    for (int o = 1; o < nl; o <<= 1) ss += __shfl_xor(ss, o, 64);
    const float rstd = rsqrtf(ss / (float)dv + 1e-6f);
    const int dcol = (lane * 16) % dv;
    unsigned o8[8];
#pragma unroll
    for (int e = 0; e < 8; e++) o8[e] = pack2(v[2 * e] * rstd * nw[dcol + 2 * e], v[2 * e + 1] * rstd * nw[dcol + 2 * e + 1]);
    *(uint4*)pf = uint4{o8[0], o8[1], o8[2], o8[3]};
    *(uint4*)(pf + 8) = uint4{o8[4], o8[5], o8[6], o8[7]};
  }
}

DI void final_norm(const Params& p) {
  const int WV = p.ph_hi;
  const int lane = tidx() & 63, w = tidx() >> 6;
  for (int row = blockIdx.x * 4 + w; row < T_LAT; row += gridDim.x * 4) {
    float* xr = p.out + (size_t)row * 1024;
    f32x4 xv[4];
    float ss = 0.f;
#pragma unroll
    for (int i = 0; i < 4; i++) {
      xv[i] = *(const f32x4*)(xr + i * 256 + lane * 4);
      ss += xv[i][0] * xv[i][0] + xv[i][1] * xv[i][1] + xv[i][2] * xv[i][2] + xv[i][3] * xv[i][3];
    }
    ss = wsum(ss);
    const float rstd = rsqrtf(ss * (1.f / 1024.f) + 1e-6f);
#pragma unroll
    for (int i = 0; i < 4; i++) {
      const f32x4 wv = *(const f32x4*)(p.final_norm_w + i * 256 + lane * 4);
      f32x4 r;
#pragma unroll
      for (int j = 0; j < 4; j++) r[j] = xv[i][j] * rstd * wv[j];
      *(f32x4*)(xr + i * 256 + lane * 4) = r;
    }
  }
}

DI void run_phase(const Params& p, int ph, char* smem) {
  const int WV = p.ph_hi;
  const int G = gridDim.x, B = blockIdx.x;
  if (ph == 0) { if (QSEL(11)) phase_pro(p, smem); return; }
  if (ph == 23) { if (QSEL(12)) final_norm(p); return; }
  const int l = (ph - 1) / 11, q = (ph - 1) % 11;
  const bool last = l == 1;
  switch (q) {
    case 0: if (!QSEL(0)) break;
      if (l == 1) for (int u = B; u < WCONV_UNITS; u += G) wconv_unit(p, 1, u, smem);
      phase_norm(p, l, smem);
      break;
    case 1: if (!QSEL(1)) break;
      for (int t = B; t < 132 * 32; t += G) gemm_tile<EPI_HG>(p, l, t % 132, t / 132, smem);
      break;
    case 2: if (!QSEL(2)) break;
      for (int u = B; u < NCH * 8; u += G) hg_prep_unit(p, l, u >> 3, u & 7, smem);
      break;
    case 3: if (!QSEL(3)) break; scan_phase_hg(p, smem); break;
    case 4: if (!QSEL(4)) break;
      for (int t = B; t < 132 * 32; t += G) gemm_tile<EPI_DNRET>(p, l, t % 132, t / 132, smem);
      onorm_rows((u16*)(p.ws + OFF_D), (const u16*)(p.ws + OFF_D + SZ_TOK1K), p.hg_norm_w + l * 128, 128, B, G, WV);
      break;
    case 5: if (!QSEL(5)) break;
      for (int u = B; u < NCH * 8; u += G) {
        if (u < NCH * 4) dn_prep_unit(p, l, u >> 2, u & 3, smem);
        else ret_prep_unit(p, l, (u - NCH * 4) >> 2, u & 3, smem);
      }
      break;
    case 6: if (!QSEL(6)) break; scan_phase_dnret(p, l, smem); break;
    case 7: if (!QSEL(7)) break;
      onorm_rows((u16*)(p.ws + OFF_E), (const u16*)(p.ws + OFF_D + SZ_TOK1K), p.dn_norm_w + l * 256, 256, B, G, WV);
      onorm_rows((u16*)(p.ws + OFF_E + SZ_TOK1K), (const u16*)(p.ws + OFF_E + 2 * SZ_TOK1K), p.ret_norm_w + l * 256, 256, B, G, WV);
      break;
    case 8: if (!QSEL(8)) break; {
      const int nrt = last ? 128 : 132;
      for (int t = B; t < nrt * 24; t += G) gemm_tile<EPI_GATE>(p, l, t % nrt, t / nrt, smem);
    } break;
    case 9: if (!QSEL(9)) break; {
      const int nrt = last ? 128 : 132;
      for (int t = B; t < nrt * 8; t += G) merge_tile(p, t % nrt, t / nrt, smem);
    } break;
    case 10: if (!QSEL(10)) break; {
      const int nrt = last ? 128 : 132;
      for (int t = B; t < nrt * 8; t += G) gemm_tile<EPI_OUT>(p, l, t % nrt, t / nrt, smem);
    } break;
  }
}

DI void grid_barrier(unsigned* ctr, unsigned target) {
  asm volatile("s_waitcnt vmcnt(0) lgkmcnt(0)" ::: "memory");
  __syncthreads();
  if (__builtin_amdgcn_workitem_id_x() == 0) {
    __builtin_amdgcn_fence(__ATOMIC_RELEASE, "agent");
    asm volatile("s_waitcnt vmcnt(0)" ::: "memory");
    __hip_atomic_fetch_add(ctr, 1u, __ATOMIC_RELAXED, __HIP_MEMORY_SCOPE_AGENT);
    while (__hip_atomic_load(ctr, __ATOMIC_RELAXED, __HIP_MEMORY_SCOPE_AGENT) < target) __builtin_amdgcn_s_sleep(1);
    __builtin_amdgcn_fence(__ATOMIC_ACQUIRE, "agent");
    asm volatile("s_waitcnt vmcnt(0)" ::: "memory");
  }
  __syncthreads();
}

__global__ void __launch_bounds__(256, 2) mk(Params p) {
  extern __shared__ __attribute__((aligned(16))) char smem[];
  p.ph_hi = __builtin_amdgcn_readfirstlane((int)__builtin_amdgcn_workitem_id_x() >> 6);
#if ONE_LAUNCH
  cg::grid_group grid = cg::this_grid();
  unsigned* bar = (unsigned*)(p.ws + OFF_BAR);
  const unsigned G = gridDim.x;
  run_phase(p, 0, smem);
  grid.sync();
#define PH(n) run_phase(p, n, smem); grid_barrier(bar, (unsigned)(n) * G);
  PH(1) PH(2) PH(3) PH(4) PH(5) PH(6) PH(7) PH(8) PH(9) PH(10) PH(11)
  PH(12) PH(13) PH(14) PH(15) PH(16) PH(17) PH(18) PH(19) PH(20) PH(21) PH(22)
  run_phase(p, 23, smem);
#else
  run_phase(p, p.ph_lo, smem);
#endif
}

extern "C" void kernel_launch(void* const* d_in, const int* in_sizes, int n_in, void* d_out,
                              int out_size, void* d_ws, size_t ws_size, hipStream_t stream) {
  static int grid_blocks = 0;
  if (!grid_blocks) {
    int dev = 0, cus = 0, per_cu = 0;
    (void)hipGetDevice(&dev);
    (void)hipDeviceGetAttribute(&cus, hipDeviceAttributeMultiprocessorCount, dev);
    (void)hipFuncSetAttribute((const void*)mk, hipFuncAttributeMaxDynamicSharedMemorySize, SMEM_BYTES);
    (void)hipOccupancyMaxActiveBlocksPerMultiprocessor(&per_cu, mk, 256, SMEM_BYTES);
    if (per_cu > 2) per_cu = 2;
    if (per_cu < 1) per_cu = 1;
    grid_blocks = cus * per_cu;
  }
  Params p{};
  const float** f = (const float**)&p;
  for (int i = 0; i < 19; i++) f[i] = (const float*)d_in[i];
  p.out = (float*)d_out;
  p.ws = (char*)d_ws;
#if ONE_LAUNCH
  p.ph_lo = 0; p.ph_hi = 24;
  (void)hipMemsetAsync((char*)d_ws + OFF_BAR, 0, 256, stream);
  void* args[] = {&p};
  (void)hipLaunchCooperativeKernel((void*)mk, dim3(grid_blocks), dim3(256), args, SMEM_BYTES, stream);
#else
  for (int ph = 0; ph < 24; ph++) {
    p.ph_lo = ph; p.ph_hi = ph + 1;
    void* args[] = {&p};
    (void)hipLaunchCooperativeKernel((void*)mk, dim3(grid_blocks), dim3(256), args, SMEM_BYTES, stream);
  }
#endif
}
```

```cpp
#include <hip/hip_runtime.h>
#include <hip/hip_cooperative_groups.h>
#include <cstdio>
namespace cg = cooperative_groups;

#ifndef ONE_LAUNCH
#define ONE_LAUNCH 1
#endif
#ifndef ONLY_Q
#define ONLY_Q -1
#endif
#define QSEL(n) (ONLY_Q < 0 || ONLY_Q == (n))

typedef unsigned short u16;
using bf16x8 = __attribute__((ext_vector_type(8))) short;
using bf16x4 = __attribute__((ext_vector_type(4))) short;
using f32x4 = __attribute__((ext_vector_type(4))) float;
#define DI __device__ __forceinline__

constexpr int T_LAT = 16384, T_ALL = 16896, NCH = 264;
constexpr int WROWS = 18448;
constexpr int W_BR = 14352, W_OUT = 17424;
constexpr size_t al(size_t x) { return (x + 255) & ~(size_t)255; }
constexpr size_t SZ_WT = (size_t)WROWS * 1024 * 2;
constexpr size_t SZ_TOK1K = (size_t)T_ALL * 1024 * 2;
constexpr size_t OFF_WT = 0;
constexpr size_t OFF_H = OFF_WT + al(SZ_WT);
constexpr size_t OFF_MOD = OFF_H + al(SZ_TOK1K);
constexpr size_t OFF_ROT = OFF_MOD + al(2 * 3 * 3072 * 4);
constexpr size_t OFF_GB = OFF_ROT + al(128 * 32 * 2 * 4);
constexpr size_t OFF_CTX1 = OFF_GB + al((size_t)T_ALL * 16 * 4);
constexpr size_t OFF_HALO = OFF_CTX1 + al(512 * 1024 * 4);
constexpr size_t OFF_DNSC = OFF_HALO + al((size_t)NCH * 4 * 2048 * 2);
constexpr size_t OFF_HGDEC = OFF_DNSC + al((size_t)NCH * 4 * 2 * 192 * 4);
constexpr size_t OFF_BAR = OFF_HGDEC + al((size_t)NCH * 8 * 2 * 128 * 4);
constexpr size_t OFF_A = OFF_BAR + 4096;
constexpr size_t OFF_B = OFF_A + 4 * SZ_TOK1K;
constexpr size_t OFF_C = OFF_B + SZ_TOK1K;
constexpr size_t OFF_D = OFF_C + SZ_TOK1K;
constexpr size_t OFF_E = OFF_D + 2 * SZ_TOK1K;
constexpr size_t WS_TOTAL = OFF_E + 3 * SZ_TOK1K;
static_assert(WS_TOTAL <= 470286336ull, "workspace too large");

constexpr int SMEM_BYTES = 72960;

struct Params {
  const float *x, *c, *ctx, *c_ctx, *norm_w, *ada_w, *ada_b, *w_in, *dn_conv, *dn_a_log, *dn_dt_bias, *dn_norm_w,
      *ret_decay, *ret_norm_w, *hg_lb, *hg_norm_w, *w_branch, *w_out, *final_norm_w;
  float* out;
  char* ws;
  int ph_lo, ph_hi;
};

DI int laneid_v() { int t; asm volatile("v_mbcnt_lo_u32_b32 %0, -1, 0\n\tv_mbcnt_hi_u32_b32 %0, -1, %0" : "=v"(t)); return t; }
#define tidx() (WV * 64 + laneid_v())
DI u16 f2bf(float f) { unsigned u = __float_as_uint(f); u += 0x7fffu + ((u >> 16) & 1u); return (u16)(u >> 16); }
DI float bf2f(u16 h) { return __uint_as_float(((unsigned)h) << 16); }
DI unsigned pack2(float a, float b) { return (unsigned)f2bf(a) | ((unsigned)f2bf(b) << 16); }
DI float sigm(float x) { return 1.f / (1.f + __expf(-x)); }
DI float silu(float x) { return x / (1.f + __expf(-x)); }
DI float wsum(float v) {
#pragma unroll
  for (int o = 32; o > 0; o >>= 1) v += __shfl_xor(v, o, 64);
  return v;
}
DI f32x4 mfma16(bf16x8 a, bf16x8 b, f32x4 c) { return __builtin_amdgcn_mfma_f32_16x16x32_bf16(a, b, c, 0, 0, 0); }
DI bf16x8 pack8(f32x4 lo, f32x4 hi) {
  bf16x8 r;
  r[0] = (short)f2bf(lo[0]); r[1] = (short)f2bf(lo[1]); r[2] = (short)f2bf(lo[2]); r[3] = (short)f2bf(lo[3]);
  r[4] = (short)f2bf(hi[0]); r[5] = (short)f2bf(hi[1]); r[6] = (short)f2bf(hi[2]); r[7] = (short)f2bf(hi[3]);
  return r;
}
DI bf16x8 ld_perm(const char* rowp, int c0) {
  bf16x4 lo = *(const bf16x4*)(rowp + c0 * 2);
  bf16x4 hi = *(const bf16x4*)(rowp + c0 * 2 + 32);
  bf16x8 r;
  r[0] = lo[0]; r[1] = lo[1]; r[2] = lo[2]; r[3] = lo[3]; r[4] = hi[0]; r[5] = hi[1]; r[6] = hi[2]; r[7] = hi[3];
  return r;
}

DI int swz(int row, int ch) { return row * 128 + ((ch ^ (row & 7)) << 4); }

DI void gemm_kloop(const u16* __restrict__ A, const u16* __restrict__ W, f32x4 (&acc)[4][4], char* smem, const int WV) {
  const int tid = tidx(), lane = tid & 63, wid = tid >> 6, wn = wid >> 1, wt = wid & 1;
  const int fr = lane & 15, fq = lane >> 4;
  uint4 ra[4], rw[4];
  const int lrow = tid >> 3, lch = tid & 7;
  const u16* Ap = A + (size_t)lrow * 1024 + lch * 8;
  const u16* Wp = W + (size_t)lrow * 1024 + lch * 8;
#pragma unroll
  for (int i = 0; i < 4; i++) {
    ra[i] = *(const uint4*)(Ap + (size_t)i * 32 * 1024);
    rw[i] = *(const uint4*)(Wp + (size_t)i * 32 * 1024);
  }
#pragma unroll
  for (int i = 0; i < 4; i++) {
    *(uint4*)(smem + swz(lrow + i * 32, lch)) = rw[i];
    *(uint4*)(smem + 16384 + swz(lrow + i * 32, lch)) = ra[i];
  }
  __syncthreads();
  for (int kt = 0; kt < 16; kt++) {
    if (kt < 15) {
#pragma unroll
      for (int i = 0; i < 4; i++) {
        ra[i] = *(const uint4*)(Ap + (size_t)i * 32 * 1024 + (kt + 1) * 64);
        rw[i] = *(const uint4*)(Wp + (size_t)i * 32 * 1024 + (kt + 1) * 64);
      }
    }
    const char* sW = smem + (kt & 1) * 32768;
    const char* sA = sW + 16384;
#pragma unroll
    for (int ks = 0; ks < 2; ks++) {
      bf16x8 fw[4], fa[4];
#pragma unroll
      for (int i = 0; i < 4; i++) {
        fw[i] = *(const bf16x8*)(sW + swz(wn * 64 + i * 16 + fr, ks * 4 + fq));
        fa[i] = *(const bf16x8*)(sA + swz(wt * 64 + i * 16 + fr, ks * 4 + fq));
      }
#pragma unroll
      for (int ni = 0; ni < 4; ni++)
#pragma unroll
        for (int ti = 0; ti < 4; ti++) acc[ni][ti] = mfma16(fw[ni], fa[ti], acc[ni][ti]);
    }
    if (kt < 15) {
      char* dW = smem + ((kt + 1) & 1) * 32768;
#pragma unroll
      for (int i = 0; i < 4; i++) {
        *(uint4*)(dW + swz(lrow + i * 32, lch)) = rw[i];
        *(uint4*)(dW + 16384 + swz(lrow + i * 32, lch)) = ra[i];
      }
    }
    __syncthreads();
  }
}

enum { EPI_HG = 0, EPI_DNRET = 1, EPI_GATE = 2, EPI_OUT = 3 };

template <int EPI>
DI void gemm_tile(const Params& p, int l, int rt, int nti, char* smem) {
  const int WV = p.ph_hi;
  const int tid = tidx(), lane = tid & 63, wid = tid >> 6, wn = wid >> 1, wt = wid & 1;
  const int fr = lane & 15, fq = lane >> 4;
  const int row0 = rt * 128;
  const u16* WT = (const u16*)(p.ws + OFF_WT);
  const u16* A;
  int wrow, n0, mixer = 0;
  if (EPI == EPI_HG) { A = (const u16*)(p.ws + OFF_H); n0 = nti * 128; wrow = 6160 + n0; }
  else if (EPI == EPI_DNRET) { A = (const u16*)(p.ws + OFF_H); mixer = nti >> 4; n0 = (nti & 15) * 128; wrow = (mixer ? 3088 : 0) + n0; }
  else if (EPI == EPI_GATE) { A = (const u16*)(p.ws + OFF_H); mixer = nti >> 3; n0 = (nti & 7) * 128; wrow = (mixer == 0 ? 2048 : (mixer == 1 ? 5136 : 10256)) + n0; }
  else { A = (const u16*)(p.ws + OFF_B); n0 = nti * 128; wrow = W_OUT + n0; }
  f32x4 acc[4][4];
#pragma unroll
  for (int i = 0; i < 4; i++)
#pragma unroll
    for (int j = 0; j < 4; j++) acc[i][j] = f32x4{0.f, 0.f, 0.f, 0.f};
  gemm_kloop(A + (size_t)row0 * 1024, WT + (size_t)wrow * 1024, acc, smem, WV);

  const float* ROT = (const float*)(p.ws + OFF_ROT);
  const float* MOD = (const float*)(p.ws + OFF_MOD);
#pragma unroll
  for (int ti = 0; ti < 4; ti++) {
    const int token = row0 + wt * 64 + ti * 16 + fr;
#pragma unroll
    for (int ni = 0; ni < 4; ni++) {
      const int nl = n0 + wn * 64 + ni * 16 + fq * 4;
      f32x4 v = acc[ni][ti];
      if (EPI == EPI_HG) {
        if (nl < 1024) { v[0] = silu(v[0]); v[1] = silu(v[1]); v[2] = silu(v[2]); v[3] = silu(v[3]); }
        u16* dst = (u16*)(p.ws + OFF_A) + (size_t)token * 4096 + nl;
        *(uint2*)dst = uint2{pack2(v[0], v[1]), pack2(v[2], v[3])};
      } else if (EPI == EPI_DNRET) {
        if (mixer == 0) {
          uint2 pk = uint2{pack2(v[0], v[1]), pack2(v[2], v[3])};
          u16* dst = (u16*)(p.ws + OFF_A) + (size_t)token * 2048 + nl;
          *(uint2*)dst = pk;
          const int tm = token & 63;
          if (tm < 2 || tm >= 62) {
            const int slot = tm < 2 ? tm : tm - 60;
            u16* hd = (u16*)(p.ws + OFF_HALO) + ((size_t)(token >> 6) * 4 + slot) * 2048 + nl;
            *(uint2*)hd = pk;
          }
        } else {
          if (nl < 1024) {
            if (token < T_LAT) {
              const int t = token & 8191, ri = t >> 6, ci = t & 63;
              const int d = nl & 127;
#pragma unroll
              for (int pp = 0; pp < 2; pp++) {
                const int pidx = (d >> 1) + pp;
                const float* rp = pidx < 32 ? ROT + (ri * 32 + pidx) * 2 : ROT + (ci * 32 + (pidx - 32)) * 2;
                const float cs = rp[0], sn = rp[1];
                const float x1 = v[2 * pp], x2 = v[2 * pp + 1];
                v[2 * pp] = x1 * cs - x2 * sn;
                v[2 * pp + 1] = x1 * sn + x2 * cs;
              }
            }
            if (nl >= 512) { const float s = 0.08838834764831845f; v[0] *= s; v[1] *= s; v[2] *= s; v[3] *= s; }
          }
          u16* dst = (u16*)(p.ws + OFF_A + 2 * SZ_TOK1K) + (size_t)token * 2048 + nl;
          *(uint2*)dst = uint2{pack2(v[0], v[1]), pack2(v[2], v[3])};
        }
      } else if (EPI == EPI_GATE) {
        char* base = mixer == 0 ? p.ws + OFF_E : (mixer == 1 ? p.ws + OFF_E + SZ_TOK1K : p.ws + OFF_D);
        u16* dst = (u16*)base + (size_t)token * 1024 + nl;
        uint2 on = *(const uint2*)dst;
        float o0 = bf2f((u16)(on.x & 0xffff)), o1 = bf2f((u16)(on.x >> 16)), o2 = bf2f((u16)(on.y & 0xffff)), o3 = bf2f((u16)(on.y >> 16));
        *(uint2*)dst = uint2{pack2(o0 * silu(v[0]), o1 * silu(v[1])), pack2(o2 * silu(v[2]), o3 * silu(v[3]))};
      } else {
        const int vec = token < T_LAT ? (token >> 13) : 2;
        const f32x4 gt = *(const f32x4*)(MOD + ((size_t)l * 3 + vec) * 3072 + 2048 + nl);
        const float* src;
        float* dst;
        if (token < T_LAT) {
          src = (l == 0 ? p.x : (const float*)p.out) + (size_t)token * 1024 + nl;
          dst = p.out + (size_t)token * 1024 + nl;
        } else {
          src = p.ctx + (size_t)(token - T_LAT) * 1024 + nl;
          dst = (float*)(p.ws + OFF_CTX1) + (size_t)(token - T_LAT) * 1024 + nl;
        }
        f32x4 xi = *(const f32x4*)src;
        f32x4 r;
        r[0] = xi[0] + gt[0] * v[0]; r[1] = xi[1] + gt[1] * v[1]; r[2] = xi[2] + gt[2] * v[2]; r[3] = xi[3] + gt[3] * v[3];
        *(f32x4*)dst = r;
      }
    }
  }
}

DI void merge_tile(const Params& p, int rt, int nti, char* smem) {
  const int WV = p.ph_hi;
  const int tid = tidx(), lane = tid & 63, wid = tid >> 6, wn = wid >> 1, wt = wid & 1;
  const int fr = lane & 15, fq = lane >> 4;
  const int row0 = rt * 128, n0 = nti * 128;
  const u16* WT = (const u16*)(p.ws + OFF_WT);
  const u16* H = (const u16*)(p.ws + OFF_H) + (size_t)row0 * 1024;
  uint2 y[4][4];
#pragma unroll
  for (int i = 0; i < 4; i++)
#pragma unroll
    for (int j = 0; j < 4; j++) y[i][j] = uint2{0u, 0u};
  for (int m = 0; m < 3; m++) {
    uint2 sg[4][4];
    {
      f32x4 acc[4][4];
#pragma unroll
      for (int i = 0; i < 4; i++)
#pragma unroll
        for (int j = 0; j < 4; j++) acc[i][j] = f32x4{0.f, 0.f, 0.f, 0.f};
      gemm_kloop(H, WT + (size_t)(11280 + m * 1024 + n0) * 1024, acc, smem, WV);
#pragma unroll
      for (int i = 0; i < 4; i++)
#pragma unroll
        for (int j = 0; j < 4; j++)
          sg[i][j] = uint2{pack2(sigm(acc[i][j][0]), sigm(acc[i][j][1])), pack2(sigm(acc[i][j][2]), sigm(acc[i][j][3]))};
    }
    {
      const char* base = m == 0 ? p.ws + OFF_E : (m == 1 ? p.ws + OFF_E + SZ_TOK1K : p.ws + OFF_D);
      f32x4 acc[4][4];
#pragma unroll
      for (int i = 0; i < 4; i++)
#pragma unroll
        for (int j = 0; j < 4; j++) acc[i][j] = f32x4{0.f, 0.f, 0.f, 0.f};
      gemm_kloop((const u16*)base + (size_t)row0 * 1024, WT + (size_t)(W_BR + m * 1024 + n0) * 1024, acc, smem, WV);
#pragma unroll
      for (int i = 0; i < 4; i++)
#pragma unroll
        for (int j = 0; j < 4; j++) {
          const float y0 = bf2f((u16)(y[i][j].x & 0xffff)) + acc[i][j][0] * bf2f((u16)(sg[i][j].x & 0xffff));
          const float y1 = bf2f((u16)(y[i][j].x >> 16)) + acc[i][j][1] * bf2f((u16)(sg[i][j].x >> 16));
          const float y2 = bf2f((u16)(y[i][j].y & 0xffff)) + acc[i][j][2] * bf2f((u16)(sg[i][j].y & 0xffff));
          const float y3 = bf2f((u16)(y[i][j].y >> 16)) + acc[i][j][3] * bf2f((u16)(sg[i][j].y >> 16));
          y[i][j] = uint2{pack2(y0, y1), pack2(y2, y3)};
        }
    }
  }
  u16* Y = (u16*)(p.ws + OFF_B);
#pragma unroll
  for (int ti = 0; ti < 4; ti++) {
    const int token = row0 + wt * 64 + ti * 16 + fr;
#pragma unroll
    for (int ni = 0; ni < 4; ni++) {
      const int nl = n0 + wn * 64 + ni * 16 + fq * 4;
      *(uint2*)(Y + (size_t)token * 1024 + nl) = y[ni][ti];
    }
  }
}

DI void wconv_tile(const float* __restrict__ src, int N, int kt, int ntile, u16* __restrict__ dst, char* smem, const int WV) {
  float* s = (float*)smem;
  const int tid = tidx();
  const int k0 = kt * 64, n0 = ntile * 64;
#pragma unroll
  for (int i = 0; i < 4; i++) {
    const int r = (tid >> 4) + i * 16, c4 = (tid & 15) * 4;
    if (n0 + c4 < N) {
      f32x4 v = *(const f32x4*)(src + (size_t)(k0 + r) * N + n0 + c4);
      s[r * 65 + c4] = v[0]; s[r * 65 + c4 + 1] = v[1]; s[r * 65 + c4 + 2] = v[2]; s[r * 65 + c4 + 3] = v[3];
    }
  }
  __syncthreads();
#pragma unroll
  for (int i = 0; i < 2; i++) {
    const int id = tid + i * 256, n = id >> 3, kc = (id & 7) * 8;
    if (n0 + n < N) {
      uint4 o;
      o.x = pack2(s[(kc + 0) * 65 + n], s[(kc + 1) * 65 + n]);
      o.y = pack2(s[(kc + 2) * 65 + n], s[(kc + 3) * 65 + n]);
      o.z = pack2(s[(kc + 4) * 65 + n], s[(kc + 5) * 65 + n]);
      o.w = pack2(s[(kc + 6) * 65 + n], s[(kc + 7) * 65 + n]);
      *(uint4*)(dst + (size_t)(n0 + n) * 1024 + k0 + kc) = o;
    }
  }
  __syncthreads();
}
constexpr int WCONV_UNITS = 16 * 225 + 3 * 256 + 256;
DI void wconv_unit(const Params& p, int l, int u, char* smem) {
  const int WV = p.ph_hi;
  u16* WT = (u16*)(p.ws + OFF_WT);
  if (u < 16 * 225) wconv_tile(p.w_in + (size_t)l * 1024 * 14352, 14352, u / 225, u % 225, WT, smem, WV);
  else if (u < 16 * 225 + 768) {
    const int v = u - 16 * 225, m = v >> 8, r = v & 255;
    wconv_tile(p.w_branch + ((size_t)l * 3 + m) * 1024 * 1024, 1024, r >> 4, r & 15, WT + (size_t)(W_BR + m * 1024) * 1024, smem, WV);
  } else {
    const int r = u - 16 * 225 - 768;
    wconv_tile(p.w_out + (size_t)l * 1024 * 1024, 1024, r >> 4, r & 15, WT + (size_t)W_OUT * 1024, smem, WV);
  }
}

DI void adaln_unit(const Params& p, int u, char* smem) {
  const int WV = p.ph_hi;
  const int l = u / 48, ng = u % 48;
  const int tid = tidx(), lane = tid & 63, w = tid >> 6;
  const int n = ng * 64 + lane;
  const float* W = p.ada_w + (size_t)l * 1024 * 3072;
  float a0 = 0.f, a1 = 0.f, a2 = 0.f;
  for (int k = w * 256; k < w * 256 + 256; k++) {
    const float wv = W[(size_t)k * 3072 + n];
    a0 += silu(p.c[k]) * wv; a1 += silu(p.c[1024 + k]) * wv; a2 += silu(p.c_ctx[k]) * wv;
  }
  float* red = (float*)smem;
  red[(w * 3 + 0) * 64 + lane] = a0; red[(w * 3 + 1) * 64 + lane] = a1; red[(w * 3 + 2) * 64 + lane] = a2;
  __syncthreads();
  if (tid < 192) {
    const int vec = tid >> 6, ln = tid & 63;
    float s = red[(0 * 3 + vec) * 64 + ln] + red[(1 * 3 + vec) * 64 + ln] + red[(2 * 3 + vec) * 64 + ln] + red[(3 * 3 + vec) * 64 + ln];
    const int nn = ng * 64 + ln;
    ((float*)(p.ws + OFF_MOD))[((size_t)l * 3 + vec) * 3072 + nn] = s + p.ada_b[(size_t)l * 3072 + nn];
  }
  __syncthreads();
}

DI void phase_pro(const Params& p, char* smem) {
  const int WV = p.ph_hi;
  const int total = 96 + 16 + WCONV_UNITS;
  for (int u = blockIdx.x; u < total; u += gridDim.x) {
    if (u < 96) adaln_unit(p, u, smem);
    else if (u < 112) {
      const int id = (u - 96) * 256 + tidx();
      const int pos = id >> 5, m = id & 31;
      const float inv = powf(10000.f, -(float)(2 * m) / 64.f);
      float s, c;
      sincosf((float)pos * inv, &s, &c);
      float* ROT = (float*)(p.ws + OFF_ROT);
      ROT[id * 2] = c; ROT[id * 2 + 1] = s;
    } else wconv_unit(p, 0, u - 112, smem);
  }
}

DI void phase_norm(const Params& p, int l, char* smem) {
  const int WV = p.ph_hi;
  const int tid = tidx(), lane = tid & 63, w = tid >> 6;
  float* sW = (float*)smem;
  const float* win = p.w_in + (size_t)l * 1024 * 14352;
  for (int i = tid; i < 16 * 1024; i += 256) {
    const int k = i >> 4, cc = i & 15;
    sW[cc * 1024 + k] = win[(size_t)k * 14352 + 3072 + cc];
  }
  __syncthreads();
  const float* MOD = (const float*)(p.ws + OFF_MOD);
  const float* nw = p.norm_w + (size_t)l * 1024;
  u16* H = (u16*)(p.ws + OFF_H);
  float* GB = (float*)(p.ws + OFF_GB);
  for (int row = blockIdx.x * 4 + w; row < T_ALL; row += gridDim.x * 4) {
    const float* xr;
    int vec;
    if (row < T_LAT) { xr = (l == 0 ? p.x : (const float*)p.out) + (size_t)row * 1024; vec = row >> 13; }
    else { xr = (l == 0 ? p.ctx : (const float*)(p.ws + OFF_CTX1)) + (size_t)(row - T_LAT) * 1024; vec = 2; }
    const float* md = MOD + ((size_t)l * 3 + vec) * 3072;
    f32x4 xv[4];
    float ss = 0.f;
#pragma unroll
    for (int i = 0; i < 4; i++) {
      xv[i] = *(const f32x4*)(xr + i * 256 + lane * 4);
      ss += xv[i][0] * xv[i][0] + xv[i][1] * xv[i][1] + xv[i][2] * xv[i][2] + xv[i][3] * xv[i][3];
    }
    ss = wsum(ss);
    const float rstd = rsqrtf(ss * (1.f / 1024.f) + 1e-6f);
    float ab[16];
#pragma unroll
    for (int cc = 0; cc < 16; cc++) ab[cc] = 0.f;
#pragma unroll
    for (int i = 0; i < 4; i++) {
      const int k = i * 256 + lane * 4;
      const f32x4 wv = *(const f32x4*)(nw + k);
      const f32x4 sh = *(const f32x4*)(md + k);
      const f32x4 sc = *(const f32x4*)(md + 1024 + k);
      f32x4 h;
#pragma unroll
      for (int j = 0; j < 4; j++) h[j] = xv[i][j] * rstd * wv[j] * (1.f + sc[j]) + sh[j];
      *(uint2*)(H + (size_t)row * 1024 + k) = uint2{pack2(h[0], h[1]), pack2(h[2], h[3])};
      asm volatile("" ::: "memory");
#pragma unroll
      for (int cc = 0; cc < 16; cc++) {
        const f32x4 ww = *(const f32x4*)(sW + cc * 1024 + k);
        ab[cc] += h[0] * ww[0] + h[1] * ww[1] + h[2] * ww[2] + h[3] * ww[3];
      }
    }
#pragma unroll
    for (int cc = 0; cc < 16; cc++) ab[cc] = wsum(ab[cc]);
    if (lane < 16) {
      float v = 0.f;
#pragma unroll
      for (int cc = 0; cc < 16; cc++) if (lane == cc) v = ab[cc];
      float r;
      if (lane < 8) {
        const float A = __expf(p.dn_a_log[l * 8 + lane]);
        const float z = v + p.dn_dt_bias[l * 8 + lane];
        const float sp = z > 20.f ? z : log1pf(__expf(z));
        r = -A * sp;
      } else r = sigm(v);
      GB[(size_t)row * 16 + lane] = r;
    }
  }
  __syncthreads();
}

DI void xyT(const char* sX, const char* sY, int it, f32x4 (&acc)[4], const int WV) {
  const int lane = tidx() & 63, fr = lane & 15, fq = lane >> 4;
#pragma unroll
  for (int j = 0; j < 4; j++) acc[j] = f32x4{0.f, 0.f, 0.f, 0.f};
#pragma unroll
  for (int ks = 0; ks < 4; ks++) {
    const bf16x8 a = *(const bf16x8*)(sX + (it * 16 + fr) * 272 + (ks * 32 + fq * 8) * 2);
#pragma unroll
    for (int jt = 0; jt < 4; jt++) {
      const bf16x8 b = *(const bf16x8*)(sY + (jt * 16 + fr) * 272 + (ks * 32 + fq * 8) * 2);
      acc[jt] = mfma16(a, b, acc[jt]);
    }
  }
}

DI void dn_prep_unit(const Params& p, int l, int c, int h, char* smem) {
  const int WV = p.ph_hi;
  const int tid = tidx(), lane = tid & 63, w = tid >> 6;
  u16* QKV = (u16*)(p.ws + OFF_A);
  const u16* HALO = (const u16*)(p.ws + OFF_HALO);
  char* sQ = smem;
  char* sK = smem + 17408;
  float* sKK = (float*)(smem + 34816);
  float* sQK = (float*)(smem + 34816 + 16384);
  float* sGC = (float*)(smem + 34816 + 32768);
  float* sBT = sGC + 128;
  const int row0 = c * 64;
  {
    const int u = tid * 2;
    const int gcol = u < 128 ? h * 128 + u : (u < 256 ? 512 + h * 128 + (u - 128) : 1024 + h * 256 + (u - 256));
    bool first, last;
    if (c < 256) { first = (c & 127) == 0; last = (c & 127) == 127; }
    else { first = ((c - 256) & 3) == 0; last = ((c - 256) & 3) == 3; }
    const float* cw = p.dn_conv + (size_t)l * 5 * 2048 + gcol;
    float cw0[5], cw1[5];
#pragma unroll
    for (int j = 0; j < 5; j++) { cw0[j] = cw[j * 2048]; cw1[j] = cw[j * 2048 + 1]; }
    auto load_ext = [&](int e) -> unsigned {
      if (e < 2) return first ? 0u : *(const unsigned*)(HALO + ((size_t)(c - 1) * 4 + 2 + e) * 2048 + gcol);
      if (e >= 66) return last ? 0u : *(const unsigned*)(HALO + ((size_t)(c + 1) * 4 + (e - 66)) * 2048 + gcol);
      return *(const unsigned*)(QKV + (size_t)(row0 + e - 2) * 2048 + gcol);
    };
    unsigned cat[12];
#pragma unroll
    for (int i = 0; i < 4; i++) cat[i] = load_ext(i);
    for (int tb = 0; tb < 8; tb++) {
#pragma unroll
      for (int i = 0; i < 8; i++) cat[4 + i] = load_ext(4 + tb * 8 + i);
#pragma unroll
      for (int i = 0; i < 8; i++) {
        const int t = tb * 8 + i;
        float y0 = 0.f, y1 = 0.f;
#pragma unroll
        for (int j = 0; j < 5; j++) {
          y0 += cw0[j] * bf2f((u16)(cat[i + j] & 0xffff));
          y1 += cw1[j] * bf2f((u16)(cat[i + j] >> 16));
        }
        y0 = silu(y0); y1 = silu(y1);
        if (w < 2) {
          const float ss = wsum(y0 * y0 + y1 * y1);
          float rs = rsqrtf(ss + 1e-6f);
          if (w == 0) rs *= 0.08838834764831845f;
          y0 *= rs; y1 *= rs;
          const unsigned pk = pack2(y0, y1);
          *(unsigned*)((w == 0 ? sQ : sK) + t * 272 + (u & 127) * 2) = pk;
          *(unsigned*)(QKV + (size_t)(row0 + t) * 2048 + gcol) = pk;
        } else {
          *(unsigned*)(QKV + (size_t)(row0 + t) * 2048 + gcol) = pack2(y0, y1);
        }
      }
#pragma unroll
      for (int i = 0; i < 4; i++) cat[i] = cat[8 + i];
    }
  }
  if (w < 2) {
    const float* GB = (const float*)(p.ws + OFF_GB);
    const float g = GB[(size_t)(row0 + lane) * 16 + w * 4 + h];
    const float bt = GB[(size_t)(row0 + lane) * 16 + 8 + w * 4 + h];
    float s = g;
    if (w == 0) {
#pragma unroll
      for (int o = 1; o < 64; o <<= 1) { const float t = __shfl_up(s, o, 64); if (lane >= o) s += t; }
    } else {
#pragma unroll
      for (int o = 1; o < 64; o <<= 1) { const float t = __shfl_down(s, o, 64); if (lane + o < 64) s += t; }
    }
    const float gl = __shfl(s, w == 0 ? 63 : 0, 64);
    sGC[w * 64 + lane] = s;
    sBT[w * 64 + lane] = bt;
    float* SC = (float*)(p.ws + OFF_DNSC) + ((size_t)(c * 4 + h) * 2 + w) * 192;
    SC[lane] = __expf(s);
    SC[64 + lane] = __expf(gl - s);
    if (lane == 0) SC[128] = __expf(gl);
  }
  __syncthreads();
  {
    const int fr = lane & 15, fq = lane >> 4;
    f32x4 acc[4];
    xyT(sK, sK, w, acc, WV);
#pragma unroll
    for (int jt = 0; jt < 4; jt++)
#pragma unroll
      for (int j = 0; j < 4; j++) sKK[(w * 16 + fq * 4 + j) * 64 + jt * 16 + fr] = acc[jt][j];
    xyT(sQ, sK, w, acc, WV);
#pragma unroll
    for (int jt = 0; jt < 4; jt++)
#pragma unroll
      for (int j = 0; j < 4; j++) sQK[(w * 16 + fq * 4 + j) * 64 + jt * 16 + fr] = acc[jt][j];
  }
  __syncthreads();
  u16* AUX = (u16*)(p.ws + OFF_B) + (size_t)(c * 4 + h) * 4 * 4096;
#pragma unroll 2
  for (int e = 0; e < 32; e++) {
    const int id = tid + e * 256, dir = id >> 12, i = (id >> 6) & 63, j = id & 63;
    const bool valid = dir == 0 ? (j <= i) : (j >= i);
    float v = 0.f;
    if (valid) v = sQK[i * 64 + j] * __expf(sGC[dir * 64 + i] - sGC[dir * 64 + j]);
    AUX[(size_t)(dir * 2 + 1) * 4096 + i * 64 + j] = f2bf(v);
  }
  __syncthreads();
  float* sL0 = sQK;
  float* sL1 = (float*)smem;
#pragma unroll 2
  for (int e = 0; e < 32; e++) {
    const int id = tid + e * 256, dir = id >> 12, ip = (id >> 6) & 63, jp = id & 63;
    const int i = dir ? 63 - ip : ip, j = dir ? 63 - jp : jp;
    float v = 0.f;
    if (jp < ip) v = sBT[dir * 64 + i] * sKK[i * 64 + j] * __expf(sGC[dir * 64 + i] - sGC[dir * 64 + j]);
    (dir ? sL1 : sL0)[ip * 64 + jp] = v;
  }
  __syncthreads();
  if (w < 2) {
    const float* L = w ? sL1 : sL0;
    float* Xs = w ? (float*)(smem + 16384) : sKK;
    const int cn = w ? 63 - lane : lane;
    const float bc = sBT[w * 64 + cn];
    for (int ip = 0; ip < 64; ip++) {
      float a0 = (ip == lane) ? bc : 0.f, a1 = 0.f, a2 = 0.f, a3 = 0.f;
      int jp = 0;
      for (; jp + 4 <= ip; jp += 4) {
        const f32x4 l4 = *(const f32x4*)(L + ip * 64 + jp);
        a0 -= l4[0] * Xs[(jp + 0) * 64 + lane];
        a1 -= l4[1] * Xs[(jp + 1) * 64 + lane];
        a2 -= l4[2] * Xs[(jp + 2) * 64 + lane];
        a3 -= l4[3] * Xs[(jp + 3) * 64 + lane];
      }
      for (; jp < ip; jp++) a0 -= L[ip * 64 + jp] * Xs[jp * 64 + lane];
      const float a = (a0 + a1) + (a2 + a3);
      Xs[ip * 64 + lane] = a;
      const int i = w ? 63 - ip : ip;
      AUX[(size_t)(w * 2 + 0) * 4096 + i * 64 + cn] = f2bf(a);
    }
  }
  __syncthreads();
}

DI void ret_prep_unit(const Params& p, int l, int c, int h, char* smem) {
  const int WV = p.ph_hi;
  const int tid = tidx(), lane = tid & 63, w = tid >> 6;
  const u16* QKV = (const u16*)(p.ws + OFF_A + 2 * SZ_TOK1K);
  char* sQ = smem;
  char* sK = smem + 17408;
  const int row0 = c * 64;
#pragma unroll
  for (int i = 0; i < 4; i++) {
    const int id = tid + i * 256, r = id >> 4, ch = id & 15;
    *(uint4*)(sQ + r * 272 + ch * 16) = *(const uint4*)(QKV + (size_t)(row0 + r) * 2048 + h * 128 + ch * 8);
    *(uint4*)(sK + r * 272 + ch * 16) = *(const uint4*)(QKV + (size_t)(row0 + r) * 2048 + 512 + h * 128 + ch * 8);
  }
  __syncthreads();
  f32x4 acc[4];
  xyT(sQ, sK, w, acc, WV);
  const int fr = lane & 15, fq = lane >> 4;
  u16* AUX = (u16*)(p.ws + OFF_C) + (size_t)(c * 4 + h) * 2 * 4096;
#pragma unroll
  for (int dir = 0; dir < 2; dir++) {
    const float rd = p.ret_decay[l * 8 + dir * 4 + h];
    const float lam = fminf(rd, 0.f) - log1pf(__expf(-fabsf(rd)));
#pragma unroll
    for (int jt = 0; jt < 4; jt++)
#pragma unroll
      for (int j = 0; j < 4; j++) {
        const int i = w * 16 + fq * 4 + j, jj = jt * 16 + fr;
        const int dd = dir == 0 ? i - jj : jj - i;
        const float v = dd >= 0 ? acc[jt][j] * __expf(lam * (float)dd) : 0.f;
        AUX[(size_t)dir * 4096 + i * 64 + jj] = f2bf(v);
      }
  }
  __syncthreads();
}

DI void hg_prep_unit(const Params& p, int l, int c, int h, char* smem) {
  const int WV = p.ph_hi;
  const int tid = tidx();
  u16* QFI = (u16*)(p.ws + OFF_A);
  u16* HGX = (u16*)(p.ws + OFF_B);
  float* sG = (float*)smem;
  u16* sQ = (u16*)(smem + 32768);
  u16* sK = (u16*)(smem + 49152);
  float* sTot = (float*)(smem + 65536);
  const int row0 = c * 64;
#pragma unroll
  for (int i = 0; i < 4; i++) {
    const int id = tid + i * 256, r = id >> 4, ch = id & 15;
    const uint4 v = *(const uint4*)(QFI + (size_t)(row0 + r) * 4096 + h * 128 + ch * 8);
    const unsigned vv[4] = {v.x, v.y, v.z, v.w};
#pragma unroll
    for (int e = 0; e < 4; e++) {
      sQ[(ch * 8 + e * 2) * 64 + r] = (u16)(vv[e] & 0xffff);
      sQ[(ch * 8 + e * 2 + 1) * 64 + r] = (u16)(vv[e] >> 16);
    }
  }
  __syncthreads();
  const int half = tid >> 7, d = tid & 127;
#pragma unroll 1
  for (int dir = 1; dir >= 0; dir--) {
    float lo = 0.f;
    if (l == 1) {
      const float b0 = p.hg_lb[dir * 1024 + h * 128 + d], b1 = p.hg_lb[2048 + dir * 1024 + h * 128 + d];
      lo = sigm(b1 - b0);
    }
    float run = 0.f;
    {
      const u16* xs = QFI + (size_t)row0 * 4096 + 1024 + dir * 1024 + h * 128 + d;
      float xv[32];
#pragma unroll
      for (int i = 0; i < 32; i++) xv[i] = bf2f(xs[(size_t)(half * 32 + (dir == 0 ? i : 31 - i)) * 4096]);
#pragma unroll
      for (int i = 0; i < 32; i++) {
        const int ii = dir == 0 ? i : 31 - i;
        const int t = half * 32 + ii;
        const float x = xv[i];
        const float sg = sigm(x);
        const float f = lo + (1.f - lo) * sg;
        const float omf = (1.f - lo) * (1.f - sg);
        run += __log2f(f);
        sG[d * 64 + t] = run;
        sK[d * 64 + t] = f2bf(omf);
      }
      sTot[half * 128 + d] = run;
    }
    __syncthreads();
    {
      const float t0 = sTot[d], t1 = sTot[128 + d];
      const float gtot = t0 + t1;
      const float add = dir == 0 ? (half == 1 ? t0 : 0.f) : (half == 0 ? t1 : 0.f);
      u16* qdst = dir == 0 ? QFI + (size_t)row0 * 4096 + h * 128 + d : HGX + (size_t)row0 * 1024 + h * 128 + d;
      const size_t qp = dir == 0 ? 4096 : 1024;
      u16* kdst = QFI + (size_t)row0 * 4096 + 1024 + dir * 1024 + h * 128 + d;
#pragma unroll 8
      for (int i = 0; i < 32; i++) {
        const int t = half * 32 + i;
        const float G = sG[d * 64 + t] + add;
        sG[d * 64 + t] = G;
        qdst[(size_t)t * qp] = f2bf(bf2f(sQ[d * 64 + t]) * exp2f(G));
        kdst[(size_t)t * 4096] = f2bf(bf2f(sK[d * 64 + t]) * exp2f(gtot - G));
      }
      if (half == 0) ((float*)(p.ws + OFF_HGDEC))[((size_t)(c * 8 + h) * 2 + dir) * 128 + d] = exp2f(gtot);
    }
    __syncthreads();
    {
      const int lane = tid & 63, I = tid >> 6, fr = lane & 15, fq = lane >> 4;
      const int rt = dir == 0 ? I * 16 - 1 : I * 16 + 16;
      const bool hasref = dir == 0 ? (I > 0) : (I < 3);
      bf16x8 af[4];
#pragma unroll
      for (int ks = 0; ks < 4; ks++) {
        asm volatile("" ::: "memory");
#pragma unroll
        for (int j = 0; j < 8; j++) {
          const int dd = ks * 32 + fq * 8 + j;
          const float R = hasref ? sG[dd * 64 + rt] : 0.f;
          const float e = exp2f(fmaxf(sG[dd * 64 + I * 16 + fr] - R, -120.f));
          af[ks][j] = (short)f2bf(bf2f(sQ[dd * 64 + I * 16 + fr]) * e);
        }
      }
      u16* AUX = (u16*)(p.ws + OFF_C) + ((size_t)(c * 8 + h) * 2 + dir) * 4096;
#pragma unroll 1
      for (int J = 0; J < 4; J++) {
        const bool actv = dir == 0 ? (J <= I) : (J >= I);
        f32x4 acc = f32x4{0.f, 0.f, 0.f, 0.f};
        if (actv) {
#pragma unroll
          for (int ks = 0; ks < 4; ks++) {
            asm volatile("" ::: "memory");
            bf16x8 bfr;
#pragma unroll
            for (int j = 0; j < 8; j++) {
              const int dd = ks * 32 + fq * 8 + j;
              const float R = hasref ? sG[dd * 64 + rt] : 0.f;
              const float e = exp2f(fminf(R - sG[dd * 64 + J * 16 + fr], 120.f));
              bfr[j] = (short)f2bf(bf2f(sK[dd * 64 + J * 16 + fr]) * e);
            }
            acc = mfma16(af[ks], bfr, acc);
          }
        }
#pragma unroll
        for (int jj = 0; jj < 4; jj++) {
          const int i = I * 16 + fq * 4 + jj, j = J * 16 + fr;
          const bool valid = actv && (dir == 0 ? (j <= i) : (j >= i));
          AUX[i * 64 + j] = f2bf(valid ? acc[jj] : 0.f);
        }
      }
    }
    __syncthreads();
  }
}

struct ScanDesc {
  const u16 *q, *k, *v;
  int qp, kp, vp;
  const u16* aux;
  size_t aux_cs;
  int attn_off, ainv_off;
  u16* o;
  int mixer, b, dir;
  const float* sc;
  size_t sc_cs;
  float lam;
};

template <int MIXER>
DI void scan_unit(const ScanDesc& s, char* smem, const int WV) {
  const int tid = tidx(), lane = tid & 63, w = tid >> 6;
  const int fr = lane & 15, fq = lane >> 4;
  char* sQm = smem;
  char* sKm = smem + 17408;
  char* sKT = smem + 34816;
  char* sAT = smem + 53248;
  char* sAI = smem + 62464;
  float* sSC = (float*)(smem + 71680);
  f32x4 S[8];
#pragma unroll
  for (int i = 0; i < 8; i++) S[i] = f32x4{0.f, 0.f, 0.f, 0.f};
  for (int step = 0; step < 132; step++) {
    int c;
    if (s.dir == 0) c = step < 4 ? 256 + 4 * s.b + step : 128 * s.b + (step - 4);
    else c = step < 4 ? 256 + 4 * s.b + (3 - step) : 128 * s.b + (131 - step);
    const int row0 = c * 64;
    const u16* qbase = s.q + (size_t)row0 * s.qp;
    const u16* kbase = s.k + (size_t)row0 * s.kp;
    const u16* vbase = s.v + (size_t)row0 * s.vp;
#pragma unroll
    for (int i = 0; i < 4; i++) {
      const int id = tid + i * 256, r = id >> 4, ch = id & 15;
      *(uint4*)(sQm + r * 272 + ch * 16) = *(const uint4*)(qbase + (unsigned)(r * s.qp + ch * 8));
      const uint4 kv = *(const uint4*)(kbase + (unsigned)(r * s.kp + ch * 8));
      *(uint4*)(sKm + r * 272 + ch * 16) = kv;
      const unsigned vv[4] = {kv.x, kv.y, kv.z, kv.w};
#pragma unroll
      for (int e = 0; e < 4; e++) {
        *(u16*)(sKT + (ch * 8 + e * 2) * 144 + r * 2) = (u16)(vv[e] & 0xffff);
        *(u16*)(sKT + (ch * 8 + e * 2 + 1) * 144 + r * 2) = (u16)(vv[e] >> 16);
      }
    }
#pragma unroll
    for (int i = 0; i < 2; i++) {
      const int id = tid + i * 256, r = id >> 3, ch = id & 7;
      const u16* ab = s.aux + (size_t)c * s.aux_cs;
      *(uint4*)(sAT + r * 144 + ch * 16) = *(const uint4*)(ab + s.attn_off + (unsigned)(r * 64 + ch * 8));
      if (MIXER == 0) *(uint4*)(sAI + r * 144 + ch * 16) = *(const uint4*)(ab + s.ainv_off + (unsigned)(r * 64 + ch * 8));
    }
    float egl = 1.f;
    if (MIXER == 0) {
      const float* sc = s.sc + (size_t)c * s.sc_cs;
      if (tid < 128) sSC[tid] = sc[tid];
      egl = sc[128];
    } else if (MIXER == 1) {
      if (tid < 64) {
        const float e1 = s.dir == 0 ? (float)(tid + 1) : (float)(64 - tid);
        sSC[tid] = __expf(s.lam * e1);
        sSC[64 + tid] = __expf(s.lam * (64.f - e1));
      }
      egl = __expf(s.lam * 64.f);
    } else {
      if (tid < 128) sSC[tid] = s.sc[(size_t)c * s.sc_cs + tid];
    }
    f32x4 V[4];
#pragma unroll
    for (int mt = 0; mt < 4; mt++)
#pragma unroll
      for (int j = 0; j < 4; j++) V[mt][j] = bf2f(vbase[(unsigned)((mt * 16 + fq * 4 + j) * s.vp + w * 16 + fr)]);
    __syncthreads();
    bf16x8 Sb[4];
#pragma unroll
    for (int ks = 0; ks < 4; ks++) Sb[ks] = pack8(S[2 * ks], S[2 * ks + 1]);
    f32x4 vn[4];
    if (MIXER == 0) {
      f32x4 P[4];
#pragma unroll
      for (int mt = 0; mt < 4; mt++) {
        P[mt] = f32x4{0.f, 0.f, 0.f, 0.f};
#pragma unroll
        for (int ks = 0; ks < 4; ks++) P[mt] = mfma16(ld_perm(sKm + (mt * 16 + fr) * 272, ks * 32 + fq * 4), Sb[ks], P[mt]);
      }
#pragma unroll
      for (int mt = 0; mt < 4; mt++)
#pragma unroll
        for (int j = 0; j < 4; j++) P[mt][j] = V[mt][j] - sSC[mt * 16 + fq * 4 + j] * P[mt][j];
      bf16x8 rb[2];
#pragma unroll
      for (int ks = 0; ks < 2; ks++) rb[ks] = pack8(P[2 * ks], P[2 * ks + 1]);
#pragma unroll
      for (int mt = 0; mt < 4; mt++) {
        vn[mt] = f32x4{0.f, 0.f, 0.f, 0.f};
#pragma unroll
        for (int ks = 0; ks < 2; ks++) vn[mt] = mfma16(ld_perm(sAI + (mt * 16 + fr) * 144, ks * 32 + fq * 4), rb[ks], vn[mt]);
      }
    } else {
#pragma unroll
      for (int mt = 0; mt < 4; mt++) vn[mt] = V[mt];
    }
    bf16x8 vb[2];
#pragma unroll
    for (int ks = 0; ks < 2; ks++) vb[ks] = pack8(vn[2 * ks], vn[2 * ks + 1]);
    u16* obase = s.o + (size_t)row0 * 1024;
#pragma unroll
    for (int mt = 0; mt < 4; mt++) {
      f32x4 o0 = f32x4{0.f, 0.f, 0.f, 0.f};
#pragma unroll
      for (int ks = 0; ks < 4; ks++) o0 = mfma16(ld_perm(sQm + (mt * 16 + fr) * 272, ks * 32 + fq * 4), Sb[ks], o0);
      if (MIXER != 2) {
#pragma unroll
        for (int j = 0; j < 4; j++) o0[j] *= sSC[mt * 16 + fq * 4 + j];
      }
#pragma unroll
      for (int ks = 0; ks < 2; ks++) o0 = mfma16(ld_perm(sAT + (mt * 16 + fr) * 144, ks * 32 + fq * 4), vb[ks], o0);
#pragma unroll
      for (int j = 0; j < 4; j++) obase[(unsigned)((mt * 16 + fq * 4 + j) * 1024 + w * 16 + fr)] = f2bf(o0[j]);
    }
    if (MIXER != 2) {
#pragma unroll
      for (int mt = 0; mt < 4; mt++)
#pragma unroll
        for (int j = 0; j < 4; j++) vn[mt][j] *= sSC[64 + mt * 16 + fq * 4 + j];
#pragma unroll
      for (int ks = 0; ks < 2; ks++) vb[ks] = pack8(vn[2 * ks], vn[2 * ks + 1]);
    }
#pragma unroll
    for (int mt = 0; mt < 8; mt++) {
      if (MIXER == 2) {
#pragma unroll
        for (int j = 0; j < 4; j++) S[mt][j] *= sSC[mt * 16 + fq * 4 + j];
      } else {
#pragma unroll
        for (int j = 0; j < 4; j++) S[mt][j] *= egl;
      }
#pragma unroll
      for (int ks = 0; ks < 2; ks++) S[mt] = mfma16(ld_perm(sKT + (mt * 16 + fr) * 144, ks * 32 + fq * 4), vb[ks], S[mt]);
    }
    __syncthreads();
  }
}

DI void scan_phase_hg(const Params& p, char* smem) {
  const int WV = p.ph_hi;
  for (int u = blockIdx.x; u < 64; u += gridDim.x) {
    const int dir = u & 1, vg = (u >> 1) & 1, h = (u >> 2) & 7, b = u >> 5;
    ScanDesc s;
    s.q = dir == 0 ? (const u16*)(p.ws + OFF_A) + h * 128 : (const u16*)(p.ws + OFF_B) + h * 128;
    s.qp = dir == 0 ? 4096 : 1024;
    s.k = (const u16*)(p.ws + OFF_A) + 1024 + dir * 1024 + h * 128; s.kp = 4096;
    s.v = (const u16*)(p.ws + OFF_A) + 3072 + h * 128 + vg * 64; s.vp = 4096;
    s.aux = (const u16*)(p.ws + OFF_C) + (size_t)(h * 2 + dir) * 4096; s.aux_cs = 8 * 2 * 4096; s.attn_off = 0; s.ainv_off = 0;
    s.o = (u16*)(p.ws + OFF_D + (dir ? SZ_TOK1K : 0)) + h * 128 + vg * 64;
    s.mixer = 2; s.b = b; s.dir = dir;
    s.sc = (const float*)(p.ws + OFF_HGDEC) + (size_t)(h * 2 + dir) * 128; s.sc_cs = 8 * 2 * 128; s.lam = 0.f;
    scan_unit<2>(s, smem, WV);
  }
}
DI void scan_phase_dnret(const Params& p, int l, char* smem) {
  const int WV = p.ph_hi;
  for (int u = blockIdx.x; u < 128; u += gridDim.x) {
    const int mixer = u & 1, dir = (u >> 1) & 1, vg = (u >> 2) & 3, h = (u >> 4) & 3, b = u >> 6;
    ScanDesc s;
    const u16* base = (const u16*)(p.ws + OFF_A + (mixer ? 2 * SZ_TOK1K : 0));
    s.q = base + h * 128; s.k = base + 512 + h * 128; s.v = base + 1024 + h * 256 + vg * 64;
    s.qp = s.kp = s.vp = 2048;
    s.mixer = mixer; s.b = b; s.dir = dir;
    if (mixer == 0) {
      s.aux = (const u16*)(p.ws + OFF_B) + (size_t)(h * 2 + dir) * 2 * 4096; s.aux_cs = 4 * 4 * 4096; s.ainv_off = 0; s.attn_off = 4096;
      s.sc = (const float*)(p.ws + OFF_DNSC) + (size_t)(h * 2 + dir) * 192; s.sc_cs = 4 * 2 * 192; s.lam = 0.f;
      s.o = (u16*)(dir == 0 ? p.ws + OFF_E : p.ws + OFF_D + SZ_TOK1K) + h * 256 + vg * 64;
      scan_unit<0>(s, smem, WV);
    } else {
      s.aux = (const u16*)(p.ws + OFF_C) + (size_t)(h * 2 + dir) * 4096; s.aux_cs = 4 * 2 * 4096; s.attn_off = 0; s.ainv_off = 0;
      const float rd = p.ret_decay[l * 8 + dir * 4 + h];
      s.lam = fminf(rd, 0.f) - log1pf(__expf(-fabsf(rd)));
      s.sc = nullptr; s.sc_cs = 0;
      s.o = (u16*)(p.ws + OFF_E + (dir == 0 ? SZ_TOK1K : 2 * SZ_TOK1K)) + h * 256 + vg * 64;
      scan_unit<1>(s, smem, WV);
    }
  }
}

DI void onorm_rows(u16* of, const u16* ob, const float* nw, int dv, int unit, int nunits_stride, const int WV) {
  const int lane = tidx() & 63, w = tidx() >> 6;
  for (int row = unit * 4 + w; row < T_ALL; row += nunits_stride * 4) {
    u16* pf = of + (size_t)row * 1024 + lane * 16;
    const u16* pb = ob + (size_t)row * 1024 + lane * 16;
    float v[16];
#pragma unroll
    for (int hv = 0; hv < 2; hv++) {
      const uint4 a = *(const uint4*)(pf + hv * 8), b = *(const uint4*)(pb + hv * 8);
      const unsigned aa[4] = {a.x, a.y, a.z, a.w}, bb[4] = {b.x, b.y, b.z, b.w};
#pragma unroll
      for (int e = 0; e < 4; e++) {
        v[hv * 8 + e * 2] = bf2f((u16)(aa[e] & 0xffff)) + bf2f((u16)(bb[e] & 0xffff));
        v[hv * 8 + e * 2 + 1] = bf2f((u16)(aa[e] >> 16)) + bf2f((u16)(bb[e] >> 16));
      }
    }
    float ss = 0.f;
#pragma unroll
    for (int e = 0; e < 16; e++) ss += v[e] * v[e];
    const int nl = dv / 16;
    for (int o = 1; o < nl; o <<= 1) ss += __shfl_xor(ss, o, 64);
    const float rstd = rsqrtf(ss / (float)dv + 1e-6f);
    const int dcol = (lane * 16) % dv;
    unsigned o8[8];
#pragma unroll
    for (int e = 0; e < 8; e++) o8[e] = pack2(v[2 * e] * rstd * nw[dcol + 2 * e], v[2 * e + 1] * rstd * nw[dcol + 2 * e + 1]);
    *(uint4*)pf = uint4{o8[0], o8[1], o8[2], o8[3]};
    *(uint4*)(pf + 8) = uint4{o8[4], o8[5], o8[6], o8[7]};
  }
}

DI void final_norm(const Params& p) {
  const int WV = p.ph_hi;
  const int lane = tidx() & 63, w = tidx() >> 6;
  for (int row = blockIdx.x * 4 + w; row < T_LAT; row += gridDim.x * 4) {
    float* xr = p.out + (size_t)row * 1024;
    f32x4 xv[4];
    float ss = 0.f;
#pragma unroll
    for (int i = 0; i < 4; i++) {
      xv[i] = *(const f32x4*)(xr + i * 256 + lane * 4);
      ss += xv[i][0] * xv[i][0] + xv[i][1] * xv[i][1] + xv[i][2] * xv[i][2] + xv[i][3] * xv[i][3];
    }
    ss = wsum(ss);
    const float rstd = rsqrtf(ss * (1.f / 1024.f) + 1e-6f);
#pragma unroll
    for (int i = 0; i < 4; i++) {
      const f32x4 wv = *(const f32x4*)(p.final_norm_w + i * 256 + lane * 4);
      f32x4 r;
#pragma unroll
      for (int j = 0; j < 4; j++) r[j] = xv[i][j] * rstd * wv[j];
      *(f32x4*)(xr + i * 256 + lane * 4) = r;
    }
  }
}

DI void run_phase(const Params& p, int ph, char* smem) {
  const int WV = p.ph_hi;
  const int G = gridDim.x, B = blockIdx.x;
  if (ph == 0) { if (QSEL(11)) phase_pro(p, smem); return; }
  if (ph == 23) { if (QSEL(12)) final_norm(p); return; }
  const int l = (ph - 1) / 11, q = (ph - 1) % 11;
  const bool last = l == 1;
  switch (q) {
    case 0: if (!QSEL(0)) break;
      if (l == 1) for (int u = B; u < WCONV_UNITS; u += G) wconv_unit(p, 1, u, smem);
      phase_norm(p, l, smem);
      break;
    case 1: if (!QSEL(1)) break;
      for (int t = B; t < 132 * 32; t += G) gemm_tile<EPI_HG>(p, l, t % 132, t / 132, smem);
      break;
    case 2: if (!QSEL(2)) break;
      for (int u = B; u < NCH * 8; u += G) hg_prep_unit(p, l, u >> 3, u & 7, smem);
      break;
    case 3: if (!QSEL(3)) break; scan_phase_hg(p, smem); break;
    case 4: if (!QSEL(4)) break;
      for (int t = B; t < 132 * 32; t += G) gemm_tile<EPI_DNRET>(p, l, t % 132, t / 132, smem);
      onorm_rows((u16*)(p.ws + OFF_D), (const u16*)(p.ws + OFF_D + SZ_TOK1K), p.hg_norm_w + l * 128, 128, B, G, WV);
      break;
    case 5: if (!QSEL(5)) break;
      for (int u = B; u < NCH * 8; u += G) {
        if (u < NCH * 4) dn_prep_unit(p, l, u >> 2, u & 3, smem);
        else ret_prep_unit(p, l, (u - NCH * 4) >> 2, u & 3, smem);
      }
      break;
    case 6: if (!QSEL(6)) break; scan_phase_dnret(p, l, smem); break;
    case 7: if (!QSEL(7)) break;
      onorm_rows((u16*)(p.ws + OFF_E), (const u16*)(p.ws + OFF_D + SZ_TOK1K), p.dn_norm_w + l * 256, 256, B, G, WV);
      onorm_rows((u16*)(p.ws + OFF_E + SZ_TOK1K), (const u16*)(p.ws + OFF_E + 2 * SZ_TOK1K), p.ret_norm_w + l * 256, 256, B, G, WV);
      break;
    case 8: if (!QSEL(8)) break; {
      const int nrt = last ? 128 : 132;
      for (int t = B; t < nrt * 24; t += G) gemm_tile<EPI_GATE>(p, l, t % nrt, t / nrt, smem);
    } break;
    case 9: if (!QSEL(9)) break; {
      const int nrt = last ? 128 : 132;
      for (int t = B; t < nrt * 8; t += G) merge_tile(p, t % nrt, t / nrt, smem);
    } break;
    case 10: if (!QSEL(10)) break; {
      const int nrt = last ? 128 : 132;
      for (int t = B; t < nrt * 8; t += G) gemm_tile<EPI_OUT>(p, l, t % nrt, t / nrt, smem);
    } break;
  }
}

DI void grid_barrier(unsigned* ctr, unsigned target) {
  asm volatile("s_waitcnt vmcnt(0) lgkmcnt(0)" ::: "memory");
  __syncthreads();
  if (__builtin_amdgcn_workitem_id_x() == 0) {
    __builtin_amdgcn_fence(__ATOMIC_RELEASE, "agent");
    asm volatile("s_waitcnt vmcnt(0)" ::: "memory");
    __hip_atomic_fetch_add(ctr, 1u, __ATOMIC_RELAXED, __HIP_MEMORY_SCOPE_AGENT);
    while (__hip_atomic_load(ctr, __ATOMIC_RELAXED, __HIP_MEMORY_SCOPE_AGENT) < target) __builtin_amdgcn_s_sleep(1);
    __builtin_amdgcn_fence(__ATOMIC_ACQUIRE, "agent");
    asm volatile("s_waitcnt vmcnt(0)" ::: "memory");
  }
  __syncthreads();
}

__global__ void __launch_bounds__(256, 2) mk(Params p) {
  extern __shared__ __attribute__((aligned(16))) char smem[];
  p.ph_hi = __builtin_amdgcn_readfirstlane((int)__builtin_amdgcn_workitem_id_x() >> 6);
#if ONE_LAUNCH
  cg::grid_group grid = cg::this_grid();
  unsigned* bar = (unsigned*)(p.ws + OFF_BAR);
  const unsigned G = gridDim.x;
  run_phase(p, 0, smem);
  grid.sync();
#define PH(n) run_phase(p, n, smem); grid_barrier(bar, (unsigned)(n) * G);
  PH(1) PH(2) PH(3) PH(4) PH(5) PH(6) PH(7) PH(8) PH(9) PH(10) PH(11)
  PH(12) PH(13) PH(14) PH(15) PH(16) PH(17) PH(18) PH(19) PH(20) PH(21) PH(22)
  run_phase(p, 23, smem);
#else
  run_phase(p, p.ph_lo, smem);
#endif
}

extern "C" void kernel_launch(void* const* d_in, const int* in_sizes, int n_in, void* d_out,
                              int out_size, void* d_ws, size_t ws_size, hipStream_t stream) {
  static int grid_blocks = 0;
  if (!grid_blocks) {
    int dev = 0, cus = 0, per_cu = 0;
    (void)hipGetDevice(&dev);
    (void)hipDeviceGetAttribute(&cus, hipDeviceAttributeMultiprocessorCount, dev);
    (void)hipFuncSetAttribute((const void*)mk, hipFuncAttributeMaxDynamicSharedMemorySize, SMEM_BYTES);
    (void)hipOccupancyMaxActiveBlocksPerMultiprocessor(&per_cu, mk, 256, SMEM_BYTES);
    if (per_cu > 2) per_cu = 2;
    if (per_cu < 1) per_cu = 1;
    grid_blocks = cus * per_cu;
  }
  Params p{};
  const float** f = (const float**)&p;
  for (int i = 0; i < 19; i++) f[i] = (const float*)d_in[i];
  p.out = (float*)d_out;
  p.ws = (char*)d_ws;
#if ONE_LAUNCH
  p.ph_lo = 0; p.ph_hi = 24;
  (void)hipMemsetAsync((char*)d_ws + OFF_BAR, 0, 256, stream);
  void* args[] = {&p};
  (void)hipLaunchCooperativeKernel((void*)mk, dim3(grid_blocks), dim3(256), args, SMEM_BYTES, stream);
#else
  for (int ph = 0; ph < 24; ph++) {
    p.ph_lo = ph; p.ph_hi = ph + 1;
    void* args[] = {&p};
    (void)hipLaunchCooperativeKernel((void*)mk, dim3(grid_blocks), dim3(256), args, SMEM_BYTES, stream);
  }
#endif
}
```

```cpp
#include <hip/hip_runtime.h>
#include <hip/hip_cooperative_groups.h>
#include <cstdio>
namespace cg = cooperative_groups;

#ifndef ONE_LAUNCH
#define ONE_LAUNCH 1
#endif
#ifndef ONLY_Q
#define ONLY_Q -1
#endif
#define QSEL(n) (ONLY_Q < 0 || ONLY_Q == (n))

typedef unsigned short u16;
using bf16x8 = __attribute__((ext_vector_type(8))) short;
using bf16x4 = __attribute__((ext_vector_type(4))) short;
using f32x4 = __attribute__((ext_vector_type(4))) float;
using u32x4 = __attribute__((ext_vector_type(4))) unsigned;
#define DI __device__ __forceinline__

constexpr int T_LAT = 16384, T_ALL = 16896, NCH = 264;
constexpr int WROWS = 18448;
constexpr int W_BR = 14352, W_OUT = 17424;
constexpr size_t al(size_t x) { return (x + 255) & ~(size_t)255; }
constexpr size_t SZ_WT = (size_t)WROWS * 1024 * 2;
constexpr size_t SZ_TOK1K = (size_t)T_ALL * 1024 * 2;
constexpr size_t OFF_WT = 0;
constexpr size_t OFF_H = OFF_WT + al(SZ_WT);
constexpr size_t OFF_MOD = OFF_H + al(SZ_TOK1K);
constexpr size_t OFF_ROT = OFF_MOD + al(2 * 3 * 3072 * 4);
constexpr size_t OFF_GB = OFF_ROT + al(128 * 32 * 2 * 4);
constexpr size_t OFF_CTX1 = OFF_GB + al((size_t)T_ALL * 16 * 4);
constexpr size_t OFF_HALO = OFF_CTX1 + al(512 * 1024 * 4);
constexpr size_t OFF_DNSC = OFF_HALO + al((size_t)NCH * 4 * 2048 * 2);
constexpr size_t OFF_HGDEC = OFF_DNSC + al((size_t)NCH * 4 * 2 * 192 * 4);
constexpr size_t OFF_BAR = OFF_HGDEC + al((size_t)NCH * 8 * 2 * 128 * 4);
constexpr size_t OFF_A = OFF_BAR + 4096;
constexpr size_t OFF_B = OFF_A + 4 * SZ_TOK1K;
constexpr size_t OFF_C = OFF_B + SZ_TOK1K;
constexpr size_t OFF_D = OFF_C + SZ_TOK1K;
constexpr size_t OFF_E = OFF_D + 2 * SZ_TOK1K;
constexpr size_t WS_TOTAL = OFF_E + 3 * SZ_TOK1K;
static_assert(WS_TOTAL <= 470286336ull, "workspace too large");

constexpr int SMEM_BYTES = 72960;

struct Params {
  const float *x, *c, *ctx, *c_ctx, *norm_w, *ada_w, *ada_b, *w_in, *dn_conv, *dn_a_log, *dn_dt_bias, *dn_norm_w,
      *ret_decay, *ret_norm_w, *hg_lb, *hg_norm_w, *w_branch, *w_out, *final_norm_w;
  float* out;
  char* ws;
  int ph_lo, ph_hi;
};

DI int laneid_v() { int t; asm volatile("v_mbcnt_lo_u32_b32 %0, -1, 0\n\tv_mbcnt_hi_u32_b32 %0, -1, %0" : "=v"(t)); return t; }
#define tidx() (WV * 64 + laneid_v())
DI u16 f2bf(float f) { unsigned u = __float_as_uint(f); u += 0x7fffu + ((u >> 16) & 1u); return (u16)(u >> 16); }
DI float bf2f(u16 h) { return __uint_as_float(((unsigned)h) << 16); }
DI unsigned pack2(float a, float b) { return (unsigned)f2bf(a) | ((unsigned)f2bf(b) << 16); }
DI float sigm(float x) { return 1.f / (1.f + __expf(-x)); }
DI float silu(float x) { return x / (1.f + __expf(-x)); }
DI float wsum(float v) {
#pragma unroll
  for (int o = 32; o > 0; o >>= 1) v += __shfl_xor(v, o, 64);
  return v;
}
DI f32x4 mfma16(bf16x8 a, bf16x8 b, f32x4 c) { return __builtin_amdgcn_mfma_f32_16x16x32_bf16(a, b, c, 0, 0, 0); }
DI bf16x8 pack8(f32x4 lo, f32x4 hi) {
  bf16x8 r;
  r[0] = (short)f2bf(lo[0]); r[1] = (short)f2bf(lo[1]); r[2] = (short)f2bf(lo[2]); r[3] = (short)f2bf(lo[3]);
  r[4] = (short)f2bf(hi[0]); r[5] = (short)f2bf(hi[1]); r[6] = (short)f2bf(hi[2]); r[7] = (short)f2bf(hi[3]);
  return r;
}
typedef __attribute__((address_space(3))) bf16x4* lds_v4p;
DI bf16x8 ld_tr2(unsigned a_lo, unsigned a_hi) {
  const bf16x4 lo = __builtin_amdgcn_ds_read_tr16_b64_v4i16((lds_v4p)(size_t)a_lo);
  const bf16x4 hi = __builtin_amdgcn_ds_read_tr16_b64_v4i16((lds_v4p)(size_t)a_hi);
  bf16x8 r;
  r[0] = lo[0]; r[1] = lo[1]; r[2] = lo[2]; r[3] = lo[3]; r[4] = hi[0]; r[5] = hi[1]; r[6] = hi[2]; r[7] = hi[3];
  return r;
}
DI bf16x8 ld_perm(const char* rowp, int c0) {
  bf16x4 lo = *(const bf16x4*)(rowp + c0 * 2);
  bf16x4 hi = *(const bf16x4*)(rowp + c0 * 2 + 32);
  bf16x8 r;
  r[0] = lo[0]; r[1] = lo[1]; r[2] = lo[2]; r[3] = lo[3]; r[4] = hi[0]; r[5] = hi[1]; r[6] = hi[2]; r[7] = hi[3];
  return r;
}

DI int swz(int row, int ch) { return row * 128 + ((ch ^ (row & 7)) << 4); }

DI void gemm_kloop(const u16* __restrict__ A, const u16* __restrict__ W, f32x4 (&acc)[4][4], char* smem, const int WV) {
  const int tid = tidx(), lane = tid & 63, wid = tid >> 6, wn = wid >> 1, wt = wid & 1;
  const int fr = lane & 15, fq = lane >> 4;
  uint4 ra[4], rw[4];
  const int lrow = tid >> 3, lch = tid & 7;
  const u16* Ap = A + (size_t)lrow * 1024 + lch * 8;
  const u16* Wp = W + (size_t)lrow * 1024 + lch * 8;
#pragma unroll
  for (int i = 0; i < 4; i++) {
    ra[i] = *(const uint4*)(Ap + (size_t)i * 32 * 1024);
    rw[i] = *(const uint4*)(Wp + (size_t)i * 32 * 1024);
  }
#pragma unroll
  for (int i = 0; i < 4; i++) {
    *(uint4*)(smem + swz(lrow + i * 32, lch)) = rw[i];
    *(uint4*)(smem + 16384 + swz(lrow + i * 32, lch)) = ra[i];
  }
  __syncthreads();
  for (int kt = 0; kt < 16; kt++) {
    if (kt < 15) {
#pragma unroll
      for (int i = 0; i < 4; i++) {
        ra[i] = *(const uint4*)(Ap + (size_t)i * 32 * 1024 + (kt + 1) * 64);
        rw[i] = *(const uint4*)(Wp + (size_t)i * 32 * 1024 + (kt + 1) * 64);
      }
    }
    const char* sW = smem + (kt & 1) * 32768;
    const char* sA = sW + 16384;
#pragma unroll
    for (int ks = 0; ks < 2; ks++) {
      bf16x8 fw[4], fa[4];
#pragma unroll
      for (int i = 0; i < 4; i++) {
        fw[i] = *(const bf16x8*)(sW + swz(wn * 64 + i * 16 + fr, ks * 4 + fq));
        fa[i] = *(const bf16x8*)(sA + swz(wt * 64 + i * 16 + fr, ks * 4 + fq));
      }
#pragma unroll
      for (int ni = 0; ni < 4; ni++)
#pragma unroll
        for (int ti = 0; ti < 4; ti++) acc[ni][ti] = mfma16(fw[ni], fa[ti], acc[ni][ti]);
    }
    if (kt < 15) {
      char* dW = smem + ((kt + 1) & 1) * 32768;
#pragma unroll
      for (int i = 0; i < 4; i++) {
        *(uint4*)(dW + swz(lrow + i * 32, lch)) = rw[i];
        *(uint4*)(dW + 16384 + swz(lrow + i * 32, lch)) = ra[i];
      }
    }
    __syncthreads();
  }
}

enum { EPI_HG = 0, EPI_DNRET = 1, EPI_GATE = 2, EPI_OUT = 3 };

template <int EPI>
DI void gemm_tile(const Params& p, int l, int rt, int nti, char* smem) {
  const int WV = p.ph_hi;
  const int tid = tidx(), lane = tid & 63, wid = tid >> 6, wn = wid >> 1, wt = wid & 1;
  const int fr = lane & 15, fq = lane >> 4;
  const int row0 = rt * 128;
  const u16* WT = (const u16*)(p.ws + OFF_WT);
  const u16* A;
  int wrow, n0, mixer = 0;
  if (EPI == EPI_HG) { A = (const u16*)(p.ws + OFF_H); n0 = nti * 128; wrow = 6160 + n0; }
  else if (EPI == EPI_DNRET) { A = (const u16*)(p.ws + OFF_H); mixer = nti >> 4; n0 = (nti & 15) * 128; wrow = (mixer ? 3088 : 0) + n0; }
  else if (EPI == EPI_GATE) { A = (const u16*)(p.ws + OFF_H); mixer = nti >> 3; n0 = (nti & 7) * 128; wrow = (mixer == 0 ? 2048 : (mixer == 1 ? 5136 : 10256)) + n0; }
  else { A = (const u16*)(p.ws + OFF_B); n0 = nti * 128; wrow = W_OUT + n0; }
  f32x4 acc[4][4];
#pragma unroll
  for (int i = 0; i < 4; i++)
#pragma unroll
    for (int j = 0; j < 4; j++) acc[i][j] = f32x4{0.f, 0.f, 0.f, 0.f};
  gemm_kloop(A + (size_t)row0 * 1024, WT + (size_t)wrow * 1024, acc, smem, WV);

  const float* ROT = (const float*)(p.ws + OFF_ROT);
  const float* MOD = (const float*)(p.ws + OFF_MOD);
#pragma unroll
  for (int ti = 0; ti < 4; ti++) {
    const int token = row0 + wt * 64 + ti * 16 + fr;
#pragma unroll
    for (int ni = 0; ni < 4; ni++) {
      const int nl = n0 + wn * 64 + ni * 16 + fq * 4;
      f32x4 v = acc[ni][ti];
      if (EPI == EPI_HG) {
        if (nl < 1024) { v[0] = silu(v[0]); v[1] = silu(v[1]); v[2] = silu(v[2]); v[3] = silu(v[3]); }
        u16* dst = (u16*)(p.ws + OFF_A) + (size_t)token * 4096 + nl;
        *(uint2*)dst = uint2{pack2(v[0], v[1]), pack2(v[2], v[3])};
      } else if (EPI == EPI_DNRET) {
        if (mixer == 0) {
          uint2 pk = uint2{pack2(v[0], v[1]), pack2(v[2], v[3])};
          u16* dst = (u16*)(p.ws + OFF_A) + (size_t)token * 2048 + nl;
          *(uint2*)dst = pk;
          const int tm = token & 63;
          if (tm < 2 || tm >= 62) {
            const int slot = tm < 2 ? tm : tm - 60;
            u16* hd = (u16*)(p.ws + OFF_HALO) + ((size_t)(token >> 6) * 4 + slot) * 2048 + nl;
            *(uint2*)hd = pk;
          }
        } else {
          if (nl < 1024) {
            if (token < T_LAT) {
              const int t = token & 8191, ri = t >> 6, ci = t & 63;
              const int d = nl & 127;
#pragma unroll
              for (int pp = 0; pp < 2; pp++) {
                const int pidx = (d >> 1) + pp;
                const float* rp = pidx < 32 ? ROT + (ri * 32 + pidx) * 2 : ROT + (ci * 32 + (pidx - 32)) * 2;
                const float cs = rp[0], sn = rp[1];
                const float x1 = v[2 * pp], x2 = v[2 * pp + 1];
                v[2 * pp] = x1 * cs - x2 * sn;
                v[2 * pp + 1] = x1 * sn + x2 * cs;
              }
            }
            if (nl >= 512) { const float s = 0.08838834764831845f; v[0] *= s; v[1] *= s; v[2] *= s; v[3] *= s; }
          }
          u16* dst = (u16*)(p.ws + OFF_A + 2 * SZ_TOK1K) + (size_t)token * 2048 + nl;
          *(uint2*)dst = uint2{pack2(v[0], v[1]), pack2(v[2], v[3])};
        }
      } else if (EPI == EPI_GATE) {
        char* base = mixer == 0 ? p.ws + OFF_E : (mixer == 1 ? p.ws + OFF_E + SZ_TOK1K : p.ws + OFF_D);
        u16* dst = (u16*)base + (size_t)token * 1024 + nl;
        uint2 on = *(const uint2*)dst;
        float o0 = bf2f((u16)(on.x & 0xffff)), o1 = bf2f((u16)(on.x >> 16)), o2 = bf2f((u16)(on.y & 0xffff)), o3 = bf2f((u16)(on.y >> 16));
        *(uint2*)dst = uint2{pack2(o0 * silu(v[0]), o1 * silu(v[1])), pack2(o2 * silu(v[2]), o3 * silu(v[3]))};
      } else {
        const int vec = token < T_LAT ? (token >> 13) : 2;
        const f32x4 gt = *(const f32x4*)(MOD + ((size_t)l * 3 + vec) * 3072 + 2048 + nl);
        const float* src;
        float* dst;
        if (token < T_LAT) {
          src = (l == 0 ? p.x : (const float*)p.out) + (size_t)token * 1024 + nl;
          dst = p.out + (size_t)token * 1024 + nl;
        } else {
          src = p.ctx + (size_t)(token - T_LAT) * 1024 + nl;
          dst = (float*)(p.ws + OFF_CTX1) + (size_t)(token - T_LAT) * 1024 + nl;
        }
        f32x4 xi = *(const f32x4*)src;
        f32x4 r;
        r[0] = xi[0] + gt[0] * v[0]; r[1] = xi[1] + gt[1] * v[1]; r[2] = xi[2] + gt[2] * v[2]; r[3] = xi[3] + gt[3] * v[3];
        *(f32x4*)dst = r;
      }
    }
  }
}

DI void merge_tile(const Params& p, int rt, int nti, char* smem) {
  const int WV = p.ph_hi;
  const int tid = tidx(), lane = tid & 63, wid = tid >> 6, wn = wid >> 1, wt = wid & 1;
  const int fr = lane & 15, fq = lane >> 4;
  const int row0 = rt * 128, n0 = nti * 128;
  const u16* WT = (const u16*)(p.ws + OFF_WT);
  const u16* H = (const u16*)(p.ws + OFF_H) + (size_t)row0 * 1024;
  uint2 y[4][4];
#pragma unroll
  for (int i = 0; i < 4; i++)
#pragma unroll
    for (int j = 0; j < 4; j++) y[i][j] = uint2{0u, 0u};
  for (int m = 0; m < 3; m++) {
    uint2 sg[4][4];
    {
      f32x4 acc[4][4];
#pragma unroll
      for (int i = 0; i < 4; i++)
#pragma unroll
        for (int j = 0; j < 4; j++) acc[i][j] = f32x4{0.f, 0.f, 0.f, 0.f};
      gemm_kloop(H, WT + (size_t)(11280 + m * 1024 + n0) * 1024, acc, smem, WV);
#pragma unroll
      for (int i = 0; i < 4; i++)
#pragma unroll
        for (int j = 0; j < 4; j++)
          sg[i][j] = uint2{pack2(sigm(acc[i][j][0]), sigm(acc[i][j][1])), pack2(sigm(acc[i][j][2]), sigm(acc[i][j][3]))};
    }
    {
      const char* base = m == 0 ? p.ws + OFF_E : (m == 1 ? p.ws + OFF_E + SZ_TOK1K : p.ws + OFF_D);
      f32x4 acc[4][4];
#pragma unroll
      for (int i = 0; i < 4; i++)
#pragma unroll
        for (int j = 0; j < 4; j++) acc[i][j] = f32x4{0.f, 0.f, 0.f, 0.f};
      gemm_kloop((const u16*)base + (size_t)row0 * 1024, WT + (size_t)(W_BR + m * 1024 + n0) * 1024, acc, smem, WV);
#pragma unroll
      for (int i = 0; i < 4; i++)
#pragma unroll
        for (int j = 0; j < 4; j++) {
          const float y0 = bf2f((u16)(y[i][j].x & 0xffff)) + acc[i][j][0] * bf2f((u16)(sg[i][j].x & 0xffff));
          const float y1 = bf2f((u16)(y[i][j].x >> 16)) + acc[i][j][1] * bf2f((u16)(sg[i][j].x >> 16));
          const float y2 = bf2f((u16)(y[i][j].y & 0xffff)) + acc[i][j][2] * bf2f((u16)(sg[i][j].y & 0xffff));
          const float y3 = bf2f((u16)(y[i][j].y >> 16)) + acc[i][j][3] * bf2f((u16)(sg[i][j].y >> 16));
          y[i][j] = uint2{pack2(y0, y1), pack2(y2, y3)};
        }
    }
  }
  u16* Y = (u16*)(p.ws + OFF_B);
#pragma unroll
  for (int ti = 0; ti < 4; ti++) {
    const int token = row0 + wt * 64 + ti * 16 + fr;
#pragma unroll
    for (int ni = 0; ni < 4; ni++) {
      const int nl = n0 + wn * 64 + ni * 16 + fq * 4;
      *(uint2*)(Y + (size_t)token * 1024 + nl) = y[ni][ti];
    }
  }
}

DI void wconv_tile(const float* __restrict__ src, int N, int kt, int ntile, u16* __restrict__ dst, char* smem, const int WV) {
  float* s = (float*)smem;
  const int tid = tidx();
  const int k0 = kt * 64, n0 = ntile * 64;
#pragma unroll
  for (int i = 0; i < 4; i++) {
    const int r = (tid >> 4) + i * 16, c4 = (tid & 15) * 4;
    if (n0 + c4 < N) {
      f32x4 v = *(const f32x4*)(src + (size_t)(k0 + r) * N + n0 + c4);
      s[r * 65 + c4] = v[0]; s[r * 65 + c4 + 1] = v[1]; s[r * 65 + c4 + 2] = v[2]; s[r * 65 + c4 + 3] = v[3];
    }
  }
  __syncthreads();
#pragma unroll
  for (int i = 0; i < 2; i++) {
    const int id = tid + i * 256, n = id >> 3, kc = (id & 7) * 8;
    if (n0 + n < N) {
      uint4 o;
      o.x = pack2(s[(kc + 0) * 65 + n], s[(kc + 1) * 65 + n]);
      o.y = pack2(s[(kc + 2) * 65 + n], s[(kc + 3) * 65 + n]);
      o.z = pack2(s[(kc + 4) * 65 + n], s[(kc + 5) * 65 + n]);
      o.w = pack2(s[(kc + 6) * 65 + n], s[(kc + 7) * 65 + n]);
      *(uint4*)(dst + (size_t)(n0 + n) * 1024 + k0 + kc) = o;
    }
  }
  __syncthreads();
}
constexpr int WCONV_UNITS = 16 * 225 + 3 * 256 + 256;
DI void wconv_unit(const Params& p, int l, int u, char* smem) {
  const int WV = p.ph_hi;
  u16* WT = (u16*)(p.ws + OFF_WT);
  if (u < 16 * 225) wconv_tile(p.w_in + (size_t)l * 1024 * 14352, 14352, u / 225, u % 225, WT, smem, WV);
  else if (u < 16 * 225 + 768) {
    const int v = u - 16 * 225, m = v >> 8, r = v & 255;
    wconv_tile(p.w_branch + ((size_t)l * 3 + m) * 1024 * 1024, 1024, r >> 4, r & 15, WT + (size_t)(W_BR + m * 1024) * 1024, smem, WV);
  } else {
    const int r = u - 16 * 225 - 768;
    wconv_tile(p.w_out + (size_t)l * 1024 * 1024, 1024, r >> 4, r & 15, WT + (size_t)W_OUT * 1024, smem, WV);
  }
}

DI void adaln_unit(const Params& p, int u, char* smem) {
  const int WV = p.ph_hi;
  const int l = u / 48, ng = u % 48;
  const int tid = tidx(), lane = tid & 63, w = tid >> 6;
  const int n = ng * 64 + lane;
  const float* W = p.ada_w + (size_t)l * 1024 * 3072;
  float a0 = 0.f, a1 = 0.f, a2 = 0.f;
  for (int k = w * 256; k < w * 256 + 256; k++) {
    const float wv = W[(size_t)k * 3072 + n];
    a0 += silu(p.c[k]) * wv; a1 += silu(p.c[1024 + k]) * wv; a2 += silu(p.c_ctx[k]) * wv;
  }
  float* red = (float*)smem;
  red[(w * 3 + 0) * 64 + lane] = a0; red[(w * 3 + 1) * 64 + lane] = a1; red[(w * 3 + 2) * 64 + lane] = a2;
  __syncthreads();
  if (tid < 192) {
    const int vec = tid >> 6, ln = tid & 63;
    float s = red[(0 * 3 + vec) * 64 + ln] + red[(1 * 3 + vec) * 64 + ln] + red[(2 * 3 + vec) * 64 + ln] + red[(3 * 3 + vec) * 64 + ln];
    const int nn = ng * 64 + ln;
    ((float*)(p.ws + OFF_MOD))[((size_t)l * 3 + vec) * 3072 + nn] = s + p.ada_b[(size_t)l * 3072 + nn];
  }
  __syncthreads();
}

DI void phase_pro(const Params& p, char* smem) {
  const int WV = p.ph_hi;
  const int total = 96 + 16 + WCONV_UNITS;
  for (int u = blockIdx.x; u < total; u += gridDim.x) {
    if (u < 96) adaln_unit(p, u, smem);
    else if (u < 112) {
      const int id = (u - 96) * 256 + tidx();
      const int pos = id >> 5, m = id & 31;
      const float inv = powf(10000.f, -(float)(2 * m) / 64.f);
      float s, c;
      sincosf((float)pos * inv, &s, &c);
      float* ROT = (float*)(p.ws + OFF_ROT);
      ROT[id * 2] = c; ROT[id * 2 + 1] = s;
    } else wconv_unit(p, 0, u - 112, smem);
  }
}

DI void phase_norm(const Params& p, int l, char* smem) {
  const int WV = p.ph_hi;
  const int tid = tidx(), lane = tid & 63, w = tid >> 6;
  float* sW = (float*)smem;
  const float* win = p.w_in + (size_t)l * 1024 * 14352;
  for (int i = tid; i < 16 * 1024; i += 256) {
    const int k = i >> 4, cc = i & 15;
    sW[cc * 1024 + k] = win[(size_t)k * 14352 + 3072 + cc];
  }
  __syncthreads();
  const float* MOD = (const float*)(p.ws + OFF_MOD);
  const float* nw = p.norm_w + (size_t)l * 1024;
  u16* H = (u16*)(p.ws + OFF_H);
  float* GB = (float*)(p.ws + OFF_GB);
  for (int row = blockIdx.x * 4 + w; row < T_ALL; row += gridDim.x * 4) {
    const float* xr;
    int vec;
    if (row < T_LAT) { xr = (l == 0 ? p.x : (const float*)p.out) + (size_t)row * 1024; vec = row >> 13; }
    else { xr = (l == 0 ? p.ctx : (const float*)(p.ws + OFF_CTX1)) + (size_t)(row - T_LAT) * 1024; vec = 2; }
    const float* md = MOD + ((size_t)l * 3 + vec) * 3072;
    f32x4 xv[4];
    float ss = 0.f;
#pragma unroll
    for (int i = 0; i < 4; i++) {
      xv[i] = *(const f32x4*)(xr + i * 256 + lane * 4);
      ss += xv[i][0] * xv[i][0] + xv[i][1] * xv[i][1] + xv[i][2] * xv[i][2] + xv[i][3] * xv[i][3];
    }
    ss = wsum(ss);
    const float rstd = rsqrtf(ss * (1.f / 1024.f) + 1e-6f);
    float ab[16];
#pragma unroll
    for (int cc = 0; cc < 16; cc++) ab[cc] = 0.f;
#pragma unroll
    for (int i = 0; i < 4; i++) {
      const int k = i * 256 + lane * 4;
      const f32x4 wv = *(const f32x4*)(nw + k);
      const f32x4 sh = *(const f32x4*)(md + k);
      const f32x4 sc = *(const f32x4*)(md + 1024 + k);
      f32x4 h;
#pragma unroll
      for (int j = 0; j < 4; j++) h[j] = xv[i][j] * rstd * wv[j] * (1.f + sc[j]) + sh[j];
      *(uint2*)(H + (size_t)row * 1024 + k) = uint2{pack2(h[0], h[1]), pack2(h[2], h[3])};
      asm volatile("" ::: "memory");
#pragma unroll
      for (int cc = 0; cc < 16; cc++) {
        const f32x4 ww = *(const f32x4*)(sW + cc * 1024 + k);
        ab[cc] += h[0] * ww[0] + h[1] * ww[1] + h[2] * ww[2] + h[3] * ww[3];
      }
    }
#pragma unroll
    for (int cc = 0; cc < 16; cc++) ab[cc] = wsum(ab[cc]);
    if (lane < 16) {
      float v = 0.f;
#pragma unroll
      for (int cc = 0; cc < 16; cc++) if (lane == cc) v = ab[cc];
      float r;
      if (lane < 8) {
        const float A = __expf(p.dn_a_log[l * 8 + lane]);
        const float z = v + p.dn_dt_bias[l * 8 + lane];
        const float sp = z > 20.f ? z : log1pf(__expf(z));
        r = -A * sp;
      } else r = sigm(v);
      GB[(size_t)row * 16 + lane] = r;
    }
  }
  __syncthreads();
}

DI void xyT(const char* sX, const char* sY, int it, f32x4 (&acc)[4], const int WV) {
  const int lane = tidx() & 63, fr = lane & 15, fq = lane >> 4;
#pragma unroll
  for (int j = 0; j < 4; j++) acc[j] = f32x4{0.f, 0.f, 0.f, 0.f};
#pragma unroll
  for (int ks = 0; ks < 4; ks++) {
    const bf16x8 a = *(const bf16x8*)(sX + (it * 16 + fr) * 272 + (ks * 32 + fq * 8) * 2);
#pragma unroll
    for (int jt = 0; jt < 4; jt++) {
      const bf16x8 b = *(const bf16x8*)(sY + (jt * 16 + fr) * 272 + (ks * 32 + fq * 8) * 2);
      acc[jt] = mfma16(a, b, acc[jt]);
    }
  }
}

DI void dn_prep_unit(const Params& p, int l, int c, int h, char* smem) {
  const int WV = p.ph_hi;
  const int tid = tidx(), lane = tid & 63, w = tid >> 6;
  u16* QKV = (u16*)(p.ws + OFF_A);
  const u16* HALO = (const u16*)(p.ws + OFF_HALO);
  char* sQ = smem;
  char* sK = smem + 17408;
  float* sKK = (float*)(smem + 34816);
  float* sQK = (float*)(smem + 34816 + 16384);
  float* sGC = (float*)(smem + 34816 + 32768);
  float* sBT = sGC + 128;
  const int row0 = c * 64;
  {
    const int u = tid * 2;
    const int gcol = u < 128 ? h * 128 + u : (u < 256 ? 512 + h * 128 + (u - 128) : 1024 + h * 256 + (u - 256));
    bool first, last;
    if (c < 256) { first = (c & 127) == 0; last = (c & 127) == 127; }
    else { first = ((c - 256) & 3) == 0; last = ((c - 256) & 3) == 3; }
    const float* cw = p.dn_conv + (size_t)l * 5 * 2048 + gcol;
    float cw0[5], cw1[5];
#pragma unroll
    for (int j = 0; j < 5; j++) { cw0[j] = cw[j * 2048]; cw1[j] = cw[j * 2048 + 1]; }
    auto load_ext = [&](int e) -> unsigned {
      if (e < 2) return first ? 0u : *(const unsigned*)(HALO + ((size_t)(c - 1) * 4 + 2 + e) * 2048 + gcol);
      if (e >= 66) return last ? 0u : *(const unsigned*)(HALO + ((size_t)(c + 1) * 4 + (e - 66)) * 2048 + gcol);
      return *(const unsigned*)(QKV + (size_t)(row0 + e - 2) * 2048 + gcol);
    };
    unsigned cat[12];
#pragma unroll
    for (int i = 0; i < 4; i++) cat[i] = load_ext(i);
    for (int tb = 0; tb < 8; tb++) {
#pragma unroll
      for (int i = 0; i < 8; i++) cat[4 + i] = load_ext(4 + tb * 8 + i);
#pragma unroll
      for (int i = 0; i < 8; i++) {
        const int t = tb * 8 + i;
        float y0 = 0.f, y1 = 0.f;
#pragma unroll
        for (int j = 0; j < 5; j++) {
          y0 += cw0[j] * bf2f((u16)(cat[i + j] & 0xffff));
          y1 += cw1[j] * bf2f((u16)(cat[i + j] >> 16));
        }
        y0 = silu(y0); y1 = silu(y1);
        if (w < 2) {
          const float ss = wsum(y0 * y0 + y1 * y1);
          float rs = rsqrtf(ss + 1e-6f);
          if (w == 0) rs *= 0.08838834764831845f;
          y0 *= rs; y1 *= rs;
          const unsigned pk = pack2(y0, y1);
          *(unsigned*)((w == 0 ? sQ : sK) + t * 272 + (u & 127) * 2) = pk;
          *(unsigned*)(QKV + (size_t)(row0 + t) * 2048 + gcol) = pk;
        } else {
          *(unsigned*)(QKV + (size_t)(row0 + t) * 2048 + gcol) = pack2(y0, y1);
        }
      }
#pragma unroll
      for (int i = 0; i < 4; i++) cat[i] = cat[8 + i];
    }
  }
  if (w < 2) {
    const float* GB = (const float*)(p.ws + OFF_GB);
    const float g = GB[(size_t)(row0 + lane) * 16 + w * 4 + h];
    const float bt = GB[(size_t)(row0 + lane) * 16 + 8 + w * 4 + h];
    float s = g;
    if (w == 0) {
#pragma unroll
      for (int o = 1; o < 64; o <<= 1) { const float t = __shfl_up(s, o, 64); if (lane >= o) s += t; }
    } else {
#pragma unroll
      for (int o = 1; o < 64; o <<= 1) { const float t = __shfl_down(s, o, 64); if (lane + o < 64) s += t; }
    }
    const float gl = __shfl(s, w == 0 ? 63 : 0, 64);
    sGC[w * 64 + lane] = s;
    sBT[w * 64 + lane] = bt;
    float* SC = (float*)(p.ws + OFF_DNSC) + ((size_t)(c * 4 + h) * 2 + w) * 192;
    SC[lane] = __expf(s);
    SC[64 + lane] = __expf(gl - s);
    if (lane == 0) SC[128] = __expf(gl);
  }
  __syncthreads();
  {
    const int fr = lane & 15, fq = lane >> 4;
    f32x4 acc[4];
    xyT(sK, sK, w, acc, WV);
#pragma unroll
    for (int jt = 0; jt < 4; jt++)
#pragma unroll
      for (int j = 0; j < 4; j++) sKK[(w * 16 + fq * 4 + j) * 64 + jt * 16 + fr] = acc[jt][j];
    xyT(sQ, sK, w, acc, WV);
#pragma unroll
    for (int jt = 0; jt < 4; jt++)
#pragma unroll
      for (int j = 0; j < 4; j++) sQK[(w * 16 + fq * 4 + j) * 64 + jt * 16 + fr] = acc[jt][j];
  }
  __syncthreads();
  u16* AUX = (u16*)(p.ws + OFF_B) + (size_t)(c * 4 + h) * 4 * 4096;
#pragma unroll 2
  for (int e = 0; e < 32; e++) {
    const int id = tid + e * 256, dir = id >> 12, i = (id >> 6) & 63, j = id & 63;
    const bool valid = dir == 0 ? (j <= i) : (j >= i);
    float v = 0.f;
    if (valid) v = sQK[i * 64 + j] * __expf(sGC[dir * 64 + i] - sGC[dir * 64 + j]);
    AUX[(size_t)(dir * 2 + 1) * 4096 + i * 64 + j] = f2bf(v);
  }
  __syncthreads();
  float* sL0 = sQK;
  float* sL1 = (float*)smem;
#pragma unroll 2
  for (int e = 0; e < 32; e++) {
    const int id = tid + e * 256, dir = id >> 12, ip = (id >> 6) & 63, jp = id & 63;
    const int i = dir ? 63 - ip : ip, j = dir ? 63 - jp : jp;
    float v = 0.f;
    if (jp < ip) v = sBT[dir * 64 + i] * sKK[i * 64 + j] * __expf(sGC[dir * 64 + i] - sGC[dir * 64 + j]);
    (dir ? sL1 : sL0)[ip * 64 + jp] = v;
  }
  __syncthreads();
  if (w < 2) {
    const float* L = w ? sL1 : sL0;
    float* Xs = w ? (float*)(smem + 16384) : sKK;
    const int cn = w ? 63 - lane : lane;
    const float bc = sBT[w * 64 + cn];
    for (int ip = 0; ip < 64; ip++) {
      float a0 = (ip == lane) ? bc : 0.f, a1 = 0.f, a2 = 0.f, a3 = 0.f;
      int jp = 0;
      for (; jp + 4 <= ip; jp += 4) {
        const f32x4 l4 = *(const f32x4*)(L + ip * 64 + jp);
        a0 -= l4[0] * Xs[(jp + 0) * 64 + lane];
        a1 -= l4[1] * Xs[(jp + 1) * 64 + lane];
        a2 -= l4[2] * Xs[(jp + 2) * 64 + lane];
        a3 -= l4[3] * Xs[(jp + 3) * 64 + lane];
      }
      for (; jp < ip; jp++) a0 -= L[ip * 64 + jp] * Xs[jp * 64 + lane];
      const float a = (a0 + a1) + (a2 + a3);
      Xs[ip * 64 + lane] = a;
      const int i = w ? 63 - ip : ip;
      AUX[(size_t)(w * 2 + 0) * 4096 + i * 64 + cn] = f2bf(a);
    }
  }
  __syncthreads();
}

DI void ret_prep_unit(const Params& p, int l, int c, int h, char* smem) {
  const int WV = p.ph_hi;
  const int tid = tidx(), lane = tid & 63, w = tid >> 6;
  const u16* QKV = (const u16*)(p.ws + OFF_A + 2 * SZ_TOK1K);
  char* sQ = smem;
  char* sK = smem + 17408;
  const int row0 = c * 64;
#pragma unroll
  for (int i = 0; i < 4; i++) {
    const int id = tid + i * 256, r = id >> 4, ch = id & 15;
    *(uint4*)(sQ + r * 272 + ch * 16) = *(const uint4*)(QKV + (size_t)(row0 + r) * 2048 + h * 128 + ch * 8);
    *(uint4*)(sK + r * 272 + ch * 16) = *(const uint4*)(QKV + (size_t)(row0 + r) * 2048 + 512 + h * 128 + ch * 8);
  }
  __syncthreads();
  f32x4 acc[4];
  xyT(sQ, sK, w, acc, WV);
  const int fr = lane & 15, fq = lane >> 4;
  u16* AUX = (u16*)(p.ws + OFF_C) + (size_t)(c * 4 + h) * 2 * 4096;
#pragma unroll
  for (int dir = 0; dir < 2; dir++) {
    const float rd = p.ret_decay[l * 8 + dir * 4 + h];
    const float lam = fminf(rd, 0.f) - log1pf(__expf(-fabsf(rd)));
#pragma unroll
    for (int jt = 0; jt < 4; jt++)
#pragma unroll
      for (int j = 0; j < 4; j++) {
        const int i = w * 16 + fq * 4 + j, jj = jt * 16 + fr;
        const int dd = dir == 0 ? i - jj : jj - i;
        const float v = dd >= 0 ? acc[jt][j] * __expf(lam * (float)dd) : 0.f;
        AUX[(size_t)dir * 4096 + i * 64 + jj] = f2bf(v);
      }
  }
  __syncthreads();
}

DI void hg_prep_unit(const Params& p, int l, int c, int h, char* smem) {
  const int WV = p.ph_hi;
  const int tid = tidx();
  u16* QFI = (u16*)(p.ws + OFF_A);
  u16* HGX = (u16*)(p.ws + OFF_B);
  float* sG = (float*)smem;
  u16* sQ = (u16*)(smem + 32768);
  u16* sK = (u16*)(smem + 49152);
  float* sTot = (float*)(smem + 65536);
  const int row0 = c * 64;
#pragma unroll
  for (int i = 0; i < 4; i++) {
    const int id = tid + i * 256, r = id >> 4, ch = id & 15;
    const uint4 v = *(const uint4*)(QFI + (size_t)(row0 + r) * 4096 + h * 128 + ch * 8);
    const unsigned vv[4] = {v.x, v.y, v.z, v.w};
#pragma unroll
    for (int e = 0; e < 4; e++) {
      sQ[(ch * 8 + e * 2) * 64 + r] = (u16)(vv[e] & 0xffff);
      sQ[(ch * 8 + e * 2 + 1) * 64 + r] = (u16)(vv[e] >> 16);
    }
  }
  __syncthreads();
  const int half = tid >> 7, d = tid & 127;
#pragma unroll 1
  for (int dir = 1; dir >= 0; dir--) {
    float lo = 0.f;
    if (l == 1) {
      const float b0 = p.hg_lb[dir * 1024 + h * 128 + d], b1 = p.hg_lb[2048 + dir * 1024 + h * 128 + d];
      lo = sigm(b1 - b0);
    }
    float run = 0.f;
    {
      const u16* xs = QFI + (size_t)row0 * 4096 + 1024 + dir * 1024 + h * 128 + d;
      float xv[32];
#pragma unroll
      for (int i = 0; i < 32; i++) xv[i] = bf2f(xs[(size_t)(half * 32 + (dir == 0 ? i : 31 - i)) * 4096]);
#pragma unroll
      for (int i = 0; i < 32; i++) {
        const int ii = dir == 0 ? i : 31 - i;
        const int t = half * 32 + ii;
        const float x = xv[i];
        const float sg = sigm(x);
        const float f = lo + (1.f - lo) * sg;
        const float omf = (1.f - lo) * (1.f - sg);
        run += __log2f(f);
        sG[d * 64 + t] = run;
        sK[d * 64 + t] = f2bf(omf);
      }
      sTot[half * 128 + d] = run;
    }
    __syncthreads();
    {
      const float t0 = sTot[d], t1 = sTot[128 + d];
      const float gtot = t0 + t1;
      const float add = dir == 0 ? (half == 1 ? t0 : 0.f) : (half == 0 ? t1 : 0.f);
      u16* qdst = dir == 0 ? QFI + (size_t)row0 * 4096 + h * 128 + d : HGX + (size_t)row0 * 1024 + h * 128 + d;
      const size_t qp = dir == 0 ? 4096 : 1024;
      u16* kdst = QFI + (size_t)row0 * 4096 + 1024 + dir * 1024 + h * 128 + d;
#pragma unroll 8
      for (int i = 0; i < 32; i++) {
        const int t = half * 32 + i;
        const float G = sG[d * 64 + t] + add;
        sG[d * 64 + t] = G;
        qdst[(size_t)t * qp] = f2bf(bf2f(sQ[d * 64 + t]) * exp2f(G));
        kdst[(size_t)t * 4096] = f2bf(bf2f(sK[d * 64 + t]) * exp2f(gtot - G));
      }
      if (half == 0) ((float*)(p.ws + OFF_HGDEC))[((size_t)(c * 8 + h) * 2 + dir) * 128 + d] = exp2f(gtot);
    }
    __syncthreads();
    {
      const int lane = tid & 63, I = tid >> 6, fr = lane & 15, fq = lane >> 4;
      const int rt = dir == 0 ? I * 16 - 1 : I * 16 + 16;
      const bool hasref = dir == 0 ? (I > 0) : (I < 3);
      bf16x8 af[4];
#pragma unroll
      for (int ks = 0; ks < 4; ks++) {
        asm volatile("" ::: "memory");
#pragma unroll
        for (int j = 0; j < 8; j++) {
          const int dd = ks * 32 + fq * 8 + j;
          const float R = hasref ? sG[dd * 64 + rt] : 0.f;
          const float e = exp2f(fmaxf(sG[dd * 64 + I * 16 + fr] - R, -120.f));
          af[ks][j] = (short)f2bf(bf2f(sQ[dd * 64 + I * 16 + fr]) * e);
        }
      }
      u16* AUX = (u16*)(p.ws + OFF_C) + ((size_t)(c * 8 + h) * 2 + dir) * 4096;
#pragma unroll 1
      for (int J = 0; J < 4; J++) {
        const bool actv = dir == 0 ? (J <= I) : (J >= I);
        f32x4 acc = f32x4{0.f, 0.f, 0.f, 0.f};
        if (actv) {
#pragma unroll
          for (int ks = 0; ks < 4; ks++) {
            asm volatile("" ::: "memory");
            bf16x8 bfr;
#pragma unroll
            for (int j = 0; j < 8; j++) {
              const int dd = ks * 32 + fq * 8 + j;
              const float R = hasref ? sG[dd * 64 + rt] : 0.f;
              const float e = exp2f(fminf(R - sG[dd * 64 + J * 16 + fr], 120.f));
              bfr[j] = (short)f2bf(bf2f(sK[dd * 64 + J * 16 + fr]) * e);
            }
            acc = mfma16(af[ks], bfr, acc);
          }
        }
#pragma unroll
        for (int jj = 0; jj < 4; jj++) {
          const int i = I * 16 + fq * 4 + jj, j = J * 16 + fr;
          const bool valid = actv && (dir == 0 ? (j <= i) : (j >= i));
          AUX[i * 64 + j] = f2bf(valid ? acc[jj] : 0.f);
        }
      }
    }
    __syncthreads();
  }
}

struct ScanDesc {
  const u16 *q, *k, *v;
  int qp, kp, vp;
  const u16* aux;
  size_t aux_cs;
  int attn_off, ainv_off;
  u16* o;
  int mixer, b, dir;
  const float* sc;
  size_t sc_cs;
  float lam;
};

DI int scan_chunk_of(int dir, int b, int step) {
  if (dir == 0) return step < 4 ? 256 + 4 * b + step : 128 * b + (step - 4);
  return step < 4 ? 256 + 4 * b + (3 - step) : 128 * b + (131 - step);
}
template <int MIXER>
DI void scan_prefetch(const u16* sq, const u16* sk, const u16* sv, int qp, int kp, int vp, const u16* saux, size_t aux_cs, int attn_off, int ainv_off,
                      const float* ssc, size_t sc_cs, int c, int tid, int w, int fr, int fq, u32x4 (&rq)[4], u32x4 (&rk)[4], u32x4 (&rat)[2], u32x4 (&rai)[2],
                      unsigned (&rv)[8], float& rsc, float& regl) {
  struct { const u16 *q, *k, *v; int qp, kp, vp; const u16* aux; size_t aux_cs; int attn_off, ainv_off; const float* sc; size_t sc_cs; } s =
      {sq, sk, sv, qp, kp, vp, saux, aux_cs, attn_off, ainv_off, ssc, sc_cs};
  const int row0 = c * 64;
  const u16* qbase = s.q + (size_t)row0 * s.qp;
  const u16* kbase = s.k + (size_t)row0 * s.kp;
  const u16* vbase = s.v + (size_t)row0 * s.vp;
  const unsigned qoff = (unsigned)((tid >> 4) * s.qp + (tid & 15) * 8);
  const unsigned koff = (unsigned)((tid >> 4) * s.kp + (tid & 15) * 8);
#pragma unroll
  for (int i = 0; i < 4; i++) {
    rq[i] = *(const u32x4*)(qbase + (size_t)(i * 16) * s.qp + qoff);
    rk[i] = *(const u32x4*)(kbase + (size_t)(i * 16) * s.kp + koff);
  }
  const u16* ab = s.aux + (size_t)c * s.aux_cs;
  const unsigned aoff = (unsigned)((tid >> 3) * 64 + (tid & 7) * 8);
#pragma unroll
  for (int i = 0; i < 2; i++) {
    rat[i] = *(const u32x4*)(ab + s.attn_off + i * 32 * 64 + aoff);
    if (MIXER == 0) rai[i] = *(const u32x4*)(ab + s.ainv_off + i * 32 * 64 + aoff);
  }
  if (MIXER == 0) {
    const float* sc = s.sc + (size_t)c * s.sc_cs;
    if (tid < 128) rsc = sc[tid];
    regl = sc[128];
  } else if (MIXER == 2) {
    if (tid < 128) rsc = s.sc[(size_t)c * s.sc_cs + tid];
  }
  const unsigned voff = (unsigned)(fq * 4 * s.vp + w * 16 + fr);
#pragma unroll
  for (int mt = 0; mt < 4; mt++)
#pragma unroll
    for (int jp = 0; jp < 2; jp++) {
      const unsigned lo = (vbase + (size_t)(mt * 16 + jp * 2) * s.vp)[voff];
      const unsigned hi = (vbase + (size_t)(mt * 16 + jp * 2 + 1) * s.vp)[voff];
      rv[mt * 2 + jp] = lo | (hi << 16);
    }
}

template <int MIXER>
DI void scan_unit(const ScanDesc& s, char* smem, const int WV) {
  const int tid = tidx(), lane = tid & 63, w = tid >> 6;
  const int fr = lane & 15, fq = lane >> 4;
  char* sQm = smem;
  char* sKm = smem + 17408;
  const unsigned km_tr = (unsigned)(size_t)sKm + (unsigned)((fq * 4 + ((lane & 15) >> 2)) * 272 + (lane & 3) * 8);
  char* sAT = smem + 53248;
  char* sAI = smem + 62464;
  float* sSC = (float*)(smem + 71680);
  f32x4 S[8];
#pragma unroll
  for (int i = 0; i < 8; i++) S[i] = f32x4{0.f, 0.f, 0.f, 0.f};
  u32x4 rq[4], rk[4], rat[2], rai[2];
  rai[0] = u32x4{0u, 0u, 0u, 0u}; rai[1] = rai[0];
  unsigned rv[8];
  float rsc = 0.f, regl = 1.f;
  scan_prefetch<MIXER>(s.q, s.k, s.v, s.qp, s.kp, s.vp, s.aux, s.aux_cs, s.attn_off, s.ainv_off, s.sc, s.sc_cs, scan_chunk_of(s.dir, s.b, 0), tid, w, fr, fq, rq, rk, rat, rai, rv, rsc, regl);
  for (int step = 0; step < 132; step++) {
    const int c = scan_chunk_of(s.dir, s.b, step);
    const int row0 = c * 64;
#pragma unroll
    for (int i = 0; i < 4; i++) {
      const int id = tid + i * 256, r = id >> 4, ch = id & 15;
      *(u32x4*)(sQm + r * 272 + ch * 16) = rq[i];
      *(u32x4*)(sKm + r * 272 + ch * 16) = rk[i];
    }
#pragma unroll
    for (int i = 0; i < 2; i++) {
      const int id = tid + i * 256, r = id >> 3, ch = id & 7;
      *(u32x4*)(sAT + r * 144 + ch * 16) = rat[i];
      if (MIXER == 0) *(u32x4*)(sAI + r * 144 + ch * 16) = rai[i];
    }
    float egl = 1.f;
    if (MIXER == 0) {
      if (tid < 128) sSC[tid] = rsc;
      egl = regl;
    } else if (MIXER == 1) {
      if (tid < 64) {
        const float e1 = s.dir == 0 ? (float)(tid + 1) : (float)(64 - tid);
        sSC[tid] = __expf(s.lam * e1);
        sSC[64 + tid] = __expf(s.lam * (64.f - e1));
      }
      egl = __expf(s.lam * 64.f);
    } else {
      if (tid < 128) sSC[tid] = rsc;
    }
    f32x4 V[4];
#pragma unroll
    for (int mt = 0; mt < 4; mt++) {
      V[mt][0] = bf2f((u16)(rv[mt * 2] & 0xffff)); V[mt][1] = bf2f((u16)(rv[mt * 2] >> 16));
      V[mt][2] = bf2f((u16)(rv[mt * 2 + 1] & 0xffff)); V[mt][3] = bf2f((u16)(rv[mt * 2 + 1] >> 16));
    }
    __syncthreads();
    if (step + 1 < 132) scan_prefetch<MIXER>(s.q, s.k, s.v, s.qp, s.kp, s.vp, s.aux, s.aux_cs, s.attn_off, s.ainv_off, s.sc, s.sc_cs, scan_chunk_of(s.dir, s.b, step + 1), tid, w, fr, fq, rq, rk, rat, rai, rv, rsc, regl);
    bf16x8 Sb[4];
#pragma unroll
    for (int ks = 0; ks < 4; ks++) Sb[ks] = pack8(S[2 * ks], S[2 * ks + 1]);
    f32x4 vn[4];
    if (MIXER == 0) {
      f32x4 P[4];
#pragma unroll
      for (int mt = 0; mt < 4; mt++) {
        P[mt] = f32x4{0.f, 0.f, 0.f, 0.f};
#pragma unroll
        for (int ks = 0; ks < 4; ks++) P[mt] = mfma16(ld_perm(sKm + (mt * 16 + fr) * 272, ks * 32 + fq * 4), Sb[ks], P[mt]);
      }
#pragma unroll
      for (int mt = 0; mt < 4; mt++)
#pragma unroll
        for (int j = 0; j < 4; j++) P[mt][j] = V[mt][j] - sSC[mt * 16 + fq * 4 + j] * P[mt][j];
      bf16x8 rb[2];
#pragma unroll
      for (int ks = 0; ks < 2; ks++) rb[ks] = pack8(P[2 * ks], P[2 * ks + 1]);
#pragma unroll
      for (int mt = 0; mt < 4; mt++) {
        vn[mt] = f32x4{0.f, 0.f, 0.f, 0.f};
#pragma unroll
        for (int ks = 0; ks < 2; ks++) vn[mt] = mfma16(ld_perm(sAI + (mt * 16 + fr) * 144, ks * 32 + fq * 4), rb[ks], vn[mt]);
      }
    } else {
#pragma unroll
      for (int mt = 0; mt < 4; mt++) vn[mt] = V[mt];
    }
    bf16x8 vb[2];
#pragma unroll
    for (int ks = 0; ks < 2; ks++) vb[ks] = pack8(vn[2 * ks], vn[2 * ks + 1]);
    u16* obase = s.o + (size_t)row0 * 1024;
#pragma unroll
    for (int mt = 0; mt < 4; mt++) {
      f32x4 o0 = f32x4{0.f, 0.f, 0.f, 0.f};
#pragma unroll
      for (int ks = 0; ks < 4; ks++) o0 = mfma16(ld_perm(sQm + (mt * 16 + fr) * 272, ks * 32 + fq * 4), Sb[ks], o0);
      if (MIXER != 2) {
#pragma unroll
        for (int j = 0; j < 4; j++) o0[j] *= sSC[mt * 16 + fq * 4 + j];
      }
#pragma unroll
      for (int ks = 0; ks < 2; ks++) o0 = mfma16(ld_perm(sAT + (mt * 16 + fr) * 144, ks * 32 + fq * 4), vb[ks], o0);
#pragma unroll
      for (int j = 0; j < 4; j++) obase[(unsigned)((mt * 16 + fq * 4 + j) * 1024 + w * 16 + fr)] = f2bf(o0[j]);
    }
    if (MIXER != 2) {
#pragma unroll
      for (int mt = 0; mt < 4; mt++)
#pragma unroll
        for (int j = 0; j < 4; j++) vn[mt][j] *= sSC[64 + mt * 16 + fq * 4 + j];
#pragma unroll
      for (int ks = 0; ks < 2; ks++) vb[ks] = pack8(vn[2 * ks], vn[2 * ks + 1]);
    }
#pragma unroll
    for (int mt = 0; mt < 8; mt++) {
      if (MIXER == 2) {
#pragma unroll
        for (int j = 0; j < 4; j++) S[mt][j] *= sSC[mt * 16 + fq * 4 + j];
      } else {
#pragma unroll
        for (int j = 0; j < 4; j++) S[mt][j] *= egl;
      }
#pragma unroll
      for (int ks = 0; ks < 2; ks++)
        S[mt] = mfma16(ld_tr2(km_tr + (unsigned)((ks * 32) * 272 + mt * 32), km_tr + (unsigned)((ks * 32 + 16) * 272 + mt * 32)), vb[ks], S[mt]);
    }
    __syncthreads();
  }
}

DI void scan_phase_hg(const Params& p, char* smem) {
  const int WV = p.ph_hi;
  for (int u = blockIdx.x; u < 64; u += gridDim.x) {
    const int dir = u & 1, vg = (u >> 1) & 1, h = (u >> 2) & 7, b = u >> 5;
    ScanDesc s;
    s.q = dir == 0 ? (const u16*)(p.ws + OFF_A) + h * 128 : (const u16*)(p.ws + OFF_B) + h * 128;
    s.qp = dir == 0 ? 4096 : 1024;
    s.k = (const u16*)(p.ws + OFF_A) + 1024 + dir * 1024 + h * 128; s.kp = 4096;
    s.v = (const u16*)(p.ws + OFF_A) + 3072 + h * 128 + vg * 64; s.vp = 4096;
    s.aux = (const u16*)(p.ws + OFF_C) + (size_t)(h * 2 + dir) * 4096; s.aux_cs = 8 * 2 * 4096; s.attn_off = 0; s.ainv_off = 0;
    s.o = (u16*)(p.ws + OFF_D + (dir ? SZ_TOK1K : 0)) + h * 128 + vg * 64;
    s.mixer = 2; s.b = b; s.dir = dir;
    s.sc = (const float*)(p.ws + OFF_HGDEC) + (size_t)(h * 2 + dir) * 128; s.sc_cs = 8 * 2 * 128; s.lam = 0.f;
    scan_unit<2>(s, smem, WV);
  }
}
DI void scan_phase_dnret(const Params& p, int l, char* smem) {
  const int WV = p.ph_hi;
  for (int u = blockIdx.x; u < 128; u += gridDim.x) {
    const int mixer = u & 1, dir = (u >> 1) & 1, vg = (u >> 2) & 3, h = (u >> 4) & 3, b = u >> 6;
    ScanDesc s;
    const u16* base = (const u16*)(p.ws + OFF_A + (mixer ? 2 * SZ_TOK1K : 0));
    s.q = base + h * 128; s.k = base + 512 + h * 128; s.v = base + 1024 + h * 256 + vg * 64;
    s.qp = s.kp = s.vp = 2048;
    s.mixer = mixer; s.b = b; s.dir = dir;
    if (mixer == 0) {
      s.aux = (const u16*)(p.ws + OFF_B) + (size_t)(h * 2 + dir) * 2 * 4096; s.aux_cs = 4 * 4 * 4096; s.ainv_off = 0; s.attn_off = 4096;
      s.sc = (const float*)(p.ws + OFF_DNSC) + (size_t)(h * 2 + dir) * 192; s.sc_cs = 4 * 2 * 192; s.lam = 0.f;
      s.o = (u16*)(dir == 0 ? p.ws + OFF_E : p.ws + OFF_D + SZ_TOK1K) + h * 256 + vg * 64;
      scan_unit<0>(s, smem, WV);
    } else {
      s.aux = (const u16*)(p.ws + OFF_C) + (size_t)(h * 2 + dir) * 4096; s.aux_cs = 4 * 2 * 4096; s.attn_off = 0; s.ainv_off = 0;
      const float rd = p.ret_decay[l * 8 + dir * 4 + h];
      s.lam = fminf(rd, 0.f) - log1pf(__expf(-fabsf(rd)));
      s.sc = nullptr; s.sc_cs = 0;
      s.o = (u16*)(p.ws + OFF_E + (dir == 0 ? SZ_TOK1K : 2 * SZ_TOK1K)) + h * 256 + vg * 64;
      scan_unit<1>(s, smem, WV);
    }
  }
}

DI void onorm_rows(u16* of, const u16* ob, const float* nw, int dv, int unit, int nunits_stride, const int WV) {
  const int lane = tidx() & 63, w = tidx() >> 6;
  for (int row = unit * 4 + w; row < T_ALL; row += nunits_stride * 4) {
    u16* pf = of + (size_t)row * 1024 + lane * 16;
    const u16* pb = ob + (size_t)row * 1024 + lane * 16;
    float v[16];
#pragma unroll
    for (int hv = 0; hv < 2; hv++) {
      const uint4 a = *(const uint4*)(pf + hv * 8), b = *(const uint4*)(pb + hv * 8);
      const unsigned aa[4] = {a.x, a.y, a.z, a.w}, bb[4] = {b.x, b.y, b.z, b.w};
#pragma unroll
      for (int e = 0; e < 4; e++) {
        v[hv * 8 + e * 2] = bf2f((u16)(aa[e] & 0xffff)) + bf2f((u16)(bb[e] & 0xffff));
        v[hv * 8 + e * 2 + 1] = bf2f((u16)(aa[e] >> 16)) + bf2f((u16)(bb[e] >> 16));
      }
    }
    float ss = 0.f;
#pragma unroll
    for (int e = 0; e < 16; e++) ss += v[e] * v[e];
    const int nl = dv / 16;
    for (int o = 1; o < nl; o <<= 1) ss += __shfl_xor(ss, o, 64);
    const float rstd = rsqrtf(ss / (float)dv + 1e-6f);
    const int dcol = (lane * 16) % dv;
    unsigned o8[8];
#pragma unroll
    for (int e = 0; e < 8; e++) o8[e] = pack2(v[2 * e] * rstd * nw[dcol + 2 * e], v[2 * e + 1] * rstd * nw[dcol + 2 * e + 1]);
    *(uint4*)pf = uint4{o8[0], o8[1], o8[2], o8[3]};
    *(uint4*)(pf + 8) = uint4{o8[4], o8[5], o8[6], o8[7]};
  }
}

DI void final_norm(const Params& p) {
  const int WV = p.ph_hi;
  const int lane = tidx() & 63, w = tidx() >> 6;
  for (int row = blockIdx.x * 4 + w; row < T_LAT; row += gridDim.x * 4) {
    float* xr = p.out + (size_t)row * 1024;
    f32x4 xv[4];
    float ss = 0.f;
#pragma unroll
    for (int i = 0; i < 4; i++) {
      xv[i] = *(const f32x4*)(xr + i * 256 + lane * 4);
      ss += xv[i][0] * xv[i][0] + xv[i][1] * xv[i][1] + xv[i][2] * xv[i][2] + xv[i][3] * xv[i][3];
    }
    ss = wsum(ss);
    const float rstd = rsqrtf(ss * (1.f / 1024.f) + 1e-6f);
#pragma unroll
    for (int i = 0; i < 4; i++) {
      const f32x4 wv = *(const f32x4*)(p.final_norm_w + i * 256 + lane * 4);
      f32x4 r;
#pragma unroll
      for (int j = 0; j < 4; j++) r[j] = xv[i][j] * rstd * wv[j];
      *(f32x4*)(xr + i * 256 + lane * 4) = r;
    }
  }
}

DI void run_phase(const Params& p, int ph, char* smem) {
  const int WV = p.ph_hi;
  const int G = gridDim.x, B = blockIdx.x;
  if (ph == 0) { if (QSEL(11)) phase_pro(p, smem); return; }
  if (ph == 23) { if (QSEL(12)) final_norm(p); return; }
  const int l = (ph - 1) / 11, q = (ph - 1) % 11;
  const bool last = l == 1;
  switch (q) {
    case 0: if (!QSEL(0)) break;
      if (l == 1) for (int u = B; u < WCONV_UNITS; u += G) wconv_unit(p, 1, u, smem);
      phase_norm(p, l, smem);
      break;
    case 1: if (!QSEL(1)) break;
      for (int t = B; t < 132 * 32; t += G) gemm_tile<EPI_HG>(p, l, t % 132, t / 132, smem);
      break;
    case 2: if (!QSEL(2)) break;
      for (int u = B; u < NCH * 8; u += G) hg_prep_unit(p, l, u >> 3, u & 7, smem);
      break;
    case 3: if (!QSEL(3)) break; scan_phase_hg(p, smem); break;
    case 4: if (!QSEL(4)) break;
      for (int t = B; t < 132 * 32; t += G) gemm_tile<EPI_DNRET>(p, l, t % 132, t / 132, smem);
      onorm_rows((u16*)(p.ws + OFF_D), (const u16*)(p.ws + OFF_D + SZ_TOK1K), p.hg_norm_w + l * 128, 128, B, G, WV);
      break;
    case 5: if (!QSEL(5)) break;
      for (int u = B; u < NCH * 8; u += G) {
        if (u < NCH * 4) dn_prep_unit(p, l, u >> 2, u & 3, smem);
        else ret_prep_unit(p, l, (u - NCH * 4) >> 2, u & 3, smem);
      }
      break;
    case 6: if (!QSEL(6)) break; scan_phase_dnret(p, l, smem); break;
    case 7: if (!QSEL(7)) break;
      onorm_rows((u16*)(p.ws + OFF_E), (const u16*)(p.ws + OFF_D + SZ_TOK1K), p.dn_norm_w + l * 256, 256, B, G, WV);
      onorm_rows((u16*)(p.ws + OFF_E + SZ_TOK1K), (const u16*)(p.ws + OFF_E + 2 * SZ_TOK1K), p.ret_norm_w + l * 256, 256, B, G, WV);
      break;
    case 8: if (!QSEL(8)) break; {
      const int nrt = last ? 128 : 132;
      for (int t = B; t < nrt * 24; t += G) gemm_tile<EPI_GATE>(p, l, t % nrt, t / nrt, smem);
    } break;
    case 9: if (!QSEL(9)) break; {
      const int nrt = last ? 128 : 132;
      for (int t = B; t < nrt * 8; t += G) merge_tile(p, t % nrt, t / nrt, smem);
    } break;
    case 10: if (!QSEL(10)) break; {
      const int nrt = last ? 128 : 132;
      for (int t = B; t < nrt * 8; t += G) gemm_tile<EPI_OUT>(p, l, t % nrt, t / nrt, smem);
    } break;
  }
}

DI void grid_barrier(unsigned* ctr, unsigned target) {
  asm volatile("s_waitcnt vmcnt(0) lgkmcnt(0)" ::: "memory");
  __syncthreads();
  if (__builtin_amdgcn_workitem_id_x() == 0) {
    __builtin_amdgcn_fence(__ATOMIC_RELEASE, "agent");
    asm volatile("s_waitcnt vmcnt(0)" ::: "memory");
    __hip_atomic_fetch_add(ctr, 1u, __ATOMIC_RELAXED, __HIP_MEMORY_SCOPE_AGENT);
    while (__hip_atomic_load(ctr, __ATOMIC_RELAXED, __HIP_MEMORY_SCOPE_AGENT) < target) __builtin_amdgcn_s_sleep(16);
    __builtin_amdgcn_fence(__ATOMIC_ACQUIRE, "agent");
    asm volatile("s_waitcnt vmcnt(0)" ::: "memory");
  }
  __syncthreads();
}

__global__ void __launch_bounds__(256, 2) mk(Params p) {
  extern __shared__ __attribute__((aligned(16))) char smem[];
  p.ph_hi = __builtin_amdgcn_readfirstlane((int)__builtin_amdgcn_workitem_id_x() >> 6);
#if ONE_LAUNCH
  cg::grid_group grid = cg::this_grid();
  unsigned* bar = (unsigned*)(p.ws + OFF_BAR);
  const unsigned G = gridDim.x;
  run_phase(p, 0, smem);
  grid.sync();
#define PH(n) run_phase(p, n, smem); grid_barrier(bar, (unsigned)(n) * G);
  PH(1) PH(2) PH(3) PH(4) PH(5) PH(6) PH(7) PH(8) PH(9) PH(10) PH(11)
  PH(12) PH(13) PH(14) PH(15) PH(16) PH(17) PH(18) PH(19) PH(20) PH(21) PH(22)
  run_phase(p, 23, smem);
#else
  run_phase(p, p.ph_lo, smem);
#endif
}

extern "C" void kernel_launch(void* const* d_in, const int* in_sizes, int n_in, void* d_out,
                              int out_size, void* d_ws, size_t ws_size, hipStream_t stream) {
  static int grid_blocks = 0;
  if (!grid_blocks) {
    int dev = 0, cus = 0, per_cu = 0;
    (void)hipGetDevice(&dev);
    (void)hipDeviceGetAttribute(&cus, hipDeviceAttributeMultiprocessorCount, dev);
    (void)hipFuncSetAttribute((const void*)mk, hipFuncAttributeMaxDynamicSharedMemorySize, SMEM_BYTES);
    (void)hipOccupancyMaxActiveBlocksPerMultiprocessor(&per_cu, mk, 256, SMEM_BYTES);
    if (per_cu > 2) per_cu = 2;
    if (per_cu < 1) per_cu = 1;
    grid_blocks = cus * per_cu;
  }
  Params p{};
  const float** f = (const float**)&p;
  for (int i = 0; i < 19; i++) f[i] = (const float*)d_in[i];
  p.out = (float*)d_out;
  p.ws = (char*)d_ws;
#if ONE_LAUNCH
  p.ph_lo = 0; p.ph_hi = 24;
  (void)hipMemsetAsync((char*)d_ws + OFF_BAR, 0, 256, stream);
  void* args[] = {&p};
  (void)hipLaunchCooperativeKernel((void*)mk, dim3(grid_blocks), dim3(256), args, SMEM_BYTES, stream);
#else
  for (int ph = 0; ph < 24; ph++) {
    p.ph_lo = ph; p.ph_hi = ph + 1;
    void* args[] = {&p};
    (void)hipLaunchCooperativeKernel((void*)mk, dim3(grid_blocks), dim3(256), args, SMEM_BYTES, stream);
  }
#endif
}
```

```cpp
#include <hip/hip_runtime.h>
#include <hip/hip_cooperative_groups.h>
#include <cstdio>
namespace cg = cooperative_groups;

#ifndef ONE_LAUNCH
#define ONE_LAUNCH 1
#endif
#ifndef ONLY_Q
#define ONLY_Q -1
#endif
#define QSEL(n) (ONLY_Q < 0 || ONLY_Q == (n))

typedef unsigned short u16;
using bf16x8 = __attribute__((ext_vector_type(8))) short;
using bf16x4 = __attribute__((ext_vector_type(4))) short;
using f32x4 = __attribute__((ext_vector_type(4))) float;
using u32x4 = __attribute__((ext_vector_type(4))) unsigned;
#define DI __device__ __forceinline__

constexpr int T_LAT = 16384, T_ALL = 16896, NCH = 264;
constexpr int WROWS = 18448;
constexpr int W_BR = 14352, W_OUT = 17424;
constexpr size_t al(size_t x) { return (x + 255) & ~(size_t)255; }
constexpr size_t SZ_WT = (size_t)WROWS * 1024 * 2;
constexpr size_t SZ_TOK1K = (size_t)T_ALL * 1024 * 2;
constexpr size_t OFF_WT = 0;
constexpr size_t OFF_H = OFF_WT + al(SZ_WT);
constexpr size_t OFF_MOD = OFF_H + al(SZ_TOK1K);
constexpr size_t OFF_ROT = OFF_MOD + al(2 * 3 * 3072 * 4);
constexpr size_t OFF_GB = OFF_ROT + al(128 * 32 * 2 * 4);
constexpr size_t OFF_CTX1 = OFF_GB + al((size_t)T_ALL * 16 * 4);
constexpr size_t OFF_HALO = OFF_CTX1 + al(512 * 1024 * 4);
constexpr size_t OFF_DNSC = OFF_HALO + al((size_t)NCH * 4 * 2048 * 2);
constexpr size_t OFF_HGDEC = OFF_DNSC + al((size_t)NCH * 4 * 2 * 192 * 4);
constexpr size_t OFF_BAR = OFF_HGDEC + al((size_t)NCH * 8 * 2 * 128 * 4);
constexpr size_t OFF_A = OFF_BAR + 4096;
constexpr size_t OFF_B = OFF_A + 4 * SZ_TOK1K;
constexpr size_t OFF_C = OFF_B + SZ_TOK1K;
constexpr size_t OFF_D = OFF_C + SZ_TOK1K;
constexpr size_t OFF_E = OFF_D + 2 * SZ_TOK1K;
constexpr size_t WS_TOTAL = OFF_E + 3 * SZ_TOK1K;
static_assert(WS_TOTAL <= 470286336ull, "workspace too large");

constexpr int SMEM_BYTES = 72960;

struct Params {
  const float *x, *c, *ctx, *c_ctx, *norm_w, *ada_w, *ada_b, *w_in, *dn_conv, *dn_a_log, *dn_dt_bias, *dn_norm_w,
      *ret_decay, *ret_norm_w, *hg_lb, *hg_norm_w, *w_branch, *w_out, *final_norm_w;
  float* out;
  char* ws;
  int ph_lo, ph_hi;
};

DI int laneid_v() { int t; asm volatile("v_mbcnt_lo_u32_b32 %0, -1, 0\n\tv_mbcnt_hi_u32_b32 %0, -1, %0" : "=v"(t)); return t; }
#define tidx() (WV * 64 + laneid_v())
typedef __bf16 hwbf2 __attribute__((ext_vector_type(2)));
DI u16 f2bf(float f) { __bf16 b = (__bf16)f; return __builtin_bit_cast(u16, b); }
DI float bf2f(u16 h) { return __uint_as_float(((unsigned)h) << 16); }
DI unsigned pack2(float a, float b) { hwbf2 v = {(__bf16)a, (__bf16)b}; return __builtin_bit_cast(unsigned, v); }
DI float sigm(float x) { return 1.f / (1.f + __expf(-x)); }
DI float silu(float x) { return x / (1.f + __expf(-x)); }
DI float wsum(float v) {
#pragma unroll
  for (int o = 32; o > 0; o >>= 1) v += __shfl_xor(v, o, 64);
  return v;
}
DI f32x4 mfma16(bf16x8 a, bf16x8 b, f32x4 c) { return __builtin_amdgcn_mfma_f32_16x16x32_bf16(a, b, c, 0, 0, 0); }
DI bf16x8 pack8(f32x4 lo, f32x4 hi) {
  u32x4 r = {pack2(lo[0], lo[1]), pack2(lo[2], lo[3]), pack2(hi[0], hi[1]), pack2(hi[2], hi[3])};
  return __builtin_bit_cast(bf16x8, r);
}
typedef __attribute__((address_space(3))) bf16x4* lds_v4p;
DI bf16x8 ld_tr2(unsigned a_lo, unsigned a_hi) {
  const bf16x4 lo = __builtin_amdgcn_ds_read_tr16_b64_v4i16((lds_v4p)(size_t)a_lo);
  const bf16x4 hi = __builtin_amdgcn_ds_read_tr16_b64_v4i16((lds_v4p)(size_t)a_hi);
  bf16x8 r;
  r[0] = lo[0]; r[1] = lo[1]; r[2] = lo[2]; r[3] = lo[3]; r[4] = hi[0]; r[5] = hi[1]; r[6] = hi[2]; r[7] = hi[3];
  return r;
}
DI bf16x8 ld_perm(const char* rowp, int c0) {
  bf16x4 lo = *(const bf16x4*)(rowp + c0 * 2);
  bf16x4 hi = *(const bf16x4*)(rowp + c0 * 2 + 32);
  bf16x8 r;
  r[0] = lo[0]; r[1] = lo[1]; r[2] = lo[2]; r[3] = lo[3]; r[4] = hi[0]; r[5] = hi[1]; r[6] = hi[2]; r[7] = hi[3];
  return r;
}

DI int swz(int row, int ch) { return row * 128 + ((ch ^ (row & 7)) << 4); }

DI void gemm_kloop(const u16* __restrict__ A, const u16* __restrict__ W, f32x4 (&acc)[4][4], char* smem, const int WV) {
  const int tid = tidx(), lane = tid & 63, wid = tid >> 6, wn = wid >> 1, wt = wid & 1;
  const int fr = lane & 15, fq = lane >> 4;
  uint4 ra[4], rw[4];
  const int lrow = tid >> 3, lch = tid & 7;
  const u16* Ap = A + (size_t)lrow * 1024 + lch * 8;
  const u16* Wp = W + (size_t)lrow * 1024 + lch * 8;
#pragma unroll
  for (int i = 0; i < 4; i++) {
    ra[i] = *(const uint4*)(Ap + (size_t)i * 32 * 1024);
    rw[i] = *(const uint4*)(Wp + (size_t)i * 32 * 1024);
  }
#pragma unroll
  for (int i = 0; i < 4; i++) {
    *(uint4*)(smem + swz(lrow + i * 32, lch)) = rw[i];
    *(uint4*)(smem + 16384 + swz(lrow + i * 32, lch)) = ra[i];
  }
  __syncthreads();
  for (int kt = 0; kt < 16; kt++) {
    if (kt < 15) {
#pragma unroll
      for (int i = 0; i < 4; i++) {
        ra[i] = *(const uint4*)(Ap + (size_t)i * 32 * 1024 + (kt + 1) * 64);
        rw[i] = *(const uint4*)(Wp + (size_t)i * 32 * 1024 + (kt + 1) * 64);
      }
    }
    const char* sW = smem + (kt & 1) * 32768;
    const char* sA = sW + 16384;
#pragma unroll
    for (int ks = 0; ks < 2; ks++) {
      bf16x8 fw[4], fa[4];
#pragma unroll
      for (int i = 0; i < 4; i++) {
        fw[i] = *(const bf16x8*)(sW + swz(wn * 64 + i * 16 + fr, ks * 4 + fq));
        fa[i] = *(const bf16x8*)(sA + swz(wt * 64 + i * 16 + fr, ks * 4 + fq));
      }
#pragma unroll
      for (int ni = 0; ni < 4; ni++)
#pragma unroll
        for (int ti = 0; ti < 4; ti++) acc[ni][ti] = mfma16(fw[ni], fa[ti], acc[ni][ti]);
    }
    if (kt < 15) {
      char* dW = smem + ((kt + 1) & 1) * 32768;
#pragma unroll
      for (int i = 0; i < 4; i++) {
        *(uint4*)(dW + swz(lrow + i * 32, lch)) = rw[i];
        *(uint4*)(dW + 16384 + swz(lrow + i * 32, lch)) = ra[i];
      }
    }
    __syncthreads();
  }
}

enum { EPI_HG = 0, EPI_DNRET = 1, EPI_GATE = 2, EPI_OUT = 3 };

template <int EPI>
DI void gemm_tile(const Params& p, int l, int rt, int nti, char* smem) {
  const int WV = p.ph_hi;
  const int tid = tidx(), lane = tid & 63, wid = tid >> 6, wn = wid >> 1, wt = wid & 1;
  const int fr = lane & 15, fq = lane >> 4;
  const int row0 = rt * 128;
  const u16* WT = (const u16*)(p.ws + OFF_WT);
  const u16* A;
  int wrow, n0, mixer = 0;
  if (EPI == EPI_HG) { A = (const u16*)(p.ws + OFF_H); n0 = nti * 128; wrow = 6160 + n0; }
  else if (EPI == EPI_DNRET) { A = (const u16*)(p.ws + OFF_H); mixer = nti >> 4; n0 = (nti & 15) * 128; wrow = (mixer ? 3088 : 0) + n0; }
  else if (EPI == EPI_GATE) { A = (const u16*)(p.ws + OFF_H); mixer = nti >> 3; n0 = (nti & 7) * 128; wrow = (mixer == 0 ? 2048 : (mixer == 1 ? 5136 : 10256)) + n0; }
  else { A = (const u16*)(p.ws + OFF_B); n0 = nti * 128; wrow = W_OUT + n0; }
  f32x4 acc[4][4];
#pragma unroll
  for (int i = 0; i < 4; i++)
#pragma unroll
    for (int j = 0; j < 4; j++) acc[i][j] = f32x4{0.f, 0.f, 0.f, 0.f};
  gemm_kloop(A + (size_t)row0 * 1024, WT + (size_t)wrow * 1024, acc, smem, WV);

  const float* ROT = (const float*)(p.ws + OFF_ROT);
  const float* MOD = (const float*)(p.ws + OFF_MOD);
#pragma unroll
  for (int ti = 0; ti < 4; ti++) {
    const int token = row0 + wt * 64 + ti * 16 + fr;
#pragma unroll
    for (int ni = 0; ni < 4; ni++) {
      const int nl = n0 + wn * 64 + ni * 16 + fq * 4;
      f32x4 v = acc[ni][ti];
      if (EPI == EPI_HG) {
        if (nl < 1024) { v[0] = silu(v[0]); v[1] = silu(v[1]); v[2] = silu(v[2]); v[3] = silu(v[3]); }
        u16* dst = (u16*)(p.ws + OFF_A) + (size_t)token * 4096 + nl;
        *(uint2*)dst = uint2{pack2(v[0], v[1]), pack2(v[2], v[3])};
      } else if (EPI == EPI_DNRET) {
        if (mixer == 0) {
          uint2 pk = uint2{pack2(v[0], v[1]), pack2(v[2], v[3])};
          u16* dst = (u16*)(p.ws + OFF_A) + (size_t)token * 2048 + nl;
          *(uint2*)dst = pk;
          const int tm = token & 63;
          if (tm < 2 || tm >= 62) {
            const int slot = tm < 2 ? tm : tm - 60;
            u16* hd = (u16*)(p.ws + OFF_HALO) + ((size_t)(token >> 6) * 4 + slot) * 2048 + nl;
            *(uint2*)hd = pk;
          }
        } else {
          if (nl < 1024) {
            if (token < T_LAT) {
              const int t = token & 8191, ri = t >> 6, ci = t & 63;
              const int d = nl & 127;
#pragma unroll
              for (int pp = 0; pp < 2; pp++) {
                const int pidx = (d >> 1) + pp;
                const float* rp = pidx < 32 ? ROT + (ri * 32 + pidx) * 2 : ROT + (ci * 32 + (pidx - 32)) * 2;
                const float cs = rp[0], sn = rp[1];
                const float x1 = v[2 * pp], x2 = v[2 * pp + 1];
                v[2 * pp] = x1 * cs - x2 * sn;
                v[2 * pp + 1] = x1 * sn + x2 * cs;
              }
            }
            if (nl >= 512) { const float s = 0.08838834764831845f; v[0] *= s; v[1] *= s; v[2] *= s; v[3] *= s; }
          }
          u16* dst = (u16*)(p.ws + OFF_A + 2 * SZ_TOK1K) + (size_t)token * 2048 + nl;
          *(uint2*)dst = uint2{pack2(v[0], v[1]), pack2(v[2], v[3])};
        }
      } else if (EPI == EPI_GATE) {
        char* base = mixer == 0 ? p.ws + OFF_E : (mixer == 1 ? p.ws + OFF_E + SZ_TOK1K : p.ws + OFF_D);
        u16* dst = (u16*)base + (size_t)token * 1024 + nl;
        uint2 on = *(const uint2*)dst;
        float o0 = bf2f((u16)(on.x & 0xffff)), o1 = bf2f((u16)(on.x >> 16)), o2 = bf2f((u16)(on.y & 0xffff)), o3 = bf2f((u16)(on.y >> 16));
        *(uint2*)dst = uint2{pack2(o0 * silu(v[0]), o1 * silu(v[1])), pack2(o2 * silu(v[2]), o3 * silu(v[3]))};
      } else {
        const int vec = token < T_LAT ? (token >> 13) : 2;
        const f32x4 gt = *(const f32x4*)(MOD + ((size_t)l * 3 + vec) * 3072 + 2048 + nl);
        const float* src;
        float* dst;
        if (token < T_LAT) {
          src = (l == 0 ? p.x : (const float*)p.out) + (size_t)token * 1024 + nl;
          dst = p.out + (size_t)token * 1024 + nl;
        } else {
          src = p.ctx + (size_t)(token - T_LAT) * 1024 + nl;
          dst = (float*)(p.ws + OFF_CTX1) + (size_t)(token - T_LAT) * 1024 + nl;
        }
        f32x4 xi = *(const f32x4*)src;
        f32x4 r;
        r[0] = xi[0] + gt[0] * v[0]; r[1] = xi[1] + gt[1] * v[1]; r[2] = xi[2] + gt[2] * v[2]; r[3] = xi[3] + gt[3] * v[3];
        *(f32x4*)dst = r;
      }
    }
  }
}

DI void merge_tile(const Params& p, int rt, int nti, char* smem) {
  const int WV = p.ph_hi;
  const int tid = tidx(), lane = tid & 63, wid = tid >> 6, wn = wid >> 1, wt = wid & 1;
  const int fr = lane & 15, fq = lane >> 4;
  const int row0 = rt * 128, n0 = nti * 128;
  const u16* WT = (const u16*)(p.ws + OFF_WT);
  const u16* H = (const u16*)(p.ws + OFF_H) + (size_t)row0 * 1024;
  uint2 y[4][4];
#pragma unroll
  for (int i = 0; i < 4; i++)
#pragma unroll
    for (int j = 0; j < 4; j++) y[i][j] = uint2{0u, 0u};
  for (int m = 0; m < 3; m++) {
    uint2 sg[4][4];
    {
      f32x4 acc[4][4];
#pragma unroll
      for (int i = 0; i < 4; i++)
#pragma unroll
        for (int j = 0; j < 4; j++) acc[i][j] = f32x4{0.f, 0.f, 0.f, 0.f};
      gemm_kloop(H, WT + (size_t)(11280 + m * 1024 + n0) * 1024, acc, smem, WV);
#pragma unroll
      for (int i = 0; i < 4; i++)
#pragma unroll
        for (int j = 0; j < 4; j++)
          sg[i][j] = uint2{pack2(sigm(acc[i][j][0]), sigm(acc[i][j][1])), pack2(sigm(acc[i][j][2]), sigm(acc[i][j][3]))};
    }
    {
      const char* base = m == 0 ? p.ws + OFF_E : (m == 1 ? p.ws + OFF_E + SZ_TOK1K : p.ws + OFF_D);
      f32x4 acc[4][4];
#pragma unroll
      for (int i = 0; i < 4; i++)
#pragma unroll
        for (int j = 0; j < 4; j++) acc[i][j] = f32x4{0.f, 0.f, 0.f, 0.f};
      gemm_kloop((const u16*)base + (size_t)row0 * 1024, WT + (size_t)(W_BR + m * 1024 + n0) * 1024, acc, smem, WV);
#pragma unroll
      for (int i = 0; i < 4; i++)
#pragma unroll
        for (int j = 0; j < 4; j++) {
          const float y0 = bf2f((u16)(y[i][j].x & 0xffff)) + acc[i][j][0] * bf2f((u16)(sg[i][j].x & 0xffff));
          const float y1 = bf2f((u16)(y[i][j].x >> 16)) + acc[i][j][1] * bf2f((u16)(sg[i][j].x >> 16));
          const float y2 = bf2f((u16)(y[i][j].y & 0xffff)) + acc[i][j][2] * bf2f((u16)(sg[i][j].y & 0xffff));
          const float y3 = bf2f((u16)(y[i][j].y >> 16)) + acc[i][j][3] * bf2f((u16)(sg[i][j].y >> 16));
          y[i][j] = uint2{pack2(y0, y1), pack2(y2, y3)};
        }
    }
  }
  u16* Y = (u16*)(p.ws + OFF_B);
#pragma unroll
  for (int ti = 0; ti < 4; ti++) {
    const int token = row0 + wt * 64 + ti * 16 + fr;
#pragma unroll
    for (int ni = 0; ni < 4; ni++) {
      const int nl = n0 + wn * 64 + ni * 16 + fq * 4;
      *(uint2*)(Y + (size_t)token * 1024 + nl) = y[ni][ti];
    }
  }
}

DI void wconv_tile(const float* __restrict__ src, int N, int kt, int ntile, u16* __restrict__ dst, char* smem, const int WV) {
  float* s = (float*)smem;
  const int tid = tidx();
  const int k0 = kt * 64, n0 = ntile * 64;
#pragma unroll
  for (int i = 0; i < 4; i++) {
    const int r = (tid >> 4) + i * 16, c4 = (tid & 15) * 4;
    if (n0 + c4 < N) {
      f32x4 v = *(const f32x4*)(src + (size_t)(k0 + r) * N + n0 + c4);
      s[r * 65 + c4] = v[0]; s[r * 65 + c4 + 1] = v[1]; s[r * 65 + c4 + 2] = v[2]; s[r * 65 + c4 + 3] = v[3];
    }
  }
  __syncthreads();
#pragma unroll
  for (int i = 0; i < 2; i++) {
    const int id = tid + i * 256, n = id >> 3, kc = (id & 7) * 8;
    if (n0 + n < N) {
      uint4 o;
      o.x = pack2(s[(kc + 0) * 65 + n], s[(kc + 1) * 65 + n]);
      o.y = pack2(s[(kc + 2) * 65 + n], s[(kc + 3) * 65 + n]);
      o.z = pack2(s[(kc + 4) * 65 + n], s[(kc + 5) * 65 + n]);
      o.w = pack2(s[(kc + 6) * 65 + n], s[(kc + 7) * 65 + n]);
      *(uint4*)(dst + (size_t)(n0 + n) * 1024 + k0 + kc) = o;
    }
  }
  __syncthreads();
}
constexpr int WCONV_UNITS = 16 * 225 + 3 * 256 + 256;
DI void wconv_unit(const Params& p, int l, int u, char* smem) {
  const int WV = p.ph_hi;
  u16* WT = (u16*)(p.ws + OFF_WT);
  if (u < 16 * 225) wconv_tile(p.w_in + (size_t)l * 1024 * 14352, 14352, u / 225, u % 225, WT, smem, WV);
  else if (u < 16 * 225 + 768) {
    const int v = u - 16 * 225, m = v >> 8, r = v & 255;
    wconv_tile(p.w_branch + ((size_t)l * 3 + m) * 1024 * 1024, 1024, r >> 4, r & 15, WT + (size_t)(W_BR + m * 1024) * 1024, smem, WV);
  } else {
    const int r = u - 16 * 225 - 768;
    wconv_tile(p.w_out + (size_t)l * 1024 * 1024, 1024, r >> 4, r & 15, WT + (size_t)W_OUT * 1024, smem, WV);
  }
}

DI void adaln_unit(const Params& p, int u, char* smem) {
  const int WV = p.ph_hi;
  const int l = u / 48, ng = u % 48;
  const int tid = tidx(), lane = tid & 63, w = tid >> 6;
  const int n = ng * 64 + lane;
  const float* W = p.ada_w + (size_t)l * 1024 * 3072;
  float a0 = 0.f, a1 = 0.f, a2 = 0.f;
#pragma unroll 8
  for (int k = w * 256; k < w * 256 + 256; k++) {
    const float wv = W[(size_t)k * 3072 + n];
    a0 += silu(p.c[k]) * wv; a1 += silu(p.c[1024 + k]) * wv; a2 += silu(p.c_ctx[k]) * wv;
  }
  float* red = (float*)smem;
  red[(w * 3 + 0) * 64 + lane] = a0; red[(w * 3 + 1) * 64 + lane] = a1; red[(w * 3 + 2) * 64 + lane] = a2;
  __syncthreads();
  if (tid < 192) {
    const int vec = tid >> 6, ln = tid & 63;
    float s = red[(0 * 3 + vec) * 64 + ln] + red[(1 * 3 + vec) * 64 + ln] + red[(2 * 3 + vec) * 64 + ln] + red[(3 * 3 + vec) * 64 + ln];
    const int nn = ng * 64 + ln;
    ((float*)(p.ws + OFF_MOD))[((size_t)l * 3 + vec) * 3072 + nn] = s + p.ada_b[(size_t)l * 3072 + nn];
  }
  __syncthreads();
}

DI void phase_pro(const Params& p, char* smem) {
  const int WV = p.ph_hi;
  const int total = 96 + 16 + WCONV_UNITS;
  for (int u = blockIdx.x; u < total; u += gridDim.x) {
    if (u < 96) adaln_unit(p, u, smem);
    else if (u < 112) {
      const int id = (u - 96) * 256 + tidx();
      const int pos = id >> 5, m = id & 31;
      const float inv = powf(10000.f, -(float)(2 * m) / 64.f);
      float s, c;
      sincosf((float)pos * inv, &s, &c);
      float* ROT = (float*)(p.ws + OFF_ROT);
      ROT[id * 2] = c; ROT[id * 2 + 1] = s;
    } else wconv_unit(p, 0, u - 112, smem);
  }
}

DI void phase_norm(const Params& p, int l, char* smem) {
  const int WV = p.ph_hi;
  const int tid = tidx(), lane = tid & 63, w = tid >> 6;
  float* sW = (float*)smem;
  const float* win = p.w_in + (size_t)l * 1024 * 14352;
  for (int i = tid; i < 16 * 1024; i += 256) {
    const int k = i >> 4, cc = i & 15;
    sW[cc * 1024 + k] = win[(size_t)k * 14352 + 3072 + cc];
  }
  __syncthreads();
  const float* MOD = (const float*)(p.ws + OFF_MOD);
  const float* nw = p.norm_w + (size_t)l * 1024;
  u16* H = (u16*)(p.ws + OFF_H);
  float* GB = (float*)(p.ws + OFF_GB);
  for (int row = blockIdx.x * 4 + w; row < T_ALL; row += gridDim.x * 4) {
    const float* xr;
    int vec;
    if (row < T_LAT) { xr = (l == 0 ? p.x : (const float*)p.out) + (size_t)row * 1024; vec = row >> 13; }
    else { xr = (l == 0 ? p.ctx : (const float*)(p.ws + OFF_CTX1)) + (size_t)(row - T_LAT) * 1024; vec = 2; }
    const float* md = MOD + ((size_t)l * 3 + vec) * 3072;
    f32x4 xv[4];
    float ss = 0.f;
#pragma unroll
    for (int i = 0; i < 4; i++) {
      xv[i] = *(const f32x4*)(xr + i * 256 + lane * 4);
      ss += xv[i][0] * xv[i][0] + xv[i][1] * xv[i][1] + xv[i][2] * xv[i][2] + xv[i][3] * xv[i][3];
    }
    ss = wsum(ss);
    const float rstd = rsqrtf(ss * (1.f / 1024.f) + 1e-6f);
    float ab[16];
#pragma unroll
    for (int cc = 0; cc < 16; cc++) ab[cc] = 0.f;
#pragma unroll
    for (int i = 0; i < 4; i++) {
      const int k = i * 256 + lane * 4;
      const f32x4 wv = *(const f32x4*)(nw + k);
      const f32x4 sh = *(const f32x4*)(md + k);
      const f32x4 sc = *(const f32x4*)(md + 1024 + k);
      f32x4 h;
#pragma unroll
      for (int j = 0; j < 4; j++) h[j] = xv[i][j] * rstd * wv[j] * (1.f + sc[j]) + sh[j];
      *(uint2*)(H + (size_t)row * 1024 + k) = uint2{pack2(h[0], h[1]), pack2(h[2], h[3])};
      asm volatile("" ::: "memory");
#pragma unroll
      for (int cc = 0; cc < 16; cc++) {
        const f32x4 ww = *(const f32x4*)(sW + cc * 1024 + k);
        ab[cc] += h[0] * ww[0] + h[1] * ww[1] + h[2] * ww[2] + h[3] * ww[3];
      }
    }
#pragma unroll
    for (int cc = 0; cc < 16; cc++) ab[cc] = wsum(ab[cc]);
    if (lane < 16) {
      float v = 0.f;
#pragma unroll
      for (int cc = 0; cc < 16; cc++) if (lane == cc) v = ab[cc];
      float r;
      if (lane < 8) {
        const float A = __expf(p.dn_a_log[l * 8 + lane]);
        const float z = v + p.dn_dt_bias[l * 8 + lane];
        const float sp = z > 20.f ? z : log1pf(__expf(z));
        r = -A * sp;
      } else r = sigm(v);
      GB[(size_t)row * 16 + lane] = r;
    }
  }
  __syncthreads();
}

DI void xyT(const char* sX, const char* sY, int it, f32x4 (&acc)[4], const int WV) {
  const int lane = tidx() & 63, fr = lane & 15, fq = lane >> 4;
#pragma unroll
  for (int j = 0; j < 4; j++) acc[j] = f32x4{0.f, 0.f, 0.f, 0.f};
#pragma unroll
  for (int ks = 0; ks < 4; ks++) {
    const bf16x8 a = *(const bf16x8*)(sX + (it * 16 + fr) * 272 + (ks * 32 + fq * 8) * 2);
#pragma unroll
    for (int jt = 0; jt < 4; jt++) {
      const bf16x8 b = *(const bf16x8*)(sY + (jt * 16 + fr) * 272 + (ks * 32 + fq * 8) * 2);
      acc[jt] = mfma16(a, b, acc[jt]);
    }
  }
}

DI void dn_prep_unit(const Params& p, int l, int c, int h, char* smem) {
  const int WV = p.ph_hi;
  const int tid = tidx(), lane = tid & 63, w = tid >> 6;
  u16* QKV = (u16*)(p.ws + OFF_A);
  const u16* HALO = (const u16*)(p.ws + OFF_HALO);
  char* sQ = smem;
  char* sK = smem + 17408;
  float* sKK = (float*)(smem + 34816);
  float* sQK = (float*)(smem + 34816 + 16384);
  float* sGC = (float*)(smem + 34816 + 32768);
  float* sBT = sGC + 128;
  const int row0 = c * 64;
  {
    const int u = tid * 2;
    const int gcol = u < 128 ? h * 128 + u : (u < 256 ? 512 + h * 128 + (u - 128) : 1024 + h * 256 + (u - 256));
    bool first, last;
    if (c < 256) { first = (c & 127) == 0; last = (c & 127) == 127; }
    else { first = ((c - 256) & 3) == 0; last = ((c - 256) & 3) == 3; }
    const float* cw = p.dn_conv + (size_t)l * 5 * 2048 + gcol;
    float cw0[5], cw1[5];
#pragma unroll
    for (int j = 0; j < 5; j++) { cw0[j] = cw[j * 2048]; cw1[j] = cw[j * 2048 + 1]; }
    auto load_ext = [&](int e) -> unsigned {
      if (e < 2) return first ? 0u : *(const unsigned*)(HALO + ((size_t)(c - 1) * 4 + 2 + e) * 2048 + gcol);
      if (e >= 66) return last ? 0u : *(const unsigned*)(HALO + ((size_t)(c + 1) * 4 + (e - 66)) * 2048 + gcol);
      return *(const unsigned*)(QKV + (size_t)(row0 + e - 2) * 2048 + gcol);
    };
    unsigned cat[12];
#pragma unroll
    for (int i = 0; i < 4; i++) cat[i] = load_ext(i);
    for (int tb = 0; tb < 8; tb++) {
#pragma unroll
      for (int i = 0; i < 8; i++) cat[4 + i] = load_ext(4 + tb * 8 + i);
#pragma unroll
      for (int i = 0; i < 8; i++) {
        const int t = tb * 8 + i;
        float y0 = 0.f, y1 = 0.f;
#pragma unroll
        for (int j = 0; j < 5; j++) {
          y0 += cw0[j] * bf2f((u16)(cat[i + j] & 0xffff));
          y1 += cw1[j] * bf2f((u16)(cat[i + j] >> 16));
        }
        y0 = silu(y0); y1 = silu(y1);
        if (w < 2) {
          const float ss = wsum(y0 * y0 + y1 * y1);
          float rs = rsqrtf(ss + 1e-6f);
          if (w == 0) rs *= 0.08838834764831845f;
          y0 *= rs; y1 *= rs;
          const unsigned pk = pack2(y0, y1);
          *(unsigned*)((w == 0 ? sQ : sK) + t * 272 + (u & 127) * 2) = pk;
          *(unsigned*)(QKV + (size_t)(row0 + t) * 2048 + gcol) = pk;
        } else {
          *(unsigned*)(QKV + (size_t)(row0 + t) * 2048 + gcol) = pack2(y0, y1);
        }
      }
#pragma unroll
      for (int i = 0; i < 4; i++) cat[i] = cat[8 + i];
    }
  }
  if (w < 2) {
    const float* GB = (const float*)(p.ws + OFF_GB);
    const float g = GB[(size_t)(row0 + lane) * 16 + w * 4 + h];
    const float bt = GB[(size_t)(row0 + lane) * 16 + 8 + w * 4 + h];
    float s = g;
    if (w == 0) {
#pragma unroll
      for (int o = 1; o < 64; o <<= 1) { const float t = __shfl_up(s, o, 64); if (lane >= o) s += t; }
    } else {
#pragma unroll
      for (int o = 1; o < 64; o <<= 1) { const float t = __shfl_down(s, o, 64); if (lane + o < 64) s += t; }
    }
    const float gl = __shfl(s, w == 0 ? 63 : 0, 64);
    sGC[w * 64 + lane] = s;
    sBT[w * 64 + lane] = bt;
    float* SC = (float*)(p.ws + OFF_DNSC) + ((size_t)(c * 4 + h) * 2 + w) * 192;
    SC[lane] = __expf(s);
    SC[64 + lane] = __expf(gl - s);
    if (lane == 0) SC[128] = __expf(gl);
  }
  __syncthreads();
  {
    const int fr = lane & 15, fq = lane >> 4;
    f32x4 acc[4];
    xyT(sK, sK, w, acc, WV);
#pragma unroll
    for (int jt = 0; jt < 4; jt++)
#pragma unroll
      for (int j = 0; j < 4; j++) sKK[(w * 16 + fq * 4 + j) * 64 + jt * 16 + fr] = acc[jt][j];
    xyT(sQ, sK, w, acc, WV);
#pragma unroll
    for (int jt = 0; jt < 4; jt++)
#pragma unroll
      for (int j = 0; j < 4; j++) sQK[(w * 16 + fq * 4 + j) * 64 + jt * 16 + fr] = acc[jt][j];
  }
  __syncthreads();
  u16* AUX = (u16*)(p.ws + OFF_B) + (size_t)(c * 4 + h) * 4 * 4096;
#pragma unroll 2
  for (int e = 0; e < 32; e++) {
    const int id = tid + e * 256, dir = id >> 12, i = (id >> 6) & 63, j = id & 63;
    const bool valid = dir == 0 ? (j <= i) : (j >= i);
    float v = 0.f;
    if (valid) v = sQK[i * 64 + j] * __expf(sGC[dir * 64 + i] - sGC[dir * 64 + j]);
    AUX[(size_t)(dir * 2 + 1) * 4096 + i * 64 + j] = f2bf(v);
  }
  __syncthreads();
  float* sL0 = sQK;
  float* sL1 = (float*)smem;
#pragma unroll 2
  for (int e = 0; e < 32; e++) {
    const int id = tid + e * 256, dir = id >> 12, ip = (id >> 6) & 63, jp = id & 63;
    const int i = dir ? 63 - ip : ip, j = dir ? 63 - jp : jp;
    float v = 0.f;
    if (jp < ip) v = sBT[dir * 64 + i] * sKK[i * 64 + j] * __expf(sGC[dir * 64 + i] - sGC[dir * 64 + j]);
    (dir ? sL1 : sL0)[ip * 64 + jp] = v;
  }
  __syncthreads();
  if (w < 2) {
    const float* L = w ? sL1 : sL0;
    float* Xs = w ? (float*)(smem + 16384) : sKK;
    const int cn = w ? 63 - lane : lane;
    const float bc = sBT[w * 64 + cn];
    for (int ip = 0; ip < 64; ip++) {
      float a0 = (ip == lane) ? bc : 0.f, a1 = 0.f, a2 = 0.f, a3 = 0.f;
      int jp = 0;
#pragma unroll 4
      for (; jp + 4 <= ip; jp += 4) {
        const f32x4 l4 = *(const f32x4*)(L + ip * 64 + jp);
        a0 -= l4[0] * Xs[(jp + 0) * 64 + lane];
        a1 -= l4[1] * Xs[(jp + 1) * 64 + lane];
        a2 -= l4[2] * Xs[(jp + 2) * 64 + lane];
        a3 -= l4[3] * Xs[(jp + 3) * 64 + lane];
      }
      for (; jp < ip; jp++) a0 -= L[ip * 64 + jp] * Xs[jp * 64 + lane];
      const float a = (a0 + a1) + (a2 + a3);
      Xs[ip * 64 + lane] = a;
      const int i = w ? 63 - ip : ip;
      AUX[(size_t)(w * 2 + 0) * 4096 + i * 64 + cn] = f2bf(a);
    }
  }
  __syncthreads();
}

DI void ret_prep_unit(const Params& p, int l, int c, int h, char* smem) {
  const int WV = p.ph_hi;
  const int tid = tidx(), lane = tid & 63, w = tid >> 6;
  const u16* QKV = (const u16*)(p.ws + OFF_A + 2 * SZ_TOK1K);
  char* sQ = smem;
  char* sK = smem + 17408;
  const int row0 = c * 64;
#pragma unroll
  for (int i = 0; i < 4; i++) {
    const int id = tid + i * 256, r = id >> 4, ch = id & 15;
    *(uint4*)(sQ + r * 272 + ch * 16) = *(const uint4*)(QKV + (size_t)(row0 + r) * 2048 + h * 128 + ch * 8);
    *(uint4*)(sK + r * 272 + ch * 16) = *(const uint4*)(QKV + (size_t)(row0 + r) * 2048 + 512 + h * 128 + ch * 8);
  }
  __syncthreads();
  f32x4 acc[4];
  xyT(sQ, sK, w, acc, WV);
  const int fr = lane & 15, fq = lane >> 4;
  u16* AUX = (u16*)(p.ws + OFF_C) + (size_t)(c * 4 + h) * 2 * 4096;
#pragma unroll
  for (int dir = 0; dir < 2; dir++) {
    const float rd = p.ret_decay[l * 8 + dir * 4 + h];
    const float lam = fminf(rd, 0.f) - log1pf(__expf(-fabsf(rd)));
#pragma unroll
    for (int jt = 0; jt < 4; jt++)
#pragma unroll
      for (int j = 0; j < 4; j++) {
        const int i = w * 16 + fq * 4 + j, jj = jt * 16 + fr;
        const int dd = dir == 0 ? i - jj : jj - i;
        const float v = dd >= 0 ? acc[jt][j] * __expf(lam * (float)dd) : 0.f;
        AUX[(size_t)dir * 4096 + i * 64 + jj] = f2bf(v);
      }
  }
  __syncthreads();
}

DI void hg_prep_unit(const Params& p, int l, int c, int h, char* smem) {
  const int WV = p.ph_hi;
  const int tid = tidx();
  u16* QFI = (u16*)(p.ws + OFF_A);
  u16* HGX = (u16*)(p.ws + OFF_B);
  float* sG = (float*)smem;
  u16* sQ = (u16*)(smem + 32768);
  u16* sK = (u16*)(smem + 49152);
  float* sTot = (float*)(smem + 65536);
  const int row0 = c * 64;
#pragma unroll
  for (int i = 0; i < 4; i++) {
    const int id = tid + i * 256, r = id >> 4, ch = id & 15;
    const uint4 v = *(const uint4*)(QFI + (size_t)(row0 + r) * 4096 + h * 128 + ch * 8);
    const unsigned vv[4] = {v.x, v.y, v.z, v.w};
#pragma unroll
    for (int e = 0; e < 4; e++) {
      sQ[(ch * 8 + e * 2) * 64 + r] = (u16)(vv[e] & 0xffff);
      sQ[(ch * 8 + e * 2 + 1) * 64 + r] = (u16)(vv[e] >> 16);
    }
  }
  __syncthreads();
  const int half = tid >> 7, d = tid & 127;
#pragma unroll 1
  for (int dir = 1; dir >= 0; dir--) {
    float lo = 0.f;
    if (l == 1) {
      const float b0 = p.hg_lb[dir * 1024 + h * 128 + d], b1 = p.hg_lb[2048 + dir * 1024 + h * 128 + d];
      lo = sigm(b1 - b0);
    }
    float run = 0.f;
    {
      const u16* xs = QFI + (size_t)row0 * 4096 + 1024 + dir * 1024 + h * 128 + d;
      float xv[32];
#pragma unroll
      for (int i = 0; i < 32; i++) xv[i] = bf2f(xs[(size_t)(half * 32 + (dir == 0 ? i : 31 - i)) * 4096]);
#pragma unroll
      for (int i = 0; i < 32; i++) {
        const int ii = dir == 0 ? i : 31 - i;
        const int t = half * 32 + ii;
        const float x = xv[i];
        const float sg = sigm(x);
        const float f = lo + (1.f - lo) * sg;
        const float omf = (1.f - lo) * (1.f - sg);
        run += __log2f(f);
        sG[d * 64 + t] = run;
        sK[d * 64 + t] = f2bf(omf);
      }
      sTot[half * 128 + d] = run;
    }
    __syncthreads();
    {
      const float t0 = sTot[d], t1 = sTot[128 + d];
      const float gtot = t0 + t1;
      const float add = dir == 0 ? (half == 1 ? t0 : 0.f) : (half == 0 ? t1 : 0.f);
      u16* qdst = dir == 0 ? QFI + (size_t)row0 * 4096 + h * 128 + d : HGX + (size_t)row0 * 1024 + h * 128 + d;
      const size_t qp = dir == 0 ? 4096 : 1024;
      u16* kdst = QFI + (size_t)row0 * 4096 + 1024 + dir * 1024 + h * 128 + d;
#pragma unroll 8
      for (int i = 0; i < 32; i++) {
        const int t = half * 32 + i;
        const float G = sG[d * 64 + t] + add;
        sG[d * 64 + t] = G;
        qdst[(size_t)t * qp] = f2bf(bf2f(sQ[d * 64 + t]) * exp2f(G));
        kdst[(size_t)t * 4096] = f2bf(bf2f(sK[d * 64 + t]) * exp2f(gtot - G));
      }
      if (half == 0) ((float*)(p.ws + OFF_HGDEC))[((size_t)(c * 8 + h) * 2 + dir) * 128 + d] = exp2f(gtot);
    }
    __syncthreads();
    {
      const int lane = tid & 63, I = tid >> 6, fr = lane & 15, fq = lane >> 4;
      const int rt = dir == 0 ? I * 16 - 1 : I * 16 + 16;
      const bool hasref = dir == 0 ? (I > 0) : (I < 3);
      bf16x8 af[4];
#pragma unroll
      for (int ks = 0; ks < 4; ks++) {
        asm volatile("" ::: "memory");
#pragma unroll
        for (int j = 0; j < 8; j++) {
          const int dd = ks * 32 + fq * 8 + j;
          const float R = hasref ? sG[dd * 64 + rt] : 0.f;
          const float e = exp2f(fmaxf(sG[dd * 64 + I * 16 + fr] - R, -120.f));
          af[ks][j] = (short)f2bf(bf2f(sQ[dd * 64 + I * 16 + fr]) * e);
        }
      }
      u16* AUX = (u16*)(p.ws + OFF_C) + ((size_t)(c * 8 + h) * 2 + dir) * 4096;
#pragma unroll 1
      for (int J = 0; J < 4; J++) {
        const bool actv = dir == 0 ? (J <= I) : (J >= I);
        f32x4 acc = f32x4{0.f, 0.f, 0.f, 0.f};
        if (actv) {
#pragma unroll
          for (int ks = 0; ks < 4; ks++) {
            asm volatile("" ::: "memory");
            bf16x8 bfr;
#pragma unroll
            for (int j = 0; j < 8; j++) {
              const int dd = ks * 32 + fq * 8 + j;
              const float R = hasref ? sG[dd * 64 + rt] : 0.f;
              const float e = exp2f(fminf(R - sG[dd * 64 + J * 16 + fr], 120.f));
              bfr[j] = (short)f2bf(bf2f(sK[dd * 64 + J * 16 + fr]) * e);
            }
            acc = mfma16(af[ks], bfr, acc);
          }
        }
#pragma unroll
        for (int jj = 0; jj < 4; jj++) {
          const int i = I * 16 + fq * 4 + jj, j = J * 16 + fr;
          const bool valid = actv && (dir == 0 ? (j <= i) : (j >= i));
          AUX[i * 64 + j] = f2bf(valid ? acc[jj] : 0.f);
        }
      }
    }
    __syncthreads();
  }
}

struct ScanDesc {
  const u16 *q, *k, *v;
  int qp, kp, vp;
  const u16* aux;
  size_t aux_cs;
  int attn_off, ainv_off;
  u16* o;
  int mixer, b, dir;
  const float* sc;
  size_t sc_cs;
  float lam;
};

DI int scan_chunk_of(int dir, int b, int step) {
  if (dir == 0) return step < 4 ? 256 + 4 * b + step : 128 * b + (step - 4);
  return step < 4 ? 256 + 4 * b + (3 - step) : 128 * b + (131 - step);
}
template <int MIXER>
DI void scan_prefetch(const u16* sq, const u16* sk, const u16* sv, int qp, int kp, int vp, const u16* saux, size_t aux_cs, int attn_off, int ainv_off,
                      const float* ssc, size_t sc_cs, int c, int tid, int w, int fr, int fq, u32x4 (&rq)[4], u32x4 (&rk)[4], u32x4 (&rat)[2], u32x4 (&rai)[2],
                      unsigned (&rv)[8], float& rsc, float& regl) {
  struct { const u16 *q, *k, *v; int qp, kp, vp; const u16* aux; size_t aux_cs; int attn_off, ainv_off; const float* sc; size_t sc_cs; } s =
      {sq, sk, sv, qp, kp, vp, saux, aux_cs, attn_off, ainv_off, ssc, sc_cs};
  const int row0 = c * 64;
  const u16* qbase = s.q + (size_t)row0 * s.qp;
  const u16* kbase = s.k + (size_t)row0 * s.kp;
  const u16* vbase = s.v + (size_t)row0 * s.vp;
  const unsigned qoff = (unsigned)((tid >> 4) * s.qp + (tid & 15) * 8);
  const unsigned koff = (unsigned)((tid >> 4) * s.kp + (tid & 15) * 8);
#pragma unroll
  for (int i = 0; i < 4; i++) {
    rq[i] = *(const u32x4*)(qbase + (size_t)(i * 16) * s.qp + qoff);
    rk[i] = *(const u32x4*)(kbase + (size_t)(i * 16) * s.kp + koff);
  }
  const u16* ab = s.aux + (size_t)c * s.aux_cs;
  const unsigned aoff = (unsigned)((tid >> 3) * 64 + (tid & 7) * 8);
#pragma unroll
  for (int i = 0; i < 2; i++) {
    rat[i] = *(const u32x4*)(ab + s.attn_off + i * 32 * 64 + aoff);
    if (MIXER == 0) rai[i] = *(const u32x4*)(ab + s.ainv_off + i * 32 * 64 + aoff);
  }
  if (MIXER == 0) {
    const float* sc = s.sc + (size_t)c * s.sc_cs;
    if (tid < 128) rsc = sc[tid];
    regl = sc[128];
  } else if (MIXER == 2) {
    if (tid < 128) rsc = s.sc[(size_t)c * s.sc_cs + tid];
  }
  const unsigned voff = (unsigned)(fq * 4 * s.vp + w * 16 + fr);
#pragma unroll
  for (int mt = 0; mt < 4; mt++)
#pragma unroll
    for (int jp = 0; jp < 2; jp++) {
      const unsigned lo = (vbase + (size_t)(mt * 16 + jp * 2) * s.vp)[voff];
      const unsigned hi = (vbase + (size_t)(mt * 16 + jp * 2 + 1) * s.vp)[voff];
      rv[mt * 2 + jp] = lo | (hi << 16);
    }
}

template <int MIXER>
DI void scan_unit(const ScanDesc& s, char* smem, const int WV) {
  const int tid = tidx(), lane = tid & 63, w = tid >> 6;
  const int fr = lane & 15, fq = lane >> 4;
  char* sQm = smem;
  char* sKm = smem + 17408;
  const unsigned km_tr = (unsigned)(size_t)sKm + (unsigned)((fq * 4 + ((lane & 15) >> 2)) * 272 + (lane & 3) * 8);
  char* sAT = smem + 53248;
  char* sAI = smem + 62464;
  float* sSC = (float*)(smem + 71680);
  f32x4 S[8];
#pragma unroll
  for (int i = 0; i < 8; i++) S[i] = f32x4{0.f, 0.f, 0.f, 0.f};
  u32x4 rq[4], rk[4], rat[2], rai[2];
  rai[0] = u32x4{0u, 0u, 0u, 0u}; rai[1] = rai[0];
  unsigned rv[8];
  float rsc = 0.f, regl = 1.f;
  scan_prefetch<MIXER>(s.q, s.k, s.v, s.qp, s.kp, s.vp, s.aux, s.aux_cs, s.attn_off, s.ainv_off, s.sc, s.sc_cs, scan_chunk_of(s.dir, s.b, 0), tid, w, fr, fq, rq, rk, rat, rai, rv, rsc, regl);
  for (int step = 0; step < 132; step++) {
    const int c = scan_chunk_of(s.dir, s.b, step);
    const int row0 = c * 64;
#pragma unroll
    for (int i = 0; i < 4; i++) {
      const int id = tid + i * 256, r = id >> 4, ch = id & 15;
      *(u32x4*)(sQm + r * 272 + ch * 16) = rq[i];
      *(u32x4*)(sKm + r * 272 + ch * 16) = rk[i];
    }
#pragma unroll
    for (int i = 0; i < 2; i++) {
      const int id = tid + i * 256, r = id >> 3, ch = id & 7;
      *(u32x4*)(sAT + r * 144 + ch * 16) = rat[i];
      if (MIXER == 0) *(u32x4*)(sAI + r * 144 + ch * 16) = rai[i];
    }
    float egl = 1.f;
    if (MIXER == 0) {
      if (tid < 128) sSC[tid] = rsc;
      egl = regl;
    } else if (MIXER == 1) {
      if (tid < 64) {
        const float e1 = s.dir == 0 ? (float)(tid + 1) : (float)(64 - tid);
        sSC[tid] = __expf(s.lam * e1);
        sSC[64 + tid] = __expf(s.lam * (64.f - e1));
      }
      egl = __expf(s.lam * 64.f);
    } else {
      if (tid < 128) sSC[tid] = rsc;
    }
    f32x4 V[4];
#pragma unroll
    for (int mt = 0; mt < 4; mt++) {
      V[mt][0] = bf2f((u16)(rv[mt * 2] & 0xffff)); V[mt][1] = bf2f((u16)(rv[mt * 2] >> 16));
      V[mt][2] = bf2f((u16)(rv[mt * 2 + 1] & 0xffff)); V[mt][3] = bf2f((u16)(rv[mt * 2 + 1] >> 16));
    }
    __syncthreads();
    if (step + 1 < 132) scan_prefetch<MIXER>(s.q, s.k, s.v, s.qp, s.kp, s.vp, s.aux, s.aux_cs, s.attn_off, s.ainv_off, s.sc, s.sc_cs, scan_chunk_of(s.dir, s.b, step + 1), tid, w, fr, fq, rq, rk, rat, rai, rv, rsc, regl);
    bf16x8 Sb[4];
#pragma unroll
    for (int ks = 0; ks < 4; ks++) Sb[ks] = pack8(S[2 * ks], S[2 * ks + 1]);
    f32x4 vn[4];
    if (MIXER == 0) {
      f32x4 P[4];
#pragma unroll
      for (int mt = 0; mt < 4; mt++) {
        P[mt] = f32x4{0.f, 0.f, 0.f, 0.f};
#pragma unroll
        for (int ks = 0; ks < 4; ks++) P[mt] = mfma16(ld_perm(sKm + (mt * 16 + fr) * 272, ks * 32 + fq * 4), Sb[ks], P[mt]);
      }
#pragma unroll
      for (int mt = 0; mt < 4; mt++)
#pragma unroll
        for (int j = 0; j < 4; j++) P[mt][j] = V[mt][j] - sSC[mt * 16 + fq * 4 + j] * P[mt][j];
      bf16x8 rb[2];
#pragma unroll
      for (int ks = 0; ks < 2; ks++) rb[ks] = pack8(P[2 * ks], P[2 * ks + 1]);
#pragma unroll
      for (int mt = 0; mt < 4; mt++) {
        vn[mt] = f32x4{0.f, 0.f, 0.f, 0.f};
#pragma unroll
        for (int ks = 0; ks < 2; ks++) vn[mt] = mfma16(ld_perm(sAI + (mt * 16 + fr) * 144, ks * 32 + fq * 4), rb[ks], vn[mt]);
      }
    } else {
#pragma unroll
      for (int mt = 0; mt < 4; mt++) vn[mt] = V[mt];
    }
    bf16x8 vb[2];
#pragma unroll
    for (int ks = 0; ks < 2; ks++) vb[ks] = pack8(vn[2 * ks], vn[2 * ks + 1]);
    u16* obase = s.o + (size_t)row0 * 1024;
#pragma unroll
    for (int mt = 0; mt < 4; mt++) {
      f32x4 o0 = f32x4{0.f, 0.f, 0.f, 0.f};
#pragma unroll
      for (int ks = 0; ks < 4; ks++) o0 = mfma16(ld_perm(sQm + (mt * 16 + fr) * 272, ks * 32 + fq * 4), Sb[ks], o0);
      if (MIXER != 2) {
#pragma unroll
        for (int j = 0; j < 4; j++) o0[j] *= sSC[mt * 16 + fq * 4 + j];
      }
#pragma unroll
      for (int ks = 0; ks < 2; ks++) o0 = mfma16(ld_perm(sAT + (mt * 16 + fr) * 144, ks * 32 + fq * 4), vb[ks], o0);
#pragma unroll
      for (int j = 0; j < 4; j++) obase[(unsigned)((mt * 16 + fq * 4 + j) * 1024 + w * 16 + fr)] = f2bf(o0[j]);
    }
    if (MIXER != 2) {
#pragma unroll
      for (int mt = 0; mt < 4; mt++)
#pragma unroll
        for (int j = 0; j < 4; j++) vn[mt][j] *= sSC[64 + mt * 16 + fq * 4 + j];
#pragma unroll
      for (int ks = 0; ks < 2; ks++) vb[ks] = pack8(vn[2 * ks], vn[2 * ks + 1]);
    }
#pragma unroll
    for (int mt = 0; mt < 8; mt++) {
      if (MIXER == 2) {
#pragma unroll
        for (int j = 0; j < 4; j++) S[mt][j] *= sSC[mt * 16 + fq * 4 + j];
      } else {
#pragma unroll
        for (int j = 0; j < 4; j++) S[mt][j] *= egl;
      }
#pragma unroll
      for (int ks = 0; ks < 2; ks++)
        S[mt] = mfma16(ld_tr2(km_tr + (unsigned)((ks * 32) * 272 + mt * 32), km_tr + (unsigned)((ks * 32 + 16) * 272 + mt * 32)), vb[ks], S[mt]);
    }
    __syncthreads();
  }
}

DI void scan_phase_hg(const Params& p, char* smem) {
  const int WV = p.ph_hi;
  for (int u = blockIdx.x; u < 64; u += gridDim.x) {
    const int dir = u & 1, vg = (u >> 1) & 1, h = (u >> 2) & 7, b = u >> 5;
    ScanDesc s;
    s.q = dir == 0 ? (const u16*)(p.ws + OFF_A) + h * 128 : (const u16*)(p.ws + OFF_B) + h * 128;
    s.qp = dir == 0 ? 4096 : 1024;
    s.k = (const u16*)(p.ws + OFF_A) + 1024 + dir * 1024 + h * 128; s.kp = 4096;
    s.v = (const u16*)(p.ws + OFF_A) + 3072 + h * 128 + vg * 64; s.vp = 4096;
    s.aux = (const u16*)(p.ws + OFF_C) + (size_t)(h * 2 + dir) * 4096; s.aux_cs = 8 * 2 * 4096; s.attn_off = 0; s.ainv_off = 0;
    s.o = (u16*)(p.ws + OFF_D + (dir ? SZ_TOK1K : 0)) + h * 128 + vg * 64;
    s.mixer = 2; s.b = b; s.dir = dir;
    s.sc = (const float*)(p.ws + OFF_HGDEC) + (size_t)(h * 2 + dir) * 128; s.sc_cs = 8 * 2 * 128; s.lam = 0.f;
    scan_unit<2>(s, smem, WV);
  }
}
DI void scan_phase_dnret(const Params& p, int l, char* smem) {
  const int WV = p.ph_hi;
  for (int u = blockIdx.x; u < 128; u += gridDim.x) {
    const int mixer = u & 1, dir = (u >> 1) & 1, vg = (u >> 2) & 3, h = (u >> 4) & 3, b = u >> 6;
    ScanDesc s;
    const u16* base = (const u16*)(p.ws + OFF_A + (mixer ? 2 * SZ_TOK1K : 0));
    s.q = base + h * 128; s.k = base + 512 + h * 128; s.v = base + 1024 + h * 256 + vg * 64;
    s.qp = s.kp = s.vp = 2048;
    s.mixer = mixer; s.b = b; s.dir = dir;
    if (mixer == 0) {
      s.aux = (const u16*)(p.ws + OFF_B) + (size_t)(h * 2 + dir) * 2 * 4096; s.aux_cs = 4 * 4 * 4096; s.ainv_off = 0; s.attn_off = 4096;
      s.sc = (const float*)(p.ws + OFF_DNSC) + (size_t)(h * 2 + dir) * 192; s.sc_cs = 4 * 2 * 192; s.lam = 0.f;
      s.o = (u16*)(dir == 0 ? p.ws + OFF_E : p.ws + OFF_D + SZ_TOK1K) + h * 256 + vg * 64;
      scan_unit<0>(s, smem, WV);
    } else {
      s.aux = (const u16*)(p.ws + OFF_C) + (size_t)(h * 2 + dir) * 4096; s.aux_cs = 4 * 2 * 4096; s.attn_off = 0; s.ainv_off = 0;
      const float rd = p.ret_decay[l * 8 + dir * 4 + h];
      s.lam = fminf(rd, 0.f) - log1pf(__expf(-fabsf(rd)));
      s.sc = nullptr; s.sc_cs = 0;
      s.o = (u16*)(p.ws + OFF_E + (dir == 0 ? SZ_TOK1K : 2 * SZ_TOK1K)) + h * 256 + vg * 64;
      scan_unit<1>(s, smem, WV);
    }
  }
}

DI void onorm_rows(u16* of, const u16* ob, const float* nw, int dv, int unit, int nunits_stride, const int WV) {
  const int lane = tidx() & 63, w = tidx() >> 6;
  for (int row = unit * 4 + w; row < T_ALL; row += nunits_stride * 4) {
    u16* pf = of + (size_t)row * 1024 + lane * 16;
    const u16* pb = ob + (size_t)row * 1024 + lane * 16;
    float v[16];
#pragma unroll
    for (int hv = 0; hv < 2; hv++) {
      const uint4 a = *(const uint4*)(pf + hv * 8), b = *(const uint4*)(pb + hv * 8);
      const unsigned aa[4] = {a.x, a.y, a.z, a.w}, bb[4] = {b.x, b.y, b.z, b.w};
#pragma unroll
      for (int e = 0; e < 4; e++) {
        v[hv * 8 + e * 2] = bf2f((u16)(aa[e] & 0xffff)) + bf2f((u16)(bb[e] & 0xffff));
        v[hv * 8 + e * 2 + 1] = bf2f((u16)(aa[e] >> 16)) + bf2f((u16)(bb[e] >> 16));
      }
    }
    float ss = 0.f;
#pragma unroll
    for (int e = 0; e < 16; e++) ss += v[e] * v[e];
    const int nl = dv / 16;
    for (int o = 1; o < nl; o <<= 1) ss += __shfl_xor(ss, o, 64);
    const float rstd = rsqrtf(ss / (float)dv + 1e-6f);
    const int dcol = (lane * 16) % dv;
    unsigned o8[8];
#pragma unroll
    for (int e = 0; e < 8; e++) o8[e] = pack2(v[2 * e] * rstd * nw[dcol + 2 * e], v[2 * e + 1] * rstd * nw[dcol + 2 * e + 1]);
    *(uint4*)pf = uint4{o8[0], o8[1], o8[2], o8[3]};
    *(uint4*)(pf + 8) = uint4{o8[4], o8[5], o8[6], o8[7]};
  }
}

DI void final_norm(const Params& p) {
  const int WV = p.ph_hi;
  const int lane = tidx() & 63, w = tidx() >> 6;
  for (int row = blockIdx.x * 4 + w; row < T_LAT; row += gridDim.x * 4) {
    float* xr = p.out + (size_t)row * 1024;
    f32x4 xv[4];
    float ss = 0.f;
#pragma unroll
    for (int i = 0; i < 4; i++) {
      xv[i] = *(const f32x4*)(xr + i * 256 + lane * 4);
      ss += xv[i][0] * xv[i][0] + xv[i][1] * xv[i][1] + xv[i][2] * xv[i][2] + xv[i][3] * xv[i][3];
    }
    ss = wsum(ss);
    const float rstd = rsqrtf(ss * (1.f / 1024.f) + 1e-6f);
#pragma unroll
    for (int i = 0; i < 4; i++) {
      const f32x4 wv = *(const f32x4*)(p.final_norm_w + i * 256 + lane * 4);
      f32x4 r;
#pragma unroll
      for (int j = 0; j < 4; j++) r[j] = xv[i][j] * rstd * wv[j];
      *(f32x4*)(xr + i * 256 + lane * 4) = r;
    }
  }
}

DI void run_phase(const Params& p, int ph, char* smem) {
  const int WV = p.ph_hi;
  const int G = gridDim.x, B = blockIdx.x;
  if (ph == 0) { if (QSEL(11)) phase_pro(p, smem); return; }
  if (ph == 23) { if (QSEL(12)) final_norm(p); return; }
  const int l = (ph - 1) / 11, q = (ph - 1) % 11;
  const bool last = l == 1;
  switch (q) {
    case 0: if (!QSEL(0)) break;
      if (l == 1) for (int u = B; u < WCONV_UNITS; u += G) wconv_unit(p, 1, u, smem);
      phase_norm(p, l, smem);
      break;
    case 1: if (!QSEL(1)) break;
      for (int t = B; t < 132 * 32; t += G) gemm_tile<EPI_HG>(p, l, t % 132, t / 132, smem);
      break;
    case 2: if (!QSEL(2)) break;
      for (int u = B; u < NCH * 8; u += G) hg_prep_unit(p, l, u >> 3, u & 7, smem);
      break;
    case 3: if (!QSEL(3)) break; scan_phase_hg(p, smem); break;
    case 4: if (!QSEL(4)) break;
      for (int t = B; t < 132 * 32; t += G) gemm_tile<EPI_DNRET>(p, l, t % 132, t / 132, smem);
      onorm_rows((u16*)(p.ws + OFF_D), (const u16*)(p.ws + OFF_D + SZ_TOK1K), p.hg_norm_w + l * 128, 128, B, G, WV);
      break;
    case 5: if (!QSEL(5)) break;
      for (int u = B; u < NCH * 8; u += G) {
        if (u < NCH * 4) dn_prep_unit(p, l, u >> 2, u & 3, smem);
        else ret_prep_unit(p, l, (u - NCH * 4) >> 2, u & 3, smem);
      }
      break;
    case 6: if (!QSEL(6)) break; scan_phase_dnret(p, l, smem); break;
    case 7: if (!QSEL(7)) break;
      onorm_rows((u16*)(p.ws + OFF_E), (const u16*)(p.ws + OFF_D + SZ_TOK1K), p.dn_norm_w + l * 256, 256, B, G, WV);
      onorm_rows((u16*)(p.ws + OFF_E + SZ_TOK1K), (const u16*)(p.ws + OFF_E + 2 * SZ_TOK1K), p.ret_norm_w + l * 256, 256, B, G, WV);
      break;
    case 8: if (!QSEL(8)) break; {
      const int nrt = last ? 128 : 132;
      for (int t = B; t < nrt * 24; t += G) gemm_tile<EPI_GATE>(p, l, t % nrt, t / nrt, smem);
    } break;
    case 9: if (!QSEL(9)) break; {
      const int nrt = last ? 128 : 132;
      for (int t = B; t < nrt * 8; t += G) merge_tile(p, t % nrt, t / nrt, smem);
    } break;
    case 10: if (!QSEL(10)) break; {
      const int nrt = last ? 128 : 132;
      for (int t = B; t < nrt * 8; t += G) gemm_tile<EPI_OUT>(p, l, t % nrt, t / nrt, smem);
    } break;
  }
}

DI void grid_barrier(unsigned* ctr, unsigned target) {
  asm volatile("s_waitcnt vmcnt(0) lgkmcnt(0)" ::: "memory");
  __syncthreads();
  if (__builtin_amdgcn_workitem_id_x() == 0) {
    __builtin_amdgcn_fence(__ATOMIC_RELEASE, "agent");
    asm volatile("s_waitcnt vmcnt(0)" ::: "memory");
    __hip_atomic_fetch_add(ctr, 1u, __ATOMIC_RELAXED, __HIP_MEMORY_SCOPE_AGENT);
    while (__hip_atomic_load(ctr, __ATOMIC_RELAXED, __HIP_MEMORY_SCOPE_AGENT) < target) __builtin_amdgcn_s_sleep(16);
    __builtin_amdgcn_fence(__ATOMIC_ACQUIRE, "agent");
    asm volatile("s_waitcnt vmcnt(0)" ::: "memory");
  }
  __syncthreads();
}

__global__ void __launch_bounds__(256, 2) mk(Params p) {
  extern __shared__ __attribute__((aligned(16))) char smem[];
  p.ph_hi = __builtin_amdgcn_readfirstlane((int)__builtin_amdgcn_workitem_id_x() >> 6);
#if ONE_LAUNCH
  cg::grid_group grid = cg::this_grid();
  unsigned* bar = (unsigned*)(p.ws + OFF_BAR);
  const unsigned G = gridDim.x;
  run_phase(p, 0, smem);
  grid.sync();
#define PH(n) run_phase(p, n, smem); grid_barrier(bar, (unsigned)(n) * G);
  PH(1) PH(2) PH(3) PH(4) PH(5) PH(6) PH(7) PH(8) PH(9) PH(10) PH(11)
  PH(12) PH(13) PH(14) PH(15) PH(16) PH(17) PH(18) PH(19) PH(20) PH(21) PH(22)
  run_phase(p, 23, smem);
#else
  run_phase(p, p.ph_lo, smem);
#endif
}

extern "C" void kernel_launch(void* const* d_in, const int* in_sizes, int n_in, void* d_out,
                              int out_size, void* d_ws, size_t ws_size, hipStream_t stream) {
  static int grid_blocks = 0;
  if (!grid_blocks) {
    int dev = 0, cus = 0, per_cu = 0;
    (void)hipGetDevice(&dev);
    (void)hipDeviceGetAttribute(&cus, hipDeviceAttributeMultiprocessorCount, dev);
    (void)hipFuncSetAttribute((const void*)mk, hipFuncAttributeMaxDynamicSharedMemorySize, SMEM_BYTES);
    (void)hipOccupancyMaxActiveBlocksPerMultiprocessor(&per_cu, mk, 256, SMEM_BYTES);
    if (per_cu > 2) per_cu = 2;
    if (per_cu < 1) per_cu = 1;
    grid_blocks = cus * per_cu;
  }
  Params p{};
  const float** f = (const float**)&p;
  for (int i = 0; i < 19; i++) f[i] = (const float*)d_in[i];
  p.out = (float*)d_out;
  p.ws = (char*)d_ws;
#if ONE_LAUNCH
  p.ph_lo = 0; p.ph_hi = 24;
  (void)hipMemsetAsync((char*)d_ws + OFF_BAR, 0, 256, stream);
  void* args[] = {&p};
  (void)hipLaunchCooperativeKernel((void*)mk, dim3(grid_blocks), dim3(256), args, SMEM_BYTES, stream);
#else
  for (int ph = 0; ph < 24; ph++) {
    p.ph_lo = ph; p.ph_hi = ph + 1;
    void* args[] = {&p};
    (void)hipLaunchCooperativeKernel((void*)mk, dim3(grid_blocks), dim3(256), args, SMEM_BYTES, stream);
  }
#endif
}
```

```cpp
#include <hip/hip_runtime.h>
#include <hip/hip_cooperative_groups.h>
#include <cstdio>
namespace cg = cooperative_groups;

#ifndef ONE_LAUNCH
#define ONE_LAUNCH 1
#endif
#ifndef ONLY_Q
#define ONLY_Q -1
#endif
#define QSEL(n) (ONLY_Q < 0 || ONLY_Q == (n))

typedef unsigned short u16;
using bf16x8 = __attribute__((ext_vector_type(8))) short;
using bf16x4 = __attribute__((ext_vector_type(4))) short;
using f32x4 = __attribute__((ext_vector_type(4))) float;
using u32x4 = __attribute__((ext_vector_type(4))) unsigned;
#define DI __device__ __forceinline__

constexpr int T_LAT = 16384, T_ALL = 16896, NCH = 264;
constexpr int WROWS = 18448;
constexpr int W_BR = 14352, W_OUT = 17424;
constexpr size_t al(size_t x) { return (x + 255) & ~(size_t)255; }
constexpr size_t SZ_WT = (size_t)WROWS * 1024 * 2;
constexpr size_t SZ_TOK1K = (size_t)T_ALL * 1024 * 2;
constexpr size_t OFF_WT = 0;
constexpr size_t OFF_H = OFF_WT + al(SZ_WT);
constexpr size_t OFF_MOD = OFF_H + al(SZ_TOK1K);
constexpr size_t OFF_ROT = OFF_MOD + al(2 * 3 * 3072 * 4);
constexpr size_t OFF_GB = OFF_ROT + al(128 * 32 * 2 * 4);
constexpr size_t OFF_CTX1 = OFF_GB + al((size_t)T_ALL * 16 * 4);
constexpr size_t OFF_HALO = OFF_CTX1 + al(512 * 1024 * 4);
constexpr size_t OFF_DNSC = OFF_HALO + al((size_t)NCH * 4 * 2048 * 2);
constexpr size_t OFF_HGDEC = OFF_DNSC + al((size_t)NCH * 4 * 2 * 192 * 4);
constexpr size_t OFF_BAR = OFF_HGDEC + al((size_t)NCH * 8 * 2 * 128 * 4);
constexpr size_t OFF_A = OFF_BAR + 16384;
constexpr size_t OFF_B = OFF_A + 4 * SZ_TOK1K;
constexpr size_t OFF_C = OFF_B + SZ_TOK1K;
constexpr size_t OFF_D = OFF_C + SZ_TOK1K;
constexpr size_t OFF_E = OFF_D + 2 * SZ_TOK1K;
constexpr size_t WS_TOTAL = OFF_E + 3 * SZ_TOK1K;
static_assert(WS_TOTAL <= 470286336ull, "workspace too large");

constexpr int SMEM_BYTES = 72960;

struct Params {
  const float *x, *c, *ctx, *c_ctx, *norm_w, *ada_w, *ada_b, *w_in, *dn_conv, *dn_a_log, *dn_dt_bias, *dn_norm_w,
      *ret_decay, *ret_norm_w, *hg_lb, *hg_norm_w, *w_branch, *w_out, *final_norm_w;
  float* out;
  char* ws;
  int ph_lo, ph_hi;
};

DI int laneid_v() { int t; asm volatile("v_mbcnt_lo_u32_b32 %0, -1, 0\n\tv_mbcnt_hi_u32_b32 %0, -1, %0" : "=v"(t)); return t; }
#define tidx() (WV * 64 + laneid_v())
typedef __bf16 hwbf2 __attribute__((ext_vector_type(2)));
DI u16 f2bf(float f) { __bf16 b = (__bf16)f; return __builtin_bit_cast(u16, b); }
DI float bf2f(u16 h) { return __uint_as_float(((unsigned)h) << 16); }
DI unsigned pack2(float a, float b) { hwbf2 v = {(__bf16)a, (__bf16)b}; return __builtin_bit_cast(unsigned, v); }
DI float sigm(float x) { return 1.f / (1.f + __expf(-x)); }
DI float silu(float x) { return x / (1.f + __expf(-x)); }
DI float dpp_f(float v, const int ctrl_sel) {
  const int iv = __float_as_int(v);
  int r;
  if (ctrl_sel == 0) r = __builtin_amdgcn_update_dpp(0, iv, 0xB1, 0xF, 0xF, false);
  else if (ctrl_sel == 1) r = __builtin_amdgcn_update_dpp(0, iv, 0x4E, 0xF, 0xF, false);
  else if (ctrl_sel == 2) r = __builtin_amdgcn_update_dpp(0, iv, 0x141, 0xF, 0xF, false);
  else r = __builtin_amdgcn_update_dpp(0, iv, 0x140, 0xF, 0xF, false);
  return __int_as_float(r);
}
DI float gsum(float v, const int n) {
  v += dpp_f(v, 0);
  v += dpp_f(v, 1);
  v += dpp_f(v, 2);
  if (n == 16) v += dpp_f(v, 3);
  return v;
}
DI float wsum(float v) {
  v = gsum(v, 16);
  v += __int_as_float(__builtin_amdgcn_update_dpp(0, __float_as_int(v), 0x142, 0xA, 0xF, false));
  v += __int_as_float(__builtin_amdgcn_update_dpp(0, __float_as_int(v), 0x143, 0xC, 0xF, false));
  return __int_as_float(__builtin_amdgcn_readlane(__float_as_int(v), 63));
}
DI f32x4 mfma16(bf16x8 a, bf16x8 b, f32x4 c) { return __builtin_amdgcn_mfma_f32_16x16x32_bf16(a, b, c, 0, 0, 0); }
DI bf16x8 pack8(f32x4 lo, f32x4 hi) {
  u32x4 r = {pack2(lo[0], lo[1]), pack2(lo[2], lo[3]), pack2(hi[0], hi[1]), pack2(hi[2], hi[3])};
  return __builtin_bit_cast(bf16x8, r);
}
typedef __attribute__((address_space(3))) bf16x4* lds_v4p;
DI bf16x8 ld_tr2(unsigned a_lo, unsigned a_hi) {
  const bf16x4 lo = __builtin_amdgcn_ds_read_tr16_b64_v4i16((lds_v4p)(size_t)a_lo);
  const bf16x4 hi = __builtin_amdgcn_ds_read_tr16_b64_v4i16((lds_v4p)(size_t)a_hi);
  bf16x8 r;
  r[0] = lo[0]; r[1] = lo[1]; r[2] = lo[2]; r[3] = lo[3]; r[4] = hi[0]; r[5] = hi[1]; r[6] = hi[2]; r[7] = hi[3];
  return r;
}
DI bf16x8 ld_perm(const char* rowp, int c0) {
  bf16x4 lo = *(const bf16x4*)(rowp + c0 * 2);
  bf16x4 hi = *(const bf16x4*)(rowp + c0 * 2 + 32);
  bf16x8 r;
  r[0] = lo[0]; r[1] = lo[1]; r[2] = lo[2]; r[3] = lo[3]; r[4] = hi[0]; r[5] = hi[1]; r[6] = hi[2]; r[7] = hi[3];
  return r;
}

DI int swz(int row, int ch) { return row * 128 + ((ch ^ (row & 7)) << 4); }

template <bool DEEP>
DI void gemm_kloop_t(const u16* __restrict__ A, const u16* __restrict__ W, f32x4 (&acc)[4][4], char* smem, const int WV) {
  const int tid = tidx(), lane = tid & 63, wid = tid >> 6, wn = wid >> 1, wt = wid & 1;
  const int fr = lane & 15, fq = lane >> 4;
  const int lrow = tid >> 3, lch = tid & 7;
  const u16* Ap = A + (size_t)lrow * 1024 + lch * 8;
  const u16* Wp = W + (size_t)lrow * 1024 + lch * 8;
  u32x4 ra0[4], rw0[4], ra1[4], rw1[4];
#define G_LOAD(RA, RW, KT) _Pragma("unroll") for (int i = 0; i < 4; i++) { \
    RA[i] = *(const u32x4*)(Ap + (size_t)i * 32 * 1024 + (KT) * 64); RW[i] = *(const u32x4*)(Wp + (size_t)i * 32 * 1024 + (KT) * 64); }
#define G_STORE(RA, RW, BUF) { char* dW = smem + (BUF) * 32768; _Pragma("unroll") for (int i = 0; i < 4; i++) { \
    *(u32x4*)(dW + swz(lrow + i * 32, lch)) = RW[i]; *(u32x4*)(dW + 16384 + swz(lrow + i * 32, lch)) = RA[i]; } }
#define G_COMPUTE(BUF) { const char* sW = smem + (BUF) * 32768; const char* sA = sW + 16384; \
    _Pragma("unroll") for (int ks = 0; ks < 2; ks++) { bf16x8 fw[4], fa[4]; \
      _Pragma("unroll") for (int i = 0; i < 4; i++) { \
        fw[i] = *(const bf16x8*)(sW + swz(wn * 64 + i * 16 + fr, ks * 4 + fq)); \
        fa[i] = *(const bf16x8*)(sA + swz(wt * 64 + i * 16 + fr, ks * 4 + fq)); } \
      _Pragma("unroll") for (int ni = 0; ni < 4; ni++) _Pragma("unroll") for (int ti = 0; ti < 4; ti++) \
        acc[ni][ti] = mfma16(fw[ni], fa[ti], acc[ni][ti]); } }
  G_LOAD(ra0, rw0, 0)
  G_STORE(ra0, rw0, 0)
  if (DEEP) { G_LOAD(ra1, rw1, 1) }
  __syncthreads();
  if (DEEP) {
    for (int kt = 0; kt < 16; kt += 2) {
      if (kt + 2 < 16) { G_LOAD(ra0, rw0, kt + 2) }
      G_COMPUTE(0)
      G_STORE(ra1, rw1, 1)
      __syncthreads();
      if (kt + 3 < 16) { G_LOAD(ra1, rw1, kt + 3) }
      G_COMPUTE(1)
      if (kt + 2 < 16) { G_STORE(ra0, rw0, 0) }
      __syncthreads();
    }
  } else {
    for (int kt = 0; kt < 16; kt++) {
      if (kt < 15) { G_LOAD(ra0, rw0, kt + 1) }
      G_COMPUTE(kt & 1)
      if (kt < 15) { G_STORE(ra0, rw0, (kt + 1) & 1) }
      __syncthreads();
    }
  }
#undef G_LOAD
#undef G_STORE
#undef G_COMPUTE
}
DI void gemm_kloop(const u16* __restrict__ A, const u16* __restrict__ W, f32x4 (&acc)[4][4], char* smem, const int WV,
                   const bool have0 = false, const u16* __restrict__ nA = nullptr, const u16* __restrict__ nW = nullptr) {
  const int tid = tidx(), lane = tid & 63, wid = tid >> 6, wn = wid >> 1, wt = wid & 1;
  const int fr = lane & 15, fq = lane >> 4;
  const int r8 = lane >> 3, chs = (lane & 7) ^ r8;
  const size_t loff = (size_t)(wid * 32 + r8) * 1024 + chs * 8;
  const u16* Asrc = A + loff;
  const u16* Wsrc = W + loff;
  char* ldsw = smem + wid * 4096;
#define G_STAGE_P(AS, WS, BUF, KT) _Pragma("unroll") for (int i = 0; i < 4; i++) { \
    __builtin_amdgcn_global_load_lds((const unsigned*)((WS) + (size_t)i * 8 * 1024 + (KT) * 64), (unsigned*)(ldsw + (BUF) * 32768 + i * 1024), 16, 0, 0); \
    __builtin_amdgcn_global_load_lds((const unsigned*)((AS) + (size_t)i * 8 * 1024 + (KT) * 64), (unsigned*)(ldsw + (BUF) * 32768 + 16384 + i * 1024), 16, 0, 0); }
#define G_COMPUTE(BUF) { const char* sW = smem + (BUF) * 32768; const char* sA = sW + 16384; \
    _Pragma("unroll") for (int ks = 0; ks < 2; ks++) { bf16x8 fw[4], fa[4]; \
      _Pragma("unroll") for (int i = 0; i < 4; i++) { \
        fw[i] = *(const bf16x8*)(sW + swz(wn * 64 + i * 16 + fr, ks * 4 + fq)); \
        fa[i] = *(const bf16x8*)(sA + swz(wt * 64 + i * 16 + fr, ks * 4 + fq)); } \
      _Pragma("unroll") for (int ni = 0; ni < 4; ni++) _Pragma("unroll") for (int ti = 0; ti < 4; ti++) \
        acc[ni][ti] = mfma16(fw[ni], fa[ti], acc[ni][ti]); } }
  if (!have0) {
    G_STAGE_P(Asrc, Wsrc, 0, 0)
    asm volatile("s_waitcnt vmcnt(0)" ::: "memory");
    __syncthreads();
  }
  for (int kt = 0; kt < 16; kt++) {
    if (kt < 15) { G_STAGE_P(Asrc, Wsrc, (kt + 1) & 1, kt + 1) }
    else if (nA != nullptr) { const u16* nAs = nA + loff; const u16* nWs = nW + loff; G_STAGE_P(nAs, nWs, 0, 0) }
    G_COMPUTE(kt & 1)
    asm volatile("s_waitcnt vmcnt(0)" ::: "memory");
    __syncthreads();
  }
#undef G_STAGE_P
#undef G_COMPUTE
}

DI void gemm_kloop256(const u16* __restrict__ A, const u16* __restrict__ W, f32x4 (&acc)[8][4], char* smem, const int WV) {
  const int tid = tidx(), lane = tid & 63, wid = tid >> 6, wn = wid >> 1, wt = wid & 1;
  const int fr = lane & 15, fq = lane >> 4;
  const int r16 = lane >> 2, chs = (lane & 3) ^ ((0 - (r16 >> 2)) & 3);
  const u16* Wsrc = W + (size_t)(wid * 64 + r16) * 1024 + chs * 8;
  const u16* Asrc = A + (size_t)(wid * 32 + r16) * 1024 + chs * 8;
  const int fpos = (fq ^ ((0 - (fr >> 2)) & 3)) << 4;
#define G_STAGE(BUF, KT) { _Pragma("unroll") for (int i = 0; i < 4; i++) \
      __builtin_amdgcn_global_load_lds((const unsigned*)(Wsrc + (size_t)i * 16 * 1024 + (KT) * 32), (unsigned*)(smem + (BUF) * 24576 + (wid * 4 + i) * 1024), 16, 0, 0); \
    _Pragma("unroll") for (int i = 0; i < 2; i++) \
      __builtin_amdgcn_global_load_lds((const unsigned*)(Asrc + (size_t)i * 16 * 1024 + (KT) * 32), (unsigned*)(smem + (BUF) * 24576 + 16384 + (wid * 2 + i) * 1024), 16, 0, 0); }
#define G_COMPUTE(BUF) { const char* sW = smem + (BUF) * 24576; const char* sA = sW + 16384; bf16x8 fw[8], fa[4]; \
    _Pragma("unroll") for (int i = 0; i < 8; i++) fw[i] = *(const bf16x8*)(sW + (wn * 128 + i * 16 + fr) * 64 + fpos); \
    _Pragma("unroll") for (int i = 0; i < 4; i++) fa[i] = *(const bf16x8*)(sA + (wt * 64 + i * 16 + fr) * 64 + fpos); \
    __builtin_amdgcn_s_setprio(1); \
    _Pragma("unroll") for (int ni = 0; ni < 8; ni++) _Pragma("unroll") for (int ti = 0; ti < 4; ti++) \
      acc[ni][ti] = mfma16(fw[ni], fa[ti], acc[ni][ti]); \
    __builtin_amdgcn_s_setprio(0); }
  G_STAGE(0, 0)
  asm volatile("s_waitcnt vmcnt(0)" ::: "memory");
  __syncthreads();
  for (int kt = 0; kt < 32; kt++) {
    if (kt < 31) { G_STAGE((kt + 1) & 1, kt + 1) }
    G_COMPUTE(kt & 1)
    asm volatile("s_waitcnt vmcnt(0)" ::: "memory");
    __syncthreads();
  }
#undef G_STAGE
#undef G_COMPUTE
}

enum { EPI_HG = 0, EPI_DNRET = 1, EPI_GATE = 2, EPI_OUT = 3 };

template <int EPI, int NI>
DI void gemm_tile(const Params& p, int l, int rt, int nti, char* smem) {
  const int WV = p.ph_hi;
  const int tid = tidx(), lane = tid & 63, wid = tid >> 6, wn = wid >> 1, wt = wid & 1;
  const int fr = lane & 15, fq = lane >> 4;
  const int row0 = rt * 128;
  constexpr int NW = NI * 32;
  const u16* WT = (const u16*)(p.ws + OFF_WT);
  const u16* A;
  int wrow, n0, mixer = 0;
  if (EPI == EPI_HG) { A = (const u16*)(p.ws + OFF_H); n0 = nti * NW; wrow = 6160 + n0; }
  else if (EPI == EPI_DNRET) { A = (const u16*)(p.ws + OFF_H); mixer = nti / (2048 / NW); n0 = (nti % (2048 / NW)) * NW; wrow = (mixer ? 3088 : 0) + n0; }
  else if (EPI == EPI_GATE) { A = (const u16*)(p.ws + OFF_H); mixer = nti / (1024 / NW); n0 = (nti % (1024 / NW)) * NW; wrow = (mixer == 0 ? 2048 : (mixer == 1 ? 5136 : 10256)) + n0; }
  else { A = (const u16*)(p.ws + OFF_B); n0 = nti * NW; wrow = W_OUT + n0; }
  f32x4 acc[NI][4];
#pragma unroll
  for (int i = 0; i < NI; i++)
#pragma unroll
    for (int j = 0; j < 4; j++) acc[i][j] = f32x4{0.f, 0.f, 0.f, 0.f};
  if constexpr (NI == 4) gemm_kloop(A + (size_t)row0 * 1024, WT + (size_t)wrow * 1024, acc, smem, WV);
  else gemm_kloop256(A + (size_t)row0 * 1024, WT + (size_t)wrow * 1024, acc, smem, WV);

  const float* ROT = (const float*)(p.ws + OFF_ROT);
  const float* MOD = (const float*)(p.ws + OFF_MOD);
#pragma unroll
  for (int ti = 0; ti < 4; ti++) {
    const int token = row0 + wt * 64 + ti * 16 + fr;
#pragma unroll
    for (int ni = 0; ni < NI; ni++) {
      const int nl = n0 + wn * (NI * 16) + ni * 16 + fq * 4;
      f32x4 v = acc[ni][ti];
      if (EPI == EPI_HG) {
        if (nl < 1024) { v[0] = silu(v[0]); v[1] = silu(v[1]); v[2] = silu(v[2]); v[3] = silu(v[3]); }
        u16* dst = (u16*)(p.ws + OFF_A) + (size_t)token * 4096 + nl;
        *(uint2*)dst = uint2{pack2(v[0], v[1]), pack2(v[2], v[3])};
      } else if (EPI == EPI_DNRET) {
        if (mixer == 0) {
          uint2 pk = uint2{pack2(v[0], v[1]), pack2(v[2], v[3])};
          u16* dst = (u16*)(p.ws + OFF_A) + (size_t)token * 2048 + nl;
          *(uint2*)dst = pk;
          const int tm = token & 63;
          if (tm < 2 || tm >= 62) {
            const int slot = tm < 2 ? tm : tm - 60;
            u16* hd = (u16*)(p.ws + OFF_HALO) + ((size_t)(token >> 6) * 4 + slot) * 2048 + nl;
            *(uint2*)hd = pk;
          }
        } else {
          if (nl < 1024) {
            if (token < T_LAT) {
              const int t = token & 8191, ri = t >> 6, ci = t & 63;
              const int d = nl & 127;
#pragma unroll
              for (int pp = 0; pp < 2; pp++) {
                const int pidx = (d >> 1) + pp;
                const float* rp = pidx < 32 ? ROT + (ri * 32 + pidx) * 2 : ROT + (ci * 32 + (pidx - 32)) * 2;
                const float cs = rp[0], sn = rp[1];
                const float x1 = v[2 * pp], x2 = v[2 * pp + 1];
                v[2 * pp] = x1 * cs - x2 * sn;
                v[2 * pp + 1] = x1 * sn + x2 * cs;
              }
            }
            if (nl >= 512) { const float s = 0.08838834764831845f; v[0] *= s; v[1] *= s; v[2] *= s; v[3] *= s; }
          }
          u16* dst = (u16*)(p.ws + OFF_A + 2 * SZ_TOK1K) + (size_t)token * 2048 + nl;
          *(uint2*)dst = uint2{pack2(v[0], v[1]), pack2(v[2], v[3])};
        }
      } else if (EPI == EPI_GATE) {
        char* base = mixer == 0 ? p.ws + OFF_E : (mixer == 1 ? p.ws + OFF_E + SZ_TOK1K : p.ws + OFF_D);
        u16* dst = (u16*)base + (size_t)token * 1024 + nl;
        uint2 on = *(const uint2*)dst;
        float o0 = bf2f((u16)(on.x & 0xffff)), o1 = bf2f((u16)(on.x >> 16)), o2 = bf2f((u16)(on.y & 0xffff)), o3 = bf2f((u16)(on.y >> 16));
        *(uint2*)dst = uint2{pack2(o0 * silu(v[0]), o1 * silu(v[1])), pack2(o2 * silu(v[2]), o3 * silu(v[3]))};
      } else {
        const int vec = token < T_LAT ? (token >> 13) : 2;
        const f32x4 gt = *(const f32x4*)(MOD + ((size_t)l * 3 + vec) * 3072 + 2048 + nl);
        const float* src;
        float* dst;
        if (token < T_LAT) {
          src = (l == 0 ? p.x : (const float*)p.out) + (size_t)token * 1024 + nl;
          dst = p.out + (size_t)token * 1024 + nl;
        } else {
          src = p.ctx + (size_t)(token - T_LAT) * 1024 + nl;
          dst = (float*)(p.ws + OFF_CTX1) + (size_t)(token - T_LAT) * 1024 + nl;
        }
        f32x4 xi = *(const f32x4*)src;
        f32x4 r;
        r[0] = xi[0] + gt[0] * v[0]; r[1] = xi[1] + gt[1] * v[1]; r[2] = xi[2] + gt[2] * v[2]; r[3] = xi[3] + gt[3] * v[3];
        *(f32x4*)dst = r;
      }
    }
  }
}

DI void merge_tile(const Params& p, int rt, int nti, char* smem, const bool have0 = false, const int nrt = -1, const int nnti = -1) {
  const int WV = p.ph_hi;
  const int tid = tidx(), lane = tid & 63, wid = tid >> 6, wn = wid >> 1, wt = wid & 1;
  const int fr = lane & 15, fq = lane >> 4;
  const int row0 = rt * 128, n0 = nti * 128;
  const u16* WT = (const u16*)(p.ws + OFF_WT);
  const u16* H = (const u16*)(p.ws + OFF_H) + (size_t)row0 * 1024;
  uint2 y[4][4];
#pragma unroll
  for (int i = 0; i < 4; i++)
#pragma unroll
    for (int j = 0; j < 4; j++) y[i][j] = uint2{0u, 0u};
  for (int m = 0; m < 3; m++) {
    uint2 sg[4][4];
    {
      f32x4 acc[4][4];
#pragma unroll
      for (int i = 0; i < 4; i++)
#pragma unroll
        for (int j = 0; j < 4; j++) acc[i][j] = f32x4{0.f, 0.f, 0.f, 0.f};
      const char* baseb = m == 0 ? p.ws + OFF_E : (m == 1 ? p.ws + OFF_E + SZ_TOK1K : p.ws + OFF_D);
      gemm_kloop(H, WT + (size_t)(11280 + m * 1024 + n0) * 1024, acc, smem, WV, have0 || m > 0,
                 (const u16*)baseb + (size_t)row0 * 1024, WT + (size_t)(W_BR + m * 1024 + n0) * 1024);
#pragma unroll
      for (int i = 0; i < 4; i++)
#pragma unroll
        for (int j = 0; j < 4; j++)
          sg[i][j] = uint2{pack2(sigm(acc[i][j][0]), sigm(acc[i][j][1])), pack2(sigm(acc[i][j][2]), sigm(acc[i][j][3]))};
    }
    {
      const char* base = m == 0 ? p.ws + OFF_E : (m == 1 ? p.ws + OFF_E + SZ_TOK1K : p.ws + OFF_D);
      f32x4 acc[4][4];
#pragma unroll
      for (int i = 0; i < 4; i++)
#pragma unroll
        for (int j = 0; j < 4; j++) acc[i][j] = f32x4{0.f, 0.f, 0.f, 0.f};
      const u16* nA = m < 2 ? H : (nrt >= 0 ? (const u16*)(p.ws + OFF_H) + (size_t)nrt * 128 * 1024 : nullptr);
      const u16* nW = m < 2 ? WT + (size_t)(11280 + (m + 1) * 1024 + n0) * 1024 : (nrt >= 0 ? WT + (size_t)(11280 + nnti * 128) * 1024 : nullptr);
      gemm_kloop((const u16*)base + (size_t)row0 * 1024, WT + (size_t)(W_BR + m * 1024 + n0) * 1024, acc, smem, WV, true, nA, nW);
#pragma unroll
      for (int i = 0; i < 4; i++)
#pragma unroll
        for (int j = 0; j < 4; j++) {
          const float y0 = bf2f((u16)(y[i][j].x & 0xffff)) + acc[i][j][0] * bf2f((u16)(sg[i][j].x & 0xffff));
          const float y1 = bf2f((u16)(y[i][j].x >> 16)) + acc[i][j][1] * bf2f((u16)(sg[i][j].x >> 16));
          const float y2 = bf2f((u16)(y[i][j].y & 0xffff)) + acc[i][j][2] * bf2f((u16)(sg[i][j].y & 0xffff));
          const float y3 = bf2f((u16)(y[i][j].y >> 16)) + acc[i][j][3] * bf2f((u16)(sg[i][j].y >> 16));
          y[i][j] = uint2{pack2(y0, y1), pack2(y2, y3)};
        }
    }
  }
  u16* Y = (u16*)(p.ws + OFF_B);
#pragma unroll
  for (int ti = 0; ti < 4; ti++) {
    const int token = row0 + wt * 64 + ti * 16 + fr;
#pragma unroll
    for (int ni = 0; ni < 4; ni++) {
      const int nl = n0 + wn * 64 + ni * 16 + fq * 4;
      *(uint2*)(Y + (size_t)token * 1024 + nl) = y[ni][ti];
    }
  }
}

DI void wconv_tile(const float* __restrict__ src, int N, int kt, int ntile, u16* __restrict__ dst, char* smem, const int WV) {
  float* s = (float*)smem;
  const int tid = tidx();
  const int k0 = kt * 64, n0 = ntile * 64;
#pragma unroll
  for (int i = 0; i < 4; i++) {
    const int r = (tid >> 4) + i * 16, c4 = (tid & 15) * 4;
    if (n0 + c4 < N) {
      f32x4 v = *(const f32x4*)(src + (size_t)(k0 + r) * N + n0 + c4);
      s[r * 65 + c4] = v[0]; s[r * 65 + c4 + 1] = v[1]; s[r * 65 + c4 + 2] = v[2]; s[r * 65 + c4 + 3] = v[3];
    }
  }
  __syncthreads();
#pragma unroll
  for (int i = 0; i < 2; i++) {
    const int id = tid + i * 256, n = id >> 3, kc = (id & 7) * 8;
    if (n0 + n < N) {
      uint4 o;
      o.x = pack2(s[(kc + 0) * 65 + n], s[(kc + 1) * 65 + n]);
      o.y = pack2(s[(kc + 2) * 65 + n], s[(kc + 3) * 65 + n]);
      o.z = pack2(s[(kc + 4) * 65 + n], s[(kc + 5) * 65 + n]);
      o.w = pack2(s[(kc + 6) * 65 + n], s[(kc + 7) * 65 + n]);
      *(uint4*)(dst + (size_t)(n0 + n) * 1024 + k0 + kc) = o;
    }
  }
  __syncthreads();
}
constexpr int WCONV_UNITS = 16 * 225 + 3 * 256 + 256;
DI void wconv_unit(const Params& p, int l, int u, char* smem) {
  const int WV = p.ph_hi;
  u16* WT = (u16*)(p.ws + OFF_WT);
  if (u < 16 * 225) wconv_tile(p.w_in + (size_t)l * 1024 * 14352, 14352, u / 225, u % 225, WT, smem, WV);
  else if (u < 16 * 225 + 768) {
    const int v = u - 16 * 225, m = v >> 8, r = v & 255;
    wconv_tile(p.w_branch + ((size_t)l * 3 + m) * 1024 * 1024, 1024, r >> 4, r & 15, WT + (size_t)(W_BR + m * 1024) * 1024, smem, WV);
  } else {
    const int r = u - 16 * 225 - 768;
    wconv_tile(p.w_out + (size_t)l * 1024 * 1024, 1024, r >> 4, r & 15, WT + (size_t)W_OUT * 1024, smem, WV);
  }
}

DI void adaln_unit(const Params& p, int u, char* smem) {
  const int WV = p.ph_hi;
  const int l = u / 48, ng = u % 48;
  const int tid = tidx(), lane = tid & 63, w = tid >> 6;
  const int n = ng * 64 + lane;
  const float* W = p.ada_w + (size_t)l * 1024 * 3072;
  float a0 = 0.f, a1 = 0.f, a2 = 0.f;
#pragma unroll 8
  for (int k = w * 256; k < w * 256 + 256; k++) {
    const float wv = W[(size_t)k * 3072 + n];
    a0 += silu(p.c[k]) * wv; a1 += silu(p.c[1024 + k]) * wv; a2 += silu(p.c_ctx[k]) * wv;
  }
  float* red = (float*)smem;
  red[(w * 3 + 0) * 64 + lane] = a0; red[(w * 3 + 1) * 64 + lane] = a1; red[(w * 3 + 2) * 64 + lane] = a2;
  __syncthreads();
  if (tid < 192) {
    const int vec = tid >> 6, ln = tid & 63;
    float s = red[(0 * 3 + vec) * 64 + ln] + red[(1 * 3 + vec) * 64 + ln] + red[(2 * 3 + vec) * 64 + ln] + red[(3 * 3 + vec) * 64 + ln];
    const int nn = ng * 64 + ln;
    ((float*)(p.ws + OFF_MOD))[((size_t)l * 3 + vec) * 3072 + nn] = s + p.ada_b[(size_t)l * 3072 + nn];
  }
  __syncthreads();
}

DI void phase_pro(const Params& p, char* smem) {
  const int WV = p.ph_hi;
  const int total = 96 + 16 + WCONV_UNITS;
  for (int u = blockIdx.x; u < total; u += gridDim.x) {
    if (u < 96) adaln_unit(p, u, smem);
    else if (u < 112) {
      const int id = (u - 96) * 256 + tidx();
      const int pos = id >> 5, m = id & 31;
      const float inv = powf(10000.f, -(float)(2 * m) / 64.f);
      float s, c;
      sincosf((float)pos * inv, &s, &c);
      float* ROT = (float*)(p.ws + OFF_ROT);
      ROT[id * 2] = c; ROT[id * 2 + 1] = s;
    } else wconv_unit(p, 0, u - 112, smem);
  }
}

DI void phase_norm(const Params& p, int l, char* smem) {
  const int WV = p.ph_hi;
  const int tid = tidx(), lane = tid & 63, w = tid >> 6;
  float* sW = (float*)smem;
  const float* win = p.w_in + (size_t)l * 1024 * 14352;
  for (int i = tid; i < 16 * 1024; i += 256) {
    const int k = i >> 4, cc = i & 15;
    sW[cc * 1024 + k] = win[(size_t)k * 14352 + 3072 + cc];
  }
  __syncthreads();
  const float* MOD = (const float*)(p.ws + OFF_MOD);
  const float* nw = p.norm_w + (size_t)l * 1024;
  u16* H = (u16*)(p.ws + OFF_H);
  float* GB = (float*)(p.ws + OFF_GB);
  for (int row = blockIdx.x * 4 + w; row < T_ALL; row += gridDim.x * 4) {
    const float* xr;
    int vec;
    if (row < T_LAT) { xr = (l == 0 ? p.x : (const float*)p.out) + (size_t)row * 1024; vec = row >> 13; }
    else { xr = (l == 0 ? p.ctx : (const float*)(p.ws + OFF_CTX1)) + (size_t)(row - T_LAT) * 1024; vec = 2; }
    const float* md = MOD + ((size_t)l * 3 + vec) * 3072;
    f32x4 xv[4];
    float ss = 0.f;
#pragma unroll
    for (int i = 0; i < 4; i++) {
      xv[i] = *(const f32x4*)(xr + i * 256 + lane * 4);
      ss += xv[i][0] * xv[i][0] + xv[i][1] * xv[i][1] + xv[i][2] * xv[i][2] + xv[i][3] * xv[i][3];
    }
    ss = wsum(ss);
    const float rstd = rsqrtf(ss * (1.f / 1024.f) + 1e-6f);
    float ab[16];
#pragma unroll
    for (int cc = 0; cc < 16; cc++) ab[cc] = 0.f;
#pragma unroll
    for (int i = 0; i < 4; i++) {
      const int k = i * 256 + lane * 4;
      const f32x4 wv = *(const f32x4*)(nw + k);
      const f32x4 sh = *(const f32x4*)(md + k);
      const f32x4 sc = *(const f32x4*)(md + 1024 + k);
      f32x4 h;
#pragma unroll
      for (int j = 0; j < 4; j++) h[j] = xv[i][j] * rstd * wv[j] * (1.f + sc[j]) + sh[j];
      *(uint2*)(H + (size_t)row * 1024 + k) = uint2{pack2(h[0], h[1]), pack2(h[2], h[3])};
      asm volatile("" ::: "memory");
#pragma unroll
      for (int cc = 0; cc < 16; cc++) {
        const f32x4 ww = *(const f32x4*)(sW + cc * 1024 + k);
        ab[cc] += h[0] * ww[0] + h[1] * ww[1] + h[2] * ww[2] + h[3] * ww[3];
      }
    }
#pragma unroll
    for (int cc = 0; cc < 16; cc++) ab[cc] = wsum(ab[cc]);
    if (lane < 16) {
      float v = 0.f;
#pragma unroll
      for (int cc = 0; cc < 16; cc++) if (lane == cc) v = ab[cc];
      float r;
      if (lane < 8) {
        const float A = __expf(p.dn_a_log[l * 8 + lane]);
        const float z = v + p.dn_dt_bias[l * 8 + lane];
        const float sp = z > 20.f ? z : log1pf(__expf(z));
        r = -A * sp;
      } else r = sigm(v);
      GB[(size_t)row * 16 + lane] = r;
    }
  }
  __syncthreads();
}

DI void xyT(const char* sX, const char* sY, int it, f32x4 (&acc)[4], const int WV) {
  const int lane = tidx() & 63, fr = lane & 15, fq = lane >> 4;
#pragma unroll
  for (int j = 0; j < 4; j++) acc[j] = f32x4{0.f, 0.f, 0.f, 0.f};
#pragma unroll
  for (int ks = 0; ks < 4; ks++) {
    const bf16x8 a = *(const bf16x8*)(sX + (it * 16 + fr) * 272 + (ks * 32 + fq * 8) * 2);
#pragma unroll
    for (int jt = 0; jt < 4; jt++) {
      const bf16x8 b = *(const bf16x8*)(sY + (jt * 16 + fr) * 272 + (ks * 32 + fq * 8) * 2);
      acc[jt] = mfma16(a, b, acc[jt]);
    }
  }
}

DI void dn_prep_unit(const Params& p, int l, int c, int h, char* smem) {
  const int WV = p.ph_hi;
  const int tid = tidx(), lane = tid & 63, w = tid >> 6;
  u16* QKV = (u16*)(p.ws + OFF_A);
  const u16* HALO = (const u16*)(p.ws + OFF_HALO);
  char* sQ = smem;
  char* sK = smem + 17408;
  float* sKK = (float*)(smem + 34816);
  float* sQK = (float*)(smem + 34816 + 16384);
  float* sGC = (float*)(smem + 34816 + 32768);
  float* sBT = sGC + 128;
  const int row0 = c * 64;
  {
    const int u = tid * 2;
    const int gcol = u < 128 ? h * 128 + u : (u < 256 ? 512 + h * 128 + (u - 128) : 1024 + h * 256 + (u - 256));
    bool first, last;
    if (c < 256) { first = (c & 127) == 0; last = (c & 127) == 127; }
    else { first = ((c - 256) & 3) == 0; last = ((c - 256) & 3) == 3; }
    const float* cw = p.dn_conv + (size_t)l * 5 * 2048 + gcol;
    float cw0[5], cw1[5];
#pragma unroll
    for (int j = 0; j < 5; j++) { cw0[j] = cw[j * 2048]; cw1[j] = cw[j * 2048 + 1]; }
    const u16* own = QKV + (size_t)row0 * 2048 + gcol;
    const u16* hl = first ? own : HALO + ((size_t)(c - 1) * 4 + 2) * 2048 + gcol;
    const u16* hr = last ? own : HALO + ((size_t)(c + 1) * 4) * 2048 + gcol;
    unsigned cat[12], nxt[8], nx2[8];
    {
      const unsigned a = *(const unsigned*)hl, b = *(const unsigned*)(hl + 2048);
      cat[0] = first ? 0u : a; cat[1] = first ? 0u : b;
      cat[2] = *(const unsigned*)own; cat[3] = *(const unsigned*)(own + 2048);
    }
#pragma unroll
    for (int i = 0; i < 8; i++) nxt[i] = *(const unsigned*)(own + (size_t)(2 + i) * 2048);
#pragma unroll
    for (int i = 0; i < 8; i++) nx2[i] = *(const unsigned*)(own + (size_t)(10 + i) * 2048);
    for (int tb = 0; tb < 8; tb++) {
#pragma unroll
      for (int i = 0; i < 8; i++) { cat[4 + i] = nxt[i]; nxt[i] = nx2[i]; }
      if (tb < 6) {
        const bool lastb = tb == 5;
#pragma unroll
        for (int i = 0; i < 8; i++) {
          const u16* pp = (lastb && i >= 6) ? hr + (size_t)(i - 6) * 2048 : own + (size_t)(2 + (tb + 2) * 8 + i) * 2048;
          const unsigned v = *(const unsigned*)pp;
          nx2[i] = (lastb && i >= 6 && last) ? 0u : v;
        }
      }
#pragma unroll
      for (int i = 0; i < 8; i++) {
        const int t = tb * 8 + i;
        float y0 = 0.f, y1 = 0.f;
#pragma unroll
        for (int j = 0; j < 5; j++) {
          y0 += cw0[j] * bf2f((u16)(cat[i + j] & 0xffff));
          y1 += cw1[j] * bf2f((u16)(cat[i + j] >> 16));
        }
        y0 = silu(y0); y1 = silu(y1);
        if (w < 2) {
          const float ss = wsum(y0 * y0 + y1 * y1);
          float rs = rsqrtf(ss + 1e-6f);
          if (w == 0) rs *= 0.08838834764831845f;
          y0 *= rs; y1 *= rs;
          const unsigned pk = pack2(y0, y1);
          *(unsigned*)((w == 0 ? sQ : sK) + t * 272 + (u & 127) * 2) = pk;
          *(unsigned*)(QKV + (size_t)(row0 + t) * 2048 + gcol) = pk;
        } else {
          *(unsigned*)(QKV + (size_t)(row0 + t) * 2048 + gcol) = pack2(y0, y1);
        }
      }
#pragma unroll
      for (int i = 0; i < 4; i++) cat[i] = cat[8 + i];
    }
  }
  if (w < 2) {
    const float* GB = (const float*)(p.ws + OFF_GB);
    const float g = GB[(size_t)(row0 + lane) * 16 + w * 4 + h];
    const float bt = GB[(size_t)(row0 + lane) * 16 + 8 + w * 4 + h];
    float s = g;
    if (w == 0) {
#pragma unroll
      for (int o = 1; o < 64; o <<= 1) { const float t = __shfl_up(s, o, 64); if (lane >= o) s += t; }
    } else {
#pragma unroll
      for (int o = 1; o < 64; o <<= 1) { const float t = __shfl_down(s, o, 64); if (lane + o < 64) s += t; }
    }
    const float gl = __shfl(s, w == 0 ? 63 : 0, 64);
    sGC[w * 64 + lane] = s;
    sBT[w * 64 + lane] = bt;
    float* SC = (float*)(p.ws + OFF_DNSC) + ((size_t)(c * 4 + h) * 2 + w) * 192;
    SC[lane] = __expf(s);
    SC[64 + lane] = __expf(gl - s);
    if (lane == 0) SC[128] = __expf(gl);
  }
  __syncthreads();
  {
    const int fr = lane & 15, fq = lane >> 4;
    f32x4 acc[4];
    xyT(sK, sK, w, acc, WV);
#pragma unroll
    for (int jt = 0; jt < 4; jt++)
#pragma unroll
      for (int j = 0; j < 4; j++) sKK[(w * 16 + fq * 4 + j) * 64 + jt * 16 + fr] = acc[jt][j];
    xyT(sQ, sK, w, acc, WV);
#pragma unroll
    for (int jt = 0; jt < 4; jt++)
#pragma unroll
      for (int j = 0; j < 4; j++) sQK[(w * 16 + fq * 4 + j) * 64 + jt * 16 + fr] = acc[jt][j];
  }
  __syncthreads();
  u16* AUX = (u16*)(p.ws + OFF_B) + (size_t)(c * 4 + h) * 4 * 4096;
#pragma unroll 2
  for (int e = 0; e < 32; e++) {
    const int id = tid + e * 256, dir = id >> 12, i = (id >> 6) & 63, j = id & 63;
    const bool valid = dir == 0 ? (j <= i) : (j >= i);
    float v = 0.f;
    if (valid) v = sQK[i * 64 + j] * __expf(sGC[dir * 64 + i] - sGC[dir * 64 + j]);
    AUX[(size_t)(dir * 2 + 1) * 4096 + i * 64 + j] = f2bf(v);
  }
  __syncthreads();
  float* sL0 = sQK;
  float* sL1 = (float*)smem;
#pragma unroll 2
  for (int e = 0; e < 32; e++) {
    const int id = tid + e * 256, dir = id >> 12, ip = (id >> 6) & 63, jp = id & 63;
    const int i = dir ? 63 - ip : ip, j = dir ? 63 - jp : jp;
    float v = 0.f;
    if (jp < ip) v = sBT[dir * 64 + i] * sKK[i * 64 + j] * __expf(sGC[dir * 64 + i] - sGC[dir * 64 + j]);
    (dir ? sL1 : sL0)[ip * 64 + jp] = v;
  }
  __syncthreads();
  if (w < 2) {
    const float* L = w ? sL1 : sL0;
    const int cn = w ? 63 - lane : lane;
    const float bc = sBT[w * 64 + cn];
    f32x4 Lb[2][16];
    float T[64];
#pragma unroll
    for (int i = 0; i < 64; i++) {
      if (i + 1 < 64) {
#pragma unroll
        for (int b4 = 0; b4 < (i + 1 + 3) / 4; b4++) Lb[(i + 1) & 1][b4] = *(const f32x4*)(L + (i + 1) * 64 + 4 * b4);
      }
      asm volatile("" ::: "memory");
      float a0 = (i == lane) ? 1.f : 0.f, a1 = 0.f, a2 = 0.f, a3 = 0.f;
#pragma unroll
      for (int r = 0; r < i; r++) {
        const float lv = Lb[i & 1][r >> 2][r & 3];
        if ((r & 3) == 0) a0 -= lv * T[r];
        else if ((r & 3) == 1) a1 -= lv * T[r];
        else if ((r & 3) == 2) a2 -= lv * T[r];
        else a3 -= lv * T[r];
      }
      T[i] = (a0 + a1) + (a2 + a3);
    }
#pragma unroll
    for (int ip = 0; ip < 64; ip++) {
      const int i = w ? 63 - ip : ip;
      AUX[(size_t)(w * 2 + 0) * 4096 + i * 64 + cn] = f2bf(T[ip] * bc);
    }
  }
  __syncthreads();
}

DI void ret_prep_unit(const Params& p, int l, int c, int h, char* smem) {
  const int WV = p.ph_hi;
  const int tid = tidx(), lane = tid & 63, w = tid >> 6;
  const u16* QKV = (const u16*)(p.ws + OFF_A + 2 * SZ_TOK1K);
  char* sQ = smem;
  char* sK = smem + 17408;
  const int row0 = c * 64;
#pragma unroll
  for (int i = 0; i < 4; i++) {
    const int id = tid + i * 256, r = id >> 4, ch = id & 15;
    *(uint4*)(sQ + r * 272 + ch * 16) = *(const uint4*)(QKV + (size_t)(row0 + r) * 2048 + h * 128 + ch * 8);
    *(uint4*)(sK + r * 272 + ch * 16) = *(const uint4*)(QKV + (size_t)(row0 + r) * 2048 + 512 + h * 128 + ch * 8);
  }
  __syncthreads();
  f32x4 acc[4];
  xyT(sQ, sK, w, acc, WV);
  const int fr = lane & 15, fq = lane >> 4;
  u16* AUX = (u16*)(p.ws + OFF_C) + (size_t)(c * 4 + h) * 2 * 4096;
#pragma unroll
  for (int dir = 0; dir < 2; dir++) {
    const float rd = p.ret_decay[l * 8 + dir * 4 + h];
    const float lam = fminf(rd, 0.f) - log1pf(__expf(-fabsf(rd)));
#pragma unroll
    for (int jt = 0; jt < 4; jt++)
#pragma unroll
      for (int j = 0; j < 4; j++) {
        const int i = w * 16 + fq * 4 + j, jj = jt * 16 + fr;
        const int dd = dir == 0 ? i - jj : jj - i;
        const float v = dd >= 0 ? acc[jt][j] * __expf(lam * (float)dd) : 0.f;
        AUX[(size_t)dir * 4096 + i * 64 + jj] = f2bf(v);
      }
  }
  __syncthreads();
}

DI void hg_prep_unit(const Params& p, int l, int c, int h, char* smem) {
  const int WV = p.ph_hi;
  const int tid = tidx();
  u16* QFI = (u16*)(p.ws + OFF_A);
  u16* HGX = (u16*)(p.ws + OFF_B);
  float* sG = (float*)smem;
  u16* sQ = (u16*)(smem + 33280);
  u16* sK = (u16*)(smem + 50176);
  float* sTot = (float*)(smem + 67072);
  const int row0 = c * 64;
#pragma unroll
  for (int i = 0; i < 4; i++) {
    const int id = tid + i * 256, r = id >> 4, ch = id & 15;
    const uint4 v = *(const uint4*)(QFI + (size_t)(row0 + r) * 4096 + h * 128 + ch * 8);
    const unsigned vv[4] = {v.x, v.y, v.z, v.w};
#pragma unroll
    for (int e = 0; e < 4; e++) {
      sQ[(ch * 8 + e * 2) * 66 + r] = (u16)(vv[e] & 0xffff);
      sQ[(ch * 8 + e * 2 + 1) * 66 + r] = (u16)(vv[e] >> 16);
    }
  }
  __syncthreads();
  const int half = tid >> 7, d = tid & 127;
#pragma unroll 1
  for (int dir = 1; dir >= 0; dir--) {
    float lo = 0.f;
    if (l == 1) {
      const float b0 = p.hg_lb[dir * 1024 + h * 128 + d], b1 = p.hg_lb[2048 + dir * 1024 + h * 128 + d];
      lo = sigm(b1 - b0);
    }
    float run = 0.f;
    {
      const u16* xs = QFI + (size_t)row0 * 4096 + 1024 + dir * 1024 + h * 128 + d;
      float xv[32];
#pragma unroll
      for (int i = 0; i < 32; i++) xv[i] = bf2f(xs[(size_t)(half * 32 + (dir == 0 ? i : 31 - i)) * 4096]);
#pragma unroll
      for (int i = 0; i < 32; i++) {
        const int ii = dir == 0 ? i : 31 - i;
        const int t = half * 32 + ii;
        const float x = xv[i];
        const float sg = sigm(x);
        const float f = lo + (1.f - lo) * sg;
        const float omf = (1.f - lo) * (1.f - sg);
        run += __log2f(f);
        sG[d * 65 + t] = run;
        sK[d * 66 + t] = f2bf(omf);
      }
      sTot[half * 128 + d] = run;
    }
    __syncthreads();
    {
      const float t0 = sTot[d], t1 = sTot[128 + d];
      const float gtot = t0 + t1;
      const float add = dir == 0 ? (half == 1 ? t0 : 0.f) : (half == 0 ? t1 : 0.f);
      u16* qdst = dir == 0 ? QFI + (size_t)row0 * 4096 + h * 128 + d : HGX + (size_t)row0 * 1024 + h * 128 + d;
      const size_t qp = dir == 0 ? 4096 : 1024;
      u16* kdst = QFI + (size_t)row0 * 4096 + 1024 + dir * 1024 + h * 128 + d;
#pragma unroll 8
      for (int i = 0; i < 32; i++) {
        const int t = half * 32 + i;
        const float G = sG[d * 65 + t] + add;
        sG[d * 65 + t] = G;
        qdst[(size_t)t * qp] = f2bf(bf2f(sQ[d * 66 + t]) * __builtin_amdgcn_exp2f(G));
        kdst[(size_t)t * 4096] = f2bf(bf2f(sK[d * 66 + t]) * __builtin_amdgcn_exp2f(gtot - G));
      }
      if (half == 0) ((float*)(p.ws + OFF_HGDEC))[((size_t)(c * 8 + h) * 2 + dir) * 128 + d] = __builtin_amdgcn_exp2f(gtot);
    }
    __syncthreads();
    {
      const int lane = tid & 63, I = tid >> 6, fr = lane & 15, fq = lane >> 4;
      const int rt = dir == 0 ? I * 16 - 1 : I * 16 + 16;
      const bool hasref = dir == 0 ? (I > 0) : (I < 3);
      bf16x8 af[4];
#pragma unroll
      for (int ks = 0; ks < 4; ks++) {
        asm volatile("" ::: "memory");
#pragma unroll
        for (int j = 0; j < 8; j++) {
          const int dd = ks * 32 + fq * 8 + j;
          const float R = hasref ? sG[dd * 65 + rt] : 0.f;
          const float e = __builtin_amdgcn_exp2f(fmaxf(sG[dd * 65 + I * 16 + fr] - R, -120.f));
          af[ks][j] = (short)f2bf(bf2f(sQ[dd * 66 + I * 16 + fr]) * e);
        }
      }
      u16* AUX = (u16*)(p.ws + OFF_C) + ((size_t)(c * 8 + h) * 2 + dir) * 4096;
#pragma unroll 1
      for (int J = 0; J < 4; J++) {
        const bool actv = dir == 0 ? (J <= I) : (J >= I);
        f32x4 acc = f32x4{0.f, 0.f, 0.f, 0.f};
        if (actv) {
#pragma unroll
          for (int ks = 0; ks < 4; ks++) {
            asm volatile("" ::: "memory");
            bf16x8 bfr;
#pragma unroll
            for (int j = 0; j < 8; j++) {
              const int dd = ks * 32 + fq * 8 + j;
              const float R = hasref ? sG[dd * 65 + rt] : 0.f;
              const float e = __builtin_amdgcn_exp2f(fminf(R - sG[dd * 65 + J * 16 + fr], 120.f));
              bfr[j] = (short)f2bf(bf2f(sK[dd * 66 + J * 16 + fr]) * e);
            }
            acc = mfma16(af[ks], bfr, acc);
          }
        }
#pragma unroll
        for (int jj = 0; jj < 4; jj++) {
          const int i = I * 16 + fq * 4 + jj, j = J * 16 + fr;
          const bool valid = actv && (dir == 0 ? (j <= i) : (j >= i));
          AUX[i * 64 + j] = f2bf(valid ? acc[jj] : 0.f);
        }
      }
    }
    __syncthreads();
  }
}

struct ScanDesc {
  const u16 *q, *k, *v;
  int qp, kp, vp;
  const u16* aux;
  size_t aux_cs;
  int attn_off, ainv_off;
  u16* o;
  int mixer, b, dir;
  const float* sc;
  size_t sc_cs;
  float lam;
};

DI int scan_chunk_of(int dir, int b, int step) {
  if (dir == 0) return step < 4 ? 256 + 4 * b + step : 128 * b + (step - 4);
  return step < 4 ? 256 + 4 * b + (3 - step) : 128 * b + (131 - step);
}
template <int MIXER>
DI void scan_prefetch(const u16* sq, const u16* sk, const u16* sv, int qp, int kp, int vp, const u16* saux, size_t aux_cs, int attn_off, int ainv_off,
                      const float* ssc, size_t sc_cs, int c, int tid, int w, int fr, int fq, u32x4 (&rq)[4], u32x4 (&rk)[4], u32x4 (&rat)[2], u32x4 (&rai)[2],
                      unsigned (&rv)[8], float& rsc, float& regl) {
  struct { const u16 *q, *k, *v; int qp, kp, vp; const u16* aux; size_t aux_cs; int attn_off, ainv_off; const float* sc; size_t sc_cs; } s =
      {sq, sk, sv, qp, kp, vp, saux, aux_cs, attn_off, ainv_off, ssc, sc_cs};
  const int row0 = c * 64;
  const u16* qbase = s.q + (size_t)row0 * s.qp;
  const u16* kbase = s.k + (size_t)row0 * s.kp;
  const u16* vbase = s.v + (size_t)row0 * s.vp;
  const unsigned qoff = (unsigned)((tid >> 4) * s.qp + (tid & 15) * 8);
  const unsigned koff = (unsigned)((tid >> 4) * s.kp + (tid & 15) * 8);
#pragma unroll
  for (int i = 0; i < 4; i++) {
    rq[i] = *(const u32x4*)(qbase + (size_t)(i * 16) * s.qp + qoff);
    rk[i] = *(const u32x4*)(kbase + (size_t)(i * 16) * s.kp + koff);
  }
  const u16* ab = s.aux + (size_t)c * s.aux_cs;
  const unsigned aoff = (unsigned)((tid >> 3) * 64 + (tid & 7) * 8);
#pragma unroll
  for (int i = 0; i < 2; i++) {
    rat[i] = *(const u32x4*)(ab + s.attn_off + i * 32 * 64 + aoff);
    if (MIXER == 0) rai[i] = *(const u32x4*)(ab + s.ainv_off + i * 32 * 64 + aoff);
  }
  if (MIXER == 0) {
    const float* sc = s.sc + (size_t)c * s.sc_cs;
    if (tid < 128) rsc = sc[tid];
    regl = sc[128];
  } else if (MIXER == 2) {
    if (tid < 128) rsc = s.sc[(size_t)c * s.sc_cs + tid];
  }
  const unsigned voff = (unsigned)(fq * 4 * s.vp + w * 16 + fr);
#pragma unroll
  for (int mt = 0; mt < 4; mt++)
#pragma unroll
    for (int jp = 0; jp < 2; jp++) {
      const unsigned lo = (vbase + (size_t)(mt * 16 + jp * 2) * s.vp)[voff];
      const unsigned hi = (vbase + (size_t)(mt * 16 + jp * 2 + 1) * s.vp)[voff];
      rv[mt * 2 + jp] = lo | (hi << 16);
    }
}

template <int MIXER>
DI void scan_unit(const ScanDesc& s, char* smem, const int WV) {
  const int tid = tidx(), lane = tid & 63, w = tid >> 6;
  const int fr = lane & 15, fq = lane >> 4;
  char* sQm = smem;
  char* sKm = smem + 17408;
  const unsigned km_tr = (unsigned)(size_t)sKm + (unsigned)((fq * 4 + ((lane & 15) >> 2)) * 272 + (lane & 3) * 8);
  char* sAT = smem + 53248;
  char* sAI = smem + 62464;
  float* sSC = (float*)(smem + 71680);
  f32x4 S[8];
#pragma unroll
  for (int i = 0; i < 8; i++) S[i] = f32x4{0.f, 0.f, 0.f, 0.f};
  u32x4 rq[4], rk[4], rat[2], rai[2];
  rai[0] = u32x4{0u, 0u, 0u, 0u}; rai[1] = rai[0];
  unsigned rv[8];
  float rsc = 0.f, regl = 1.f;
  scan_prefetch<MIXER>(s.q, s.k, s.v, s.qp, s.kp, s.vp, s.aux, s.aux_cs, s.attn_off, s.ainv_off, s.sc, s.sc_cs, scan_chunk_of(s.dir, s.b, 0), tid, w, fr, fq, rq, rk, rat, rai, rv, rsc, regl);
  for (int step = 0; step < 132; step++) {
    const int c = scan_chunk_of(s.dir, s.b, step);
    const int row0 = c * 64;
#pragma unroll
    for (int i = 0; i < 4; i++) {
      const int id = tid + i * 256, r = id >> 4, ch = id & 15;
      *(u32x4*)(sQm + r * 272 + ch * 16) = rq[i];
      *(u32x4*)(sKm + r * 272 + ch * 16) = rk[i];
    }
#pragma unroll
    for (int i = 0; i < 2; i++) {
      const int id = tid + i * 256, r = id >> 3, ch = id & 7;
      *(u32x4*)(sAT + r * 144 + ch * 16) = rat[i];
      if (MIXER == 0) *(u32x4*)(sAI + r * 144 + ch * 16) = rai[i];
    }
    float egl = 1.f;
    if (MIXER == 0) {
      if (tid < 128) sSC[tid] = rsc;
      egl = regl;
    } else if (MIXER == 1) {
      if (tid < 64) {
        const float e1 = s.dir == 0 ? (float)(tid + 1) : (float)(64 - tid);
        sSC[tid] = __expf(s.lam * e1);
        sSC[64 + tid] = __expf(s.lam * (64.f - e1));
      }
      egl = __expf(s.lam * 64.f);
    } else {
      if (tid < 128) sSC[tid] = rsc;
    }
    f32x4 V[4];
#pragma unroll
    for (int mt = 0; mt < 4; mt++) {
      V[mt][0] = bf2f((u16)(rv[mt * 2] & 0xffff)); V[mt][1] = bf2f((u16)(rv[mt * 2] >> 16));
      V[mt][2] = bf2f((u16)(rv[mt * 2 + 1] & 0xffff)); V[mt][3] = bf2f((u16)(rv[mt * 2 + 1] >> 16));
    }
    __syncthreads();
    if (step + 1 < 132) scan_prefetch<MIXER>(s.q, s.k, s.v, s.qp, s.kp, s.vp, s.aux, s.aux_cs, s.attn_off, s.ainv_off, s.sc, s.sc_cs, scan_chunk_of(s.dir, s.b, step + 1), tid, w, fr, fq, rq, rk, rat, rai, rv, rsc, regl);
    bf16x8 Sb[4];
#pragma unroll
    for (int ks = 0; ks < 4; ks++) Sb[ks] = pack8(S[2 * ks], S[2 * ks + 1]);
    f32x4 vn[4];
    f32x4 oq[4];
#pragma unroll
    for (int mt = 0; mt < 4; mt++) oq[mt] = f32x4{0.f, 0.f, 0.f, 0.f};
    if (MIXER == 0) {
      f32x4 P[4];
      bf16x8 aai[2][4];
#pragma unroll
      for (int ks = 0; ks < 2; ks++)
#pragma unroll
        for (int mt = 0; mt < 4; mt++) aai[ks][mt] = ld_perm(sAI + (mt * 16 + fr) * 144, ks * 32 + fq * 4);
#pragma unroll
      for (int mt = 0; mt < 4; mt++) P[mt] = f32x4{0.f, 0.f, 0.f, 0.f};
#pragma unroll
      for (int ks = 0; ks < 4; ks++) {
        bf16x8 ak[4], aq[4];
#pragma unroll
        for (int mt = 0; mt < 4; mt++) { ak[mt] = ld_perm(sKm + (mt * 16 + fr) * 272, ks * 32 + fq * 4); aq[mt] = ld_perm(sQm + (mt * 16 + fr) * 272, ks * 32 + fq * 4); }
#pragma unroll
        for (int mt = 0; mt < 4; mt++) P[mt] = mfma16(ak[mt], Sb[ks], P[mt]);
#pragma unroll
        for (int mt = 0; mt < 4; mt++) oq[mt] = mfma16(aq[mt], Sb[ks], oq[mt]);
      }
#pragma unroll
      for (int mt = 0; mt < 4; mt++)
#pragma unroll
        for (int j = 0; j < 4; j++) P[mt][j] = V[mt][j] - sSC[mt * 16 + fq * 4 + j] * P[mt][j];
      bf16x8 rb[2];
#pragma unroll
      for (int ks = 0; ks < 2; ks++) rb[ks] = pack8(P[2 * ks], P[2 * ks + 1]);
#pragma unroll
      for (int mt = 0; mt < 4; mt++) vn[mt] = f32x4{0.f, 0.f, 0.f, 0.f};
#pragma unroll
      for (int ks = 0; ks < 2; ks++) {
#pragma unroll
        for (int mt = 0; mt < 4; mt++) vn[mt] = mfma16(aai[ks][mt], rb[ks], vn[mt]);
      }
    } else {
#pragma unroll
      for (int ks = 0; ks < 4; ks++) {
        bf16x8 aq[4];
#pragma unroll
        for (int mt = 0; mt < 4; mt++) aq[mt] = ld_perm(sQm + (mt * 16 + fr) * 272, ks * 32 + fq * 4);
#pragma unroll
        for (int mt = 0; mt < 4; mt++) oq[mt] = mfma16(aq[mt], Sb[ks], oq[mt]);
      }
#pragma unroll
      for (int mt = 0; mt < 4; mt++) vn[mt] = V[mt];
    }
    bf16x8 vb[2];
#pragma unroll
    for (int ks = 0; ks < 2; ks++) vb[ks] = pack8(vn[2 * ks], vn[2 * ks + 1]);
    if (MIXER != 2) {
#pragma unroll
      for (int mt = 0; mt < 4; mt++)
#pragma unroll
        for (int j = 0; j < 4; j++) oq[mt][j] *= sSC[mt * 16 + fq * 4 + j];
    }
#pragma unroll
    for (int ks = 0; ks < 2; ks++) {
      bf16x8 aa[4];
#pragma unroll
      for (int mt = 0; mt < 4; mt++) aa[mt] = ld_perm(sAT + (mt * 16 + fr) * 144, ks * 32 + fq * 4);
#pragma unroll
      for (int mt = 0; mt < 4; mt++) oq[mt] = mfma16(aa[mt], vb[ks], oq[mt]);
    }
    if (MIXER != 2) {
#pragma unroll
      for (int mt = 0; mt < 4; mt++)
#pragma unroll
        for (int j = 0; j < 4; j++) vn[mt][j] *= sSC[64 + mt * 16 + fq * 4 + j];
#pragma unroll
      for (int ks = 0; ks < 2; ks++) vb[ks] = pack8(vn[2 * ks], vn[2 * ks + 1]);
    }
#pragma unroll
    for (int mt = 0; mt < 8; mt++) {
      if (MIXER == 2) {
#pragma unroll
        for (int j = 0; j < 4; j++) S[mt][j] *= sSC[mt * 16 + fq * 4 + j];
      } else {
#pragma unroll
        for (int j = 0; j < 4; j++) S[mt][j] *= egl;
      }
    }
#pragma unroll
    for (int ks = 0; ks < 2; ks++) {
      bf16x8 at[8];
#pragma unroll
      for (int mt = 0; mt < 8; mt++) at[mt] = ld_tr2(km_tr + (unsigned)((ks * 32) * 272 + mt * 32), km_tr + (unsigned)((ks * 32 + 16) * 272 + mt * 32));
#pragma unroll
      for (int mt = 0; mt < 8; mt++) S[mt] = mfma16(at[mt], vb[ks], S[mt]);
    }
    {
      u16* obase = s.o + (size_t)row0 * 1024;
#pragma unroll
      for (int mt = 0; mt < 4; mt++)
#pragma unroll
        for (int j = 0; j < 4; j++) obase[(unsigned)((mt * 16 + fq * 4 + j) * 1024 + w * 16 + fr)] = f2bf(oq[mt][j]);
    }
    __syncthreads();
  }
}

DI void scan_phase_hg(const Params& p, char* smem) {
  const int WV = p.ph_hi;
  if ((blockIdx.x & 3) == 0 && (blockIdx.x >> 2) < 64) {
    const int u = blockIdx.x >> 2;
    const int dir = u & 1, vg = (u >> 1) & 1, h = (u >> 2) & 7, b = u >> 5;
    ScanDesc s;
    s.q = dir == 0 ? (const u16*)(p.ws + OFF_A) + h * 128 : (const u16*)(p.ws + OFF_B) + h * 128;
    s.qp = dir == 0 ? 4096 : 1024;
    s.k = (const u16*)(p.ws + OFF_A) + 1024 + dir * 1024 + h * 128; s.kp = 4096;
    s.v = (const u16*)(p.ws + OFF_A) + 3072 + h * 128 + vg * 64; s.vp = 4096;
    s.aux = (const u16*)(p.ws + OFF_C) + (size_t)(h * 2 + dir) * 4096; s.aux_cs = 8 * 2 * 4096; s.attn_off = 0; s.ainv_off = 0;
    s.o = (u16*)(p.ws + OFF_D + (dir ? SZ_TOK1K : 0)) + h * 128 + vg * 64;
    s.mixer = 2; s.b = b; s.dir = dir;
    s.sc = (const float*)(p.ws + OFF_HGDEC) + (size_t)(h * 2 + dir) * 128; s.sc_cs = 8 * 2 * 128; s.lam = 0.f;
    scan_unit<2>(s, smem, WV);
  }
}
DI void scan_phase_dnret(const Params& p, int l, char* smem) {
  const int WV = p.ph_hi;
  if ((blockIdx.x & 1) == 0 && (blockIdx.x >> 1) < 128) {
    const int u = blockIdx.x >> 1;
    const int mixer = u & 1, dir = (u >> 1) & 1, vg = (u >> 2) & 3, h = (u >> 4) & 3, b = u >> 6;
    ScanDesc s;
    const u16* base = (const u16*)(p.ws + OFF_A + (mixer ? 2 * SZ_TOK1K : 0));
    s.q = base + h * 128; s.k = base + 512 + h * 128; s.v = base + 1024 + h * 256 + vg * 64;
    s.qp = s.kp = s.vp = 2048;
    s.mixer = mixer; s.b = b; s.dir = dir;
    if (mixer == 0) {
      s.aux = (const u16*)(p.ws + OFF_B) + (size_t)(h * 2 + dir) * 2 * 4096; s.aux_cs = 4 * 4 * 4096; s.ainv_off = 0; s.attn_off = 4096;
      s.sc = (const float*)(p.ws + OFF_DNSC) + (size_t)(h * 2 + dir) * 192; s.sc_cs = 4 * 2 * 192; s.lam = 0.f;
      s.o = (u16*)(dir == 0 ? p.ws + OFF_E : p.ws + OFF_D + SZ_TOK1K) + h * 256 + vg * 64;
      scan_unit<0>(s, smem, WV);
    } else {
      s.aux = (const u16*)(p.ws + OFF_C) + (size_t)(h * 2 + dir) * 4096; s.aux_cs = 4 * 2 * 4096; s.attn_off = 0; s.ainv_off = 0;
      const float rd = p.ret_decay[l * 8 + dir * 4 + h];
      s.lam = fminf(rd, 0.f) - log1pf(__expf(-fabsf(rd)));
      s.sc = nullptr; s.sc_cs = 0;
      s.o = (u16*)(p.ws + OFF_E + (dir == 0 ? SZ_TOK1K : 2 * SZ_TOK1K)) + h * 256 + vg * 64;
      scan_unit<1>(s, smem, WV);
    }
  }
}

DI void onorm_rows(u16* of, const u16* ob, const float* nw, int dv, int unit, int nunits_stride, const int WV) {
  const int lane = tidx() & 63, w = tidx() >> 6;
  float nwr[16];
  {
    const int dcol0 = (lane * 16) % dv;
#pragma unroll
    for (int e = 0; e < 4; e++) {
      const f32x4 t4 = *(const f32x4*)(nw + dcol0 + 4 * e);
      nwr[4 * e] = t4[0]; nwr[4 * e + 1] = t4[1]; nwr[4 * e + 2] = t4[2]; nwr[4 * e + 3] = t4[3];
    }
  }
  for (int row = unit * 4 + w; row < T_ALL; row += nunits_stride * 4) {
    u16* pf = of + (size_t)row * 1024 + lane * 16;
    const u16* pb = ob + (size_t)row * 1024 + lane * 16;
    float v[16];
#pragma unroll
    for (int hv = 0; hv < 2; hv++) {
      const uint4 a = *(const uint4*)(pf + hv * 8), b = *(const uint4*)(pb + hv * 8);
      const unsigned aa[4] = {a.x, a.y, a.z, a.w}, bb[4] = {b.x, b.y, b.z, b.w};
#pragma unroll
      for (int e = 0; e < 4; e++) {
        v[hv * 8 + e * 2] = bf2f((u16)(aa[e] & 0xffff)) + bf2f((u16)(bb[e] & 0xffff));
        v[hv * 8 + e * 2 + 1] = bf2f((u16)(aa[e] >> 16)) + bf2f((u16)(bb[e] >> 16));
      }
    }
    float ss = 0.f;
#pragma unroll
    for (int e = 0; e < 16; e++) ss += v[e] * v[e];
    ss = dv == 256 ? gsum(ss, 16) : gsum(ss, 8);
    const float rstd = rsqrtf(ss / (float)dv + 1e-6f);
    unsigned o8[8];
#pragma unroll
    for (int e = 0; e < 8; e++) o8[e] = pack2(v[2 * e] * rstd * nwr[2 * e], v[2 * e + 1] * rstd * nwr[2 * e + 1]);
    *(uint4*)pf = uint4{o8[0], o8[1], o8[2], o8[3]};
    *(uint4*)(pf + 8) = uint4{o8[4], o8[5], o8[6], o8[7]};
  }
}

DI void final_norm(const Params& p) {
  const int WV = p.ph_hi;
  const int lane = tidx() & 63, w = tidx() >> 6;
  for (int row = blockIdx.x * 4 + w; row < T_LAT; row += gridDim.x * 4) {
    float* xr = p.out + (size_t)row * 1024;
    f32x4 xv[4];
    float ss = 0.f;
#pragma unroll
    for (int i = 0; i < 4; i++) {
      xv[i] = *(const f32x4*)(xr + i * 256 + lane * 4);
      ss += xv[i][0] * xv[i][0] + xv[i][1] * xv[i][1] + xv[i][2] * xv[i][2] + xv[i][3] * xv[i][3];
    }
    ss = wsum(ss);
    const float rstd = rsqrtf(ss * (1.f / 1024.f) + 1e-6f);
#pragma unroll
    for (int i = 0; i < 4; i++) {
      const f32x4 wv = *(const f32x4*)(p.final_norm_w + i * 256 + lane * 4);
      f32x4 r;
#pragma unroll
      for (int j = 0; j < 4; j++) r[j] = xv[i][j] * rstd * wv[j];
      *(f32x4*)(xr + i * 256 + lane * 4) = r;
    }
  }
}

DI void run_phase(const Params& p, int ph, char* smem) {
  const int WV = p.ph_hi;
  const int G = gridDim.x, B = blockIdx.x;
  if (ph == 0) { if (QSEL(11)) phase_pro(p, smem); return; }
  if (ph == 23) { if (QSEL(12)) final_norm(p); return; }
  const int l = (ph - 1) / 11, q = (ph - 1) % 11;
  const bool last = l == 1;
  switch (q) {
    case 0: if (!QSEL(0)) break;
      if (l == 1) for (int u = B; u < WCONV_UNITS; u += G) wconv_unit(p, 1, u, smem);
      phase_norm(p, l, smem);
      break;
    case 1: if (!QSEL(1)) break;
      for (int t = B; t < 128 * 16; t += G) gemm_tile<EPI_HG, 8>(p, l, t % 128, t / 128, smem);
      for (int t = B; t < 4 * 32; t += G) gemm_tile<EPI_HG, 4>(p, l, 128 + (t & 3), t >> 2, smem);
      break;
    case 2: if (!QSEL(2)) break;
      for (int u = B; u < NCH * 8; u += G) hg_prep_unit(p, l, u >> 3, u & 7, smem);
      break;
    case 3: if (!QSEL(3)) break; scan_phase_hg(p, smem); break;
    case 4: if (!QSEL(4)) break;
      for (int t = B; t < 128 * 16; t += G) gemm_tile<EPI_DNRET, 8>(p, l, t % 128, t / 128, smem);
      for (int t = B; t < 4 * 32; t += G) gemm_tile<EPI_DNRET, 4>(p, l, 128 + (t & 3), t >> 2, smem);
      onorm_rows((u16*)(p.ws + OFF_D), (const u16*)(p.ws + OFF_D + SZ_TOK1K), p.hg_norm_w + l * 128, 128, B, G, WV);
      break;
    case 5: if (!QSEL(5)) break;
      for (int u = B; u < NCH * 8; u += G) {
        if (u < NCH * 4) dn_prep_unit(p, l, u >> 2, u & 3, smem);
        else ret_prep_unit(p, l, (u - NCH * 4) >> 2, u & 3, smem);
      }
      break;
    case 6: if (!QSEL(6)) break; scan_phase_dnret(p, l, smem); break;
    case 7: if (!QSEL(7)) break;
      onorm_rows((u16*)(p.ws + OFF_E), (const u16*)(p.ws + OFF_D + SZ_TOK1K), p.dn_norm_w + l * 256, 256, B, G, WV);
      onorm_rows((u16*)(p.ws + OFF_E + SZ_TOK1K), (const u16*)(p.ws + OFF_E + 2 * SZ_TOK1K), p.ret_norm_w + l * 256, 256, B, G, WV);
      break;
    case 8: if (!QSEL(8)) break; {
      const int nrt = last ? 128 : 132;
      for (int t = B; t < 128 * 12; t += G) gemm_tile<EPI_GATE, 8>(p, l, t % 128, t / 128, smem);
      if (!last) for (int t = B; t < 4 * 24; t += G) gemm_tile<EPI_GATE, 4>(p, l, 128 + (t & 3), t >> 2, smem);
    } break;
    case 9: if (!QSEL(9)) break; {
      const int nrt = last ? 128 : 132;
      for (int t = B; t < nrt * 8; t += G) {
        const int tn = t + G;
        const bool more = tn < nrt * 8;
        merge_tile(p, t % nrt, t / nrt, smem, t != B, more ? tn % nrt : -1, more ? tn / nrt : -1);
      }
    } break;
    case 10: if (!QSEL(10)) break; {
      const int nrt = last ? 128 : 132;
      for (int t = B; t < 128 * 4; t += G) gemm_tile<EPI_OUT, 8>(p, l, t % 128, t / 128, smem);
      if (!last) for (int t = B; t < 4 * 8; t += G) gemm_tile<EPI_OUT, 4>(p, l, 128 + (t & 3), t >> 2, smem);
    } break;
  }
}

#define XB_XCNT(j) (64 * (j))
#define XB_XSUB(j) (1024 + 64 * (j))
#define XB_XGEN(j) (2048 + 64 * (j))
#define XB_TOP 3072
#define XB_TOPGEN 3136
DI unsigned xb_ld(unsigned* q) { return __hip_atomic_load(q, __ATOMIC_RELAXED, __HIP_MEMORY_SCOPE_AGENT); }
DI unsigned xb_add(unsigned* q, unsigned v) { return __hip_atomic_fetch_add(q, v, __ATOMIC_RELAXED, __HIP_MEMORY_SCOPE_AGENT); }
DI void grid_barrier(unsigned* bar, volatile unsigned* st) {
  asm volatile("s_waitcnt vmcnt(0) lgkmcnt(0)" ::: "memory");
  __syncthreads();
  if (__builtin_amdgcn_workitem_id_x() == 0) {
    const unsigned nloc = st[0], nx = st[1], x = st[2];
    const unsigned old = xb_add(&bar[XB_XSUB(x)], 1u);
    const unsigned gen = old / nloc;
    if (old + 1u == (gen + 1u) * nloc) {
      __builtin_amdgcn_fence(__ATOMIC_RELEASE, "agent");
      asm volatile("s_waitcnt vmcnt(0)" ::: "memory");
      const unsigned og = xb_add(&bar[XB_TOP], 1u);
      const unsigned tg = og / nx;
      if (og + 1u == (tg + 1u) * nx) xb_add(&bar[XB_TOPGEN], 1u);
      else while (xb_ld(&bar[XB_TOPGEN]) == tg) __builtin_amdgcn_s_sleep(2);
      __builtin_amdgcn_fence(__ATOMIC_ACQUIRE, "agent");
      xb_add(&bar[XB_XGEN(x)], 1u);
      asm volatile("s_waitcnt vmcnt(0)" ::: "memory");
    } else {
      while (xb_ld(&bar[XB_XGEN(x)]) == gen) __builtin_amdgcn_s_sleep(8);
      __builtin_amdgcn_fence(__ATOMIC_ACQUIRE, "agent");
      asm volatile("s_waitcnt vmcnt(0)" ::: "memory");
    }
  }
  __syncthreads();
}

__global__ void __launch_bounds__(256, 2) mk(Params p) {
  extern __shared__ __attribute__((aligned(16))) char smem[];
  p.ph_hi = __builtin_amdgcn_readfirstlane((int)__builtin_amdgcn_workitem_id_x() >> 6);
#if ONE_LAUNCH
  cg::grid_group grid = cg::this_grid();
  unsigned* bar = (unsigned*)(p.ws + OFF_BAR);
  __shared__ uint4 xbw;
  if (__builtin_amdgcn_workitem_id_x() == 0)
    (void)xb_add(&bar[XB_XCNT((unsigned)__builtin_amdgcn_s_getreg((3 << 11) | 20) & 0xFu)], 1u);
#ifdef PROBE_MASK
  long long tacc = 0, t0 = wall_clock64();
#define PTICK(n) { const long long t1 = wall_clock64(); if ((PROBE_MASK >> (n)) & 1) tacc += t1 - t0; t0 = t1; }
#else
#define PTICK(n)
#endif
  run_phase(p, 0, smem);
  grid.sync();
  if (__builtin_amdgcn_workitem_id_x() == 0) {
    const unsigned x = (unsigned)__builtin_amdgcn_s_getreg((3 << 11) | 20) & 0xFu;
    unsigned cnt = 0u, mine = 1u;
#pragma unroll
    for (unsigned j = 0; j < 16; ++j) { const unsigned c = xb_ld(&bar[XB_XCNT(j)]); cnt += c > 0u ? 1u : 0u; mine = j == x ? c : mine; }
    xbw = make_uint4(mine > 0u ? mine : 1u, cnt > 0u ? cnt : 1u, x, 0u);
  }
  __syncthreads();
  volatile unsigned* xst = (volatile unsigned*)&xbw;
  PTICK(0)
#define PH(n) run_phase(p, n, smem); grid_barrier(bar, xst); PTICK(n)
  PH(1) PH(2) PH(3) PH(4) PH(5) PH(6) PH(7) PH(8) PH(9) PH(10) PH(11)
  PH(12) PH(13) PH(14) PH(15) PH(16) PH(17) PH(18) PH(19) PH(20) PH(21) PH(22)
  run_phase(p, 23, smem);
  PTICK(23)
#ifdef PROBE_MASK
  if (blockIdx.x == 0 && __builtin_amdgcn_workitem_id_x() == 0) {
    const long long tend = wall_clock64() + tacc * 4;
    while (wall_clock64() < tend) __builtin_amdgcn_s_sleep(20);
  }
#endif
#else
  run_phase(p, p.ph_lo, smem);
#endif
}

extern "C" void kernel_launch(void* const* d_in, const int* in_sizes, int n_in, void* d_out,
                              int out_size, void* d_ws, size_t ws_size, hipStream_t stream) {
  static int grid_blocks = 0;
  if (!grid_blocks) {
    int dev = 0, cus = 0, per_cu = 0;
    (void)hipGetDevice(&dev);
    (void)hipDeviceGetAttribute(&cus, hipDeviceAttributeMultiprocessorCount, dev);
    (void)hipFuncSetAttribute((const void*)mk, hipFuncAttributeMaxDynamicSharedMemorySize, SMEM_BYTES);
    (void)hipOccupancyMaxActiveBlocksPerMultiprocessor(&per_cu, mk, 256, SMEM_BYTES);
    if (per_cu > 2) per_cu = 2;
    if (per_cu < 1) per_cu = 1;
    grid_blocks = cus * per_cu;
  }
  Params p{};
  const float** f = (const float**)&p;
  for (int i = 0; i < 19; i++) f[i] = (const float*)d_in[i];
  p.out = (float*)d_out;
  p.ws = (char*)d_ws;
#if ONE_LAUNCH
  p.ph_lo = 0; p.ph_hi = 24;
  (void)hipMemsetAsync((char*)d_ws + OFF_BAR, 0, 16384, stream);
  void* args[] = {&p};
  (void)hipLaunchCooperativeKernel((void*)mk, dim3(grid_blocks), dim3(256), args, SMEM_BYTES, stream);
#else
  for (int ph = 0; ph < 24; ph++) {
    p.ph_lo = ph; p.ph_hi = ph + 1;
    void* args[] = {&p};
    (void)hipLaunchCooperativeKernel((void*)mk, dim3(grid_blocks), dim3(256), args, SMEM_BYTES, stream);
  }
#endif
}
```

```cpp
#include <hip/hip_runtime.h>
#include <hip/hip_cooperative_groups.h>
#include <cstdio>
namespace cg = cooperative_groups;

#ifndef ONE_LAUNCH
#define ONE_LAUNCH 1
#endif
#ifndef ONLY_Q
#define ONLY_Q -1
#endif
#define QSEL(n) (ONLY_Q < 0 || ONLY_Q == (n))

typedef unsigned short u16;
using bf16x8 = __attribute__((ext_vector_type(8))) short;
using bf16x4 = __attribute__((ext_vector_type(4))) short;
using f32x4 = __attribute__((ext_vector_type(4))) float;
using u32x4 = __attribute__((ext_vector_type(4))) unsigned;
#define DI __device__ __forceinline__

constexpr int T_LAT = 16384, T_ALL = 16896, NCH = 264;
constexpr int WROWS = 18448;
constexpr int W_BR = 14352, W_OUT = 17424;
constexpr size_t al(size_t x) { return (x + 255) & ~(size_t)255; }
constexpr size_t SZ_WT = (size_t)WROWS * 1024 * 2;
constexpr size_t SZ_TOK1K = (size_t)T_ALL * 1024 * 2;
constexpr size_t OFF_WT = 0;
constexpr size_t OFF_H = OFF_WT + al(SZ_WT);
constexpr size_t OFF_MOD = OFF_H + al(SZ_TOK1K);
constexpr size_t OFF_ROT = OFF_MOD + al(2 * 3 * 3072 * 4);
constexpr size_t OFF_GB = OFF_ROT + al(128 * 32 * 2 * 4);
constexpr size_t OFF_CTX1 = OFF_GB + al((size_t)T_ALL * 16 * 4);
constexpr size_t OFF_HALO = OFF_CTX1 + al(512 * 1024 * 4);
constexpr size_t OFF_DNSC = OFF_HALO + al((size_t)NCH * 4 * 2048 * 2);
constexpr size_t OFF_HGDEC = OFF_DNSC + al((size_t)NCH * 4 * 2 * 192 * 4);
constexpr size_t OFF_BAR = OFF_HGDEC + al((size_t)NCH * 8 * 2 * 128 * 4);
constexpr size_t OFF_A = OFF_BAR + 16384;
constexpr size_t OFF_B = OFF_A + 4 * SZ_TOK1K;
constexpr size_t OFF_C = OFF_B + SZ_TOK1K;
constexpr size_t OFF_D = OFF_C + SZ_TOK1K;
constexpr size_t OFF_E = OFF_D + 2 * SZ_TOK1K;
constexpr size_t WS_TOTAL = OFF_E + 3 * SZ_TOK1K;
static_assert(WS_TOTAL <= 470286336ull, "workspace too large");

constexpr int SMEM_BYTES = 72960;

struct Params {
  const float *x, *c, *ctx, *c_ctx, *norm_w, *ada_w, *ada_b, *w_in, *dn_conv, *dn_a_log, *dn_dt_bias, *dn_norm_w,
      *ret_decay, *ret_norm_w, *hg_lb, *hg_norm_w, *w_branch, *w_out, *final_norm_w;
  float* out;
  char* ws;
  int ph_lo, ph_hi;
};

DI int laneid_v() { int t; asm volatile("v_mbcnt_lo_u32_b32 %0, -1, 0\n\tv_mbcnt_hi_u32_b32 %0, -1, %0" : "=v"(t)); return t; }
#define tidx() (WV * 64 + laneid_v())
typedef __bf16 hwbf2 __attribute__((ext_vector_type(2)));
DI u16 f2bf(float f) { __bf16 b = (__bf16)f; return __builtin_bit_cast(u16, b); }
DI float bf2f(u16 h) { return __uint_as_float(((unsigned)h) << 16); }
DI unsigned pack2(float a, float b) { hwbf2 v = {(__bf16)a, (__bf16)b}; return __builtin_bit_cast(unsigned, v); }
DI float sigm(float x) { return 1.f / (1.f + __expf(-x)); }
DI float silu(float x) { return x / (1.f + __expf(-x)); }
DI float dpp_f(float v, const int ctrl_sel) {
  const int iv = __float_as_int(v);
  int r;
  if (ctrl_sel == 0) r = __builtin_amdgcn_update_dpp(0, iv, 0xB1, 0xF, 0xF, false);
  else if (ctrl_sel == 1) r = __builtin_amdgcn_update_dpp(0, iv, 0x4E, 0xF, 0xF, false);
  else if (ctrl_sel == 2) r = __builtin_amdgcn_update_dpp(0, iv, 0x141, 0xF, 0xF, false);
  else r = __builtin_amdgcn_update_dpp(0, iv, 0x140, 0xF, 0xF, false);
  return __int_as_float(r);
}
DI float gsum(float v, const int n) {
  v += dpp_f(v, 0);
  v += dpp_f(v, 1);
  v += dpp_f(v, 2);
  if (n == 16) v += dpp_f(v, 3);
  return v;
}
DI float wsum(float v) {
  v = gsum(v, 16);
  v += __int_as_float(__builtin_amdgcn_update_dpp(0, __float_as_int(v), 0x142, 0xA, 0xF, false));
  v += __int_as_float(__builtin_amdgcn_update_dpp(0, __float_as_int(v), 0x143, 0xC, 0xF, false));
  return __int_as_float(__builtin_amdgcn_readlane(__float_as_int(v), 63));
}
DI f32x4 mfma16(bf16x8 a, bf16x8 b, f32x4 c) { return __builtin_amdgcn_mfma_f32_16x16x32_bf16(a, b, c, 0, 0, 0); }
DI bf16x8 pack8(f32x4 lo, f32x4 hi) {
  u32x4 r = {pack2(lo[0], lo[1]), pack2(lo[2], lo[3]), pack2(hi[0], hi[1]), pack2(hi[2], hi[3])};
  return __builtin_bit_cast(bf16x8, r);
}
typedef __attribute__((address_space(3))) bf16x4* lds_v4p;
DI bf16x8 ld_tr2(unsigned a_lo, unsigned a_hi) {
  const bf16x4 lo = __builtin_amdgcn_ds_read_tr16_b64_v4i16((lds_v4p)(size_t)a_lo);
  const bf16x4 hi = __builtin_amdgcn_ds_read_tr16_b64_v4i16((lds_v4p)(size_t)a_hi);
  bf16x8 r;
  r[0] = lo[0]; r[1] = lo[1]; r[2] = lo[2]; r[3] = lo[3]; r[4] = hi[0]; r[5] = hi[1]; r[6] = hi[2]; r[7] = hi[3];
  return r;
}
DI bf16x8 ld_perm(const char* rowp, int c0) {
  bf16x4 lo = *(const bf16x4*)(rowp + c0 * 2);
  bf16x4 hi = *(const bf16x4*)(rowp + c0 * 2 + 32);
  bf16x8 r;
  r[0] = lo[0]; r[1] = lo[1]; r[2] = lo[2]; r[3] = lo[3]; r[4] = hi[0]; r[5] = hi[1]; r[6] = hi[2]; r[7] = hi[3];
  return r;
}

DI int swz(int row, int ch) { return row * 128 + ((ch ^ (row & 7)) << 4); }

template <bool DEEP>
DI void gemm_kloop_t(const u16* __restrict__ A, const u16* __restrict__ W, f32x4 (&acc)[4][4], char* smem, const int WV) {
  const int tid = tidx(), lane = tid & 63, wid = tid >> 6, wn = wid >> 1, wt = wid & 1;
  const int fr = lane & 15, fq = lane >> 4;
  const int lrow = tid >> 3, lch = tid & 7;
  const u16* Ap = A + (size_t)lrow * 1024 + lch * 8;
  const u16* Wp = W + (size_t)lrow * 1024 + lch * 8;
  u32x4 ra0[4], rw0[4], ra1[4], rw1[4];
#define G_LOAD(RA, RW, KT) _Pragma("unroll") for (int i = 0; i < 4; i++) { \
    RA[i] = *(const u32x4*)(Ap + (size_t)i * 32 * 1024 + (KT) * 64); RW[i] = *(const u32x4*)(Wp + (size_t)i * 32 * 1024 + (KT) * 64); }
#define G_STORE(RA, RW, BUF) { char* dW = smem + (BUF) * 32768; _Pragma("unroll") for (int i = 0; i < 4; i++) { \
    *(u32x4*)(dW + swz(lrow + i * 32, lch)) = RW[i]; *(u32x4*)(dW + 16384 + swz(lrow + i * 32, lch)) = RA[i]; } }
#define G_COMPUTE(BUF) { const char* sW = smem + (BUF) * 32768; const char* sA = sW + 16384; \
    _Pragma("unroll") for (int ks = 0; ks < 2; ks++) { bf16x8 fw[4], fa[4]; \
      _Pragma("unroll") for (int i = 0; i < 4; i++) { \
        fw[i] = *(const bf16x8*)(sW + swz(wn * 64 + i * 16 + fr, ks * 4 + fq)); \
        fa[i] = *(const bf16x8*)(sA + swz(wt * 64 + i * 16 + fr, ks * 4 + fq)); } \
      _Pragma("unroll") for (int ni = 0; ni < 4; ni++) _Pragma("unroll") for (int ti = 0; ti < 4; ti++) \
        acc[ni][ti] = mfma16(fw[ni], fa[ti], acc[ni][ti]); } }
  G_LOAD(ra0, rw0, 0)
  G_STORE(ra0, rw0, 0)
  if (DEEP) { G_LOAD(ra1, rw1, 1) }
  __syncthreads();
  if (DEEP) {
    for (int kt = 0; kt < 16; kt += 2) {
      if (kt + 2 < 16) { G_LOAD(ra0, rw0, kt + 2) }
      G_COMPUTE(0)
      G_STORE(ra1, rw1, 1)
      __syncthreads();
      if (kt + 3 < 16) { G_LOAD(ra1, rw1, kt + 3) }
      G_COMPUTE(1)
      if (kt + 2 < 16) { G_STORE(ra0, rw0, 0) }
      __syncthreads();
    }
  } else {
    for (int kt = 0; kt < 16; kt++) {
      if (kt < 15) { G_LOAD(ra0, rw0, kt + 1) }
      G_COMPUTE(kt & 1)
      if (kt < 15) { G_STORE(ra0, rw0, (kt + 1) & 1) }
      __syncthreads();
    }
  }
#undef G_LOAD
#undef G_STORE
#undef G_COMPUTE
}
DI void gemm_kloop(const u16* __restrict__ A, const u16* __restrict__ W, f32x4 (&acc)[4][4], char* smem, const int WV,
                   const bool have0 = false, const u16* __restrict__ nA = nullptr, const u16* __restrict__ nW = nullptr) {
  const int tid = tidx(), lane = tid & 63, wid = tid >> 6, wn = wid >> 1, wt = wid & 1;
  const int fr = lane & 15, fq = lane >> 4;
  const int r8 = lane >> 3, chs = (lane & 7) ^ r8;
  const size_t loff = (size_t)(wid * 32 + r8) * 1024 + chs * 8;
  const u16* Asrc = A + loff;
  const u16* Wsrc = W + loff;
  char* ldsw = smem + wid * 4096;
#define G_STAGE_P(AS, WS, BUF, KT) _Pragma("unroll") for (int i = 0; i < 4; i++) { \
    __builtin_amdgcn_global_load_lds((const unsigned*)((WS) + (size_t)i * 8 * 1024 + (KT) * 64), (unsigned*)(ldsw + (BUF) * 32768 + i * 1024), 16, 0, 0); \
    __builtin_amdgcn_global_load_lds((const unsigned*)((AS) + (size_t)i * 8 * 1024 + (KT) * 64), (unsigned*)(ldsw + (BUF) * 32768 + 16384 + i * 1024), 16, 0, 0); }
#define G_COMPUTE(BUF) { const char* sW = smem + (BUF) * 32768; const char* sA = sW + 16384; \
    _Pragma("unroll") for (int ks = 0; ks < 2; ks++) { bf16x8 fw[4], fa[4]; \
      _Pragma("unroll") for (int i = 0; i < 4; i++) { \
        fw[i] = *(const bf16x8*)(sW + swz(wn * 64 + i * 16 + fr, ks * 4 + fq)); \
        fa[i] = *(const bf16x8*)(sA + swz(wt * 64 + i * 16 + fr, ks * 4 + fq)); } \
      _Pragma("unroll") for (int ni = 0; ni < 4; ni++) _Pragma("unroll") for (int ti = 0; ti < 4; ti++) \
        acc[ni][ti] = mfma16(fw[ni], fa[ti], acc[ni][ti]); } }
  if (!have0) {
    G_STAGE_P(Asrc, Wsrc, 0, 0)
    asm volatile("s_waitcnt vmcnt(0)" ::: "memory");
    __syncthreads();
  }
  for (int kt = 0; kt < 16; kt++) {
    if (kt < 15) { G_STAGE_P(Asrc, Wsrc, (kt + 1) & 1, kt + 1) }
    else if (nA != nullptr) { const u16* nAs = nA + loff; const u16* nWs = nW + loff; G_STAGE_P(nAs, nWs, 0, 0) }
    G_COMPUTE(kt & 1)
    asm volatile("s_waitcnt vmcnt(0)" ::: "memory");
    __syncthreads();
  }
#undef G_STAGE_P
#undef G_COMPUTE
}

DI void gemm_kloop256(const u16* __restrict__ A, const u16* __restrict__ W, f32x4 (&acc)[8][4], char* smem, const int WV) {
  const int tid = tidx(), lane = tid & 63, wid = tid >> 6, wn = wid >> 1, wt = wid & 1;
  const int fr = lane & 15, fq = lane >> 4;
  const int r16 = lane >> 2, chs = (lane & 3) ^ ((0 - (r16 >> 2)) & 3);
  const u16* Wsrc = W + (size_t)(wid * 64 + r16) * 1024 + chs * 8;
  const u16* Asrc = A + (size_t)(wid * 32 + r16) * 1024 + chs * 8;
  const int fpos = (fq ^ ((0 - (fr >> 2)) & 3)) << 4;
#define G_STAGE(BUF, KT) { _Pragma("unroll") for (int i = 0; i < 4; i++) \
      __builtin_amdgcn_global_load_lds((const unsigned*)(Wsrc + (size_t)i * 16 * 1024 + (KT) * 32), (unsigned*)(smem + (BUF) * 24576 + (wid * 4 + i) * 1024), 16, 0, 0); \
    _Pragma("unroll") for (int i = 0; i < 2; i++) \
      __builtin_amdgcn_global_load_lds((const unsigned*)(Asrc + (size_t)i * 16 * 1024 + (KT) * 32), (unsigned*)(smem + (BUF) * 24576 + 16384 + (wid * 2 + i) * 1024), 16, 0, 0); }
#define G_COMPUTE(BUF) { const char* sW = smem + (BUF) * 24576; const char* sA = sW + 16384; bf16x8 fw[8], fa[4]; \
    _Pragma("unroll") for (int i = 0; i < 8; i++) fw[i] = *(const bf16x8*)(sW + (wn * 128 + i * 16 + fr) * 64 + fpos); \
    _Pragma("unroll") for (int i = 0; i < 4; i++) fa[i] = *(const bf16x8*)(sA + (wt * 64 + i * 16 + fr) * 64 + fpos); \
    __builtin_amdgcn_s_setprio(1); \
    _Pragma("unroll") for (int ni = 0; ni < 8; ni++) _Pragma("unroll") for (int ti = 0; ti < 4; ti++) \
      acc[ni][ti] = mfma16(fw[ni], fa[ti], acc[ni][ti]); \
    __builtin_amdgcn_s_setprio(0); }
  G_STAGE(0, 0)
  asm volatile("s_waitcnt vmcnt(0)" ::: "memory");
  __syncthreads();
  for (int kt = 0; kt < 32; kt++) {
    if (kt < 31) { G_STAGE((kt + 1) & 1, kt + 1) }
    G_COMPUTE(kt & 1)
    asm volatile("s_waitcnt vmcnt(0)" ::: "memory");
    __syncthreads();
  }
#undef G_STAGE
#undef G_COMPUTE
}

enum { EPI_HG = 0, EPI_DNRET = 1, EPI_GATE = 2, EPI_OUT = 3 };

template <int EPI, int NI>
DI void gemm_tile(const Params& p, int l, int rt, int nti, char* smem) {
  const int WV = p.ph_hi;
  const int tid = tidx(), lane = tid & 63, wid = tid >> 6, wn = wid >> 1, wt = wid & 1;
  const int fr = lane & 15, fq = lane >> 4;
  const int row0 = rt * 128;
  constexpr int NW = NI * 32;
  const u16* WT = (const u16*)(p.ws + OFF_WT);
  const u16* A;
  int wrow, n0, mixer = 0;
  if (EPI == EPI_HG) { A = (const u16*)(p.ws + OFF_H); n0 = nti * NW; wrow = 6160 + n0; }
  else if (EPI == EPI_DNRET) { A = (const u16*)(p.ws + OFF_H); mixer = nti / (2048 / NW); n0 = (nti % (2048 / NW)) * NW; wrow = (mixer ? 3088 : 0) + n0; }
  else if (EPI == EPI_GATE) { A = (const u16*)(p.ws + OFF_H); mixer = nti / (1024 / NW); n0 = (nti % (1024 / NW)) * NW; wrow = (mixer == 0 ? 2048 : (mixer == 1 ? 5136 : 10256)) + n0; }
  else { A = (const u16*)(p.ws + OFF_B); n0 = nti * NW; wrow = W_OUT + n0; }
  f32x4 acc[NI][4];
#pragma unroll
  for (int i = 0; i < NI; i++)
#pragma unroll
    for (int j = 0; j < 4; j++) acc[i][j] = f32x4{0.f, 0.f, 0.f, 0.f};
  if constexpr (NI == 4) gemm_kloop(A + (size_t)row0 * 1024, WT + (size_t)wrow * 1024, acc, smem, WV);
  else gemm_kloop256(A + (size_t)row0 * 1024, WT + (size_t)wrow * 1024, acc, smem, WV);

  const float* ROT = (const float*)(p.ws + OFF_ROT);
  const float* MOD = (const float*)(p.ws + OFF_MOD);
#pragma unroll
  for (int ti = 0; ti < 4; ti++) {
    const int token = row0 + wt * 64 + ti * 16 + fr;
#pragma unroll
    for (int ni = 0; ni < NI; ni++) {
      const int nl = n0 + wn * (NI * 16) + ni * 16 + fq * 4;
      f32x4 v = acc[ni][ti];
      if (EPI == EPI_HG) {
        if (nl < 1024) { v[0] = silu(v[0]); v[1] = silu(v[1]); v[2] = silu(v[2]); v[3] = silu(v[3]); }
        u16* dst = (u16*)(p.ws + OFF_A) + (size_t)token * 4096 + nl;
        *(uint2*)dst = uint2{pack2(v[0], v[1]), pack2(v[2], v[3])};
      } else if (EPI == EPI_DNRET) {
        if (mixer == 0) {
          uint2 pk = uint2{pack2(v[0], v[1]), pack2(v[2], v[3])};
          u16* dst = (u16*)(p.ws + OFF_A) + (size_t)token * 2048 + nl;
          *(uint2*)dst = pk;
          const int tm = token & 63;
          if (tm < 2 || tm >= 62) {
            const int slot = tm < 2 ? tm : tm - 60;
            u16* hd = (u16*)(p.ws + OFF_HALO) + ((size_t)(token >> 6) * 4 + slot) * 2048 + nl;
            *(uint2*)hd = pk;
          }
        } else {
          if (nl < 1024) {
            if (token < T_LAT) {
              const int t = token & 8191, ri = t >> 6, ci = t & 63;
              const int d = nl & 127;
#pragma unroll
              for (int pp = 0; pp < 2; pp++) {
                const int pidx = (d >> 1) + pp;
                const float* rp = pidx < 32 ? ROT + (ri * 32 + pidx) * 2 : ROT + (ci * 32 + (pidx - 32)) * 2;
                const float cs = rp[0], sn = rp[1];
                const float x1 = v[2 * pp], x2 = v[2 * pp + 1];
                v[2 * pp] = x1 * cs - x2 * sn;
                v[2 * pp + 1] = x1 * sn + x2 * cs;
              }
            }
            if (nl >= 512) { const float s = 0.08838834764831845f; v[0] *= s; v[1] *= s; v[2] *= s; v[3] *= s; }
          }
          u16* dst = (u16*)(p.ws + OFF_A + 2 * SZ_TOK1K) + (size_t)token * 2048 + nl;
          *(uint2*)dst = uint2{pack2(v[0], v[1]), pack2(v[2], v[3])};
        }
      } else if (EPI == EPI_GATE) {
        char* base = mixer == 0 ? p.ws + OFF_E : (mixer == 1 ? p.ws + OFF_E + SZ_TOK1K : p.ws + OFF_D);
        u16* dst = (u16*)base + (size_t)token * 1024 + nl;
        uint2 on = *(const uint2*)dst;
        float o0 = bf2f((u16)(on.x & 0xffff)), o1 = bf2f((u16)(on.x >> 16)), o2 = bf2f((u16)(on.y & 0xffff)), o3 = bf2f((u16)(on.y >> 16));
        *(uint2*)dst = uint2{pack2(o0 * silu(v[0]), o1 * silu(v[1])), pack2(o2 * silu(v[2]), o3 * silu(v[3]))};
      } else {
        const int vec = token < T_LAT ? (token >> 13) : 2;
        const f32x4 gt = *(const f32x4*)(MOD + ((size_t)l * 3 + vec) * 3072 + 2048 + nl);
        const float* src;
        float* dst;
        if (token < T_LAT) {
          src = (l == 0 ? p.x : (const float*)p.out) + (size_t)token * 1024 + nl;
          dst = p.out + (size_t)token * 1024 + nl;
        } else {
          src = p.ctx + (size_t)(token - T_LAT) * 1024 + nl;
          dst = (float*)(p.ws + OFF_CTX1) + (size_t)(token - T_LAT) * 1024 + nl;
        }
        f32x4 xi = *(const f32x4*)src;
        f32x4 r;
        r[0] = xi[0] + gt[0] * v[0]; r[1] = xi[1] + gt[1] * v[1]; r[2] = xi[2] + gt[2] * v[2]; r[3] = xi[3] + gt[3] * v[3];
        *(f32x4*)dst = r;
      }
    }
  }
}

DI void merge_tile(const Params& p, int rt, int nti, char* smem, const bool have0 = false, const int nrt = -1, const int nnti = -1) {
  const int WV = p.ph_hi;
  const int tid = tidx(), lane = tid & 63, wid = tid >> 6, wn = wid >> 1, wt = wid & 1;
  const int fr = lane & 15, fq = lane >> 4;
  const int row0 = rt * 128, n0 = nti * 128;
  const u16* WT = (const u16*)(p.ws + OFF_WT);
  const u16* H = (const u16*)(p.ws + OFF_H) + (size_t)row0 * 1024;
  uint2 y[4][4];
#pragma unroll
  for (int i = 0; i < 4; i++)
#pragma unroll
    for (int j = 0; j < 4; j++) y[i][j] = uint2{0u, 0u};
  for (int m = 0; m < 3; m++) {
    uint2 sg[4][4];
    {
      f32x4 acc[4][4];
#pragma unroll
      for (int i = 0; i < 4; i++)
#pragma unroll
        for (int j = 0; j < 4; j++) acc[i][j] = f32x4{0.f, 0.f, 0.f, 0.f};
      const char* baseb = m == 0 ? p.ws + OFF_E : (m == 1 ? p.ws + OFF_E + SZ_TOK1K : p.ws + OFF_D);
      gemm_kloop(H, WT + (size_t)(11280 + m * 1024 + n0) * 1024, acc, smem, WV, have0 || m > 0,
                 (const u16*)baseb + (size_t)row0 * 1024, WT + (size_t)(W_BR + m * 1024 + n0) * 1024);
#pragma unroll
      for (int i = 0; i < 4; i++)
#pragma unroll
        for (int j = 0; j < 4; j++)
          sg[i][j] = uint2{pack2(sigm(acc[i][j][0]), sigm(acc[i][j][1])), pack2(sigm(acc[i][j][2]), sigm(acc[i][j][3]))};
    }
    {
      const char* base = m == 0 ? p.ws + OFF_E : (m == 1 ? p.ws + OFF_E + SZ_TOK1K : p.ws + OFF_D);
      f32x4 acc[4][4];
#pragma unroll
      for (int i = 0; i < 4; i++)
#pragma unroll
        for (int j = 0; j < 4; j++) acc[i][j] = f32x4{0.f, 0.f, 0.f, 0.f};
      const u16* nA = m < 2 ? H : (nrt >= 0 ? (const u16*)(p.ws + OFF_H) + (size_t)nrt * 128 * 1024 : nullptr);
      const u16* nW = m < 2 ? WT + (size_t)(11280 + (m + 1) * 1024 + n0) * 1024 : (nrt >= 0 ? WT + (size_t)(11280 + nnti * 128) * 1024 : nullptr);
      gemm_kloop((const u16*)base + (size_t)row0 * 1024, WT + (size_t)(W_BR + m * 1024 + n0) * 1024, acc, smem, WV, true, nA, nW);
#pragma unroll
      for (int i = 0; i < 4; i++)
#pragma unroll
        for (int j = 0; j < 4; j++) {
          const float y0 = bf2f((u16)(y[i][j].x & 0xffff)) + acc[i][j][0] * bf2f((u16)(sg[i][j].x & 0xffff));
          const float y1 = bf2f((u16)(y[i][j].x >> 16)) + acc[i][j][1] * bf2f((u16)(sg[i][j].x >> 16));
          const float y2 = bf2f((u16)(y[i][j].y & 0xffff)) + acc[i][j][2] * bf2f((u16)(sg[i][j].y & 0xffff));
          const float y3 = bf2f((u16)(y[i][j].y >> 16)) + acc[i][j][3] * bf2f((u16)(sg[i][j].y >> 16));
          y[i][j] = uint2{pack2(y0, y1), pack2(y2, y3)};
        }
    }
  }
  u16* Y = (u16*)(p.ws + OFF_B);
#pragma unroll
  for (int ti = 0; ti < 4; ti++) {
    const int token = row0 + wt * 64 + ti * 16 + fr;
#pragma unroll
    for (int ni = 0; ni < 4; ni++) {
      const int nl = n0 + wn * 64 + ni * 16 + fq * 4;
      *(uint2*)(Y + (size_t)token * 1024 + nl) = y[ni][ti];
    }
  }
}

DI void wconv_tile(const float* __restrict__ src, int N, int kt, int ntile, u16* __restrict__ dst, char* smem, const int WV) {
  float* s = (float*)smem;
  const int tid = tidx();
  const int k0 = kt * 64, n0 = ntile * 64;
#pragma unroll
  for (int i = 0; i < 4; i++) {
    const int r = (tid >> 4) + i * 16, c4 = (tid & 15) * 4;
    if (n0 + c4 < N) {
      f32x4 v = *(const f32x4*)(src + (size_t)(k0 + r) * N + n0 + c4);
      s[r * 65 + c4] = v[0]; s[r * 65 + c4 + 1] = v[1]; s[r * 65 + c4 + 2] = v[2]; s[r * 65 + c4 + 3] = v[3];
    }
  }
  __syncthreads();
#pragma unroll
  for (int i = 0; i < 2; i++) {
    const int id = tid + i * 256, n = id >> 3, kc = (id & 7) * 8;
    if (n0 + n < N) {
      uint4 o;
      o.x = pack2(s[(kc + 0) * 65 + n], s[(kc + 1) * 65 + n]);
      o.y = pack2(s[(kc + 2) * 65 + n], s[(kc + 3) * 65 + n]);
      o.z = pack2(s[(kc + 4) * 65 + n], s[(kc + 5) * 65 + n]);
      o.w = pack2(s[(kc + 6) * 65 + n], s[(kc + 7) * 65 + n]);
      *(uint4*)(dst + (size_t)(n0 + n) * 1024 + k0 + kc) = o;
    }
  }
  __syncthreads();
}
constexpr int WCONV_UNITS = 16 * 225 + 3 * 256 + 256;
DI void wconv_unit(const Params& p, int l, int u, char* smem) {
  const int WV = p.ph_hi;
  u16* WT = (u16*)(p.ws + OFF_WT);
  if (u < 16 * 225) wconv_tile(p.w_in + (size_t)l * 1024 * 14352, 14352, u / 225, u % 225, WT, smem, WV);
  else if (u < 16 * 225 + 768) {
    const int v = u - 16 * 225, m = v >> 8, r = v & 255;
    wconv_tile(p.w_branch + ((size_t)l * 3 + m) * 1024 * 1024, 1024, r >> 4, r & 15, WT + (size_t)(W_BR + m * 1024) * 1024, smem, WV);
  } else {
    const int r = u - 16 * 225 - 768;
    wconv_tile(p.w_out + (size_t)l * 1024 * 1024, 1024, r >> 4, r & 15, WT + (size_t)W_OUT * 1024, smem, WV);
  }
}

DI void adaln_unit(const Params& p, int u, char* smem) {
  const int WV = p.ph_hi;
  const int l = u / 48, ng = u % 48;
  const int tid = tidx(), lane = tid & 63, w = tid >> 6;
  const int n = ng * 64 + lane;
  const float* W = p.ada_w + (size_t)l * 1024 * 3072;
  float* ssc = (float*)smem + 1024;
  for (int i = tid; i < 3072; i += 256) {
    const float cv = i < 2048 ? p.c[i] : p.c_ctx[i - 2048];
    ssc[i] = silu(cv);
  }
  __syncthreads();
  float a0 = 0.f, a1 = 0.f, a2 = 0.f;
#pragma unroll 8
  for (int k = w * 256; k < w * 256 + 256; k++) {
    const float wv = W[(size_t)k * 3072 + n];
    a0 += ssc[k] * wv; a1 += ssc[1024 + k] * wv; a2 += ssc[2048 + k] * wv;
  }
  float* red = (float*)smem;
  red[(w * 3 + 0) * 64 + lane] = a0; red[(w * 3 + 1) * 64 + lane] = a1; red[(w * 3 + 2) * 64 + lane] = a2;
  __syncthreads();
  if (tid < 192) {
    const int vec = tid >> 6, ln = tid & 63;
    float s = red[(0 * 3 + vec) * 64 + ln] + red[(1 * 3 + vec) * 64 + ln] + red[(2 * 3 + vec) * 64 + ln] + red[(3 * 3 + vec) * 64 + ln];
    const int nn = ng * 64 + ln;
    ((float*)(p.ws + OFF_MOD))[((size_t)l * 3 + vec) * 3072 + nn] = s + p.ada_b[(size_t)l * 3072 + nn];
  }
  __syncthreads();
}

DI void phase_pro(const Params& p, char* smem) {
  const int WV = p.ph_hi;
  const int total = 96 + 16 + WCONV_UNITS;
  for (int u = blockIdx.x; u < total; u += gridDim.x) {
    if (u < 96) adaln_unit(p, u, smem);
    else if (u < 112) {
      const int id = (u - 96) * 256 + tidx();
      const int pos = id >> 5, m = id & 31;
      const float inv = powf(10000.f, -(float)(2 * m) / 64.f);
      float s, c;
      sincosf((float)pos * inv, &s, &c);
      float* ROT = (float*)(p.ws + OFF_ROT);
      ROT[id * 2] = c; ROT[id * 2 + 1] = s;
    } else wconv_unit(p, 0, u - 112, smem);
  }
}

DI void phase_norm(const Params& p, int l, char* smem) {
  const int WV = p.ph_hi;
  const int tid = tidx(), lane = tid & 63, w = tid >> 6;
  float* sW = (float*)smem;
  const float* win = p.w_in + (size_t)l * 1024 * 14352;
  for (int i = tid; i < 16 * 1024; i += 256) {
    const int k = i >> 4, cc = i & 15;
    sW[cc * 1024 + k] = win[(size_t)k * 14352 + 3072 + cc];
  }
  __syncthreads();
  const float* MOD = (const float*)(p.ws + OFF_MOD);
  const float* nw = p.norm_w + (size_t)l * 1024;
  u16* H = (u16*)(p.ws + OFF_H);
  float* GB = (float*)(p.ws + OFF_GB);
  for (int row = blockIdx.x * 4 + w; row < T_ALL; row += gridDim.x * 4) {
    const float* xr;
    int vec;
    if (row < T_LAT) { xr = (l == 0 ? p.x : (const float*)p.out) + (size_t)row * 1024; vec = row >> 13; }
    else { xr = (l == 0 ? p.ctx : (const float*)(p.ws + OFF_CTX1)) + (size_t)(row - T_LAT) * 1024; vec = 2; }
    const float* md = MOD + ((size_t)l * 3 + vec) * 3072;
    f32x4 xv[4];
    float ss = 0.f;
#pragma unroll
    for (int i = 0; i < 4; i++) {
      xv[i] = *(const f32x4*)(xr + i * 256 + lane * 4);
      ss += xv[i][0] * xv[i][0] + xv[i][1] * xv[i][1] + xv[i][2] * xv[i][2] + xv[i][3] * xv[i][3];
    }
    ss = wsum(ss);
    const float rstd = rsqrtf(ss * (1.f / 1024.f) + 1e-6f);
    float ab[16];
#pragma unroll
    for (int cc = 0; cc < 16; cc++) ab[cc] = 0.f;
#pragma unroll
    for (int i = 0; i < 4; i++) {
      const int k = i * 256 + lane * 4;
      const f32x4 wv = *(const f32x4*)(nw + k);
      const f32x4 sh = *(const f32x4*)(md + k);
      const f32x4 sc = *(const f32x4*)(md + 1024 + k);
      f32x4 h;
#pragma unroll
      for (int j = 0; j < 4; j++) h[j] = xv[i][j] * rstd * wv[j] * (1.f + sc[j]) + sh[j];
      *(uint2*)(H + (size_t)row * 1024 + k) = uint2{pack2(h[0], h[1]), pack2(h[2], h[3])};
      asm volatile("" ::: "memory");
#pragma unroll
      for (int cc = 0; cc < 16; cc++) {
        const f32x4 ww = *(const f32x4*)(sW + cc * 1024 + k);
        ab[cc] += h[0] * ww[0] + h[1] * ww[1] + h[2] * ww[2] + h[3] * ww[3];
      }
    }
#pragma unroll
    for (int cc = 0; cc < 16; cc++) ab[cc] = wsum(ab[cc]);
    if (lane < 16) {
      float v = 0.f;
#pragma unroll
      for (int cc = 0; cc < 16; cc++) if (lane == cc) v = ab[cc];
      float r;
      if (lane < 8) {
        const float A = __expf(p.dn_a_log[l * 8 + lane]);
        const float z = v + p.dn_dt_bias[l * 8 + lane];
        const float sp = z > 20.f ? z : log1pf(__expf(z));
        r = -A * sp;
      } else r = sigm(v);
      GB[(size_t)row * 16 + lane] = r;
    }
  }
  __syncthreads();
}

DI void xyT(const char* sX, const char* sY, int it, f32x4 (&acc)[4], const int WV) {
  const int lane = tidx() & 63, fr = lane & 15, fq = lane >> 4;
#pragma unroll
  for (int j = 0; j < 4; j++) acc[j] = f32x4{0.f, 0.f, 0.f, 0.f};
#pragma unroll
  for (int ks = 0; ks < 4; ks++) {
    const bf16x8 a = *(const bf16x8*)(sX + (it * 16 + fr) * 272 + (ks * 32 + fq * 8) * 2);
#pragma unroll
    for (int jt = 0; jt < 4; jt++) {
      const bf16x8 b = *(const bf16x8*)(sY + (jt * 16 + fr) * 272 + (ks * 32 + fq * 8) * 2);
      acc[jt] = mfma16(a, b, acc[jt]);
    }
  }
}

DI void dn_prep_unit(const Params& p, int l, int c, int h, char* smem) {
  const int WV = p.ph_hi;
  const int tid = tidx(), lane = tid & 63, w = tid >> 6;
  u16* QKV = (u16*)(p.ws + OFF_A);
  const u16* HALO = (const u16*)(p.ws + OFF_HALO);
  char* sQ = smem;
  char* sK = smem + 17408;
  float* sKK = (float*)(smem + 34816);
  float* sQK = (float*)(smem + 34816 + 16384);
  float* sGC = (float*)(smem + 34816 + 32768);
  float* sBT = sGC + 128;
  const int row0 = c * 64;
  {
    const int u = tid * 2;
    const int gcol = u < 128 ? h * 128 + u : (u < 256 ? 512 + h * 128 + (u - 128) : 1024 + h * 256 + (u - 256));
    bool first, last;
    if (c < 256) { first = (c & 127) == 0; last = (c & 127) == 127; }
    else { first = ((c - 256) & 3) == 0; last = ((c - 256) & 3) == 3; }
    const float* cw = p.dn_conv + (size_t)l * 5 * 2048 + gcol;
    float cw0[5], cw1[5];
#pragma unroll
    for (int j = 0; j < 5; j++) { cw0[j] = cw[j * 2048]; cw1[j] = cw[j * 2048 + 1]; }
    const u16* own = QKV + (size_t)row0 * 2048 + gcol;
    const u16* hl = first ? own : HALO + ((size_t)(c - 1) * 4 + 2) * 2048 + gcol;
    const u16* hr = last ? own : HALO + ((size_t)(c + 1) * 4) * 2048 + gcol;
    unsigned cat[12], nxt[8], nx2[8];
    {
      const unsigned a = *(const unsigned*)hl, b = *(const unsigned*)(hl + 2048);
      cat[0] = first ? 0u : a; cat[1] = first ? 0u : b;
      cat[2] = *(const unsigned*)own; cat[3] = *(const unsigned*)(own + 2048);
    }
#pragma unroll
    for (int i = 0; i < 8; i++) nxt[i] = *(const unsigned*)(own + (size_t)(2 + i) * 2048);
#pragma unroll
    for (int i = 0; i < 8; i++) nx2[i] = *(const unsigned*)(own + (size_t)(10 + i) * 2048);
    for (int tb = 0; tb < 8; tb++) {
#pragma unroll
      for (int i = 0; i < 8; i++) { cat[4 + i] = nxt[i]; nxt[i] = nx2[i]; }
      if (tb < 6) {
        const bool lastb = tb == 5;
#pragma unroll
        for (int i = 0; i < 8; i++) {
          const u16* pp = (lastb && i >= 6) ? hr + (size_t)(i - 6) * 2048 : own + (size_t)(2 + (tb + 2) * 8 + i) * 2048;
          const unsigned v = *(const unsigned*)pp;
          nx2[i] = (lastb && i >= 6 && last) ? 0u : v;
        }
      }
#pragma unroll
      for (int i = 0; i < 8; i++) {
        const int t = tb * 8 + i;
        float y0 = 0.f, y1 = 0.f;
#pragma unroll
        for (int j = 0; j < 5; j++) {
          y0 += cw0[j] * bf2f((u16)(cat[i + j] & 0xffff));
          y1 += cw1[j] * bf2f((u16)(cat[i + j] >> 16));
        }
        y0 = silu(y0); y1 = silu(y1);
        if (w < 2) {
          const float ss = wsum(y0 * y0 + y1 * y1);
          float rs = rsqrtf(ss + 1e-6f);
          if (w == 0) rs *= 0.08838834764831845f;
          y0 *= rs; y1 *= rs;
          const unsigned pk = pack2(y0, y1);
          *(unsigned*)((w == 0 ? sQ : sK) + t * 272 + (u & 127) * 2) = pk;
          *(unsigned*)(QKV + (size_t)(row0 + t) * 2048 + gcol) = pk;
        } else {
          *(unsigned*)(QKV + (size_t)(row0 + t) * 2048 + gcol) = pack2(y0, y1);
        }
      }
#pragma unroll
      for (int i = 0; i < 4; i++) cat[i] = cat[8 + i];
    }
  }
  if (w < 2) {
    const float* GB = (const float*)(p.ws + OFF_GB);
    const float g = GB[(size_t)(row0 + lane) * 16 + w * 4 + h];
    const float bt = GB[(size_t)(row0 + lane) * 16 + 8 + w * 4 + h];
    float s = g;
    if (w == 0) {
#pragma unroll
      for (int o = 1; o < 64; o <<= 1) { const float t = __shfl_up(s, o, 64); if (lane >= o) s += t; }
    } else {
#pragma unroll
      for (int o = 1; o < 64; o <<= 1) { const float t = __shfl_down(s, o, 64); if (lane + o < 64) s += t; }
    }
    const float gl = __shfl(s, w == 0 ? 63 : 0, 64);
    sGC[w * 64 + lane] = s;
    sBT[w * 64 + lane] = bt;
    float* SC = (float*)(p.ws + OFF_DNSC) + ((size_t)(c * 4 + h) * 2 + w) * 192;
    SC[lane] = __expf(s);
    SC[64 + lane] = __expf(gl - s);
    if (lane == 0) SC[128] = __expf(gl);
  }
  __syncthreads();
  {
    const int fr = lane & 15, fq = lane >> 4;
    f32x4 acc[4];
    xyT(sK, sK, w, acc, WV);
#pragma unroll
    for (int jt = 0; jt < 4; jt++)
#pragma unroll
      for (int j = 0; j < 4; j++) sKK[(w * 16 + fq * 4 + j) * 64 + jt * 16 + fr] = acc[jt][j];
    xyT(sQ, sK, w, acc, WV);
#pragma unroll
    for (int jt = 0; jt < 4; jt++)
#pragma unroll
      for (int j = 0; j < 4; j++) sQK[(w * 16 + fq * 4 + j) * 64 + jt * 16 + fr] = acc[jt][j];
  }
  __syncthreads();
  u16* AUX = (u16*)(p.ws + OFF_B) + (size_t)(c * 4 + h) * 4 * 4096;
#pragma unroll 2
  for (int e = 0; e < 32; e++) {
    const int id = tid + e * 256, dir = id >> 12, i = (id >> 6) & 63, j = id & 63;
    const bool valid = dir == 0 ? (j <= i) : (j >= i);
    float v = 0.f;
    if (valid) v = sQK[i * 64 + j] * __expf(sGC[dir * 64 + i] - sGC[dir * 64 + j]);
    AUX[(size_t)(dir * 2 + 1) * 4096 + i * 64 + j] = f2bf(v);
  }
  __syncthreads();
  float* sL0 = sQK;
  float* sL1 = (float*)smem;
#pragma unroll 2
  for (int e = 0; e < 32; e++) {
    const int id = tid + e * 256, dir = id >> 12, ip = (id >> 6) & 63, jp = id & 63;
    const int i = dir ? 63 - ip : ip, j = dir ? 63 - jp : jp;
    float v = 0.f;
    if (jp < ip) v = sBT[dir * 64 + i] * sKK[i * 64 + j] * __expf(sGC[dir * 64 + i] - sGC[dir * 64 + j]);
    (dir ? sL1 : sL0)[ip * 64 + jp] = v;
  }
  __syncthreads();
  if (w < 2) {
    const float* L = w ? sL1 : sL0;
    const int cn = w ? 63 - lane : lane;
    const float bc = sBT[w * 64 + cn];
    f32x4 Lb[2][16];
    float T[64];
#pragma unroll
    for (int i = 0; i < 64; i++) {
      if (i + 1 < 64) {
#pragma unroll
        for (int b4 = 0; b4 < (i + 1 + 3) / 4; b4++) Lb[(i + 1) & 1][b4] = *(const f32x4*)(L + (i + 1) * 64 + 4 * b4);
      }
      asm volatile("" ::: "memory");
      float a0 = (i == lane) ? 1.f : 0.f, a1 = 0.f, a2 = 0.f, a3 = 0.f;
#pragma unroll
      for (int r = 0; r < i; r++) {
        const float lv = Lb[i & 1][r >> 2][r & 3];
        if ((r & 3) == 0) a0 -= lv * T[r];
        else if ((r & 3) == 1) a1 -= lv * T[r];
        else if ((r & 3) == 2) a2 -= lv * T[r];
        else a3 -= lv * T[r];
      }
      T[i] = (a0 + a1) + (a2 + a3);
    }
#pragma unroll
    for (int ip = 0; ip < 64; ip++) {
      const int i = w ? 63 - ip : ip;
      AUX[(size_t)(w * 2 + 0) * 4096 + i * 64 + cn] = f2bf(T[ip] * bc);
    }
  }
  __syncthreads();
}

DI void ret_prep_unit(const Params& p, int l, int c, int h, char* smem) {
  const int WV = p.ph_hi;
  const int tid = tidx(), lane = tid & 63, w = tid >> 6;
  const u16* QKV = (const u16*)(p.ws + OFF_A + 2 * SZ_TOK1K);
  char* sQ = smem;
  char* sK = smem + 17408;
  const int row0 = c * 64;
#pragma unroll
  for (int i = 0; i < 4; i++) {
    const int id = tid + i * 256, r = id >> 4, ch = id & 15;
    *(uint4*)(sQ + r * 272 + ch * 16) = *(const uint4*)(QKV + (size_t)(row0 + r) * 2048 + h * 128 + ch * 8);
    *(uint4*)(sK + r * 272 + ch * 16) = *(const uint4*)(QKV + (size_t)(row0 + r) * 2048 + 512 + h * 128 + ch * 8);
  }
  __syncthreads();
  f32x4 acc[4];
  xyT(sQ, sK, w, acc, WV);
  const int fr = lane & 15, fq = lane >> 4;
  u16* AUX = (u16*)(p.ws + OFF_C) + (size_t)(c * 4 + h) * 2 * 4096;
#pragma unroll
  for (int dir = 0; dir < 2; dir++) {
    const float rd = p.ret_decay[l * 8 + dir * 4 + h];
    const float lam = fminf(rd, 0.f) - log1pf(__expf(-fabsf(rd)));
#pragma unroll
    for (int jt = 0; jt < 4; jt++)
#pragma unroll
      for (int j = 0; j < 4; j++) {
        const int i = w * 16 + fq * 4 + j, jj = jt * 16 + fr;
        const int dd = dir == 0 ? i - jj : jj - i;
        const float v = dd >= 0 ? acc[jt][j] * __expf(lam * (float)dd) : 0.f;
        AUX[(size_t)dir * 4096 + i * 64 + jj] = f2bf(v);
      }
  }
  __syncthreads();
}

DI void hg_prep_unit(const Params& p, int l, int c, int h, char* smem) {
  const int WV = p.ph_hi;
  const int tid = tidx();
  u16* QFI = (u16*)(p.ws + OFF_A);
  u16* HGX = (u16*)(p.ws + OFF_B);
  float* sG = (float*)smem;
  u16* sQ = (u16*)(smem + 33280);
  u16* sK = (u16*)(smem + 50176);
  float* sTot = (float*)(smem + 67072);
  const int row0 = c * 64;
#pragma unroll
  for (int i = 0; i < 4; i++) {
    const int id = tid + i * 256, r = id >> 4, ch = id & 15;
    const uint4 v = *(const uint4*)(QFI + (size_t)(row0 + r) * 4096 + h * 128 + ch * 8);
    const unsigned vv[4] = {v.x, v.y, v.z, v.w};
#pragma unroll
    for (int e = 0; e < 4; e++) {
      sQ[(ch * 8 + e * 2) * 66 + r] = (u16)(vv[e] & 0xffff);
      sQ[(ch * 8 + e * 2 + 1) * 66 + r] = (u16)(vv[e] >> 16);
    }
  }
  __syncthreads();
  const int half = tid >> 7, d = tid & 127;
#pragma unroll 1
  for (int dir = 1; dir >= 0; dir--) {
    float lo = 0.f;
    if (l == 1) {
      const float b0 = p.hg_lb[dir * 1024 + h * 128 + d], b1 = p.hg_lb[2048 + dir * 1024 + h * 128 + d];
      lo = sigm(b1 - b0);
    }
    float run = 0.f;
    {
      const u16* xs = QFI + (size_t)row0 * 4096 + 1024 + dir * 1024 + h * 128 + d;
      float xv[32];
#pragma unroll
      for (int i = 0; i < 32; i++) xv[i] = bf2f(xs[(size_t)(half * 32 + (dir == 0 ? i : 31 - i)) * 4096]);
#pragma unroll
      for (int i = 0; i < 32; i++) {
        const int ii = dir == 0 ? i : 31 - i;
        const int t = half * 32 + ii;
        const float x = xv[i];
        const float sg = sigm(x);
        const float f = lo + (1.f - lo) * sg;
        const float omf = (1.f - lo) * (1.f - sg);
        run += __log2f(f);
        sG[d * 65 + t] = run;
        sK[d * 66 + t] = f2bf(omf);
      }
      sTot[half * 128 + d] = run;
    }
    __syncthreads();
    {
      const float t0 = sTot[d], t1 = sTot[128 + d];
      const float gtot = t0 + t1;
      const float add = dir == 0 ? (half == 1 ? t0 : 0.f) : (half == 0 ? t1 : 0.f);
      u16* qdst = dir == 0 ? QFI + (size_t)row0 * 4096 + h * 128 + d : HGX + (size_t)row0 * 1024 + h * 128 + d;
      const size_t qp = dir == 0 ? 4096 : 1024;
      u16* kdst = QFI + (size_t)row0 * 4096 + 1024 + dir * 1024 + h * 128 + d;
#pragma unroll 8
      for (int i = 0; i < 32; i++) {
        const int t = half * 32 + i;
        const float G = sG[d * 65 + t] + add;
        sG[d * 65 + t] = G;
        qdst[(size_t)t * qp] = f2bf(bf2f(sQ[d * 66 + t]) * __builtin_amdgcn_exp2f(G));
        kdst[(size_t)t * 4096] = f2bf(bf2f(sK[d * 66 + t]) * __builtin_amdgcn_exp2f(gtot - G));
      }
      if (half == 0) ((float*)(p.ws + OFF_HGDEC))[((size_t)(c * 8 + h) * 2 + dir) * 128 + d] = __builtin_amdgcn_exp2f(gtot);
    }
    __syncthreads();
    {
      const int lane = tid & 63, I = tid >> 6, fr = lane & 15, fq = lane >> 4;
      const int rt = dir == 0 ? I * 16 - 1 : I * 16 + 16;
      const bool hasref = dir == 0 ? (I > 0) : (I < 3);
      bf16x8 af[4];
#pragma unroll
      for (int ks = 0; ks < 4; ks++) {
        asm volatile("" ::: "memory");
#pragma unroll
        for (int j = 0; j < 8; j++) {
          const int dd = ks * 32 + fq * 8 + j;
          const float R = hasref ? sG[dd * 65 + rt] : 0.f;
          const float e = __builtin_amdgcn_exp2f(fmaxf(sG[dd * 65 + I * 16 + fr] - R, -120.f));
          af[ks][j] = (short)f2bf(bf2f(sQ[dd * 66 + I * 16 + fr]) * e);
        }
      }
      u16* AUX = (u16*)(p.ws + OFF_C) + ((size_t)(c * 8 + h) * 2 + dir) * 4096;
#pragma unroll 1
      for (int J = 0; J < 4; J++) {
        const bool actv = dir == 0 ? (J <= I) : (J >= I);
        f32x4 acc = f32x4{0.f, 0.f, 0.f, 0.f};
        if (actv) {
#pragma unroll
          for (int ks = 0; ks < 4; ks++) {
            asm volatile("" ::: "memory");
            bf16x8 bfr;
#pragma unroll
            for (int j = 0; j < 8; j++) {
              const int dd = ks * 32 + fq * 8 + j;
              const float R = hasref ? sG[dd * 65 + rt] : 0.f;
              const float e = __builtin_amdgcn_exp2f(fminf(R - sG[dd * 65 + J * 16 + fr], 120.f));
              bfr[j] = (short)f2bf(bf2f(sK[dd * 66 + J * 16 + fr]) * e);
            }
            acc = mfma16(af[ks], bfr, acc);
          }
        }
#pragma unroll
        for (int jj = 0; jj < 4; jj++) {
          const int i = I * 16 + fq * 4 + jj, j = J * 16 + fr;
          const bool valid = actv && (dir == 0 ? (j <= i) : (j >= i));
          AUX[i * 64 + j] = f2bf(valid ? acc[jj] : 0.f);
        }
      }
    }
    __syncthreads();
  }
}

struct ScanDesc {
  const u16 *q, *k, *v;
  int qp, kp, vp;
  const u16* aux;
  size_t aux_cs;
  int attn_off, ainv_off;
  u16* o;
  int mixer, b, dir;
  const float* sc;
  size_t sc_cs;
  float lam;
};

DI int scan_chunk_of(int dir, int b, int step) {
  if (dir == 0) return step < 4 ? 256 + 4 * b + step : 128 * b + (step - 4);
  return step < 4 ? 256 + 4 * b + (3 - step) : 128 * b + (131 - step);
}
template <int MIXER>
DI void scan_prefetch(const u16* sq, const u16* sk, const u16* sv, int qp, int kp, int vp, const u16* saux, size_t aux_cs, int attn_off, int ainv_off,
                      const float* ssc, size_t sc_cs, int c, int tid, int w, int fr, int fq, u32x4 (&rq)[4], u32x4 (&rk)[4], u32x4 (&rat)[2], u32x4 (&rai)[2],
                      unsigned (&rv)[8], float& rsc, float& regl) {
  struct { const u16 *q, *k, *v; int qp, kp, vp; const u16* aux; size_t aux_cs; int attn_off, ainv_off; const float* sc; size_t sc_cs; } s =
      {sq, sk, sv, qp, kp, vp, saux, aux_cs, attn_off, ainv_off, ssc, sc_cs};
  const int row0 = c * 64;
  const u16* qbase = s.q + (size_t)row0 * s.qp;
  const u16* kbase = s.k + (size_t)row0 * s.kp;
  const u16* vbase = s.v + (size_t)row0 * s.vp;
  const unsigned qoff = (unsigned)((tid >> 4) * s.qp + (tid & 15) * 8);
  const unsigned koff = (unsigned)((tid >> 4) * s.kp + (tid & 15) * 8);
#pragma unroll
  for (int i = 0; i < 4; i++) {
    rq[i] = *(const u32x4*)(qbase + (size_t)(i * 16) * s.qp + qoff);
    rk[i] = *(const u32x4*)(kbase + (size_t)(i * 16) * s.kp + koff);
  }
  const u16* ab = s.aux + (size_t)c * s.aux_cs;
  const unsigned aoff = (unsigned)((tid >> 3) * 64 + (tid & 7) * 8);
#pragma unroll
  for (int i = 0; i < 2; i++) {
    rat[i] = *(const u32x4*)(ab + s.attn_off + i * 32 * 64 + aoff);
    if (MIXER == 0) rai[i] = *(const u32x4*)(ab + s.ainv_off + i * 32 * 64 + aoff);
  }
  if (MIXER == 0) {
    const float* sc = s.sc + (size_t)c * s.sc_cs;
    if (tid < 128) rsc = sc[tid];
    regl = sc[128];
  } else if (MIXER == 2) {
    if (tid < 128) rsc = s.sc[(size_t)c * s.sc_cs + tid];
  }
  const unsigned voff = (unsigned)(fq * 4 * s.vp + w * 16 + fr);
#pragma unroll
  for (int mt = 0; mt < 4; mt++)
#pragma unroll
    for (int jp = 0; jp < 2; jp++) {
      const unsigned lo = (vbase + (size_t)(mt * 16 + jp * 2) * s.vp)[voff];
      const unsigned hi = (vbase + (size_t)(mt * 16 + jp * 2 + 1) * s.vp)[voff];
      rv[mt * 2 + jp] = lo | (hi << 16);
    }
}

template <int MIXER>
DI void scan_unit(const ScanDesc& s, char* smem, const int WV) {
  const int tid = tidx(), lane = tid & 63, w = tid >> 6;
  const int fr = lane & 15, fq = lane >> 4;
  char* sQm = smem;
  char* sKm = smem + 17408;
  const unsigned km_tr = (unsigned)(size_t)sKm + (unsigned)((fq * 4 + ((lane & 15) >> 2)) * 272 + (lane & 3) * 8);
  char* sAT = smem + 53248;
  char* sAI = smem + 62464;
  float* sSC = (float*)(smem + 71680);
  f32x4 S[8];
#pragma unroll
  for (int i = 0; i < 8; i++) S[i] = f32x4{0.f, 0.f, 0.f, 0.f};
  u32x4 rq[4], rk[4], rat[2], rai[2];
  rai[0] = u32x4{0u, 0u, 0u, 0u}; rai[1] = rai[0];
  unsigned rv[8];
  float rsc = 0.f, regl = 1.f;
  scan_prefetch<MIXER>(s.q, s.k, s.v, s.qp, s.kp, s.vp, s.aux, s.aux_cs, s.attn_off, s.ainv_off, s.sc, s.sc_cs, scan_chunk_of(s.dir, s.b, 0), tid, w, fr, fq, rq, rk, rat, rai, rv, rsc, regl);
  for (int step = 0; step < 132; step++) {
    const int c = scan_chunk_of(s.dir, s.b, step);
    const int row0 = c * 64;
#pragma unroll
    for (int i = 0; i < 4; i++) {
      const int id = tid + i * 256, r = id >> 4, ch = id & 15;
      *(u32x4*)(sQm + r * 272 + ch * 16) = rq[i];
      *(u32x4*)(sKm + r * 272 + ch * 16) = rk[i];
    }
#pragma unroll
    for (int i = 0; i < 2; i++) {
      const int id = tid + i * 256, r = id >> 3, ch = id & 7;
      *(u32x4*)(sAT + r * 144 + ch * 16) = rat[i];
      if (MIXER == 0) *(u32x4*)(sAI + r * 144 + ch * 16) = rai[i];
    }
    float egl = 1.f;
    if (MIXER == 0) {
      if (tid < 128) sSC[tid] = rsc;
      egl = regl;
    } else if (MIXER == 1) {
      if (tid < 64) {
        const float e1 = s.dir == 0 ? (float)(tid + 1) : (float)(64 - tid);
        sSC[tid] = __expf(s.lam * e1);
        sSC[64 + tid] = __expf(s.lam * (64.f - e1));
      }
      egl = __expf(s.lam * 64.f);
    } else {
      if (tid < 128) sSC[tid] = rsc;
    }
    f32x4 V[4];
#pragma unroll
    for (int mt = 0; mt < 4; mt++) {
      V[mt][0] = bf2f((u16)(rv[mt * 2] & 0xffff)); V[mt][1] = bf2f((u16)(rv[mt * 2] >> 16));
      V[mt][2] = bf2f((u16)(rv[mt * 2 + 1] & 0xffff)); V[mt][3] = bf2f((u16)(rv[mt * 2 + 1] >> 16));
    }
    __syncthreads();
    if (step + 1 < 132) scan_prefetch<MIXER>(s.q, s.k, s.v, s.qp, s.kp, s.vp, s.aux, s.aux_cs, s.attn_off, s.ainv_off, s.sc, s.sc_cs, scan_chunk_of(s.dir, s.b, step + 1), tid, w, fr, fq, rq, rk, rat, rai, rv, rsc, regl);
    bf16x8 Sb[4];
#pragma unroll
    for (int ks = 0; ks < 4; ks++) Sb[ks] = pack8(S[2 * ks], S[2 * ks + 1]);
    f32x4 vn[4];
    f32x4 oq[4];
#pragma unroll
    for (int mt = 0; mt < 4; mt++) oq[mt] = f32x4{0.f, 0.f, 0.f, 0.f};
    if (MIXER == 0) {
      f32x4 P[4];
      bf16x8 aai[2][4];
#pragma unroll
      for (int ks = 0; ks < 2; ks++)
#pragma unroll
        for (int mt = 0; mt < 4; mt++) aai[ks][mt] = ld_perm(sAI + (mt * 16 + fr) * 144, ks * 32 + fq * 4);
#pragma unroll
      for (int mt = 0; mt < 4; mt++) P[mt] = f32x4{0.f, 0.f, 0.f, 0.f};
#pragma unroll
      for (int ks = 0; ks < 4; ks++) {
        bf16x8 ak[4], aq[4];
#pragma unroll
        for (int mt = 0; mt < 4; mt++) { ak[mt] = ld_perm(sKm + (mt * 16 + fr) * 272, ks * 32 + fq * 4); aq[mt] = ld_perm(sQm + (mt * 16 + fr) * 272, ks * 32 + fq * 4); }
#pragma unroll
        for (int mt = 0; mt < 4; mt++) P[mt] = mfma16(ak[mt], Sb[ks], P[mt]);
#pragma unroll
        for (int mt = 0; mt < 4; mt++) oq[mt] = mfma16(aq[mt], Sb[ks], oq[mt]);
      }
#pragma unroll
      for (int mt = 0; mt < 4; mt++)
#pragma unroll
        for (int j = 0; j < 4; j++) P[mt][j] = V[mt][j] - sSC[mt * 16 + fq * 4 + j] * P[mt][j];
      bf16x8 rb[2];
#pragma unroll
      for (int ks = 0; ks < 2; ks++) rb[ks] = pack8(P[2 * ks], P[2 * ks + 1]);
#pragma unroll
      for (int mt = 0; mt < 4; mt++) vn[mt] = f32x4{0.f, 0.f, 0.f, 0.f};
#pragma unroll
      for (int ks = 0; ks < 2; ks++) {
#pragma unroll
        for (int mt = 0; mt < 4; mt++) vn[mt] = mfma16(aai[ks][mt], rb[ks], vn[mt]);
      }
    } else {
#pragma unroll
      for (int ks = 0; ks < 4; ks++) {
        bf16x8 aq[4];
#pragma unroll
        for (int mt = 0; mt < 4; mt++) aq[mt] = ld_perm(sQm + (mt * 16 + fr) * 272, ks * 32 + fq * 4);
#pragma unroll
        for (int mt = 0; mt < 4; mt++) oq[mt] = mfma16(aq[mt], Sb[ks], oq[mt]);
      }
#pragma unroll
      for (int mt = 0; mt < 4; mt++) vn[mt] = V[mt];
    }
    bf16x8 vb[2];
#pragma unroll
    for (int ks = 0; ks < 2; ks++) vb[ks] = pack8(vn[2 * ks], vn[2 * ks + 1]);
    if (MIXER != 2) {
#pragma unroll
      for (int mt = 0; mt < 4; mt++)
#pragma unroll
        for (int j = 0; j < 4; j++) oq[mt][j] *= sSC[mt * 16 + fq * 4 + j];
    }
#pragma unroll
    for (int ks = 0; ks < 2; ks++) {
      bf16x8 aa[4];
#pragma unroll
      for (int mt = 0; mt < 4; mt++) aa[mt] = ld_perm(sAT + (mt * 16 + fr) * 144, ks * 32 + fq * 4);
#pragma unroll
      for (int mt = 0; mt < 4; mt++) oq[mt] = mfma16(aa[mt], vb[ks], oq[mt]);
    }
    if (MIXER != 2) {
#pragma unroll
      for (int mt = 0; mt < 4; mt++)
#pragma unroll
        for (int j = 0; j < 4; j++) vn[mt][j] *= sSC[64 + mt * 16 + fq * 4 + j];
#pragma unroll
      for (int ks = 0; ks < 2; ks++) vb[ks] = pack8(vn[2 * ks], vn[2 * ks + 1]);
    }
#pragma unroll
    for (int mt = 0; mt < 8; mt++) {
      if (MIXER == 2) {
#pragma unroll
        for (int j = 0; j < 4; j++) S[mt][j] *= sSC[mt * 16 + fq * 4 + j];
      } else {
#pragma unroll
        for (int j = 0; j < 4; j++) S[mt][j] *= egl;
      }
    }
#pragma unroll
    for (int ks = 0; ks < 2; ks++) {
      bf16x8 at[8];
#pragma unroll
      for (int mt = 0; mt < 8; mt++) at[mt] = ld_tr2(km_tr + (unsigned)((ks * 32) * 272 + mt * 32), km_tr + (unsigned)((ks * 32 + 16) * 272 + mt * 32));
#pragma unroll
      for (int mt = 0; mt < 8; mt++) S[mt] = mfma16(at[mt], vb[ks], S[mt]);
    }
    {
      u16* obase = s.o + (size_t)row0 * 1024;
#pragma unroll
      for (int mt = 0; mt < 4; mt++)
#pragma unroll
        for (int j = 0; j < 4; j++) obase[(unsigned)((mt * 16 + fq * 4 + j) * 1024 + w * 16 + fr)] = f2bf(oq[mt][j]);
    }
    __syncthreads();
  }
}

DI void scan_phase_hg(const Params& p, char* smem) {
  const int WV = p.ph_hi;
  if ((blockIdx.x & 3) == 0 && (blockIdx.x >> 2) < 64) {
    const int u = blockIdx.x >> 2;
    const int dir = u & 1, vg = (u >> 1) & 1, h = (u >> 2) & 7, b = u >> 5;
    ScanDesc s;
    s.q = dir == 0 ? (const u16*)(p.ws + OFF_A) + h * 128 : (const u16*)(p.ws + OFF_B) + h * 128;
    s.qp = dir == 0 ? 4096 : 1024;
    s.k = (const u16*)(p.ws + OFF_A) + 1024 + dir * 1024 + h * 128; s.kp = 4096;
    s.v = (const u16*)(p.ws + OFF_A) + 3072 + h * 128 + vg * 64; s.vp = 4096;
    s.aux = (const u16*)(p.ws + OFF_C) + (size_t)(h * 2 + dir) * 4096; s.aux_cs = 8 * 2 * 4096; s.attn_off = 0; s.ainv_off = 0;
    s.o = (u16*)(p.ws + OFF_D + (dir ? SZ_TOK1K : 0)) + h * 128 + vg * 64;
    s.mixer = 2; s.b = b; s.dir = dir;
    s.sc = (const float*)(p.ws + OFF_HGDEC) + (size_t)(h * 2 + dir) * 128; s.sc_cs = 8 * 2 * 128; s.lam = 0.f;
    scan_unit<2>(s, smem, WV);
  }
}
DI void scan_phase_dnret(const Params& p, int l, char* smem) {
  const int WV = p.ph_hi;
  if ((blockIdx.x & 1) == 0 && (blockIdx.x >> 1) < 128) {
    const int u = blockIdx.x >> 1;
    const int mixer = u & 1, dir = (u >> 1) & 1, vg = (u >> 2) & 3, h = (u >> 4) & 3, b = u >> 6;
    ScanDesc s;
    const u16* base = (const u16*)(p.ws + OFF_A + (mixer ? 2 * SZ_TOK1K : 0));
    s.q = base + h * 128; s.k = base + 512 + h * 128; s.v = base + 1024 + h * 256 + vg * 64;
    s.qp = s.kp = s.vp = 2048;
    s.mixer = mixer; s.b = b; s.dir = dir;
    if (mixer == 0) {
      s.aux = (const u16*)(p.ws + OFF_B) + (size_t)(h * 2 + dir) * 2 * 4096; s.aux_cs = 4 * 4 * 4096; s.ainv_off = 0; s.attn_off = 4096;
      s.sc = (const float*)(p.ws + OFF_DNSC) + (size_t)(h * 2 + dir) * 192; s.sc_cs = 4 * 2 * 192; s.lam = 0.f;
      s.o = (u16*)(dir == 0 ? p.ws + OFF_E : p.ws + OFF_D + SZ_TOK1K) + h * 256 + vg * 64;
      scan_unit<0>(s, smem, WV);
    } else {
      s.aux = (const u16*)(p.ws + OFF_C) + (size_t)(h * 2 + dir) * 4096; s.aux_cs = 4 * 2 * 4096; s.attn_off = 0; s.ainv_off = 0;
      const float rd = p.ret_decay[l * 8 + dir * 4 + h];
      s.lam = fminf(rd, 0.f) - log1pf(__expf(-fabsf(rd)));
      s.sc = nullptr; s.sc_cs = 0;
      s.o = (u16*)(p.ws + OFF_E + (dir == 0 ? SZ_TOK1K : 2 * SZ_TOK1K)) + h * 256 + vg * 64;
      scan_unit<1>(s, smem, WV);
    }
  }
}

DI void onorm_rows(u16* of, const u16* ob, const float* nw, int dv, int unit, int nunits_stride, const int WV) {
  const int lane = tidx() & 63, w = tidx() >> 6;
  float nwr[16];
  {
    const int dcol0 = (lane * 16) % dv;
#pragma unroll
    for (int e = 0; e < 4; e++) {
      const f32x4 t4 = *(const f32x4*)(nw + dcol0 + 4 * e);
      nwr[4 * e] = t4[0]; nwr[4 * e + 1] = t4[1]; nwr[4 * e + 2] = t4[2]; nwr[4 * e + 3] = t4[3];
    }
  }
  for (int row = unit * 4 + w; row < T_ALL; row += nunits_stride * 4) {
    u16* pf = of + (size_t)row * 1024 + lane * 16;
    const u16* pb = ob + (size_t)row * 1024 + lane * 16;
    float v[16];
#pragma unroll
    for (int hv = 0; hv < 2; hv++) {
      const uint4 a = *(const uint4*)(pf + hv * 8), b = *(const uint4*)(pb + hv * 8);
      const unsigned aa[4] = {a.x, a.y, a.z, a.w}, bb[4] = {b.x, b.y, b.z, b.w};
#pragma unroll
      for (int e = 0; e < 4; e++) {
        v[hv * 8 + e * 2] = bf2f((u16)(aa[e] & 0xffff)) + bf2f((u16)(bb[e] & 0xffff));
        v[hv * 8 + e * 2 + 1] = bf2f((u16)(aa[e] >> 16)) + bf2f((u16)(bb[e] >> 16));
      }
    }
    float ss = 0.f;
#pragma unroll
    for (int e = 0; e < 16; e++) ss += v[e] * v[e];
    ss = dv == 256 ? gsum(ss, 16) : gsum(ss, 8);
    const float rstd = rsqrtf(ss / (float)dv + 1e-6f);
    unsigned o8[8];
#pragma unroll
    for (int e = 0; e < 8; e++) o8[e] = pack2(v[2 * e] * rstd * nwr[2 * e], v[2 * e + 1] * rstd * nwr[2 * e + 1]);
    *(uint4*)pf = uint4{o8[0], o8[1], o8[2], o8[3]};
    *(uint4*)(pf + 8) = uint4{o8[4], o8[5], o8[6], o8[7]};
  }
}

DI void final_norm(const Params& p) {
  const int WV = p.ph_hi;
  const int lane = tidx() & 63, w = tidx() >> 6;
  for (int row = blockIdx.x * 4 + w; row < T_LAT; row += gridDim.x * 4) {
    float* xr = p.out + (size_t)row * 1024;
    f32x4 xv[4];
    float ss = 0.f;
#pragma unroll
    for (int i = 0; i < 4; i++) {
      xv[i] = *(const f32x4*)(xr + i * 256 + lane * 4);
      ss += xv[i][0] * xv[i][0] + xv[i][1] * xv[i][1] + xv[i][2] * xv[i][2] + xv[i][3] * xv[i][3];
    }
    ss = wsum(ss);
    const float rstd = rsqrtf(ss * (1.f / 1024.f) + 1e-6f);
#pragma unroll
    for (int i = 0; i < 4; i++) {
      const f32x4 wv = *(const f32x4*)(p.final_norm_w + i * 256 + lane * 4);
      f32x4 r;
#pragma unroll
      for (int j = 0; j < 4; j++) r[j] = xv[i][j] * rstd * wv[j];
      *(f32x4*)(xr + i * 256 + lane * 4) = r;
    }
  }
}

DI void run_phase(const Params& p, int ph, char* smem) {
  const int WV = p.ph_hi;
  const int G = gridDim.x, B = blockIdx.x;
  if (ph == 0) { if (QSEL(11)) phase_pro(p, smem); return; }
  if (ph == 23) { if (QSEL(12)) final_norm(p); return; }
  const int l = (ph - 1) / 11, q = (ph - 1) % 11;
  const bool last = l == 1;
  switch (q) {
    case 0: if (!QSEL(0)) break;
      if (l == 1) for (int u = B; u < WCONV_UNITS; u += G) wconv_unit(p, 1, u, smem);
      phase_norm(p, l, smem);
      break;
    case 1: if (!QSEL(1)) break;
      for (int t = B; t < 128 * 16; t += G) gemm_tile<EPI_HG, 8>(p, l, t % 128, t / 128, smem);
      for (int t = B; t < 4 * 32; t += G) gemm_tile<EPI_HG, 4>(p, l, 128 + (t & 3), t >> 2, smem);
      break;
    case 2: if (!QSEL(2)) break;
      for (int u = B; u < NCH * 8; u += G) hg_prep_unit(p, l, u >> 3, u & 7, smem);
      break;
    case 3: if (!QSEL(3)) break; scan_phase_hg(p, smem); break;
    case 4: if (!QSEL(4)) break;
      for (int t = B; t < 128 * 16; t += G) gemm_tile<EPI_DNRET, 8>(p, l, t % 128, t / 128, smem);
      for (int t = B; t < 4 * 32; t += G) gemm_tile<EPI_DNRET, 4>(p, l, 128 + (t & 3), t >> 2, smem);
      onorm_rows((u16*)(p.ws + OFF_D), (const u16*)(p.ws + OFF_D + SZ_TOK1K), p.hg_norm_w + l * 128, 128, B, G, WV);
      break;
    case 5: if (!QSEL(5)) break;
      for (int u = B; u < NCH * 8; u += G) {
        if (u < NCH * 4) dn_prep_unit(p, l, u >> 2, u & 3, smem);
        else ret_prep_unit(p, l, (u - NCH * 4) >> 2, u & 3, smem);
      }
      break;
    case 6: if (!QSEL(6)) break; scan_phase_dnret(p, l, smem); break;
    case 7: if (!QSEL(7)) break;
      onorm_rows((u16*)(p.ws + OFF_E), (const u16*)(p.ws + OFF_D + SZ_TOK1K), p.dn_norm_w + l * 256, 256, B, G, WV);
      onorm_rows((u16*)(p.ws + OFF_E + SZ_TOK1K), (const u16*)(p.ws + OFF_E + 2 * SZ_TOK1K), p.ret_norm_w + l * 256, 256, B, G, WV);
      break;
    case 8: if (!QSEL(8)) break; {
      const int nrt = last ? 128 : 132;
      for (int t = B; t < 128 * 12; t += G) gemm_tile<EPI_GATE, 8>(p, l, t % 128, t / 128, smem);
      if (!last) for (int t = B; t < 4 * 24; t += G) gemm_tile<EPI_GATE, 4>(p, l, 128 + (t & 3), t >> 2, smem);
    } break;
    case 9: if (!QSEL(9)) break; {
      const int nrt = last ? 128 : 132;
      for (int t = B; t < nrt * 8; t += G) {
        const int tn = t + G;
        const bool more = tn < nrt * 8;
        merge_tile(p, t % nrt, t / nrt, smem, t != B, more ? tn % nrt : -1, more ? tn / nrt : -1);
      }
    } break;
    case 10: if (!QSEL(10)) break; {
      const int nrt = last ? 128 : 132;
      for (int t = B; t < 128 * 4; t += G) gemm_tile<EPI_OUT, 8>(p, l, t % 128, t / 128, smem);
      if (!last) for (int t = B; t < 4 * 8; t += G) gemm_tile<EPI_OUT, 4>(p, l, 128 + (t & 3), t >> 2, smem);
    } break;
  }
}

#define XB_XCNT(j) (64 * (j))
#define XB_XSUB(j) (1024 + 64 * (j))
#define XB_XGEN(j) (2048 + 64 * (j))
#define XB_TOP 3072
#define XB_TOPGEN 3136
DI unsigned xb_ld(unsigned* q) { return __hip_atomic_load(q, __ATOMIC_RELAXED, __HIP_MEMORY_SCOPE_AGENT); }
DI unsigned xb_add(unsigned* q, unsigned v) { return __hip_atomic_fetch_add(q, v, __ATOMIC_RELAXED, __HIP_MEMORY_SCOPE_AGENT); }
DI void grid_barrier(unsigned* bar, volatile unsigned* st) {
  asm volatile("s_waitcnt vmcnt(0) lgkmcnt(0)" ::: "memory");
  __syncthreads();
  if (__builtin_amdgcn_workitem_id_x() == 0) {
    const unsigned nloc = st[0], nx = st[1], x = st[2];
    const unsigned old = xb_add(&bar[XB_XSUB(x)], 1u);
    const unsigned gen = old / nloc;
    if (old + 1u == (gen + 1u) * nloc) {
      __builtin_amdgcn_fence(__ATOMIC_RELEASE, "agent");
      asm volatile("s_waitcnt vmcnt(0)" ::: "memory");
      const unsigned og = xb_add(&bar[XB_TOP], 1u);
      const unsigned tg = og / nx;
      if (og + 1u == (tg + 1u) * nx) xb_add(&bar[XB_TOPGEN], 1u);
      else while (xb_ld(&bar[XB_TOPGEN]) == tg) __builtin_amdgcn_s_sleep(2);
      __builtin_amdgcn_fence(__ATOMIC_ACQUIRE, "agent");
      xb_add(&bar[XB_XGEN(x)], 1u);
      asm volatile("s_waitcnt vmcnt(0)" ::: "memory");
    } else {
      while (xb_ld(&bar[XB_XGEN(x)]) == gen) __builtin_amdgcn_s_sleep(8);
      __builtin_amdgcn_fence(__ATOMIC_ACQUIRE, "agent");
      asm volatile("s_waitcnt vmcnt(0)" ::: "memory");
    }
  }
  __syncthreads();
}

__global__ void __launch_bounds__(256, 2) mk(Params p) {
  extern __shared__ __attribute__((aligned(16))) char smem[];
  p.ph_hi = __builtin_amdgcn_readfirstlane((int)__builtin_amdgcn_workitem_id_x() >> 6);
#if ONE_LAUNCH
  cg::grid_group grid = cg::this_grid();
  unsigned* bar = (unsigned*)(p.ws + OFF_BAR);
  __shared__ uint4 xbw;
  if (__builtin_amdgcn_workitem_id_x() == 0)
    (void)xb_add(&bar[XB_XCNT((unsigned)__builtin_amdgcn_s_getreg((3 << 11) | 20) & 0xFu)], 1u);
#ifdef PROBE_MASK
  long long tacc = 0, t0 = wall_clock64();
#define PTICK(n) { const long long t1 = wall_clock64(); if ((PROBE_MASK >> (n)) & 1) tacc += t1 - t0; t0 = t1; }
#else
#define PTICK(n)
#endif
  run_phase(p, 0, smem);
  grid.sync();
  if (__builtin_amdgcn_workitem_id_x() == 0) {
    const unsigned x = (unsigned)__builtin_amdgcn_s_getreg((3 << 11) | 20) & 0xFu;
    unsigned cnt = 0u, mine = 1u;
#pragma unroll
    for (unsigned j = 0; j < 16; ++j) { const unsigned c = xb_ld(&bar[XB_XCNT(j)]); cnt += c > 0u ? 1u : 0u; mine = j == x ? c : mine; }
    xbw = make_uint4(mine > 0u ? mine : 1u, cnt > 0u ? cnt : 1u, x, 0u);
  }
  __syncthreads();
  volatile unsigned* xst = (volatile unsigned*)&xbw;
  PTICK(0)
#define PH(n) run_phase(p, n, smem); grid_barrier(bar, xst); PTICK(n)
  PH(1) PH(2) PH(3) PH(4) PH(5) PH(6) PH(7) PH(8) PH(9) PH(10) PH(11)
  PH(12) PH(13) PH(14) PH(15) PH(16) PH(17) PH(18) PH(19) PH(20) PH(21) PH(22)
  run_phase(p, 23, smem);
  PTICK(23)
#ifdef PROBE_MASK
  if (blockIdx.x == 0 && __builtin_amdgcn_workitem_id_x() == 0) {
    const long long tend = wall_clock64() + tacc * 4;
    while (wall_clock64() < tend) __builtin_amdgcn_s_sleep(20);
  }
#endif
#else
  run_phase(p, p.ph_lo, smem);
#endif
}

extern "C" void kernel_launch(void* const* d_in, const int* in_sizes, int n_in, void* d_out,
                              int out_size, void* d_ws, size_t ws_size, hipStream_t stream) {
  static int grid_blocks = 0;
  if (!grid_blocks) {
    int dev = 0, cus = 0, per_cu = 0;
    (void)hipGetDevice(&dev);
    (void)hipDeviceGetAttribute(&cus, hipDeviceAttributeMultiprocessorCount, dev);
    (void)hipFuncSetAttribute((const void*)mk, hipFuncAttributeMaxDynamicSharedMemorySize, SMEM_BYTES);
    (void)hipOccupancyMaxActiveBlocksPerMultiprocessor(&per_cu, mk, 256, SMEM_BYTES);
    if (per_cu > 2) per_cu = 2;
    if (per_cu < 1) per_cu = 1;
    grid_blocks = cus * per_cu;
  }
  Params p{};
  const float** f = (const float**)&p;
  for (int i = 0; i < 19; i++) f[i] = (const float*)d_in[i];
  p.out = (float*)d_out;
  p.ws = (char*)d_ws;
#if ONE_LAUNCH
  p.ph_lo = 0; p.ph_hi = 24;
  (void)hipMemsetAsync((char*)d_ws + OFF_BAR, 0, 16384, stream);
  void* args[] = {&p};
  (void)hipLaunchCooperativeKernel((void*)mk, dim3(grid_blocks), dim3(256), args, SMEM_BYTES, stream);
#else
  for (int ph = 0; ph < 24; ph++) {
    p.ph_lo = ph; p.ph_hi = ph + 1;
    void* args[] = {&p};
    (void)hipLaunchCooperativeKernel((void*)mk, dim3(grid_blocks), dim3(256), args, SMEM_BYTES, stream);
  }
#endif
}
```

```cpp
#include <hip/hip_runtime.h>
#include <hip/hip_cooperative_groups.h>
#include <cstdio>
namespace cg = cooperative_groups;

#ifndef ONE_LAUNCH
#define ONE_LAUNCH 1
#endif
#ifndef ONLY_Q
#define ONLY_Q -1
#endif
#define QSEL(n) (ONLY_Q < 0 || ONLY_Q == (n))

typedef unsigned short u16;
using bf16x8 = __attribute__((ext_vector_type(8))) short;
using bf16x4 = __attribute__((ext_vector_type(4))) short;
using f32x4 = __attribute__((ext_vector_type(4))) float;
using u32x4 = __attribute__((ext_vector_type(4))) unsigned;
#define DI __device__ __forceinline__

constexpr int T_LAT = 16384, T_ALL = 16896, NCH = 264;
constexpr int WROWS = 18448;
constexpr int W_BR = 14352, W_OUT = 17424;
constexpr size_t al(size_t x) { return (x + 255) & ~(size_t)255; }
constexpr size_t SZ_WT = (size_t)WROWS * 1024 * 2;
constexpr size_t SZ_TOK1K = (size_t)T_ALL * 1024 * 2;
constexpr size_t OFF_WT = 0;
constexpr size_t OFF_H = OFF_WT + al(SZ_WT);
constexpr size_t OFF_MOD = OFF_H + al(SZ_TOK1K);
constexpr size_t OFF_ROT = OFF_MOD + al(2 * 3 * 3072 * 4);
constexpr size_t OFF_GB = OFF_ROT + al(128 * 32 * 2 * 4);
constexpr size_t OFF_CTX1 = OFF_GB + al((size_t)T_ALL * 16 * 4);
constexpr size_t OFF_HALO = OFF_CTX1 + al(512 * 1024 * 4);
constexpr size_t OFF_DNSC = OFF_HALO + al((size_t)NCH * 4 * 2048 * 2);
constexpr size_t OFF_HGDEC = OFF_DNSC + al((size_t)NCH * 4 * 2 * 192 * 4);
constexpr size_t OFF_BAR = OFF_HGDEC + al((size_t)NCH * 8 * 2 * 128 * 4);
constexpr size_t OFF_A = OFF_BAR + 16384;
constexpr size_t OFF_B = OFF_A + 4 * SZ_TOK1K;
constexpr size_t OFF_C = OFF_B + SZ_TOK1K;
constexpr size_t OFF_D = OFF_C + SZ_TOK1K;
constexpr size_t OFF_E = OFF_D + 2 * SZ_TOK1K;
constexpr size_t WS_TOTAL = OFF_E + 3 * SZ_TOK1K;
static_assert(WS_TOTAL <= 470286336ull, "workspace too large");

constexpr int SMEM_BYTES = 72960;

struct Params {
  const float *x, *c, *ctx, *c_ctx, *norm_w, *ada_w, *ada_b, *w_in, *dn_conv, *dn_a_log, *dn_dt_bias, *dn_norm_w,
      *ret_decay, *ret_norm_w, *hg_lb, *hg_norm_w, *w_branch, *w_out, *final_norm_w;
  float* out;
  char* ws;
  int ph_lo, ph_hi;
};

DI int laneid_v() { int t; asm volatile("v_mbcnt_lo_u32_b32 %0, -1, 0\n\tv_mbcnt_hi_u32_b32 %0, -1, %0" : "=v"(t)); return t; }
#define tidx() (WV * 64 + laneid_v())
typedef __bf16 hwbf2 __attribute__((ext_vector_type(2)));
DI u16 f2bf(float f) { __bf16 b = (__bf16)f; return __builtin_bit_cast(u16, b); }
DI float bf2f(u16 h) { return __uint_as_float(((unsigned)h) << 16); }
DI unsigned pack2(float a, float b) { hwbf2 v = {(__bf16)a, (__bf16)b}; return __builtin_bit_cast(unsigned, v); }
DI float sigm(float x) { return 1.f / (1.f + __expf(-x)); }
DI float silu(float x) { return x / (1.f + __expf(-x)); }
DI float dpp_f(float v, const int ctrl_sel) {
  const int iv = __float_as_int(v);
  int r;
  if (ctrl_sel == 0) r = __builtin_amdgcn_update_dpp(0, iv, 0xB1, 0xF, 0xF, false);
  else if (ctrl_sel == 1) r = __builtin_amdgcn_update_dpp(0, iv, 0x4E, 0xF, 0xF, false);
  else if (ctrl_sel == 2) r = __builtin_amdgcn_update_dpp(0, iv, 0x141, 0xF, 0xF, false);
  else r = __builtin_amdgcn_update_dpp(0, iv, 0x140, 0xF, 0xF, false);
  return __int_as_float(r);
}
DI float gsum(float v, const int n) {
  v += dpp_f(v, 0);
  v += dpp_f(v, 1);
  v += dpp_f(v, 2);
  if (n == 16) v += dpp_f(v, 3);
  return v;
}
DI float wsum(float v) {
  v = gsum(v, 16);
  v += __int_as_float(__builtin_amdgcn_update_dpp(0, __float_as_int(v), 0x142, 0xA, 0xF, false));
  v += __int_as_float(__builtin_amdgcn_update_dpp(0, __float_as_int(v), 0x143, 0xC, 0xF, false));
  return __int_as_float(__builtin_amdgcn_readlane(__float_as_int(v), 63));
}
DI f32x4 mfma16(bf16x8 a, bf16x8 b, f32x4 c) { return __builtin_amdgcn_mfma_f32_16x16x32_bf16(a, b, c, 0, 0, 0); }
DI bf16x8 pack8(f32x4 lo, f32x4 hi) {
  u32x4 r = {pack2(lo[0], lo[1]), pack2(lo[2], lo[3]), pack2(hi[0], hi[1]), pack2(hi[2], hi[3])};
  return __builtin_bit_cast(bf16x8, r);
}
typedef __attribute__((address_space(3))) bf16x4* lds_v4p;
DI bf16x8 ld_tr2(unsigned a_lo, unsigned a_hi) {
  const bf16x4 lo = __builtin_amdgcn_ds_read_tr16_b64_v4i16((lds_v4p)(size_t)a_lo);
  const bf16x4 hi = __builtin_amdgcn_ds_read_tr16_b64_v4i16((lds_v4p)(size_t)a_hi);
  bf16x8 r;
  r[0] = lo[0]; r[1] = lo[1]; r[2] = lo[2]; r[3] = lo[3]; r[4] = hi[0]; r[5] = hi[1]; r[6] = hi[2]; r[7] = hi[3];
  return r;
}
DI bf16x8 ld_perm(const char* rowp, int c0) {
  bf16x4 lo = *(const bf16x4*)(rowp + c0 * 2);
  bf16x4 hi = *(const bf16x4*)(rowp + c0 * 2 + 32);
  bf16x8 r;
  r[0] = lo[0]; r[1] = lo[1]; r[2] = lo[2]; r[3] = lo[3]; r[4] = hi[0]; r[5] = hi[1]; r[6] = hi[2]; r[7] = hi[3];
  return r;
}

DI int swz(int row, int ch) { return row * 128 + ((ch ^ (row & 7)) << 4); }

template <bool DEEP>
DI void gemm_kloop_t(const u16* __restrict__ A, const u16* __restrict__ W, f32x4 (&acc)[4][4], char* smem, const int WV) {
  const int tid = tidx(), lane = tid & 63, wid = tid >> 6, wn = wid >> 1, wt = wid & 1;
  const int fr = lane & 15, fq = lane >> 4;
  const int lrow = tid >> 3, lch = tid & 7;
  const u16* Ap = A + (size_t)lrow * 1024 + lch * 8;
  const u16* Wp = W + (size_t)lrow * 1024 + lch * 8;
  u32x4 ra0[4], rw0[4], ra1[4], rw1[4];
#define G_LOAD(RA, RW, KT) _Pragma("unroll") for (int i = 0; i < 4; i++) { \
    RA[i] = *(const u32x4*)(Ap + (size_t)i * 32 * 1024 + (KT) * 64); RW[i] = *(const u32x4*)(Wp + (size_t)i * 32 * 1024 + (KT) * 64); }
#define G_STORE(RA, RW, BUF) { char* dW = smem + (BUF) * 32768; _Pragma("unroll") for (int i = 0; i < 4; i++) { \
    *(u32x4*)(dW + swz(lrow + i * 32, lch)) = RW[i]; *(u32x4*)(dW + 16384 + swz(lrow + i * 32, lch)) = RA[i]; } }
#define G_COMPUTE(BUF) { const char* sW = smem + (BUF) * 32768; const char* sA = sW + 16384; \
    _Pragma("unroll") for (int ks = 0; ks < 2; ks++) { bf16x8 fw[4], fa[4]; \
      _Pragma("unroll") for (int i = 0; i < 4; i++) { \
        fw[i] = *(const bf16x8*)(sW + swz(wn * 64 + i * 16 + fr, ks * 4 + fq)); \
        fa[i] = *(const bf16x8*)(sA + swz(wt * 64 + i * 16 + fr, ks * 4 + fq)); } \
      _Pragma("unroll") for (int ni = 0; ni < 4; ni++) _Pragma("unroll") for (int ti = 0; ti < 4; ti++) \
        acc[ni][ti] = mfma16(fw[ni], fa[ti], acc[ni][ti]); } }
  G_LOAD(ra0, rw0, 0)
  G_STORE(ra0, rw0, 0)
  if (DEEP) { G_LOAD(ra1, rw1, 1) }
  __syncthreads();
  if (DEEP) {
    for (int kt = 0; kt < 16; kt += 2) {
      if (kt + 2 < 16) { G_LOAD(ra0, rw0, kt + 2) }
      G_COMPUTE(0)
      G_STORE(ra1, rw1, 1)
      __syncthreads();
      if (kt + 3 < 16) { G_LOAD(ra1, rw1, kt + 3) }
      G_COMPUTE(1)
      if (kt + 2 < 16) { G_STORE(ra0, rw0, 0) }
      __syncthreads();
    }
  } else {
    for (int kt = 0; kt < 16; kt++) {
      if (kt < 15) { G_LOAD(ra0, rw0, kt + 1) }
      G_COMPUTE(kt & 1)
      if (kt < 15) { G_STORE(ra0, rw0, (kt + 1) & 1) }
      __syncthreads();
    }
  }
#undef G_LOAD
#undef G_STORE
#undef G_COMPUTE
}
DI void gemm_kloop(const u16* __restrict__ A, const u16* __restrict__ W, f32x4 (&acc)[4][4], char* smem, const int WV,
                   const bool have0 = false, const u16* __restrict__ nA = nullptr, const u16* __restrict__ nW = nullptr) {
  const int tid = tidx(), lane = tid & 63, wid = tid >> 6, wn = wid >> 1, wt = wid & 1;
  const int fr = lane & 15, fq = lane >> 4;
  const int r8 = lane >> 3, chs = (lane & 7) ^ r8;
  const size_t loff = (size_t)(wid * 32 + r8) * 1024 + chs * 8;
  const u16* Asrc = A + loff;
  const u16* Wsrc = W + loff;
  char* ldsw = smem + wid * 4096;
#define G_STAGE_P(AS, WS, BUF, KT) _Pragma("unroll") for (int i = 0; i < 4; i++) { \
    __builtin_amdgcn_global_load_lds((const unsigned*)((WS) + (size_t)i * 8 * 1024 + (KT) * 64), (unsigned*)(ldsw + (BUF) * 32768 + i * 1024), 16, 0, 0); \
    __builtin_amdgcn_global_load_lds((const unsigned*)((AS) + (size_t)i * 8 * 1024 + (KT) * 64), (unsigned*)(ldsw + (BUF) * 32768 + 16384 + i * 1024), 16, 0, 0); }
#define G_COMPUTE(BUF) { const char* sW = smem + (BUF) * 32768; const char* sA = sW + 16384; \
    _Pragma("unroll") for (int ks = 0; ks < 2; ks++) { bf16x8 fw[4], fa[4]; \
      _Pragma("unroll") for (int i = 0; i < 4; i++) { \
        fw[i] = *(const bf16x8*)(sW + swz(wn * 64 + i * 16 + fr, ks * 4 + fq)); \
        fa[i] = *(const bf16x8*)(sA + swz(wt * 64 + i * 16 + fr, ks * 4 + fq)); } \
      _Pragma("unroll") for (int ni = 0; ni < 4; ni++) _Pragma("unroll") for (int ti = 0; ti < 4; ti++) \
        acc[ni][ti] = mfma16(fw[ni], fa[ti], acc[ni][ti]); } }
  if (!have0) {
    G_STAGE_P(Asrc, Wsrc, 0, 0)
    asm volatile("s_waitcnt vmcnt(0)" ::: "memory");
    __syncthreads();
  }
  for (int kt = 0; kt < 16; kt++) {
    if (kt < 15) { G_STAGE_P(Asrc, Wsrc, (kt + 1) & 1, kt + 1) }
    else if (nA != nullptr) { const u16* nAs = nA + loff; const u16* nWs = nW + loff; G_STAGE_P(nAs, nWs, 0, 0) }
    G_COMPUTE(kt & 1)
    asm volatile("s_waitcnt vmcnt(0)" ::: "memory");
    __syncthreads();
  }
#undef G_STAGE_P
#undef G_COMPUTE
}

DI void gemm_kloop256(const u16* __restrict__ A, const u16* __restrict__ W, f32x4 (&acc)[8][4], char* smem, const int WV,
                      const bool have0 = false, const u16* __restrict__ nA = nullptr, const u16* __restrict__ nW = nullptr) {
  const int tid = tidx(), lane = tid & 63, wid = tid >> 6, wn = wid >> 1, wt = wid & 1;
  const int fr = lane & 15, fq = lane >> 4;
  const int r16 = lane >> 2, chs = (lane & 3) ^ ((0 - (r16 >> 2)) & 3);
  const u16* Wsrc = W + (size_t)(wid * 64 + r16) * 1024 + chs * 8;
  const u16* Asrc = A + (size_t)(wid * 32 + r16) * 1024 + chs * 8;
  const int fpos = (fq ^ ((0 - (fr >> 2)) & 3)) << 4;
#define G_STAGE(BUF, KT) { _Pragma("unroll") for (int i = 0; i < 4; i++) \
      __builtin_amdgcn_global_load_lds((const unsigned*)(Wsrc + (size_t)i * 16 * 1024 + (KT) * 32), (unsigned*)(smem + (BUF) * 24576 + (wid * 4 + i) * 1024), 16, 0, 0); \
    _Pragma("unroll") for (int i = 0; i < 2; i++) \
      __builtin_amdgcn_global_load_lds((const unsigned*)(Asrc + (size_t)i * 16 * 1024 + (KT) * 32), (unsigned*)(smem + (BUF) * 24576 + 16384 + (wid * 2 + i) * 1024), 16, 0, 0); }
#define G_COMPUTE(BUF) { const char* sW = smem + (BUF) * 24576; const char* sA = sW + 16384; bf16x8 fw[8], fa[4]; \
    _Pragma("unroll") for (int i = 0; i < 8; i++) fw[i] = *(const bf16x8*)(sW + (wn * 128 + i * 16 + fr) * 64 + fpos); \
    _Pragma("unroll") for (int i = 0; i < 4; i++) fa[i] = *(const bf16x8*)(sA + (wt * 64 + i * 16 + fr) * 64 + fpos); \
    __builtin_amdgcn_s_setprio(1); \
    _Pragma("unroll") for (int ni = 0; ni < 8; ni++) _Pragma("unroll") for (int ti = 0; ti < 4; ti++) \
      acc[ni][ti] = mfma16(fw[ni], fa[ti], acc[ni][ti]); \
    __builtin_amdgcn_s_setprio(0); }
  if (!have0) { G_STAGE(0, 0) }
  asm volatile("s_waitcnt vmcnt(0)" ::: "memory");
  __syncthreads();
  for (int kt = 0; kt < 31; kt++) {
    G_STAGE((kt + 1) & 1, kt + 1)
    G_COMPUTE(kt & 1)
    asm volatile("s_waitcnt vmcnt(0)" ::: "memory");
    __syncthreads();
  }
  if (nA != nullptr) {
    const u16* Wn = nW + (size_t)(wid * 64 + r16) * 1024 + chs * 8;
    const u16* An = nA + (size_t)(wid * 32 + r16) * 1024 + chs * 8;
#pragma unroll
    for (int i = 0; i < 4; i++)
      __builtin_amdgcn_global_load_lds((const unsigned*)(Wn + (size_t)i * 16 * 1024), (unsigned*)(smem + (wid * 4 + i) * 1024), 16, 0, 0);
#pragma unroll
    for (int i = 0; i < 2; i++)
      __builtin_amdgcn_global_load_lds((const unsigned*)(An + (size_t)i * 16 * 1024), (unsigned*)(smem + 16384 + (wid * 2 + i) * 1024), 16, 0, 0);
  }
  G_COMPUTE(1)
  asm volatile("s_waitcnt lgkmcnt(0)\n\ts_barrier" ::: "memory");
#undef G_STAGE
#undef G_COMPUTE
}

enum { EPI_HG = 0, EPI_DNRET = 1, EPI_GATE = 2, EPI_OUT = 3 };

template <int EPI, int NI>
DI const u16* gemm_wptr(const Params& p, int nti) {
  constexpr int NW = NI * 32;
  const u16* WT = (const u16*)(p.ws + OFF_WT);
  int wrow;
  if (EPI == EPI_HG) wrow = 6160 + nti * NW;
  else if (EPI == EPI_DNRET) { const int mx = nti / (2048 / NW); wrow = (mx ? 3088 : 0) + (nti % (2048 / NW)) * NW; }
  else if (EPI == EPI_GATE) { const int mx = nti / (1024 / NW); wrow = (mx == 0 ? 2048 : (mx == 1 ? 5136 : 10256)) + (nti % (1024 / NW)) * NW; }
  else wrow = W_OUT + nti * NW;
  return WT + (size_t)wrow * 1024;
}
template <int EPI, int NI>
DI void gemm_tile(const Params& p, int l, int rt, int nti, char* smem, const bool have0 = false, const int nrt = -1, const int nnti = -1) {
  const int WV = p.ph_hi;
  const int tid = tidx(), lane = tid & 63, wid = tid >> 6, wn = wid >> 1, wt = wid & 1;
  const int fr = lane & 15, fq = lane >> 4;
  const int row0 = rt * 128;
  constexpr int NW = NI * 32;
  const u16* WT = (const u16*)(p.ws + OFF_WT);
  const u16* A;
  int wrow, n0, mixer = 0;
  if (EPI == EPI_HG) { A = (const u16*)(p.ws + OFF_H); n0 = nti * NW; wrow = 6160 + n0; }
  else if (EPI == EPI_DNRET) { A = (const u16*)(p.ws + OFF_H); mixer = nti / (2048 / NW); n0 = (nti % (2048 / NW)) * NW; wrow = (mixer ? 3088 : 0) + n0; }
  else if (EPI == EPI_GATE) { A = (const u16*)(p.ws + OFF_H); mixer = nti / (1024 / NW); n0 = (nti % (1024 / NW)) * NW; wrow = (mixer == 0 ? 2048 : (mixer == 1 ? 5136 : 10256)) + n0; }
  else { A = (const u16*)(p.ws + OFF_B); n0 = nti * NW; wrow = W_OUT + n0; }
  f32x4 acc[NI][4];
#pragma unroll
  for (int i = 0; i < NI; i++)
#pragma unroll
    for (int j = 0; j < 4; j++) acc[i][j] = f32x4{0.f, 0.f, 0.f, 0.f};
  if constexpr (NI == 4) gemm_kloop(A + (size_t)row0 * 1024, WT + (size_t)wrow * 1024, acc, smem, WV);
  else gemm_kloop256(A + (size_t)row0 * 1024, WT + (size_t)wrow * 1024, acc, smem, WV, have0,
                     nrt >= 0 ? A + (size_t)nrt * 128 * 1024 : nullptr, nrt >= 0 ? gemm_wptr<EPI, NI>(p, nnti) : nullptr);

  const float* ROT = (const float*)(p.ws + OFF_ROT);
  const float* MOD = (const float*)(p.ws + OFF_MOD);
#pragma unroll
  for (int ti = 0; ti < 4; ti++) {
    const int token = row0 + wt * 64 + ti * 16 + fr;
#pragma unroll
    for (int ni = 0; ni < NI; ni++) {
      const int nl = n0 + wn * (NI * 16) + ni * 16 + fq * 4;
      f32x4 v = acc[ni][ti];
      if (EPI == EPI_HG) {
        if (nl < 1024) { v[0] = silu(v[0]); v[1] = silu(v[1]); v[2] = silu(v[2]); v[3] = silu(v[3]); }
        u16* dst = (u16*)(p.ws + OFF_A) + (size_t)token * 4096 + nl;
        *(uint2*)dst = uint2{pack2(v[0], v[1]), pack2(v[2], v[3])};
      } else if (EPI == EPI_DNRET) {
        if (mixer == 0) {
          uint2 pk = uint2{pack2(v[0], v[1]), pack2(v[2], v[3])};
          u16* dst = (u16*)(p.ws + OFF_A) + (size_t)token * 2048 + nl;
          *(uint2*)dst = pk;
          const int tm = token & 63;
          if (tm < 2 || tm >= 62) {
            const int slot = tm < 2 ? tm : tm - 60;
            u16* hd = (u16*)(p.ws + OFF_HALO) + ((size_t)(token >> 6) * 4 + slot) * 2048 + nl;
            *(uint2*)hd = pk;
          }
        } else {
          if (nl < 1024) {
            if (token < T_LAT) {
              const int t = token & 8191, ri = t >> 6, ci = t & 63;
              const int d = nl & 127;
#pragma unroll
              for (int pp = 0; pp < 2; pp++) {
                const int pidx = (d >> 1) + pp;
                const float* rp = pidx < 32 ? ROT + (ri * 32 + pidx) * 2 : ROT + (ci * 32 + (pidx - 32)) * 2;
                const float cs = rp[0], sn = rp[1];
                const float x1 = v[2 * pp], x2 = v[2 * pp + 1];
                v[2 * pp] = x1 * cs - x2 * sn;
                v[2 * pp + 1] = x1 * sn + x2 * cs;
              }
            }
            if (nl >= 512) { const float s = 0.08838834764831845f; v[0] *= s; v[1] *= s; v[2] *= s; v[3] *= s; }
          }
          u16* dst = (u16*)(p.ws + OFF_A + 2 * SZ_TOK1K) + (size_t)token * 2048 + nl;
          *(uint2*)dst = uint2{pack2(v[0], v[1]), pack2(v[2], v[3])};
        }
      } else if (EPI == EPI_GATE) {
        char* base = mixer == 0 ? p.ws + OFF_E : (mixer == 1 ? p.ws + OFF_E + SZ_TOK1K : p.ws + OFF_D);
        u16* dst = (u16*)base + (size_t)token * 1024 + nl;
        uint2 on = *(const uint2*)dst;
        float o0 = bf2f((u16)(on.x & 0xffff)), o1 = bf2f((u16)(on.x >> 16)), o2 = bf2f((u16)(on.y & 0xffff)), o3 = bf2f((u16)(on.y >> 16));
        *(uint2*)dst = uint2{pack2(o0 * silu(v[0]), o1 * silu(v[1])), pack2(o2 * silu(v[2]), o3 * silu(v[3]))};
      } else {
        const int vec = token < T_LAT ? (token >> 13) : 2;
        const f32x4 gt = *(const f32x4*)(MOD + ((size_t)l * 3 + vec) * 3072 + 2048 + nl);
        const float* src;
        float* dst;
        if (token < T_LAT) {
          src = (l == 0 ? p.x : (const float*)p.out) + (size_t)token * 1024 + nl;
          dst = p.out + (size_t)token * 1024 + nl;
        } else {
          src = p.ctx + (size_t)(token - T_LAT) * 1024 + nl;
          dst = (float*)(p.ws + OFF_CTX1) + (size_t)(token - T_LAT) * 1024 + nl;
        }
        f32x4 xi = *(const f32x4*)src;
        f32x4 r;
        r[0] = xi[0] + gt[0] * v[0]; r[1] = xi[1] + gt[1] * v[1]; r[2] = xi[2] + gt[2] * v[2]; r[3] = xi[3] + gt[3] * v[3];
        *(f32x4*)dst = r;
      }
    }
  }
}

DI void merge_tile(const Params& p, int rt, int nti, char* smem, const bool have0 = false, const int nrt = -1, const int nnti = -1) {
  const int WV = p.ph_hi;
  const int tid = tidx(), lane = tid & 63, wid = tid >> 6, wn = wid >> 1, wt = wid & 1;
  const int fr = lane & 15, fq = lane >> 4;
  const int row0 = rt * 128, n0 = nti * 128;
  const u16* WT = (const u16*)(p.ws + OFF_WT);
  const u16* H = (const u16*)(p.ws + OFF_H) + (size_t)row0 * 1024;
  uint2 y[4][4];
#pragma unroll
  for (int i = 0; i < 4; i++)
#pragma unroll
    for (int j = 0; j < 4; j++) y[i][j] = uint2{0u, 0u};
  for (int m = 0; m < 3; m++) {
    uint2 sg[4][4];
    {
      f32x4 acc[4][4];
#pragma unroll
      for (int i = 0; i < 4; i++)
#pragma unroll
        for (int j = 0; j < 4; j++) acc[i][j] = f32x4{0.f, 0.f, 0.f, 0.f};
      const char* baseb = m == 0 ? p.ws + OFF_E : (m == 1 ? p.ws + OFF_E + SZ_TOK1K : p.ws + OFF_D);
      gemm_kloop(H, WT + (size_t)(11280 + m * 1024 + n0) * 1024, acc, smem, WV, have0 || m > 0,
                 (const u16*)baseb + (size_t)row0 * 1024, WT + (size_t)(W_BR + m * 1024 + n0) * 1024);
#pragma unroll
      for (int i = 0; i < 4; i++)
#pragma unroll
        for (int j = 0; j < 4; j++)
          sg[i][j] = uint2{pack2(sigm(acc[i][j][0]), sigm(acc[i][j][1])), pack2(sigm(acc[i][j][2]), sigm(acc[i][j][3]))};
    }
    {
      const char* base = m == 0 ? p.ws + OFF_E : (m == 1 ? p.ws + OFF_E + SZ_TOK1K : p.ws + OFF_D);
      f32x4 acc[4][4];
#pragma unroll
      for (int i = 0; i < 4; i++)
#pragma unroll
        for (int j = 0; j < 4; j++) acc[i][j] = f32x4{0.f, 0.f, 0.f, 0.f};
      const u16* nA = m < 2 ? H : (nrt >= 0 ? (const u16*)(p.ws + OFF_H) + (size_t)nrt * 128 * 1024 : nullptr);
      const u16* nW = m < 2 ? WT + (size_t)(11280 + (m + 1) * 1024 + n0) * 1024 : (nrt >= 0 ? WT + (size_t)(11280 + nnti * 128) * 1024 : nullptr);
      gemm_kloop((const u16*)base + (size_t)row0 * 1024, WT + (size_t)(W_BR + m * 1024 + n0) * 1024, acc, smem, WV, true, nA, nW);
#pragma unroll
      for (int i = 0; i < 4; i++)
#pragma unroll
        for (int j = 0; j < 4; j++) {
          const float y0 = bf2f((u16)(y[i][j].x & 0xffff)) + acc[i][j][0] * bf2f((u16)(sg[i][j].x & 0xffff));
          const float y1 = bf2f((u16)(y[i][j].x >> 16)) + acc[i][j][1] * bf2f((u16)(sg[i][j].x >> 16));
          const float y2 = bf2f((u16)(y[i][j].y & 0xffff)) + acc[i][j][2] * bf2f((u16)(sg[i][j].y & 0xffff));
          const float y3 = bf2f((u16)(y[i][j].y >> 16)) + acc[i][j][3] * bf2f((u16)(sg[i][j].y >> 16));
          y[i][j] = uint2{pack2(y0, y1), pack2(y2, y3)};
        }
    }
  }
  u16* Y = (u16*)(p.ws + OFF_B);
#pragma unroll
  for (int ti = 0; ti < 4; ti++) {
    const int token = row0 + wt * 64 + ti * 16 + fr;
#pragma unroll
    for (int ni = 0; ni < 4; ni++) {
      const int nl = n0 + wn * 64 + ni * 16 + fq * 4;
      *(uint2*)(Y + (size_t)token * 1024 + nl) = y[ni][ti];
    }
  }
}

DI void wconv_tile(const float* __restrict__ src, int N, int kt, int ntile, u16* __restrict__ dst, char* smem, const int WV) {
  float* s = (float*)smem;
  const int tid = tidx();
  const int k0 = kt * 64, n0 = ntile * 64;
#pragma unroll
  for (int i = 0; i < 4; i++) {
    const int r = (tid >> 4) + i * 16, c4 = (tid & 15) * 4;
    if (n0 + c4 < N) {
      f32x4 v = *(const f32x4*)(src + (size_t)(k0 + r) * N + n0 + c4);
      s[r * 65 + c4] = v[0]; s[r * 65 + c4 + 1] = v[1]; s[r * 65 + c4 + 2] = v[2]; s[r * 65 + c4 + 3] = v[3];
    }
  }
  __syncthreads();
#pragma unroll
  for (int i = 0; i < 2; i++) {
    const int id = tid + i * 256, n = id >> 3, kc = (id & 7) * 8;
    if (n0 + n < N) {
      uint4 o;
      o.x = pack2(s[(kc + 0) * 65 + n], s[(kc + 1) * 65 + n]);
      o.y = pack2(s[(kc + 2) * 65 + n], s[(kc + 3) * 65 + n]);
      o.z = pack2(s[(kc + 4) * 65 + n], s[(kc + 5) * 65 + n]);
      o.w = pack2(s[(kc + 6) * 65 + n], s[(kc + 7) * 65 + n]);
      *(uint4*)(dst + (size_t)(n0 + n) * 1024 + k0 + kc) = o;
    }
  }
  __syncthreads();
}
constexpr int WCONV_UNITS = 16 * 225 + 3 * 256 + 256;
DI void wconv_unit(const Params& p, int l, int u, char* smem) {
  const int WV = p.ph_hi;
  u16* WT = (u16*)(p.ws + OFF_WT);
  if (u < 16 * 225) wconv_tile(p.w_in + (size_t)l * 1024 * 14352, 14352, u / 225, u % 225, WT, smem, WV);
  else if (u < 16 * 225 + 768) {
    const int v = u - 16 * 225, m = v >> 8, r = v & 255;
    wconv_tile(p.w_branch + ((size_t)l * 3 + m) * 1024 * 1024, 1024, r >> 4, r & 15, WT + (size_t)(W_BR + m * 1024) * 1024, smem, WV);
  } else {
    const int r = u - 16 * 225 - 768;
    wconv_tile(p.w_out + (size_t)l * 1024 * 1024, 1024, r >> 4, r & 15, WT + (size_t)W_OUT * 1024, smem, WV);
  }
}

DI void adaln_unit(const Params& p, int u, char* smem) {
  const int WV = p.ph_hi;
  const int l = u / 48, ng = u % 48;
  const int tid = tidx(), lane = tid & 63, w = tid >> 6;
  const int n = ng * 64 + lane;
  const float* W = p.ada_w + (size_t)l * 1024 * 3072;
  float* ssc = (float*)smem + 1024;
  for (int i = tid; i < 3072; i += 256) {
    const float cv = i < 2048 ? p.c[i] : p.c_ctx[i - 2048];
    ssc[i] = silu(cv);
  }
  __syncthreads();
  float a0 = 0.f, a1 = 0.f, a2 = 0.f;
#pragma unroll 8
  for (int k = w * 256; k < w * 256 + 256; k++) {
    const float wv = W[(size_t)k * 3072 + n];
    a0 += ssc[k] * wv; a1 += ssc[1024 + k] * wv; a2 += ssc[2048 + k] * wv;
  }
  float* red = (float*)smem;
  red[(w * 3 + 0) * 64 + lane] = a0; red[(w * 3 + 1) * 64 + lane] = a1; red[(w * 3 + 2) * 64 + lane] = a2;
  __syncthreads();
  if (tid < 192) {
    const int vec = tid >> 6, ln = tid & 63;
    float s = red[(0 * 3 + vec) * 64 + ln] + red[(1 * 3 + vec) * 64 + ln] + red[(2 * 3 + vec) * 64 + ln] + red[(3 * 3 + vec) * 64 + ln];
    const int nn = ng * 64 + ln;
    ((float*)(p.ws + OFF_MOD))[((size_t)l * 3 + vec) * 3072 + nn] = s + p.ada_b[(size_t)l * 3072 + nn];
  }
  __syncthreads();
}

DI void phase_pro(const Params& p, char* smem) {
  const int WV = p.ph_hi;
  const int total = 96 + 16 + WCONV_UNITS;
  for (int u = blockIdx.x; u < total; u += gridDim.x) {
    if (u < 96) adaln_unit(p, u, smem);
    else if (u < 112) {
      const int id = (u - 96) * 256 + tidx();
      const int pos = id >> 5, m = id & 31;
      const float inv = powf(10000.f, -(float)(2 * m) / 64.f);
      float s, c;
      sincosf((float)pos * inv, &s, &c);
      float* ROT = (float*)(p.ws + OFF_ROT);
      ROT[id * 2] = c; ROT[id * 2 + 1] = s;
    } else wconv_unit(p, 0, u - 112, smem);
  }
}

DI void phase_norm(const Params& p, int l, char* smem) {
  const int WV = p.ph_hi;
  const int tid = tidx(), lane = tid & 63, w = tid >> 6;
  float* sW = (float*)smem;
  const float* win = p.w_in + (size_t)l * 1024 * 14352;
  for (int i = tid; i < 16 * 1024; i += 256) {
    const int k = i >> 4, cc = i & 15;
    sW[cc * 1024 + k] = win[(size_t)k * 14352 + 3072 + cc];
  }
  __syncthreads();
  const float* MOD = (const float*)(p.ws + OFF_MOD);
  const float* nw = p.norm_w + (size_t)l * 1024;
  u16* H = (u16*)(p.ws + OFF_H);
  float* GB = (float*)(p.ws + OFF_GB);
  for (int row = blockIdx.x * 4 + w; row < T_ALL; row += gridDim.x * 4) {
    const float* xr;
    int vec;
    if (row < T_LAT) { xr = (l == 0 ? p.x : (const float*)p.out) + (size_t)row * 1024; vec = row >> 13; }
    else { xr = (l == 0 ? p.ctx : (const float*)(p.ws + OFF_CTX1)) + (size_t)(row - T_LAT) * 1024; vec = 2; }
    const float* md = MOD + ((size_t)l * 3 + vec) * 3072;
    f32x4 xv[4];
    float ss = 0.f;
#pragma unroll
    for (int i = 0; i < 4; i++) {
      xv[i] = *(const f32x4*)(xr + i * 256 + lane * 4);
      ss += xv[i][0] * xv[i][0] + xv[i][1] * xv[i][1] + xv[i][2] * xv[i][2] + xv[i][3] * xv[i][3];
    }
    ss = wsum(ss);
    const float rstd = rsqrtf(ss * (1.f / 1024.f) + 1e-6f);
    float ab[16];
#pragma unroll
    for (int cc = 0; cc < 16; cc++) ab[cc] = 0.f;
#pragma unroll
    for (int i = 0; i < 4; i++) {
      const int k = i * 256 + lane * 4;
      const f32x4 wv = *(const f32x4*)(nw + k);
      const f32x4 sh = *(const f32x4*)(md + k);
      const f32x4 sc = *(const f32x4*)(md + 1024 + k);
      f32x4 h;
#pragma unroll
      for (int j = 0; j < 4; j++) h[j] = xv[i][j] * rstd * wv[j] * (1.f + sc[j]) + sh[j];
      *(uint2*)(H + (size_t)row * 1024 + k) = uint2{pack2(h[0], h[1]), pack2(h[2], h[3])};
      asm volatile("" ::: "memory");
#pragma unroll
      for (int cc = 0; cc < 16; cc++) {
        const f32x4 ww = *(const f32x4*)(sW + cc * 1024 + k);
        ab[cc] += h[0] * ww[0] + h[1] * ww[1] + h[2] * ww[2] + h[3] * ww[3];
      }
    }
#pragma unroll
    for (int cc = 0; cc < 16; cc++) ab[cc] = wsum(ab[cc]);
    if (lane < 16) {
      float v = 0.f;
#pragma unroll
      for (int cc = 0; cc < 16; cc++) if (lane == cc) v = ab[cc];
      float r;
      if (lane < 8) {
        const float A = __expf(p.dn_a_log[l * 8 + lane]);
        const float z = v + p.dn_dt_bias[l * 8 + lane];
        const float sp = z > 20.f ? z : log1pf(__expf(z));
        r = -A * sp;
      } else r = sigm(v);
      GB[(size_t)row * 16 + lane] = r;
    }
  }
  __syncthreads();
}

DI void xyT(const char* sX, const char* sY, int it, f32x4 (&acc)[4], const int WV) {
  const int lane = tidx() & 63, fr = lane & 15, fq = lane >> 4;
#pragma unroll
  for (int j = 0; j < 4; j++) acc[j] = f32x4{0.f, 0.f, 0.f, 0.f};
#pragma unroll
  for (int ks = 0; ks < 4; ks++) {
    const bf16x8 a = *(const bf16x8*)(sX + (it * 16 + fr) * 272 + (ks * 32 + fq * 8) * 2);
#pragma unroll
    for (int jt = 0; jt < 4; jt++) {
      const bf16x8 b = *(const bf16x8*)(sY + (jt * 16 + fr) * 272 + (ks * 32 + fq * 8) * 2);
      acc[jt] = mfma16(a, b, acc[jt]);
    }
  }
}

DI void dn_prep_unit(const Params& p, int l, int c, int h, char* smem) {
  const int WV = p.ph_hi;
  const int tid = tidx(), lane = tid & 63, w = tid >> 6;
  u16* QKV = (u16*)(p.ws + OFF_A);
  const u16* HALO = (const u16*)(p.ws + OFF_HALO);
  char* sQ = smem;
  char* sK = smem + 17408;
  float* sKK = (float*)(smem + 34816);
  float* sQK = (float*)(smem + 34816 + 16384);
  float* sGC = (float*)(smem + 34816 + 32768);
  float* sBT = sGC + 128;
  const int row0 = c * 64;
  {
    const int u = tid * 2;
    const int gcol = u < 128 ? h * 128 + u : (u < 256 ? 512 + h * 128 + (u - 128) : 1024 + h * 256 + (u - 256));
    bool first, last;
    if (c < 256) { first = (c & 127) == 0; last = (c & 127) == 127; }
    else { first = ((c - 256) & 3) == 0; last = ((c - 256) & 3) == 3; }
    const float* cw = p.dn_conv + (size_t)l * 5 * 2048 + gcol;
    float cw0[5], cw1[5];
#pragma unroll
    for (int j = 0; j < 5; j++) { cw0[j] = cw[j * 2048]; cw1[j] = cw[j * 2048 + 1]; }
    const u16* own = QKV + (size_t)row0 * 2048 + gcol;
    const u16* hl = first ? own : HALO + ((size_t)(c - 1) * 4 + 2) * 2048 + gcol;
    const u16* hr = last ? own : HALO + ((size_t)(c + 1) * 4) * 2048 + gcol;
    unsigned cat[12], nxt[8], nx2[8];
    {
      const unsigned a = *(const unsigned*)hl, b = *(const unsigned*)(hl + 2048);
      cat[0] = first ? 0u : a; cat[1] = first ? 0u : b;
      cat[2] = *(const unsigned*)own; cat[3] = *(const unsigned*)(own + 2048);
    }
#pragma unroll
    for (int i = 0; i < 8; i++) nxt[i] = *(const unsigned*)(own + (size_t)(2 + i) * 2048);
#pragma unroll
    for (int i = 0; i < 8; i++) nx2[i] = *(const unsigned*)(own + (size_t)(10 + i) * 2048);
    for (int tb = 0; tb < 8; tb++) {
#pragma unroll
      for (int i = 0; i < 8; i++) { cat[4 + i] = nxt[i]; nxt[i] = nx2[i]; }
      if (tb < 6) {
        const bool lastb = tb == 5;
#pragma unroll
        for (int i = 0; i < 8; i++) {
          const u16* pp = (lastb && i >= 6) ? hr + (size_t)(i - 6) * 2048 : own + (size_t)(2 + (tb + 2) * 8 + i) * 2048;
          const unsigned v = *(const unsigned*)pp;
          nx2[i] = (lastb && i >= 6 && last) ? 0u : v;
        }
      }
#pragma unroll
      for (int i = 0; i < 8; i++) {
        const int t = tb * 8 + i;
        float y0 = 0.f, y1 = 0.f;
#pragma unroll
        for (int j = 0; j < 5; j++) {
          y0 += cw0[j] * bf2f((u16)(cat[i + j] & 0xffff));
          y1 += cw1[j] * bf2f((u16)(cat[i + j] >> 16));
        }
        y0 = silu(y0); y1 = silu(y1);
        if (w < 2) {
          const float ss = wsum(y0 * y0 + y1 * y1);
          float rs = rsqrtf(ss + 1e-6f);
          if (w == 0) rs *= 0.08838834764831845f;
          y0 *= rs; y1 *= rs;
          const unsigned pk = pack2(y0, y1);
          *(unsigned*)((w == 0 ? sQ : sK) + t * 272 + (u & 127) * 2) = pk;
          *(unsigned*)(QKV + (size_t)(row0 + t) * 2048 + gcol) = pk;
        } else {
          *(unsigned*)(QKV + (size_t)(row0 + t) * 2048 + gcol) = pack2(y0, y1);
        }
      }
#pragma unroll
      for (int i = 0; i < 4; i++) cat[i] = cat[8 + i];
    }
  }
  if (w < 2) {
    const float* GB = (const float*)(p.ws + OFF_GB);
    const float g = GB[(size_t)(row0 + lane) * 16 + w * 4 + h];
    const float bt = GB[(size_t)(row0 + lane) * 16 + 8 + w * 4 + h];
    float s = g;
    if (w == 0) {
#pragma unroll
      for (int o = 1; o < 64; o <<= 1) { const float t = __shfl_up(s, o, 64); if (lane >= o) s += t; }
    } else {
#pragma unroll
      for (int o = 1; o < 64; o <<= 1) { const float t = __shfl_down(s, o, 64); if (lane + o < 64) s += t; }
    }
    const float gl = __shfl(s, w == 0 ? 63 : 0, 64);
    sGC[w * 64 + lane] = s;
    sBT[w * 64 + lane] = bt;
    float* SC = (float*)(p.ws + OFF_DNSC) + ((size_t)(c * 4 + h) * 2 + w) * 192;
    SC[lane] = __expf(s);
    SC[64 + lane] = __expf(gl - s);
    if (lane == 0) SC[128] = __expf(gl);
  }
  __syncthreads();
  {
    const int fr = lane & 15, fq = lane >> 4;
    f32x4 acc[4];
    xyT(sK, sK, w, acc, WV);
#pragma unroll
    for (int jt = 0; jt < 4; jt++)
#pragma unroll
      for (int j = 0; j < 4; j++) sKK[(w * 16 + fq * 4 + j) * 64 + jt * 16 + fr] = acc[jt][j];
    xyT(sQ, sK, w, acc, WV);
#pragma unroll
    for (int jt = 0; jt < 4; jt++)
#pragma unroll
      for (int j = 0; j < 4; j++) sQK[(w * 16 + fq * 4 + j) * 64 + jt * 16 + fr] = acc[jt][j];
  }
  __syncthreads();
  u16* AUX = (u16*)(p.ws + OFF_B) + (size_t)(c * 4 + h) * 4 * 4096;
#pragma unroll 2
  for (int e = 0; e < 32; e++) {
    const int id = tid + e * 256, dir = id >> 12, i = (id >> 6) & 63, j = id & 63;
    const bool valid = dir == 0 ? (j <= i) : (j >= i);
    float v = 0.f;
    if (valid) v = sQK[i * 64 + j] * __expf(sGC[dir * 64 + i] - sGC[dir * 64 + j]);
    AUX[(size_t)(dir * 2 + 1) * 4096 + i * 64 + j] = f2bf(v);
  }
  __syncthreads();
  float* sL0 = sQK;
  float* sL1 = (float*)smem;
#pragma unroll 2
  for (int e = 0; e < 32; e++) {
    const int id = tid + e * 256, dir = id >> 12, ip = (id >> 6) & 63, jp = id & 63;
    const int i = dir ? 63 - ip : ip, j = dir ? 63 - jp : jp;
    float v = 0.f;
    if (jp < ip) v = sBT[dir * 64 + i] * sKK[i * 64 + j] * __expf(sGC[dir * 64 + i] - sGC[dir * 64 + j]);
    (dir ? sL1 : sL0)[ip * 64 + jp] = v;
  }
  __syncthreads();
  if (w < 2) {
    const float* L = w ? sL1 : sL0;
    const int cn = w ? 63 - lane : lane;
    const float bc = sBT[w * 64 + cn];
    f32x4 Lb[2][16];
    float T[64];
#pragma unroll
    for (int i = 0; i < 64; i++) {
      if (i + 1 < 64) {
#pragma unroll
        for (int b4 = 0; b4 < (i + 1 + 3) / 4; b4++) Lb[(i + 1) & 1][b4] = *(const f32x4*)(L + (i + 1) * 64 + 4 * b4);
      }
      asm volatile("" ::: "memory");
      float a0 = (i == lane) ? 1.f : 0.f, a1 = 0.f, a2 = 0.f, a3 = 0.f;
#pragma unroll
      for (int r = 0; r < i; r++) {
        const float lv = Lb[i & 1][r >> 2][r & 3];
        if ((r & 3) == 0) a0 -= lv * T[r];
        else if ((r & 3) == 1) a1 -= lv * T[r];
        else if ((r & 3) == 2) a2 -= lv * T[r];
        else a3 -= lv * T[r];
      }
      T[i] = (a0 + a1) + (a2 + a3);
    }
#pragma unroll
    for (int ip = 0; ip < 64; ip++) {
      const int i = w ? 63 - ip : ip;
      AUX[(size_t)(w * 2 + 0) * 4096 + i * 64 + cn] = f2bf(T[ip] * bc);
    }
  }
  __syncthreads();
}

DI void ret_prep_unit(const Params& p, int l, int c, int h, char* smem) {
  const int WV = p.ph_hi;
  const int tid = tidx(), lane = tid & 63, w = tid >> 6;
  const u16* QKV = (const u16*)(p.ws + OFF_A + 2 * SZ_TOK1K);
  char* sQ = smem;
  char* sK = smem + 17408;
  const int row0 = c * 64;
#pragma unroll
  for (int i = 0; i < 4; i++) {
    const int id = tid + i * 256, r = id >> 4, ch = id & 15;
    *(uint4*)(sQ + r * 272 + ch * 16) = *(const uint4*)(QKV + (size_t)(row0 + r) * 2048 + h * 128 + ch * 8);
    *(uint4*)(sK + r * 272 + ch * 16) = *(const uint4*)(QKV + (size_t)(row0 + r) * 2048 + 512 + h * 128 + ch * 8);
  }
  __syncthreads();
  f32x4 acc[4];
  xyT(sQ, sK, w, acc, WV);
  const int fr = lane & 15, fq = lane >> 4;
  u16* AUX = (u16*)(p.ws + OFF_C) + (size_t)(c * 4 + h) * 2 * 4096;
#pragma unroll
  for (int dir = 0; dir < 2; dir++) {
    const float rd = p.ret_decay[l * 8 + dir * 4 + h];
    const float lam = fminf(rd, 0.f) - log1pf(__expf(-fabsf(rd)));
#pragma unroll
    for (int jt = 0; jt < 4; jt++)
#pragma unroll
      for (int j = 0; j < 4; j++) {
        const int i = w * 16 + fq * 4 + j, jj = jt * 16 + fr;
        const int dd = dir == 0 ? i - jj : jj - i;
        const float v = dd >= 0 ? acc[jt][j] * __expf(lam * (float)dd) : 0.f;
        AUX[(size_t)dir * 4096 + i * 64 + jj] = f2bf(v);
      }
  }
  __syncthreads();
}

DI void hg_prep_unit(const Params& p, int l, int c, int h, char* smem) {
  const int WV = p.ph_hi;
  const int tid = tidx();
  u16* QFI = (u16*)(p.ws + OFF_A);
  u16* HGX = (u16*)(p.ws + OFF_B);
  float* sG = (float*)smem;
  u16* sQ = (u16*)(smem + 33280);
  u16* sK = (u16*)(smem + 50176);
  float* sTot = (float*)(smem + 67072);
  const int row0 = c * 64;
#pragma unroll
  for (int i = 0; i < 4; i++) {
    const int id = tid + i * 256, r = id >> 4, ch = id & 15;
    const uint4 v = *(const uint4*)(QFI + (size_t)(row0 + r) * 4096 + h * 128 + ch * 8);
    const unsigned vv[4] = {v.x, v.y, v.z, v.w};
#pragma unroll
    for (int e = 0; e < 4; e++) {
      sQ[(ch * 8 + e * 2) * 66 + r] = (u16)(vv[e] & 0xffff);
      sQ[(ch * 8 + e * 2 + 1) * 66 + r] = (u16)(vv[e] >> 16);
    }
  }
  __syncthreads();
  const int half = tid >> 7, d = tid & 127;
#pragma unroll 1
  for (int dir = 1; dir >= 0; dir--) {
    float lo = 0.f;
    if (l == 1) {
      const float b0 = p.hg_lb[dir * 1024 + h * 128 + d], b1 = p.hg_lb[2048 + dir * 1024 + h * 128 + d];
      lo = sigm(b1 - b0);
    }
    float run = 0.f;
    {
      const u16* xs = QFI + (size_t)row0 * 4096 + 1024 + dir * 1024 + h * 128 + d;
      float xv[32];
#pragma unroll
      for (int i = 0; i < 32; i++) xv[i] = bf2f(xs[(size_t)(half * 32 + (dir == 0 ? i : 31 - i)) * 4096]);
#pragma unroll
      for (int i = 0; i < 32; i++) {
        const int ii = dir == 0 ? i : 31 - i;
        const int t = half * 32 + ii;
        const float x = xv[i];
        const float sg = sigm(x);
        const float f = lo + (1.f - lo) * sg;
        const float omf = (1.f - lo) * (1.f - sg);
        run += __log2f(f);
        sG[d * 65 + t] = run;
        sK[d * 66 + t] = f2bf(omf);
      }
      sTot[half * 128 + d] = run;
    }
    __syncthreads();
    {
      const float t0 = sTot[d], t1 = sTot[128 + d];
      const float gtot = t0 + t1;
      const float add = dir == 0 ? (half == 1 ? t0 : 0.f) : (half == 0 ? t1 : 0.f);
      u16* qdst = dir == 0 ? QFI + (size_t)row0 * 4096 + h * 128 + d : HGX + (size_t)row0 * 1024 + h * 128 + d;
      const size_t qp = dir == 0 ? 4096 : 1024;
      u16* kdst = QFI + (size_t)row0 * 4096 + 1024 + dir * 1024 + h * 128 + d;
#pragma unroll 8
      for (int i = 0; i < 32; i++) {
        const int t = half * 32 + i;
        const float G = sG[d * 65 + t] + add;
        sG[d * 65 + t] = G;
        qdst[(size_t)t * qp] = f2bf(bf2f(sQ[d * 66 + t]) * __builtin_amdgcn_exp2f(G));
        kdst[(size_t)t * 4096] = f2bf(bf2f(sK[d * 66 + t]) * __builtin_amdgcn_exp2f(gtot - G));
      }
      if (half == 0) ((float*)(p.ws + OFF_HGDEC))[((size_t)(c * 8 + h) * 2 + dir) * 128 + d] = __builtin_amdgcn_exp2f(gtot);
    }
    __syncthreads();
    {
      const int lane = tid & 63, I = tid >> 6, fr = lane & 15, fq = lane >> 4;
      const int rt = dir == 0 ? I * 16 - 1 : I * 16 + 16;
      const bool hasref = dir == 0 ? (I > 0) : (I < 3);
      bf16x8 af[4];
#pragma unroll
      for (int ks = 0; ks < 4; ks++) {
        asm volatile("" ::: "memory");
#pragma unroll
        for (int j = 0; j < 8; j++) {
          const int dd = ks * 32 + fq * 8 + j;
          const float R = hasref ? sG[dd * 65 + rt] : 0.f;
          const float e = __builtin_amdgcn_exp2f(fmaxf(sG[dd * 65 + I * 16 + fr] - R, -120.f));
          af[ks][j] = (short)f2bf(bf2f(sQ[dd * 66 + I * 16 + fr]) * e);
        }
      }
      u16* AUX = (u16*)(p.ws + OFF_C) + ((size_t)(c * 8 + h) * 2 + dir) * 4096;
#pragma unroll 1
      for (int J = 0; J < 4; J++) {
        const bool actv = dir == 0 ? (J <= I) : (J >= I);
        f32x4 acc = f32x4{0.f, 0.f, 0.f, 0.f};
        if (actv) {
#pragma unroll
          for (int ks = 0; ks < 4; ks++) {
            asm volatile("" ::: "memory");
            bf16x8 bfr;
#pragma unroll
            for (int j = 0; j < 8; j++) {
              const int dd = ks * 32 + fq * 8 + j;
              const float R = hasref ? sG[dd * 65 + rt] : 0.f;
              const float e = __builtin_amdgcn_exp2f(fminf(R - sG[dd * 65 + J * 16 + fr], 120.f));
              bfr[j] = (short)f2bf(bf2f(sK[dd * 66 + J * 16 + fr]) * e);
            }
            acc = mfma16(af[ks], bfr, acc);
          }
        }
#pragma unroll
        for (int jj = 0; jj < 4; jj++) {
          const int i = I * 16 + fq * 4 + jj, j = J * 16 + fr;
          const bool valid = actv && (dir == 0 ? (j <= i) : (j >= i));
          AUX[i * 64 + j] = f2bf(valid ? acc[jj] : 0.f);
        }
      }
    }
    __syncthreads();
  }
}

struct ScanDesc {
  const u16 *q, *k, *v;
  int qp, kp, vp;
  const u16* aux;
  size_t aux_cs;
  int attn_off, ainv_off;
  u16* o;
  int mixer, b, dir;
  const float* sc;
  size_t sc_cs;
  float lam;
};

DI int scan_chunk_of(int dir, int b, int step) {
  if (dir == 0) return step < 4 ? 256 + 4 * b + step : 128 * b + (step - 4);
  return step < 4 ? 256 + 4 * b + (3 - step) : 128 * b + (131 - step);
}
template <int MIXER>
DI void scan_prefetch(const u16* sq, const u16* sk, const u16* sv, int qp, int kp, int vp, const u16* saux, size_t aux_cs, int attn_off, int ainv_off,
                      const float* ssc, size_t sc_cs, int c, int tid, int w, int fr, int fq, u32x4 (&rq)[4], u32x4 (&rk)[4], u32x4 (&rat)[2], u32x4 (&rai)[2],
                      unsigned (&rv)[8], float& rsc, float& regl) {
  struct { const u16 *q, *k, *v; int qp, kp, vp; const u16* aux; size_t aux_cs; int attn_off, ainv_off; const float* sc; size_t sc_cs; } s =
      {sq, sk, sv, qp, kp, vp, saux, aux_cs, attn_off, ainv_off, ssc, sc_cs};
  const int row0 = c * 64;
  const u16* qbase = s.q + (size_t)row0 * s.qp;
  const u16* kbase = s.k + (size_t)row0 * s.kp;
  const u16* vbase = s.v + (size_t)row0 * s.vp;
  const unsigned qoff = (unsigned)((tid >> 4) * s.qp + (tid & 15) * 8);
  const unsigned koff = (unsigned)((tid >> 4) * s.kp + (tid & 15) * 8);
#pragma unroll
  for (int i = 0; i < 4; i++) {
    rq[i] = *(const u32x4*)(qbase + (size_t)(i * 16) * s.qp + qoff);
    rk[i] = *(const u32x4*)(kbase + (size_t)(i * 16) * s.kp + koff);
  }
  const u16* ab = s.aux + (size_t)c * s.aux_cs;
  const unsigned aoff = (unsigned)((tid >> 3) * 64 + (tid & 7) * 8);
#pragma unroll
  for (int i = 0; i < 2; i++) {
    rat[i] = *(const u32x4*)(ab + s.attn_off + i * 32 * 64 + aoff);
    if (MIXER == 0) rai[i] = *(const u32x4*)(ab + s.ainv_off + i * 32 * 64 + aoff);
  }
  if (MIXER == 0) {
    const float* sc = s.sc + (size_t)c * s.sc_cs;
    if (tid < 128) rsc = sc[tid];
    regl = sc[128];
  } else if (MIXER == 2) {
    if (tid < 128) rsc = s.sc[(size_t)c * s.sc_cs + tid];
  }
  const unsigned voff = (unsigned)(fq * 4 * s.vp + w * 16 + fr);
#pragma unroll
  for (int mt = 0; mt < 4; mt++)
#pragma unroll
    for (int jp = 0; jp < 2; jp++) {
      const unsigned lo = (vbase + (size_t)(mt * 16 + jp * 2) * s.vp)[voff];
      const unsigned hi = (vbase + (size_t)(mt * 16 + jp * 2 + 1) * s.vp)[voff];
      rv[mt * 2 + jp] = lo | (hi << 16);
    }
}

template <int MIXER>
DI void scan_unit(const ScanDesc& s, char* smem, const int WV) {
  const int tid = tidx(), lane = tid & 63, w = tid >> 6;
  const int fr = lane & 15, fq = lane >> 4;
  char* sQm = smem;
  char* sKm = smem + 17408;
  const unsigned km_tr = (unsigned)(size_t)sKm + (unsigned)((fq * 4 + ((lane & 15) >> 2)) * 272 + (lane & 3) * 8);
  char* sAT = smem + 53248;
  char* sAI = smem + 62464;
  float* sSC = (float*)(smem + 71680);
  f32x4 S[8];
#pragma unroll
  for (int i = 0; i < 8; i++) S[i] = f32x4{0.f, 0.f, 0.f, 0.f};
  u32x4 rq[4], rk[4], rat[2], rai[2];
  rai[0] = u32x4{0u, 0u, 0u, 0u}; rai[1] = rai[0];
  unsigned rv[8];
  float rsc = 0.f, regl = 1.f;
  scan_prefetch<MIXER>(s.q, s.k, s.v, s.qp, s.kp, s.vp, s.aux, s.aux_cs, s.attn_off, s.ainv_off, s.sc, s.sc_cs, scan_chunk_of(s.dir, s.b, 0), tid, w, fr, fq, rq, rk, rat, rai, rv, rsc, regl);
  for (int step = 0; step < 132; step++) {
    const int c = scan_chunk_of(s.dir, s.b, step);
    const int row0 = c * 64;
#pragma unroll
    for (int i = 0; i < 4; i++) {
      const int id = tid + i * 256, r = id >> 4, ch = id & 15;
      *(u32x4*)(sQm + r * 272 + ch * 16) = rq[i];
      *(u32x4*)(sKm + r * 272 + ch * 16) = rk[i];
    }
#pragma unroll
    for (int i = 0; i < 2; i++) {
      const int id = tid + i * 256, r = id >> 3, ch = id & 7;
      *(u32x4*)(sAT + r * 144 + ch * 16) = rat[i];
      if (MIXER == 0) *(u32x4*)(sAI + r * 144 + ch * 16) = rai[i];
    }
    float egl = 1.f;
    if (MIXER == 0) {
      if (tid < 128) sSC[tid] = rsc;
      egl = regl;
    } else if (MIXER == 1) {
      if (tid < 64) {
        const float e1 = s.dir == 0 ? (float)(tid + 1) : (float)(64 - tid);
        sSC[tid] = __expf(s.lam * e1);
        sSC[64 + tid] = __expf(s.lam * (64.f - e1));
      }
      egl = __expf(s.lam * 64.f);
    } else {
      if (tid < 128) sSC[tid] = rsc;
    }
    f32x4 V[4];
#pragma unroll
    for (int mt = 0; mt < 4; mt++) {
      V[mt][0] = bf2f((u16)(rv[mt * 2] & 0xffff)); V[mt][1] = bf2f((u16)(rv[mt * 2] >> 16));
      V[mt][2] = bf2f((u16)(rv[mt * 2 + 1] & 0xffff)); V[mt][3] = bf2f((u16)(rv[mt * 2 + 1] >> 16));
    }
    __syncthreads();
    if (step + 1 < 132) scan_prefetch<MIXER>(s.q, s.k, s.v, s.qp, s.kp, s.vp, s.aux, s.aux_cs, s.attn_off, s.ainv_off, s.sc, s.sc_cs, scan_chunk_of(s.dir, s.b, step + 1), tid, w, fr, fq, rq, rk, rat, rai, rv, rsc, regl);
    bf16x8 Sb[4];
#pragma unroll
    for (int ks = 0; ks < 4; ks++) Sb[ks] = pack8(S[2 * ks], S[2 * ks + 1]);
    f32x4 vn[4];
    f32x4 oq[4];
#pragma unroll
    for (int mt = 0; mt < 4; mt++) oq[mt] = f32x4{0.f, 0.f, 0.f, 0.f};
    if (MIXER == 0) {
      f32x4 P[4];
      bf16x8 aai[2][4];
#pragma unroll
      for (int ks = 0; ks < 2; ks++)
#pragma unroll
        for (int mt = 0; mt < 4; mt++) aai[ks][mt] = ld_perm(sAI + (mt * 16 + fr) * 144, ks * 32 + fq * 4);
#pragma unroll
      for (int mt = 0; mt < 4; mt++) P[mt] = f32x4{0.f, 0.f, 0.f, 0.f};
#pragma unroll
      for (int ks = 0; ks < 4; ks++) {
        bf16x8 ak[4], aq[4];
#pragma unroll
        for (int mt = 0; mt < 4; mt++) { ak[mt] = ld_perm(sKm + (mt * 16 + fr) * 272, ks * 32 + fq * 4); aq[mt] = ld_perm(sQm + (mt * 16 + fr) * 272, ks * 32 + fq * 4); }
#pragma unroll
        for (int mt = 0; mt < 4; mt++) P[mt] = mfma16(ak[mt], Sb[ks], P[mt]);
#pragma unroll
        for (int mt = 0; mt < 4; mt++) oq[mt] = mfma16(aq[mt], Sb[ks], oq[mt]);
      }
#pragma unroll
      for (int mt = 0; mt < 4; mt++)
#pragma unroll
        for (int j = 0; j < 4; j++) P[mt][j] = V[mt][j] - sSC[mt * 16 + fq * 4 + j] * P[mt][j];
      bf16x8 rb[2];
#pragma unroll
      for (int ks = 0; ks < 2; ks++) rb[ks] = pack8(P[2 * ks], P[2 * ks + 1]);
#pragma unroll
      for (int mt = 0; mt < 4; mt++) vn[mt] = f32x4{0.f, 0.f, 0.f, 0.f};
#pragma unroll
      for (int ks = 0; ks < 2; ks++) {
#pragma unroll
        for (int mt = 0; mt < 4; mt++) vn[mt] = mfma16(aai[ks][mt], rb[ks], vn[mt]);
      }
    } else {
#pragma unroll
      for (int ks = 0; ks < 4; ks++) {
        bf16x8 aq[4];
#pragma unroll
        for (int mt = 0; mt < 4; mt++) aq[mt] = ld_perm(sQm + (mt * 16 + fr) * 272, ks * 32 + fq * 4);
#pragma unroll
        for (int mt = 0; mt < 4; mt++) oq[mt] = mfma16(aq[mt], Sb[ks], oq[mt]);
      }
#pragma unroll
      for (int mt = 0; mt < 4; mt++) vn[mt] = V[mt];
    }
    bf16x8 vb[2];
#pragma unroll
    for (int ks = 0; ks < 2; ks++) vb[ks] = pack8(vn[2 * ks], vn[2 * ks + 1]);
    if (MIXER != 2) {
#pragma unroll
      for (int mt = 0; mt < 4; mt++)
#pragma unroll
        for (int j = 0; j < 4; j++) oq[mt][j] *= sSC[mt * 16 + fq * 4 + j];
    }
#pragma unroll
    for (int ks = 0; ks < 2; ks++) {
      bf16x8 aa[4];
#pragma unroll
      for (int mt = 0; mt < 4; mt++) aa[mt] = ld_perm(sAT + (mt * 16 + fr) * 144, ks * 32 + fq * 4);
#pragma unroll
      for (int mt = 0; mt < 4; mt++) oq[mt] = mfma16(aa[mt], vb[ks], oq[mt]);
    }
    if (MIXER != 2) {
#pragma unroll
      for (int mt = 0; mt < 4; mt++)
#pragma unroll
        for (int j = 0; j < 4; j++) vn[mt][j] *= sSC[64 + mt * 16 + fq * 4 + j];
#pragma unroll
      for (int ks = 0; ks < 2; ks++) vb[ks] = pack8(vn[2 * ks], vn[2 * ks + 1]);
    }
#pragma unroll
    for (int mt = 0; mt < 8; mt++) {
      if (MIXER == 2) {
#pragma unroll
        for (int j = 0; j < 4; j++) S[mt][j] *= sSC[mt * 16 + fq * 4 + j];
      } else {
#pragma unroll
        for (int j = 0; j < 4; j++) S[mt][j] *= egl;
      }
    }
#pragma unroll
    for (int ks = 0; ks < 2; ks++) {
      bf16x8 at[8];
#pragma unroll
      for (int mt = 0; mt < 8; mt++) at[mt] = ld_tr2(km_tr + (unsigned)((ks * 32) * 272 + mt * 32), km_tr + (unsigned)((ks * 32 + 16) * 272 + mt * 32));
#pragma unroll
      for (int mt = 0; mt < 8; mt++) S[mt] = mfma16(at[mt], vb[ks], S[mt]);
    }
    {
      u16* obase = s.o + (size_t)row0 * 1024;
#pragma unroll
      for (int mt = 0; mt < 4; mt++)
#pragma unroll
        for (int j = 0; j < 4; j++) obase[(unsigned)((mt * 16 + fq * 4 + j) * 1024 + w * 16 + fr)] = f2bf(oq[mt][j]);
    }
    __syncthreads();
  }
}

DI void scan_phase_hg(const Params& p, char* smem) {
  const int WV = p.ph_hi;
  if ((blockIdx.x & 3) == 0 && (blockIdx.x >> 2) < 64) {
    const int u = blockIdx.x >> 2;
    const int dir = u & 1, vg = (u >> 1) & 1, h = (u >> 2) & 7, b = u >> 5;
    ScanDesc s;
    s.q = dir == 0 ? (const u16*)(p.ws + OFF_A) + h * 128 : (const u16*)(p.ws + OFF_B) + h * 128;
    s.qp = dir == 0 ? 4096 : 1024;
    s.k = (const u16*)(p.ws + OFF_A) + 1024 + dir * 1024 + h * 128; s.kp = 4096;
    s.v = (const u16*)(p.ws + OFF_A) + 3072 + h * 128 + vg * 64; s.vp = 4096;
    s.aux = (const u16*)(p.ws + OFF_C) + (size_t)(h * 2 + dir) * 4096; s.aux_cs = 8 * 2 * 4096; s.attn_off = 0; s.ainv_off = 0;
    s.o = (u16*)(p.ws + OFF_D + (dir ? SZ_TOK1K : 0)) + h * 128 + vg * 64;
    s.mixer = 2; s.b = b; s.dir = dir;
    s.sc = (const float*)(p.ws + OFF_HGDEC) + (size_t)(h * 2 + dir) * 128; s.sc_cs = 8 * 2 * 128; s.lam = 0.f;
    scan_unit<2>(s, smem, WV);
  }
}
DI void scan_phase_dnret(const Params& p, int l, char* smem) {
  const int WV = p.ph_hi;
  if ((blockIdx.x & 1) == 0 && (blockIdx.x >> 1) < 128) {
    const int u = blockIdx.x >> 1;
    const int mixer = u & 1, dir = (u >> 1) & 1, vg = (u >> 2) & 3, h = (u >> 4) & 3, b = u >> 6;
    ScanDesc s;
    const u16* base = (const u16*)(p.ws + OFF_A + (mixer ? 2 * SZ_TOK1K : 0));
    s.q = base + h * 128; s.k = base + 512 + h * 128; s.v = base + 1024 + h * 256 + vg * 64;
    s.qp = s.kp = s.vp = 2048;
    s.mixer = mixer; s.b = b; s.dir = dir;
    if (mixer == 0) {
      s.aux = (const u16*)(p.ws + OFF_B) + (size_t)(h * 2 + dir) * 2 * 4096; s.aux_cs = 4 * 4 * 4096; s.ainv_off = 0; s.attn_off = 4096;
      s.sc = (const float*)(p.ws + OFF_DNSC) + (size_t)(h * 2 + dir) * 192; s.sc_cs = 4 * 2 * 192; s.lam = 0.f;
      s.o = (u16*)(dir == 0 ? p.ws + OFF_E : p.ws + OFF_D + SZ_TOK1K) + h * 256 + vg * 64;
      scan_unit<0>(s, smem, WV);
    } else {
      s.aux = (const u16*)(p.ws + OFF_C) + (size_t)(h * 2 + dir) * 4096; s.aux_cs = 4 * 2 * 4096; s.attn_off = 0; s.ainv_off = 0;
      const float rd = p.ret_decay[l * 8 + dir * 4 + h];
      s.lam = fminf(rd, 0.f) - log1pf(__expf(-fabsf(rd)));
      s.sc = nullptr; s.sc_cs = 0;
      s.o = (u16*)(p.ws + OFF_E + (dir == 0 ? SZ_TOK1K : 2 * SZ_TOK1K)) + h * 256 + vg * 64;
      scan_unit<1>(s, smem, WV);
    }
  }
}

DI void onorm_rows(u16* of, const u16* ob, const float* nw, int dv, int unit, int nunits_stride, const int WV) {
  const int lane = tidx() & 63, w = tidx() >> 6;
  float nwr[16];
  {
    const int dcol0 = (lane * 16) % dv;
#pragma unroll
    for (int e = 0; e < 4; e++) {
      const f32x4 t4 = *(const f32x4*)(nw + dcol0 + 4 * e);
      nwr[4 * e] = t4[0]; nwr[4 * e + 1] = t4[1]; nwr[4 * e + 2] = t4[2]; nwr[4 * e + 3] = t4[3];
    }
  }
  for (int row = unit * 4 + w; row < T_ALL; row += nunits_stride * 4) {
    u16* pf = of + (size_t)row * 1024 + lane * 16;
    const u16* pb = ob + (size_t)row * 1024 + lane * 16;
    float v[16];
#pragma unroll
    for (int hv = 0; hv < 2; hv++) {
      const uint4 a = *(const uint4*)(pf + hv * 8), b = *(const uint4*)(pb + hv * 8);
      const unsigned aa[4] = {a.x, a.y, a.z, a.w}, bb[4] = {b.x, b.y, b.z, b.w};
#pragma unroll
      for (int e = 0; e < 4; e++) {
        v[hv * 8 + e * 2] = bf2f((u16)(aa[e] & 0xffff)) + bf2f((u16)(bb[e] & 0xffff));
        v[hv * 8 + e * 2 + 1] = bf2f((u16)(aa[e] >> 16)) + bf2f((u16)(bb[e] >> 16));
      }
    }
    float ss = 0.f;
#pragma unroll
    for (int e = 0; e < 16; e++) ss += v[e] * v[e];
    ss = dv == 256 ? gsum(ss, 16) : gsum(ss, 8);
    const float rstd = rsqrtf(ss / (float)dv + 1e-6f);
    unsigned o8[8];
#pragma unroll
    for (int e = 0; e < 8; e++) o8[e] = pack2(v[2 * e] * rstd * nwr[2 * e], v[2 * e + 1] * rstd * nwr[2 * e + 1]);
    *(uint4*)pf = uint4{o8[0], o8[1], o8[2], o8[3]};
    *(uint4*)(pf + 8) = uint4{o8[4], o8[5], o8[6], o8[7]};
  }
}

DI void final_norm(const Params& p) {
  const int WV = p.ph_hi;
  const int lane = tidx() & 63, w = tidx() >> 6;
  for (int row = blockIdx.x * 4 + w; row < T_LAT; row += gridDim.x * 4) {
    float* xr = p.out + (size_t)row * 1024;
    f32x4 xv[4];
    float ss = 0.f;
#pragma unroll
    for (int i = 0; i < 4; i++) {
      xv[i] = *(const f32x4*)(xr + i * 256 + lane * 4);
      ss += xv[i][0] * xv[i][0] + xv[i][1] * xv[i][1] + xv[i][2] * xv[i][2] + xv[i][3] * xv[i][3];
    }
    ss = wsum(ss);
    const float rstd = rsqrtf(ss * (1.f / 1024.f) + 1e-6f);
#pragma unroll
    for (int i = 0; i < 4; i++) {
      const f32x4 wv = *(const f32x4*)(p.final_norm_w + i * 256 + lane * 4);
      f32x4 r;
#pragma unroll
      for (int j = 0; j < 4; j++) r[j] = xv[i][j] * rstd * wv[j];
      *(f32x4*)(xr + i * 256 + lane * 4) = r;
    }
  }
}

DI void run_phase(const Params& p, int ph, char* smem) {
  const int WV = p.ph_hi;
  const int G = gridDim.x, B = blockIdx.x;
  if (ph == 0) { if (QSEL(11)) phase_pro(p, smem); return; }
  if (ph == 23) { if (QSEL(12)) final_norm(p); return; }
  const int l = (ph - 1) / 11, q = (ph - 1) % 11;
  const bool last = l == 1;
  switch (q) {
    case 0: if (!QSEL(0)) break;
      if (l == 1) for (int u = B; u < WCONV_UNITS; u += G) wconv_unit(p, 1, u, smem);
      phase_norm(p, l, smem);
      break;
    case 1: if (!QSEL(1)) break;
      for (int t = B; t < 128 * 16; t += G) {
        const int tn = t + G;
        const bool more = tn < 128 * 16;
        gemm_tile<EPI_HG, 8>(p, l, t % 128, t / 128, smem, t != B, more ? tn % 128 : -1, more ? tn / 128 : -1);
      }
      for (int t = B; t < 4 * 32; t += G) gemm_tile<EPI_HG, 4>(p, l, 128 + (t & 3), t >> 2, smem);
      break;
    case 2: if (!QSEL(2)) break;
      for (int u = B; u < NCH * 8; u += G) hg_prep_unit(p, l, u >> 3, u & 7, smem);
      break;
    case 3: if (!QSEL(3)) break; scan_phase_hg(p, smem); break;
    case 4: if (!QSEL(4)) break;
      for (int t = B; t < 128 * 16; t += G) {
        const int tn = t + G;
        const bool more = tn < 128 * 16;
        gemm_tile<EPI_DNRET, 8>(p, l, t % 128, t / 128, smem, t != B, more ? tn % 128 : -1, more ? tn / 128 : -1);
      }
      for (int t = B; t < 4 * 32; t += G) gemm_tile<EPI_DNRET, 4>(p, l, 128 + (t & 3), t >> 2, smem);
      onorm_rows((u16*)(p.ws + OFF_D), (const u16*)(p.ws + OFF_D + SZ_TOK1K), p.hg_norm_w + l * 128, 128, B, G, WV);
      break;
    case 5: if (!QSEL(5)) break;
      for (int u = B; u < NCH * 8; u += G) {
        if (u < NCH * 4) dn_prep_unit(p, l, u >> 2, u & 3, smem);
        else ret_prep_unit(p, l, (u - NCH * 4) >> 2, u & 3, smem);
      }
      break;
    case 6: if (!QSEL(6)) break; scan_phase_dnret(p, l, smem); break;
    case 7: if (!QSEL(7)) break;
      onorm_rows((u16*)(p.ws + OFF_E), (const u16*)(p.ws + OFF_D + SZ_TOK1K), p.dn_norm_w + l * 256, 256, B, G, WV);
      onorm_rows((u16*)(p.ws + OFF_E + SZ_TOK1K), (const u16*)(p.ws + OFF_E + 2 * SZ_TOK1K), p.ret_norm_w + l * 256, 256, B, G, WV);
      break;
    case 8: if (!QSEL(8)) break; {
      const int nrt = last ? 128 : 132;
      for (int t = B; t < 128 * 12; t += G) {
        const int tn = t + G;
        const bool more = tn < 128 * 12;
        gemm_tile<EPI_GATE, 8>(p, l, t % 128, t / 128, smem, t != B, more ? tn % 128 : -1, more ? tn / 128 : -1);
      }
      if (!last) for (int t = B; t < 4 * 24; t += G) gemm_tile<EPI_GATE, 4>(p, l, 128 + (t & 3), t >> 2, smem);
    } break;
    case 9: if (!QSEL(9)) break; {
      const int nrt = last ? 128 : 132;
      for (int t = B; t < nrt * 8; t += G) {
        const int tn = t + G;
        const bool more = tn < nrt * 8;
        merge_tile(p, t % nrt, t / nrt, smem, t != B, more ? tn % nrt : -1, more ? tn / nrt : -1);
      }
    } break;
    case 10: if (!QSEL(10)) break; {
      const int nrt = last ? 128 : 132;
      for (int t = B; t < 128 * 4; t += G) {
        const int tn = t + G;
        const bool more = tn < 128 * 4;
        gemm_tile<EPI_OUT, 8>(p, l, t % 128, t / 128, smem, t != B, more ? tn % 128 : -1, more ? tn / 128 : -1);
      }
      if (!last) for (int t = B; t < 4 * 8; t += G) gemm_tile<EPI_OUT, 4>(p, l, 128 + (t & 3), t >> 2, smem);
    } break;
  }
}

#define XB_XCNT(j) (64 * (j))
#define XB_XSUB(j) (1024 + 64 * (j))
#define XB_XGEN(j) (2048 + 64 * (j))
#define XB_TOP 3072
#define XB_TOPGEN 3136
DI unsigned xb_ld(unsigned* q) { return __hip_atomic_load(q, __ATOMIC_RELAXED, __HIP_MEMORY_SCOPE_AGENT); }
DI unsigned xb_add(unsigned* q, unsigned v) { return __hip_atomic_fetch_add(q, v, __ATOMIC_RELAXED, __HIP_MEMORY_SCOPE_AGENT); }
DI void grid_barrier(unsigned* bar, volatile unsigned* st) {
  asm volatile("s_waitcnt vmcnt(0) lgkmcnt(0)" ::: "memory");
  __syncthreads();
  if (__builtin_amdgcn_workitem_id_x() == 0) {
    const unsigned nloc = st[0], nx = st[1], x = st[2];
    const unsigned old = xb_add(&bar[XB_XSUB(x)], 1u);
    const unsigned gen = old / nloc;
    if (old + 1u == (gen + 1u) * nloc) {
      __builtin_amdgcn_fence(__ATOMIC_RELEASE, "agent");
      asm volatile("s_waitcnt vmcnt(0)" ::: "memory");
      const unsigned og = xb_add(&bar[XB_TOP], 1u);
      const unsigned tg = og / nx;
      if (og + 1u == (tg + 1u) * nx) xb_add(&bar[XB_TOPGEN], 1u);
      else while (xb_ld(&bar[XB_TOPGEN]) == tg) __builtin_amdgcn_s_sleep(2);
      __builtin_amdgcn_fence(__ATOMIC_ACQUIRE, "agent");
      xb_add(&bar[XB_XGEN(x)], 1u);
      asm volatile("s_waitcnt vmcnt(0)" ::: "memory");
    } else {
      while (xb_ld(&bar[XB_XGEN(x)]) == gen) __builtin_amdgcn_s_sleep(8);
      __builtin_amdgcn_fence(__ATOMIC_ACQUIRE, "agent");
      asm volatile("s_waitcnt vmcnt(0)" ::: "memory");
    }
  }
  __syncthreads();
}

__global__ void __launch_bounds__(256, 2) mk(Params p) {
  extern __shared__ __attribute__((aligned(16))) char smem[];
  p.ph_hi = __builtin_amdgcn_readfirstlane((int)__builtin_amdgcn_workitem_id_x() >> 6);
#if ONE_LAUNCH
  cg::grid_group grid = cg::this_grid();
  unsigned* bar = (unsigned*)(p.ws + OFF_BAR);
  __shared__ uint4 xbw;
  if (__builtin_amdgcn_workitem_id_x() == 0)
    (void)xb_add(&bar[XB_XCNT((unsigned)__builtin_amdgcn_s_getreg((3 << 11) | 20) & 0xFu)], 1u);
#ifdef PROBE_MASK
  long long tacc = 0, t0 = wall_clock64();
#define PTICK(n) { const long long t1 = wall_clock64(); if ((PROBE_MASK >> (n)) & 1) tacc += t1 - t0; t0 = t1; }
#else
#define PTICK(n)
#endif
  run_phase(p, 0, smem);
  grid.sync();
  if (__builtin_amdgcn_workitem_id_x() == 0) {
    const unsigned x = (unsigned)__builtin_amdgcn_s_getreg((3 << 11) | 20) & 0xFu;
    unsigned cnt = 0u, mine = 1u;
#pragma unroll
    for (unsigned j = 0; j < 16; ++j) { const unsigned c = xb_ld(&bar[XB_XCNT(j)]); cnt += c > 0u ? 1u : 0u; mine = j == x ? c : mine; }
    xbw = make_uint4(mine > 0u ? mine : 1u, cnt > 0u ? cnt : 1u, x, 0u);
  }
  __syncthreads();
  volatile unsigned* xst = (volatile unsigned*)&xbw;
  PTICK(0)
#define PH(n) run_phase(p, n, smem); grid_barrier(bar, xst); PTICK(n)
  PH(1) PH(2) PH(3) PH(4) PH(5) PH(6) PH(7) PH(8) PH(9) PH(10) PH(11)
  PH(12) PH(13) PH(14) PH(15) PH(16) PH(17) PH(18) PH(19) PH(20) PH(21) PH(22)
  run_phase(p, 23, smem);
  PTICK(23)
#ifdef PROBE_MASK
  if (blockIdx.x == 0 && __builtin_amdgcn_workitem_id_x() == 0) {
    const long long tend = wall_clock64() + tacc * 4;
    while (wall_clock64() < tend) __builtin_amdgcn_s_sleep(20);
  }
#endif
#else
  run_phase(p, p.ph_lo, smem);
#endif
}

extern "C" void kernel_launch(void* const* d_in, const int* in_sizes, int n_in, void* d_out,
                              int out_size, void* d_ws, size_t ws_size, hipStream_t stream) {
  static int grid_blocks = 0;
  if (!grid_blocks) {
    int dev = 0, cus = 0, per_cu = 0;
    (void)hipGetDevice(&dev);
    (void)hipDeviceGetAttribute(&cus, hipDeviceAttributeMultiprocessorCount, dev);
    (void)hipFuncSetAttribute((const void*)mk, hipFuncAttributeMaxDynamicSharedMemorySize, SMEM_BYTES);
    (void)hipOccupancyMaxActiveBlocksPerMultiprocessor(&per_cu, mk, 256, SMEM_BYTES);
    if (per_cu > 2) per_cu = 2;
    if (per_cu < 1) per_cu = 1;
    grid_blocks = cus * per_cu;
  }
  Params p{};
  const float** f = (const float**)&p;
  for (int i = 0; i < 19; i++) f[i] = (const float*)d_in[i];
  p.out = (float*)d_out;
  p.ws = (char*)d_ws;
#if ONE_LAUNCH
  p.ph_lo = 0; p.ph_hi = 24;
  (void)hipMemsetAsync((char*)d_ws + OFF_BAR, 0, 16384, stream);
  void* args[] = {&p};
  (void)hipLaunchCooperativeKernel((void*)mk, dim3(grid_blocks), dim3(256), args, SMEM_BYTES, stream);
#else
  for (int ph = 0; ph < 24; ph++) {
    p.ph_lo = ph; p.ph_hi = ph + 1;
    void* args[] = {&p};
    (void)hipLaunchCooperativeKernel((void*)mk, dim3(grid_blocks), dim3(256), args, SMEM_BYTES, stream);
  }
#endif
}
```

```cpp
#include <hip/hip_runtime.h>
#include <hip/hip_cooperative_groups.h>
#include <cstdio>
namespace cg = cooperative_groups;

#ifndef ONE_LAUNCH
#define ONE_LAUNCH 1
#endif
#ifndef ONLY_Q
#define ONLY_Q -1
#endif
#define QSEL(n) (ONLY_Q < 0 || ONLY_Q == (n))

typedef unsigned short u16;
using bf16x8 = __attribute__((ext_vector_type(8))) short;
using bf16x4 = __attribute__((ext_vector_type(4))) short;
using f32x4 = __attribute__((ext_vector_type(4))) float;
using u32x4 = __attribute__((ext_vector_type(4))) unsigned;
#define DI __device__ __forceinline__

constexpr int T_LAT = 16384, T_ALL = 16896, NCH = 264;
constexpr int WROWS = 18448;
constexpr int W_BR = 14352, W_OUT = 17424;
constexpr size_t al(size_t x) { return (x + 255) & ~(size_t)255; }
constexpr size_t SZ_WT = (size_t)WROWS * 1024 * 2;
constexpr size_t SZ_TOK1K = (size_t)T_ALL * 1024 * 2;
constexpr size_t OFF_WT = 0;
constexpr size_t OFF_H = OFF_WT + al(SZ_WT);
constexpr size_t OFF_MOD = OFF_H + al(SZ_TOK1K);
constexpr size_t OFF_ROT = OFF_MOD + al(2 * 3 * 3072 * 4);
constexpr size_t OFF_GB = OFF_ROT + al(128 * 32 * 2 * 4);
constexpr size_t OFF_CTX1 = OFF_GB + al((size_t)T_ALL * 16 * 4);
constexpr size_t OFF_HALO = OFF_CTX1 + al(512 * 1024 * 4);
constexpr size_t OFF_DNSC = OFF_HALO + al((size_t)NCH * 4 * 2048 * 2);
constexpr size_t OFF_HGDEC = OFF_DNSC + al((size_t)NCH * 4 * 2 * 192 * 4);
constexpr size_t OFF_BAR = OFF_HGDEC + al((size_t)NCH * 8 * 2 * 128 * 4);
constexpr size_t OFF_A = OFF_BAR + 16384;
constexpr size_t OFF_B = OFF_A + 4 * SZ_TOK1K;
constexpr size_t OFF_C = OFF_B + SZ_TOK1K;
constexpr size_t OFF_D = OFF_C + SZ_TOK1K;
constexpr size_t OFF_E = OFF_D + 2 * SZ_TOK1K;
constexpr size_t WS_TOTAL = OFF_E + 3 * SZ_TOK1K;
static_assert(WS_TOTAL <= 470286336ull, "workspace too large");

constexpr int SMEM_BYTES = 72960;

struct Params {
  const float *x, *c, *ctx, *c_ctx, *norm_w, *ada_w, *ada_b, *w_in, *dn_conv, *dn_a_log, *dn_dt_bias, *dn_norm_w,
      *ret_decay, *ret_norm_w, *hg_lb, *hg_norm_w, *w_branch, *w_out, *final_norm_w;
  float* out;
  char* ws;
  int ph_lo, ph_hi;
};

DI int laneid_v() { int t; asm volatile("v_mbcnt_lo_u32_b32 %0, -1, 0\n\tv_mbcnt_hi_u32_b32 %0, -1, %0" : "=v"(t)); return t; }
#define tidx() (WV * 64 + laneid_v())
typedef __bf16 hwbf2 __attribute__((ext_vector_type(2)));
DI u16 f2bf(float f) { __bf16 b = (__bf16)f; return __builtin_bit_cast(u16, b); }
DI float bf2f(u16 h) { return __uint_as_float(((unsigned)h) << 16); }
DI unsigned pack2(float a, float b) { hwbf2 v = {(__bf16)a, (__bf16)b}; return __builtin_bit_cast(unsigned, v); }
DI float sigm(float x) { return 1.f / (1.f + __expf(-x)); }
DI float silu(float x) { return x / (1.f + __expf(-x)); }
DI float dpp_f(float v, const int ctrl_sel) {
  const int iv = __float_as_int(v);
  int r;
  if (ctrl_sel == 0) r = __builtin_amdgcn_update_dpp(0, iv, 0xB1, 0xF, 0xF, false);
  else if (ctrl_sel == 1) r = __builtin_amdgcn_update_dpp(0, iv, 0x4E, 0xF, 0xF, false);
  else if (ctrl_sel == 2) r = __builtin_amdgcn_update_dpp(0, iv, 0x141, 0xF, 0xF, false);
  else r = __builtin_amdgcn_update_dpp(0, iv, 0x140, 0xF, 0xF, false);
  return __int_as_float(r);
}
DI float gsum(float v, const int n) {
  v += dpp_f(v, 0);
  v += dpp_f(v, 1);
  v += dpp_f(v, 2);
  if (n == 16) v += dpp_f(v, 3);
  return v;
}
DI float wsum(float v) {
  v = gsum(v, 16);
  v += __int_as_float(__builtin_amdgcn_update_dpp(0, __float_as_int(v), 0x142, 0xA, 0xF, false));
  v += __int_as_float(__builtin_amdgcn_update_dpp(0, __float_as_int(v), 0x143, 0xC, 0xF, false));
  return __int_as_float(__builtin_amdgcn_readlane(__float_as_int(v), 63));
}
DI f32x4 mfma16(bf16x8 a, bf16x8 b, f32x4 c) { return __builtin_amdgcn_mfma_f32_16x16x32_bf16(a, b, c, 0, 0, 0); }
DI bf16x8 pack8(f32x4 lo, f32x4 hi) {
  u32x4 r = {pack2(lo[0], lo[1]), pack2(lo[2], lo[3]), pack2(hi[0], hi[1]), pack2(hi[2], hi[3])};
  return __builtin_bit_cast(bf16x8, r);
}
typedef __attribute__((address_space(3))) bf16x4* lds_v4p;
DI bf16x8 ld_tr2(unsigned a_lo, unsigned a_hi) {
  const bf16x4 lo = __builtin_amdgcn_ds_read_tr16_b64_v4i16((lds_v4p)(size_t)a_lo);
  const bf16x4 hi = __builtin_amdgcn_ds_read_tr16_b64_v4i16((lds_v4p)(size_t)a_hi);
  bf16x8 r;
  r[0] = lo[0]; r[1] = lo[1]; r[2] = lo[2]; r[3] = lo[3]; r[4] = hi[0]; r[5] = hi[1]; r[6] = hi[2]; r[7] = hi[3];
  return r;
}
DI bf16x8 ld_perm(const char* rowp, int c0) {
  bf16x4 lo = *(const bf16x4*)(rowp + c0 * 2);
  bf16x4 hi = *(const bf16x4*)(rowp + c0 * 2 + 32);
  bf16x8 r;
  r[0] = lo[0]; r[1] = lo[1]; r[2] = lo[2]; r[3] = lo[3]; r[4] = hi[0]; r[5] = hi[1]; r[6] = hi[2]; r[7] = hi[3];
  return r;
}

DI int swz(int row, int ch) { return row * 128 + ((ch ^ (row & 7)) << 4); }

template <bool DEEP>
DI void gemm_kloop_t(const u16* __restrict__ A, const u16* __restrict__ W, f32x4 (&acc)[4][4], char* smem, const int WV) {
  const int tid = tidx(), lane = tid & 63, wid = tid >> 6, wn = wid >> 1, wt = wid & 1;
  const int fr = lane & 15, fq = lane >> 4;
  const int lrow = tid >> 3, lch = tid & 7;
  const u16* Ap = A + (size_t)lrow * 1024 + lch * 8;
  const u16* Wp = W + (size_t)lrow * 1024 + lch * 8;
  u32x4 ra0[4], rw0[4], ra1[4], rw1[4];
#define G_LOAD(RA, RW, KT) _Pragma("unroll") for (int i = 0; i < 4; i++) { \
    RA[i] = *(const u32x4*)(Ap + (size_t)i * 32 * 1024 + (KT) * 64); RW[i] = *(const u32x4*)(Wp + (size_t)i * 32 * 1024 + (KT) * 64); }
#define G_STORE(RA, RW, BUF) { char* dW = smem + (BUF) * 32768; _Pragma("unroll") for (int i = 0; i < 4; i++) { \
    *(u32x4*)(dW + swz(lrow + i * 32, lch)) = RW[i]; *(u32x4*)(dW + 16384 + swz(lrow + i * 32, lch)) = RA[i]; } }
#define G_COMPUTE(BUF) { const char* sW = smem + (BUF) * 32768; const char* sA = sW + 16384; \
    _Pragma("unroll") for (int ks = 0; ks < 2; ks++) { bf16x8 fw[4], fa[4]; \
      _Pragma("unroll") for (int i = 0; i < 4; i++) { \
        fw[i] = *(const bf16x8*)(sW + swz(wn * 64 + i * 16 + fr, ks * 4 + fq)); \
        fa[i] = *(const bf16x8*)(sA + swz(wt * 64 + i * 16 + fr, ks * 4 + fq)); } \
      _Pragma("unroll") for (int ni = 0; ni < 4; ni++) _Pragma("unroll") for (int ti = 0; ti < 4; ti++) \
        acc[ni][ti] = mfma16(fw[ni], fa[ti], acc[ni][ti]); } }
  G_LOAD(ra0, rw0, 0)
  G_STORE(ra0, rw0, 0)
  if (DEEP) { G_LOAD(ra1, rw1, 1) }
  __syncthreads();
  if (DEEP) {
    for (int kt = 0; kt < 16; kt += 2) {
      if (kt + 2 < 16) { G_LOAD(ra0, rw0, kt + 2) }
      G_COMPUTE(0)
      G_STORE(ra1, rw1, 1)
      __syncthreads();
      if (kt + 3 < 16) { G_LOAD(ra1, rw1, kt + 3) }
      G_COMPUTE(1)
      if (kt + 2 < 16) { G_STORE(ra0, rw0, 0) }
      __syncthreads();
    }
  } else {
    for (int kt = 0; kt < 16; kt++) {
      if (kt < 15) { G_LOAD(ra0, rw0, kt + 1) }
      G_COMPUTE(kt & 1)
      if (kt < 15) { G_STORE(ra0, rw0, (kt + 1) & 1) }
      __syncthreads();
    }
  }
#undef G_LOAD
#undef G_STORE
#undef G_COMPUTE
}
DI void gemm_kloop(const u16* __restrict__ A, const u16* __restrict__ W, f32x4 (&acc)[4][4], char* smem, const int WV,
                   const bool have0 = false, const u16* __restrict__ nA = nullptr, const u16* __restrict__ nW = nullptr) {
  const int tid = tidx(), lane = tid & 63, wid = tid >> 6, wn = wid >> 1, wt = wid & 1;
  const int fr = lane & 15, fq = lane >> 4;
  const int r8 = lane >> 3, chs = (lane & 7) ^ r8;
  const size_t loff = (size_t)(wid * 32 + r8) * 1024 + chs * 8;
  const u16* Asrc = A + loff;
  const u16* Wsrc = W + loff;
  char* ldsw = smem + wid * 4096;
#define G_STAGE_P(AS, WS, BUF, KT) _Pragma("unroll") for (int i = 0; i < 4; i++) { \
    __builtin_amdgcn_global_load_lds((const unsigned*)((WS) + (size_t)i * 8 * 1024 + (KT) * 64), (unsigned*)(ldsw + (BUF) * 32768 + i * 1024), 16, 0, 0); \
    __builtin_amdgcn_global_load_lds((const unsigned*)((AS) + (size_t)i * 8 * 1024 + (KT) * 64), (unsigned*)(ldsw + (BUF) * 32768 + 16384 + i * 1024), 16, 0, 0); }
#define G_COMPUTE(BUF) { const char* sW = smem + (BUF) * 32768; const char* sA = sW + 16384; \
    _Pragma("unroll") for (int ks = 0; ks < 2; ks++) { bf16x8 fw[4], fa[4]; \
      _Pragma("unroll") for (int i = 0; i < 4; i++) { \
        fw[i] = *(const bf16x8*)(sW + swz(wn * 64 + i * 16 + fr, ks * 4 + fq)); \
        fa[i] = *(const bf16x8*)(sA + swz(wt * 64 + i * 16 + fr, ks * 4 + fq)); } \
      _Pragma("unroll") for (int ni = 0; ni < 4; ni++) _Pragma("unroll") for (int ti = 0; ti < 4; ti++) \
        acc[ni][ti] = mfma16(fw[ni], fa[ti], acc[ni][ti]); } }
  if (!have0) {
    G_STAGE_P(Asrc, Wsrc, 0, 0)
    asm volatile("s_waitcnt vmcnt(0)" ::: "memory");
    __syncthreads();
  }
  for (int kt = 0; kt < 16; kt++) {
    if (kt < 15) { G_STAGE_P(Asrc, Wsrc, (kt + 1) & 1, kt + 1) }
    else if (nA != nullptr) { const u16* nAs = nA + loff; const u16* nWs = nW + loff; G_STAGE_P(nAs, nWs, 0, 0) }
    G_COMPUTE(kt & 1)
    asm volatile("s_waitcnt vmcnt(0)" ::: "memory");
    __syncthreads();
  }
#undef G_STAGE_P
#undef G_COMPUTE
}

DI void gemm_kloop256(const u16* __restrict__ A, const u16* __restrict__ W, f32x4 (&acc)[8][4], char* smem, const int WV,
                      const bool have0 = false, const u16* __restrict__ nA = nullptr, const u16* __restrict__ nW = nullptr) {
  const int tid = tidx(), lane = tid & 63, wid = tid >> 6, wn = wid >> 1, wt = wid & 1;
  const int fr = lane & 15, fq = lane >> 4;
  const int r16 = lane >> 2, chs = (lane & 3) ^ ((0 - (r16 >> 2)) & 3);
  const u16* Wsrc = W + (size_t)(wid * 64 + r16) * 1024 + chs * 8;
  const u16* Asrc = A + (size_t)(wid * 32 + r16) * 1024 + chs * 8;
  const int fpos = (fq ^ ((0 - (fr >> 2)) & 3)) << 4;
#define G_STAGE(BUF, KT) { _Pragma("unroll") for (int i = 0; i < 4; i++) \
      __builtin_amdgcn_global_load_lds((const unsigned*)(Wsrc + (size_t)i * 16 * 1024 + (KT) * 32), (unsigned*)(smem + (BUF) * 24576 + (wid * 4 + i) * 1024), 16, 0, 0); \
    _Pragma("unroll") for (int i = 0; i < 2; i++) \
      __builtin_amdgcn_global_load_lds((const unsigned*)(Asrc + (size_t)i * 16 * 1024 + (KT) * 32), (unsigned*)(smem + (BUF) * 24576 + 16384 + (wid * 2 + i) * 1024), 16, 0, 0); }
#define G_COMPUTE(BUF) { const char* sW = smem + (BUF) * 24576; const char* sA = sW + 16384; bf16x8 fw[8], fa[4]; \
    _Pragma("unroll") for (int i = 0; i < 8; i++) fw[i] = *(const bf16x8*)(sW + (wn * 128 + i * 16 + fr) * 64 + fpos); \
    _Pragma("unroll") for (int i = 0; i < 4; i++) fa[i] = *(const bf16x8*)(sA + (wt * 64 + i * 16 + fr) * 64 + fpos); \
    __builtin_amdgcn_s_setprio(1); \
    _Pragma("unroll") for (int ni = 0; ni < 8; ni++) _Pragma("unroll") for (int ti = 0; ti < 4; ti++) \
      acc[ni][ti] = mfma16(fw[ni], fa[ti], acc[ni][ti]); \
    __builtin_amdgcn_s_setprio(0); }
  if (!have0) { G_STAGE(0, 0) }
  asm volatile("s_waitcnt vmcnt(0)" ::: "memory");
  __syncthreads();
  for (int kt = 0; kt < 31; kt++) {
    G_STAGE((kt + 1) & 1, kt + 1)
    G_COMPUTE(kt & 1)
    asm volatile("s_waitcnt vmcnt(0)" ::: "memory");
    __syncthreads();
  }
  if (nA != nullptr) {
    const u16* Wn = nW + (size_t)(wid * 64 + r16) * 1024 + chs * 8;
    const u16* An = nA + (size_t)(wid * 32 + r16) * 1024 + chs * 8;
#pragma unroll
    for (int i = 0; i < 4; i++)
      __builtin_amdgcn_global_load_lds((const unsigned*)(Wn + (size_t)i * 16 * 1024), (unsigned*)(smem + (wid * 4 + i) * 1024), 16, 0, 0);
#pragma unroll
    for (int i = 0; i < 2; i++)
      __builtin_amdgcn_global_load_lds((const unsigned*)(An + (size_t)i * 16 * 1024), (unsigned*)(smem + 16384 + (wid * 2 + i) * 1024), 16, 0, 0);
  }
  G_COMPUTE(1)
  asm volatile("s_waitcnt lgkmcnt(0)\n\ts_barrier" ::: "memory");
#undef G_STAGE
#undef G_COMPUTE
}

enum { EPI_HG = 0, EPI_DNRET = 1, EPI_GATE = 2, EPI_OUT = 3 };

template <int EPI, int NI>
DI const u16* gemm_wptr(const Params& p, int nti) {
  constexpr int NW = NI * 32;
  const u16* WT = (const u16*)(p.ws + OFF_WT);
  int wrow;
  if (EPI == EPI_HG) wrow = 6160 + nti * NW;
  else if (EPI == EPI_DNRET) { const int mx = nti / (2048 / NW); wrow = (mx ? 3088 : 0) + (nti % (2048 / NW)) * NW; }
  else if (EPI == EPI_GATE) { const int mx = nti / (1024 / NW); wrow = (mx == 0 ? 2048 : (mx == 1 ? 5136 : 10256)) + (nti % (1024 / NW)) * NW; }
  else wrow = W_OUT + nti * NW;
  return WT + (size_t)wrow * 1024;
}
template <int EPI, int NI>
DI void gemm_tile(const Params& p, int l, int rt, int nti, char* smem, const bool have0 = false, const int nrt = -1, const int nnti = -1) {
  const int WV = p.ph_hi;
  const int tid = tidx(), lane = tid & 63, wid = tid >> 6, wn = wid >> 1, wt = wid & 1;
  const int fr = lane & 15, fq = lane >> 4;
  const int row0 = rt * 128;
  constexpr int NW = NI * 32;
  const u16* WT = (const u16*)(p.ws + OFF_WT);
  const u16* A;
  int wrow, n0, mixer = 0;
  if (EPI == EPI_HG) { A = (const u16*)(p.ws + OFF_H); n0 = nti * NW; wrow = 6160 + n0; }
  else if (EPI == EPI_DNRET) { A = (const u16*)(p.ws + OFF_H); mixer = nti / (2048 / NW); n0 = (nti % (2048 / NW)) * NW; wrow = (mixer ? 3088 : 0) + n0; }
  else if (EPI == EPI_GATE) { A = (const u16*)(p.ws + OFF_H); mixer = nti / (1024 / NW); n0 = (nti % (1024 / NW)) * NW; wrow = (mixer == 0 ? 2048 : (mixer == 1 ? 5136 : 10256)) + n0; }
  else { A = (const u16*)(p.ws + OFF_B); n0 = nti * NW; wrow = W_OUT + n0; }
  f32x4 acc[NI][4];
#pragma unroll
  for (int i = 0; i < NI; i++)
#pragma unroll
    for (int j = 0; j < 4; j++) acc[i][j] = f32x4{0.f, 0.f, 0.f, 0.f};
  if constexpr (NI == 4) gemm_kloop(A + (size_t)row0 * 1024, WT + (size_t)wrow * 1024, acc, smem, WV);
  else gemm_kloop256(A + (size_t)row0 * 1024, WT + (size_t)wrow * 1024, acc, smem, WV, have0,
                     nrt >= 0 ? A + (size_t)nrt * 128 * 1024 : nullptr, nrt >= 0 ? gemm_wptr<EPI, NI>(p, nnti) : nullptr);

  const float* ROT = (const float*)(p.ws + OFF_ROT);
  const float* MOD = (const float*)(p.ws + OFF_MOD);
#pragma unroll
  for (int ti = 0; ti < 4; ti++) {
    const int token = row0 + wt * 64 + ti * 16 + fr;
#pragma unroll
    for (int ni = 0; ni < NI; ni++) {
      const int nl = n0 + wn * (NI * 16) + ni * 16 + fq * 4;
      f32x4 v = acc[ni][ti];
      if (EPI == EPI_HG) {
        if (nl < 1024) { v[0] = silu(v[0]); v[1] = silu(v[1]); v[2] = silu(v[2]); v[3] = silu(v[3]); }
        u16* dst = (u16*)(p.ws + OFF_A) + (size_t)token * 4096 + nl;
        *(uint2*)dst = uint2{pack2(v[0], v[1]), pack2(v[2], v[3])};
      } else if (EPI == EPI_DNRET) {
        if (mixer == 0) {
          uint2 pk = uint2{pack2(v[0], v[1]), pack2(v[2], v[3])};
          u16* dst = (u16*)(p.ws + OFF_A) + (size_t)token * 2048 + nl;
          *(uint2*)dst = pk;
          const int tm = token & 63;
          if (tm < 2 || tm >= 62) {
            const int slot = tm < 2 ? tm : tm - 60;
            u16* hd = (u16*)(p.ws + OFF_HALO) + ((size_t)(token >> 6) * 4 + slot) * 2048 + nl;
            *(uint2*)hd = pk;
          }
        } else {
          if (nl < 1024) {
            if (token < T_LAT) {
              const int t = token & 8191, ri = t >> 6, ci = t & 63;
              const int d = nl & 127;
#pragma unroll
              for (int pp = 0; pp < 2; pp++) {
                const int pidx = (d >> 1) + pp;
                const float* rp = pidx < 32 ? ROT + (ri * 32 + pidx) * 2 : ROT + (ci * 32 + (pidx - 32)) * 2;
                const float cs = rp[0], sn = rp[1];
                const float x1 = v[2 * pp], x2 = v[2 * pp + 1];
                v[2 * pp] = x1 * cs - x2 * sn;
                v[2 * pp + 1] = x1 * sn + x2 * cs;
              }
            }
            if (nl >= 512) { const float s = 0.08838834764831845f; v[0] *= s; v[1] *= s; v[2] *= s; v[3] *= s; }
          }
          u16* dst = (u16*)(p.ws + OFF_A + 2 * SZ_TOK1K) + (size_t)token * 2048 + nl;
          *(uint2*)dst = uint2{pack2(v[0], v[1]), pack2(v[2], v[3])};
        }
      } else if (EPI == EPI_GATE) {
        char* base = mixer == 0 ? p.ws + OFF_E : (mixer == 1 ? p.ws + OFF_E + SZ_TOK1K : p.ws + OFF_D);
        u16* dst = (u16*)base + (size_t)token * 1024 + nl;
        uint2 on = *(const uint2*)dst;
        float o0 = bf2f((u16)(on.x & 0xffff)), o1 = bf2f((u16)(on.x >> 16)), o2 = bf2f((u16)(on.y & 0xffff)), o3 = bf2f((u16)(on.y >> 16));
        *(uint2*)dst = uint2{pack2(o0 * silu(v[0]), o1 * silu(v[1])), pack2(o2 * silu(v[2]), o3 * silu(v[3]))};
      } else {
        const int vec = token < T_LAT ? (token >> 13) : 2;
        const f32x4 gt = *(const f32x4*)(MOD + ((size_t)l * 3 + vec) * 3072 + 2048 + nl);
        const float* src;
        float* dst;
        if (token < T_LAT) {
          src = (l == 0 ? p.x : (const float*)p.out) + (size_t)token * 1024 + nl;
          dst = p.out + (size_t)token * 1024 + nl;
        } else {
          src = p.ctx + (size_t)(token - T_LAT) * 1024 + nl;
          dst = (float*)(p.ws + OFF_CTX1) + (size_t)(token - T_LAT) * 1024 + nl;
        }
        f32x4 xi = *(const f32x4*)src;
        f32x4 r;
        r[0] = xi[0] + gt[0] * v[0]; r[1] = xi[1] + gt[1] * v[1]; r[2] = xi[2] + gt[2] * v[2]; r[3] = xi[3] + gt[3] * v[3];
        *(f32x4*)dst = r;
      }
    }
  }
}

DI void merge_tile(const Params& p, int rt, int nti, char* smem, const bool have0 = false, const int nrt = -1, const int nnti = -1) {
  const int WV = p.ph_hi;
  const int tid = tidx(), lane = tid & 63, wid = tid >> 6, wn = wid >> 1, wt = wid & 1;
  const int fr = lane & 15, fq = lane >> 4;
  const int row0 = rt * 128, n0 = nti * 128;
  const u16* WT = (const u16*)(p.ws + OFF_WT);
  const u16* H = (const u16*)(p.ws + OFF_H) + (size_t)row0 * 1024;
  uint2 y[4][4];
#pragma unroll
  for (int i = 0; i < 4; i++)
#pragma unroll
    for (int j = 0; j < 4; j++) y[i][j] = uint2{0u, 0u};
  for (int m = 0; m < 3; m++) {
    uint2 sg[4][4];
    {
      f32x4 acc[4][4];
#pragma unroll
      for (int i = 0; i < 4; i++)
#pragma unroll
        for (int j = 0; j < 4; j++) acc[i][j] = f32x4{0.f, 0.f, 0.f, 0.f};
      const char* baseb = m == 0 ? p.ws + OFF_E : (m == 1 ? p.ws + OFF_E + SZ_TOK1K : p.ws + OFF_D);
      gemm_kloop(H, WT + (size_t)(11280 + m * 1024 + n0) * 1024, acc, smem, WV, have0 || m > 0,
                 (const u16*)baseb + (size_t)row0 * 1024, WT + (size_t)(W_BR + m * 1024 + n0) * 1024);
#pragma unroll
      for (int i = 0; i < 4; i++)
#pragma unroll
        for (int j = 0; j < 4; j++)
          sg[i][j] = uint2{pack2(sigm(acc[i][j][0]), sigm(acc[i][j][1])), pack2(sigm(acc[i][j][2]), sigm(acc[i][j][3]))};
    }
    {
      const char* base = m == 0 ? p.ws + OFF_E : (m == 1 ? p.ws + OFF_E + SZ_TOK1K : p.ws + OFF_D);
      f32x4 acc[4][4];
#pragma unroll
      for (int i = 0; i < 4; i++)
#pragma unroll
        for (int j = 0; j < 4; j++) acc[i][j] = f32x4{0.f, 0.f, 0.f, 0.f};
      const u16* nA = m < 2 ? H : (nrt >= 0 ? (const u16*)(p.ws + OFF_H) + (size_t)nrt * 128 * 1024 : nullptr);
      const u16* nW = m < 2 ? WT + (size_t)(11280 + (m + 1) * 1024 + n0) * 1024 : (nrt >= 0 ? WT + (size_t)(11280 + nnti * 128) * 1024 : nullptr);
      gemm_kloop((const u16*)base + (size_t)row0 * 1024, WT + (size_t)(W_BR + m * 1024 + n0) * 1024, acc, smem, WV, true, nA, nW);
#pragma unroll
      for (int i = 0; i < 4; i++)
#pragma unroll
        for (int j = 0; j < 4; j++) {
          const float y0 = bf2f((u16)(y[i][j].x & 0xffff)) + acc[i][j][0] * bf2f((u16)(sg[i][j].x & 0xffff));
          const float y1 = bf2f((u16)(y[i][j].x >> 16)) + acc[i][j][1] * bf2f((u16)(sg[i][j].x >> 16));
          const float y2 = bf2f((u16)(y[i][j].y & 0xffff)) + acc[i][j][2] * bf2f((u16)(sg[i][j].y & 0xffff));
          const float y3 = bf2f((u16)(y[i][j].y >> 16)) + acc[i][j][3] * bf2f((u16)(sg[i][j].y >> 16));
          y[i][j] = uint2{pack2(y0, y1), pack2(y2, y3)};
        }
    }
  }
  u16* Y = (u16*)(p.ws + OFF_B);
#pragma unroll
  for (int ti = 0; ti < 4; ti++) {
    const int token = row0 + wt * 64 + ti * 16 + fr;
#pragma unroll
    for (int ni = 0; ni < 4; ni++) {
      const int nl = n0 + wn * 64 + ni * 16 + fq * 4;
      *(uint2*)(Y + (size_t)token * 1024 + nl) = y[ni][ti];
    }
  }
}

DI void wconv_tile(const float* __restrict__ src, int N, int kt, int ntile, u16* __restrict__ dst, char* smem, const int WV) {
  float* s = (float*)smem;
  const int tid = tidx();
  const int k0 = kt * 64, n0 = ntile * 64;
#pragma unroll
  for (int i = 0; i < 4; i++) {
    const int r = (tid >> 4) + i * 16, c4 = (tid & 15) * 4;
    if (n0 + c4 < N) {
      f32x4 v = *(const f32x4*)(src + (size_t)(k0 + r) * N + n0 + c4);
      s[r * 65 + c4] = v[0]; s[r * 65 + c4 + 1] = v[1]; s[r * 65 + c4 + 2] = v[2]; s[r * 65 + c4 + 3] = v[3];
    }
  }
  __syncthreads();
#pragma unroll
  for (int i = 0; i < 2; i++) {
    const int id = tid + i * 256, n = id >> 3, kc = (id & 7) * 8;
    if (n0 + n < N) {
      uint4 o;
      o.x = pack2(s[(kc + 0) * 65 + n], s[(kc + 1) * 65 + n]);
      o.y = pack2(s[(kc + 2) * 65 + n], s[(kc + 3) * 65 + n]);
      o.z = pack2(s[(kc + 4) * 65 + n], s[(kc + 5) * 65 + n]);
      o.w = pack2(s[(kc + 6) * 65 + n], s[(kc + 7) * 65 + n]);
      *(uint4*)(dst + (size_t)(n0 + n) * 1024 + k0 + kc) = o;
    }
  }
  __syncthreads();
}
constexpr int WCONV_UNITS = 16 * 225 + 3 * 256 + 256;
DI void wconv_unit(const Params& p, int l, int u, char* smem) {
  const int WV = p.ph_hi;
  u16* WT = (u16*)(p.ws + OFF_WT);
  if (u < 16 * 225) wconv_tile(p.w_in + (size_t)l * 1024 * 14352, 14352, u / 225, u % 225, WT, smem, WV);
  else if (u < 16 * 225 + 768) {
    const int v = u - 16 * 225, m = v >> 8, r = v & 255;
    wconv_tile(p.w_branch + ((size_t)l * 3 + m) * 1024 * 1024, 1024, r >> 4, r & 15, WT + (size_t)(W_BR + m * 1024) * 1024, smem, WV);
  } else {
    const int r = u - 16 * 225 - 768;
    wconv_tile(p.w_out + (size_t)l * 1024 * 1024, 1024, r >> 4, r & 15, WT + (size_t)W_OUT * 1024, smem, WV);
  }
}

DI void adaln_unit(const Params& p, int u, char* smem) {
  const int WV = p.ph_hi;
  const int l = u / 48, ng = u % 48;
  const int tid = tidx(), lane = tid & 63, w = tid >> 6;
  const int n = ng * 64 + lane;
  const float* W = p.ada_w + (size_t)l * 1024 * 3072;
  float* ssc = (float*)smem + 1024;
  for (int i = tid; i < 3072; i += 256) {
    const float cv = i < 2048 ? p.c[i] : p.c_ctx[i - 2048];
    ssc[i] = silu(cv);
  }
  __syncthreads();
  float a0 = 0.f, a1 = 0.f, a2 = 0.f;
#pragma unroll 8
  for (int k = w * 256; k < w * 256 + 256; k++) {
    const float wv = W[(size_t)k * 3072 + n];
    a0 += ssc[k] * wv; a1 += ssc[1024 + k] * wv; a2 += ssc[2048 + k] * wv;
  }
  float* red = (float*)smem;
  red[(w * 3 + 0) * 64 + lane] = a0; red[(w * 3 + 1) * 64 + lane] = a1; red[(w * 3 + 2) * 64 + lane] = a2;
  __syncthreads();
  if (tid < 192) {
    const int vec = tid >> 6, ln = tid & 63;
    float s = red[(0 * 3 + vec) * 64 + ln] + red[(1 * 3 + vec) * 64 + ln] + red[(2 * 3 + vec) * 64 + ln] + red[(3 * 3 + vec) * 64 + ln];
    const int nn = ng * 64 + ln;
    ((float*)(p.ws + OFF_MOD))[((size_t)l * 3 + vec) * 3072 + nn] = s + p.ada_b[(size_t)l * 3072 + nn];
  }
  __syncthreads();
}

DI void phase_pro(const Params& p, char* smem) {
  const int WV = p.ph_hi;
  const int total = 96 + 16 + WCONV_UNITS;
  for (int u = blockIdx.x; u < total; u += gridDim.x) {
    if (u < 96) adaln_unit(p, u, smem);
    else if (u < 112) {
      const int id = (u - 96) * 256 + tidx();
      const int pos = id >> 5, m = id & 31;
      const float inv = powf(10000.f, -(float)(2 * m) / 64.f);
      float s, c;
      sincosf((float)pos * inv, &s, &c);
      float* ROT = (float*)(p.ws + OFF_ROT);
      ROT[id * 2] = c; ROT[id * 2 + 1] = s;
    } else wconv_unit(p, 0, u - 112, smem);
  }
}

DI void phase_norm(const Params& p, int l, char* smem) {
  const int WV = p.ph_hi;
  const int tid = tidx(), lane = tid & 63, w = tid >> 6;
  float* sW = (float*)smem;
  const float* win = p.w_in + (size_t)l * 1024 * 14352;
  for (int i = tid; i < 16 * 1024; i += 256) {
    const int k = i >> 4, cc = i & 15;
    sW[cc * 1024 + k] = win[(size_t)k * 14352 + 3072 + cc];
  }
  __syncthreads();
  const float* MOD = (const float*)(p.ws + OFF_MOD);
  const float* nw = p.norm_w + (size_t)l * 1024;
  u16* H = (u16*)(p.ws + OFF_H);
  float* GB = (float*)(p.ws + OFF_GB);
  for (int row = blockIdx.x * 4 + w; row < T_ALL; row += gridDim.x * 4) {
    const float* xr;
    int vec;
    if (row < T_LAT) { xr = (l == 0 ? p.x : (const float*)p.out) + (size_t)row * 1024; vec = row >> 13; }
    else { xr = (l == 0 ? p.ctx : (const float*)(p.ws + OFF_CTX1)) + (size_t)(row - T_LAT) * 1024; vec = 2; }
    const float* md = MOD + ((size_t)l * 3 + vec) * 3072;
    f32x4 xv[4];
    float ss = 0.f;
#pragma unroll
    for (int i = 0; i < 4; i++) {
      xv[i] = *(const f32x4*)(xr + i * 256 + lane * 4);
      ss += xv[i][0] * xv[i][0] + xv[i][1] * xv[i][1] + xv[i][2] * xv[i][2] + xv[i][3] * xv[i][3];
    }
    ss = wsum(ss);
    const float rstd = rsqrtf(ss * (1.f / 1024.f) + 1e-6f);
    float ab[16];
#pragma unroll
    for (int cc = 0; cc < 16; cc++) ab[cc] = 0.f;
#pragma unroll
    for (int i = 0; i < 4; i++) {
      const int k = i * 256 + lane * 4;
      const f32x4 wv = *(const f32x4*)(nw + k);
      const f32x4 sh = *(const f32x4*)(md + k);
      const f32x4 sc = *(const f32x4*)(md + 1024 + k);
      f32x4 h;
#pragma unroll
      for (int j = 0; j < 4; j++) h[j] = xv[i][j] * rstd * wv[j] * (1.f + sc[j]) + sh[j];
      *(uint2*)(H + (size_t)row * 1024 + k) = uint2{pack2(h[0], h[1]), pack2(h[2], h[3])};
      asm volatile("" ::: "memory");
#pragma unroll
      for (int cc = 0; cc < 16; cc++) {
        const f32x4 ww = *(const f32x4*)(sW + cc * 1024 + k);
        ab[cc] += h[0] * ww[0] + h[1] * ww[1] + h[2] * ww[2] + h[3] * ww[3];
      }
    }
#pragma unroll
    for (int cc = 0; cc < 16; cc++) ab[cc] = wsum(ab[cc]);
    if (lane < 16) {
      float v = 0.f;
#pragma unroll
      for (int cc = 0; cc < 16; cc++) if (lane == cc) v = ab[cc];
      float r;
      if (lane < 8) {
        const float A = __expf(p.dn_a_log[l * 8 + lane]);
        const float z = v + p.dn_dt_bias[l * 8 + lane];
        const float sp = z > 20.f ? z : log1pf(__expf(z));
        r = -A * sp;
      } else r = sigm(v);
      GB[(size_t)row * 16 + lane] = r;
    }
  }
  __syncthreads();
}

DI void xyT(const char* sX, const char* sY, int it, f32x4 (&acc)[4], const int WV) {
  const int lane = tidx() & 63, fr = lane & 15, fq = lane >> 4;
#pragma unroll
  for (int j = 0; j < 4; j++) acc[j] = f32x4{0.f, 0.f, 0.f, 0.f};
#pragma unroll
  for (int ks = 0; ks < 4; ks++) {
    const bf16x8 a = *(const bf16x8*)(sX + (it * 16 + fr) * 272 + (ks * 32 + fq * 8) * 2);
#pragma unroll
    for (int jt = 0; jt < 4; jt++) {
      const bf16x8 b = *(const bf16x8*)(sY + (jt * 16 + fr) * 272 + (ks * 32 + fq * 8) * 2);
      acc[jt] = mfma16(a, b, acc[jt]);
    }
  }
}

DI void dn_prep_unit(const Params& p, int l, int c, int h, char* smem) {
  const int WV = p.ph_hi;
  const int tid = tidx(), lane = tid & 63, w = tid >> 6;
  u16* QKV = (u16*)(p.ws + OFF_A);
  const u16* HALO = (const u16*)(p.ws + OFF_HALO);
  char* sQ = smem;
  char* sK = smem + 17408;
  float* sKK = (float*)(smem + 34816);
  float* sQK = (float*)(smem + 34816 + 16384);
  float* sGC = (float*)(smem + 34816 + 32768);
  float* sBT = sGC + 128;
  const int row0 = c * 64;
  {
    const int u = tid * 2;
    const int gcol = u < 128 ? h * 128 + u : (u < 256 ? 512 + h * 128 + (u - 128) : 1024 + h * 256 + (u - 256));
    bool first, last;
    if (c < 256) { first = (c & 127) == 0; last = (c & 127) == 127; }
    else { first = ((c - 256) & 3) == 0; last = ((c - 256) & 3) == 3; }
    const float* cw = p.dn_conv + (size_t)l * 5 * 2048 + gcol;
    float cw0[5], cw1[5];
#pragma unroll
    for (int j = 0; j < 5; j++) { cw0[j] = cw[j * 2048]; cw1[j] = cw[j * 2048 + 1]; }
    const u16* own = QKV + (size_t)row0 * 2048 + gcol;
    const u16* hl = first ? own : HALO + ((size_t)(c - 1) * 4 + 2) * 2048 + gcol;
    const u16* hr = last ? own : HALO + ((size_t)(c + 1) * 4) * 2048 + gcol;
    unsigned cat[12], nxt[8], nx2[8];
    {
      const unsigned a = *(const unsigned*)hl, b = *(const unsigned*)(hl + 2048);
      cat[0] = first ? 0u : a; cat[1] = first ? 0u : b;
      cat[2] = *(const unsigned*)own; cat[3] = *(const unsigned*)(own + 2048);
    }
#pragma unroll
    for (int i = 0; i < 8; i++) nxt[i] = *(const unsigned*)(own + (size_t)(2 + i) * 2048);
#pragma unroll
    for (int i = 0; i < 8; i++) nx2[i] = *(const unsigned*)(own + (size_t)(10 + i) * 2048);
    for (int tb = 0; tb < 8; tb++) {
#pragma unroll
      for (int i = 0; i < 8; i++) { cat[4 + i] = nxt[i]; nxt[i] = nx2[i]; }
      if (tb < 6) {
        const bool lastb = tb == 5;
#pragma unroll
        for (int i = 0; i < 8; i++) {
          const u16* pp = (lastb && i >= 6) ? hr + (size_t)(i - 6) * 2048 : own + (size_t)(2 + (tb + 2) * 8 + i) * 2048;
          const unsigned v = *(const unsigned*)pp;
          nx2[i] = (lastb && i >= 6 && last) ? 0u : v;
        }
      }
#pragma unroll
      for (int i = 0; i < 8; i++) {
        const int t = tb * 8 + i;
        float y0 = 0.f, y1 = 0.f;
#pragma unroll
        for (int j = 0; j < 5; j++) {
          y0 += cw0[j] * bf2f((u16)(cat[i + j] & 0xffff));
          y1 += cw1[j] * bf2f((u16)(cat[i + j] >> 16));
        }
        y0 = silu(y0); y1 = silu(y1);
        if (w < 2) {
          const float ss = wsum(y0 * y0 + y1 * y1);
          float rs = rsqrtf(ss + 1e-6f);
          if (w == 0) rs *= 0.08838834764831845f;
          y0 *= rs; y1 *= rs;
          const unsigned pk = pack2(y0, y1);
          *(unsigned*)((w == 0 ? sQ : sK) + t * 272 + (u & 127) * 2) = pk;
          *(unsigned*)(QKV + (size_t)(row0 + t) * 2048 + gcol) = pk;
        } else {
          *(unsigned*)(QKV + (size_t)(row0 + t) * 2048 + gcol) = pack2(y0, y1);
        }
      }
#pragma unroll
      for (int i = 0; i < 4; i++) cat[i] = cat[8 + i];
    }
  }
  if (w < 2) {
    const float* GB = (const float*)(p.ws + OFF_GB);
    const float g = GB[(size_t)(row0 + lane) * 16 + w * 4 + h];
    const float bt = GB[(size_t)(row0 + lane) * 16 + 8 + w * 4 + h];
    float s = g;
    if (w == 0) {
#pragma unroll
      for (int o = 1; o < 64; o <<= 1) { const float t = __shfl_up(s, o, 64); if (lane >= o) s += t; }
    } else {
#pragma unroll
      for (int o = 1; o < 64; o <<= 1) { const float t = __shfl_down(s, o, 64); if (lane + o < 64) s += t; }
    }
    const float gl = __shfl(s, w == 0 ? 63 : 0, 64);
    sGC[w * 64 + lane] = s;
    sBT[w * 64 + lane] = bt;
    float* SC = (float*)(p.ws + OFF_DNSC) + ((size_t)(c * 4 + h) * 2 + w) * 192;
    SC[lane] = __expf(s);
    SC[64 + lane] = __expf(gl - s);
    if (lane == 0) SC[128] = __expf(gl);
  }
  __syncthreads();
  {
    const int fr = lane & 15, fq = lane >> 4;
    f32x4 acc[4];
    xyT(sK, sK, w, acc, WV);
#pragma unroll
    for (int jt = 0; jt < 4; jt++)
#pragma unroll
      for (int j = 0; j < 4; j++) sKK[(w * 16 + fq * 4 + j) * 64 + jt * 16 + fr] = acc[jt][j];
    xyT(sQ, sK, w, acc, WV);
#pragma unroll
    for (int jt = 0; jt < 4; jt++)
#pragma unroll
      for (int j = 0; j < 4; j++) sQK[(w * 16 + fq * 4 + j) * 64 + jt * 16 + fr] = acc[jt][j];
  }
  __syncthreads();
  u16* AUX = (u16*)(p.ws + OFF_B) + (size_t)(c * 4 + h) * 4 * 4096;
#pragma unroll 2
  for (int e = 0; e < 32; e++) {
    const int id = tid + e * 256, dir = id >> 12, i = (id >> 6) & 63, j = id & 63;
    const bool valid = dir == 0 ? (j <= i) : (j >= i);
    float v = 0.f;
    if (valid) v = sQK[i * 64 + j] * __expf(sGC[dir * 64 + i] - sGC[dir * 64 + j]);
    AUX[(size_t)(dir * 2 + 1) * 4096 + i * 64 + j] = f2bf(v);
  }
  __syncthreads();
  float* sL0 = sQK;
  float* sL1 = (float*)smem;
#pragma unroll 2
  for (int e = 0; e < 32; e++) {
    const int id = tid + e * 256, dir = id >> 12, ip = (id >> 6) & 63, jp = id & 63;
    const int i = dir ? 63 - ip : ip, j = dir ? 63 - jp : jp;
    float v = 0.f;
    if (jp < ip) v = sBT[dir * 64 + i] * sKK[i * 64 + j] * __expf(sGC[dir * 64 + i] - sGC[dir * 64 + j]);
    (dir ? sL1 : sL0)[ip * 64 + jp] = v;
  }
  __syncthreads();
  if (w < 2) {
    const float* L = w ? sL1 : sL0;
    const int cn = w ? 63 - lane : lane;
    const float bc = sBT[w * 64 + cn];
    f32x4 Lb[2][16];
    float T[64];
#pragma unroll
    for (int i = 0; i < 64; i++) {
      if (i + 1 < 64) {
#pragma unroll
        for (int b4 = 0; b4 < (i + 1 + 3) / 4; b4++) Lb[(i + 1) & 1][b4] = *(const f32x4*)(L + (i + 1) * 64 + 4 * b4);
      }
      asm volatile("" ::: "memory");
      float a0 = (i == lane) ? 1.f : 0.f, a1 = 0.f, a2 = 0.f, a3 = 0.f;
#pragma unroll
      for (int r = 0; r < i; r++) {
        const float lv = Lb[i & 1][r >> 2][r & 3];
        if ((r & 3) == 0) a0 -= lv * T[r];
        else if ((r & 3) == 1) a1 -= lv * T[r];
        else if ((r & 3) == 2) a2 -= lv * T[r];
        else a3 -= lv * T[r];
      }
      T[i] = (a0 + a1) + (a2 + a3);
    }
#pragma unroll
    for (int ip = 0; ip < 64; ip++) {
      const int i = w ? 63 - ip : ip;
      AUX[(size_t)(w * 2 + 0) * 4096 + i * 64 + cn] = f2bf(T[ip] * bc);
    }
  }
  __syncthreads();
}

DI void ret_prep_unit(const Params& p, int l, int c, int h, char* smem) {
  const int WV = p.ph_hi;
  const int tid = tidx(), lane = tid & 63, w = tid >> 6;
  const u16* QKV = (const u16*)(p.ws + OFF_A + 2 * SZ_TOK1K);
  char* sQ = smem;
  char* sK = smem + 17408;
  const int row0 = c * 64;
#pragma unroll
  for (int i = 0; i < 4; i++) {
    const int id = tid + i * 256, r = id >> 4, ch = id & 15;
    *(uint4*)(sQ + r * 272 + ch * 16) = *(const uint4*)(QKV + (size_t)(row0 + r) * 2048 + h * 128 + ch * 8);
    *(uint4*)(sK + r * 272 + ch * 16) = *(const uint4*)(QKV + (size_t)(row0 + r) * 2048 + 512 + h * 128 + ch * 8);
  }
  __syncthreads();
  f32x4 acc[4];
  xyT(sQ, sK, w, acc, WV);
  const int fr = lane & 15, fq = lane >> 4;
  u16* AUX = (u16*)(p.ws + OFF_C) + (size_t)(c * 4 + h) * 2 * 4096;
#pragma unroll
  for (int dir = 0; dir < 2; dir++) {
    const float rd = p.ret_decay[l * 8 + dir * 4 + h];
    const float lam = fminf(rd, 0.f) - log1pf(__expf(-fabsf(rd)));
#pragma unroll
    for (int jt = 0; jt < 4; jt++)
#pragma unroll
      for (int j = 0; j < 4; j++) {
        const int i = w * 16 + fq * 4 + j, jj = jt * 16 + fr;
        const int dd = dir == 0 ? i - jj : jj - i;
        const float v = dd >= 0 ? acc[jt][j] * __expf(lam * (float)dd) : 0.f;
        AUX[(size_t)dir * 4096 + i * 64 + jj] = f2bf(v);
      }
  }
  __syncthreads();
}

DI void hg_prep_unit(const Params& p, int l, int c, int h, char* smem) {
  const int WV = p.ph_hi;
  const int tid = tidx();
  u16* QFI = (u16*)(p.ws + OFF_A);
  u16* HGX = (u16*)(p.ws + OFF_B);
  float* sG = (float*)smem;
  u16* sQ = (u16*)(smem + 33280);
  u16* sK = (u16*)(smem + 50176);
  float* sTot = (float*)(smem + 67072);
  const int row0 = c * 64;
#pragma unroll
  for (int i = 0; i < 4; i++) {
    const int id = tid + i * 256, r = id >> 4, ch = id & 15;
    const uint4 v = *(const uint4*)(QFI + (size_t)(row0 + r) * 4096 + h * 128 + ch * 8);
    const unsigned vv[4] = {v.x, v.y, v.z, v.w};
#pragma unroll
    for (int e = 0; e < 4; e++) {
      sQ[(ch * 8 + e * 2) * 66 + r] = (u16)(vv[e] & 0xffff);
      sQ[(ch * 8 + e * 2 + 1) * 66 + r] = (u16)(vv[e] >> 16);
    }
  }
  __syncthreads();
  const int half = tid >> 7, d = tid & 127;
#pragma unroll 1
  for (int dir = 1; dir >= 0; dir--) {
    float lo = 0.f;
    if (l == 1) {
      const float b0 = p.hg_lb[dir * 1024 + h * 128 + d], b1 = p.hg_lb[2048 + dir * 1024 + h * 128 + d];
      lo = sigm(b1 - b0);
    }
    float run = 0.f;
    {
      const u16* xs = QFI + (size_t)row0 * 4096 + 1024 + dir * 1024 + h * 128 + d;
      float xv[32];
#pragma unroll
      for (int i = 0; i < 32; i++) xv[i] = bf2f(xs[(size_t)(half * 32 + (dir == 0 ? i : 31 - i)) * 4096]);
#pragma unroll
      for (int i = 0; i < 32; i++) {
        const int ii = dir == 0 ? i : 31 - i;
        const int t = half * 32 + ii;
        const float x = xv[i];
        const float sg = sigm(x);
        const float f = lo + (1.f - lo) * sg;
        const float omf = (1.f - lo) * (1.f - sg);
        run += __log2f(f);
        sG[d * 65 + t] = run;
        sK[d * 66 + t] = f2bf(omf);
      }
      sTot[half * 128 + d] = run;
    }
    __syncthreads();
    {
      const float t0 = sTot[d], t1 = sTot[128 + d];
      const float gtot = t0 + t1;
      const float add = dir == 0 ? (half == 1 ? t0 : 0.f) : (half == 0 ? t1 : 0.f);
      u16* qdst = dir == 0 ? QFI + (size_t)row0 * 4096 + h * 128 + d : HGX + (size_t)row0 * 1024 + h * 128 + d;
      const size_t qp = dir == 0 ? 4096 : 1024;
      u16* kdst = QFI + (size_t)row0 * 4096 + 1024 + dir * 1024 + h * 128 + d;
#pragma unroll 8
      for (int i = 0; i < 32; i++) {
        const int t = half * 32 + i;
        const float G = sG[d * 65 + t] + add;
        sG[d * 65 + t] = G;
        qdst[(size_t)t * qp] = f2bf(bf2f(sQ[d * 66 + t]) * __builtin_amdgcn_exp2f(G));
        kdst[(size_t)t * 4096] = f2bf(bf2f(sK[d * 66 + t]) * __builtin_amdgcn_exp2f(gtot - G));
      }
      if (half == 0) ((float*)(p.ws + OFF_HGDEC))[((size_t)(c * 8 + h) * 2 + dir) * 128 + d] = __builtin_amdgcn_exp2f(gtot);
    }
    __syncthreads();
    {
      const int lane = tid & 63, I = tid >> 6, fr = lane & 15, fq = lane >> 4;
      const int rt = dir == 0 ? I * 16 - 1 : I * 16 + 16;
      const bool hasref = dir == 0 ? (I > 0) : (I < 3);
      bf16x8 af[4];
#pragma unroll
      for (int ks = 0; ks < 4; ks++) {
        asm volatile("" ::: "memory");
#pragma unroll
        for (int j = 0; j < 8; j++) {
          const int dd = ks * 32 + fq * 8 + j;
          const float R = hasref ? sG[dd * 65 + rt] : 0.f;
          const float e = __builtin_amdgcn_exp2f(fmaxf(sG[dd * 65 + I * 16 + fr] - R, -120.f));
          af[ks][j] = (short)f2bf(bf2f(sQ[dd * 66 + I * 16 + fr]) * e);
        }
      }
      u16* AUX = (u16*)(p.ws + OFF_C) + ((size_t)(c * 8 + h) * 2 + dir) * 4096;
#pragma unroll 1
      for (int J = 0; J < 4; J++) {
        const bool actv = dir == 0 ? (J <= I) : (J >= I);
        f32x4 acc = f32x4{0.f, 0.f, 0.f, 0.f};
        if (actv) {
#pragma unroll
          for (int ks = 0; ks < 4; ks++) {
            asm volatile("" ::: "memory");
            bf16x8 bfr;
#pragma unroll
            for (int j = 0; j < 8; j++) {
              const int dd = ks * 32 + fq * 8 + j;
              const float R = hasref ? sG[dd * 65 + rt] : 0.f;
              const float e = __builtin_amdgcn_exp2f(fminf(R - sG[dd * 65 + J * 16 + fr], 120.f));
              bfr[j] = (short)f2bf(bf2f(sK[dd * 66 + J * 16 + fr]) * e);
            }
            acc = mfma16(af[ks], bfr, acc);
          }
        }
#pragma unroll
        for (int jj = 0; jj < 4; jj++) {
          const int i = I * 16 + fq * 4 + jj, j = J * 16 + fr;
          const bool valid = actv && (dir == 0 ? (j <= i) : (j >= i));
          AUX[i * 64 + j] = f2bf(valid ? acc[jj] : 0.f);
        }
      }
    }
    __syncthreads();
  }
}

struct ScanDesc {
  const u16 *q, *k, *v;
  int qp, kp, vp;
  const u16* aux;
  size_t aux_cs;
  int attn_off, ainv_off;
  u16* o;
  int mixer, b, dir;
  const float* sc;
  size_t sc_cs;
  float lam;
};

DI int scan_chunk_of(int dir, int b, int step) {
  if (dir == 0) return step < 4 ? 256 + 4 * b + step : 128 * b + (step - 4);
  return step < 4 ? 256 + 4 * b + (3 - step) : 128 * b + (131 - step);
}
template <int MIXER>
DI void scan_prefetch(const u16* sq, const u16* sk, const u16* sv, int qp, int kp, int vp, const u16* saux, size_t aux_cs, int attn_off, int ainv_off,
                      const float* ssc, size_t sc_cs, int c, int tid, int w, int fr, int fq, u32x4 (&rq)[4], u32x4 (&rk)[4], u32x4 (&rat)[2], u32x4 (&rai)[2],
                      unsigned (&rv)[8], float& rsc, float& regl) {
  struct { const u16 *q, *k, *v; int qp, kp, vp; const u16* aux; size_t aux_cs; int attn_off, ainv_off; const float* sc; size_t sc_cs; } s =
      {sq, sk, sv, qp, kp, vp, saux, aux_cs, attn_off, ainv_off, ssc, sc_cs};
  const int row0 = c * 64;
  const u16* qbase = s.q + (size_t)row0 * s.qp;
  const u16* kbase = s.k + (size_t)row0 * s.kp;
  const u16* vbase = s.v + (size_t)row0 * s.vp;
  const unsigned qoff = (unsigned)((tid >> 4) * s.qp + (tid & 15) * 8);
  const unsigned koff = (unsigned)((tid >> 4) * s.kp + (tid & 15) * 8);
#pragma unroll
  for (int i = 0; i < 4; i++) {
    rq[i] = *(const u32x4*)(qbase + (size_t)(i * 16) * s.qp + qoff);
    rk[i] = *(const u32x4*)(kbase + (size_t)(i * 16) * s.kp + koff);
  }
  const u16* ab = s.aux + (size_t)c * s.aux_cs;
  const unsigned aoff = (unsigned)((tid >> 3) * 64 + (tid & 7) * 8);
#pragma unroll
  for (int i = 0; i < 2; i++) {
    rat[i] = *(const u32x4*)(ab + s.attn_off + i * 32 * 64 + aoff);
    if (MIXER == 0) rai[i] = *(const u32x4*)(ab + s.ainv_off + i * 32 * 64 + aoff);
  }
  if (MIXER == 0) {
    const float* sc = s.sc + (size_t)c * s.sc_cs;
    if (tid < 128) rsc = sc[tid];
    regl = sc[128];
  } else if (MIXER == 2) {
    if (tid < 128) rsc = s.sc[(size_t)c * s.sc_cs + tid];
  }
  const unsigned voff = (unsigned)(fq * 4 * s.vp + w * 16 + fr);
#pragma unroll
  for (int mt = 0; mt < 4; mt++)
#pragma unroll
    for (int jp = 0; jp < 2; jp++) {
      const unsigned lo = (vbase + (size_t)(mt * 16 + jp * 2) * s.vp)[voff];
      const unsigned hi = (vbase + (size_t)(mt * 16 + jp * 2 + 1) * s.vp)[voff];
      rv[mt * 2 + jp] = lo | (hi << 16);
    }
}

template <int MIXER>
DI void scan_unit(const ScanDesc& s, char* smem, const int WV) {
  const int tid = tidx(), lane = tid & 63, w = tid >> 6;
  const int fr = lane & 15, fq = lane >> 4;
  char* sQm = smem;
  char* sKm = smem + 17408;
  const unsigned km_tr = (unsigned)(size_t)sKm + (unsigned)((fq * 4 + ((lane & 15) >> 2)) * 272 + (lane & 3) * 8);
  char* sAT = smem + 53248;
  char* sAI = smem + 62464;
  float* sSC = (float*)(smem + 71680);
  f32x4 S[8];
#pragma unroll
  for (int i = 0; i < 8; i++) S[i] = f32x4{0.f, 0.f, 0.f, 0.f};
  u32x4 rq[4], rk[4], rat[2], rai[2];
  rai[0] = u32x4{0u, 0u, 0u, 0u}; rai[1] = rai[0];
  unsigned rv[8];
  float rsc = 0.f, regl = 1.f;
  scan_prefetch<MIXER>(s.q, s.k, s.v, s.qp, s.kp, s.vp, s.aux, s.aux_cs, s.attn_off, s.ainv_off, s.sc, s.sc_cs, scan_chunk_of(s.dir, s.b, 0), tid, w, fr, fq, rq, rk, rat, rai, rv, rsc, regl);
  for (int step = 0; step < 132; step++) {
    const int c = scan_chunk_of(s.dir, s.b, step);
    const int row0 = c * 64;
#pragma unroll
    for (int i = 0; i < 4; i++) {
      const int id = tid + i * 256, r = id >> 4, ch = id & 15;
      *(u32x4*)(sQm + r * 272 + ch * 16) = rq[i];
      *(u32x4*)(sKm + r * 272 + ch * 16) = rk[i];
    }
#pragma unroll
    for (int i = 0; i < 2; i++) {
      const int id = tid + i * 256, r = id >> 3, ch = id & 7;
      *(u32x4*)(sAT + r * 144 + ch * 16) = rat[i];
      if (MIXER == 0) *(u32x4*)(sAI + r * 144 + ch * 16) = rai[i];
    }
    float egl = 1.f;
    if (MIXER == 0) {
      if (tid < 128) sSC[tid] = rsc;
      egl = regl;
    } else if (MIXER == 1) {
      if (tid < 64) {
        const float e1 = s.dir == 0 ? (float)(tid + 1) : (float)(64 - tid);
        sSC[tid] = __expf(s.lam * e1);
        sSC[64 + tid] = __expf(s.lam * (64.f - e1));
      }
      egl = __expf(s.lam * 64.f);
    } else {
      if (tid < 128) sSC[tid] = rsc;
    }
    f32x4 V[4];
#pragma unroll
    for (int mt = 0; mt < 4; mt++) {
      V[mt][0] = bf2f((u16)(rv[mt * 2] & 0xffff)); V[mt][1] = bf2f((u16)(rv[mt * 2] >> 16));
      V[mt][2] = bf2f((u16)(rv[mt * 2 + 1] & 0xffff)); V[mt][3] = bf2f((u16)(rv[mt * 2 + 1] >> 16));
    }
    __syncthreads();
    if (step + 1 < 132) scan_prefetch<MIXER>(s.q, s.k, s.v, s.qp, s.kp, s.vp, s.aux, s.aux_cs, s.attn_off, s.ainv_off, s.sc, s.sc_cs, scan_chunk_of(s.dir, s.b, step + 1), tid, w, fr, fq, rq, rk, rat, rai, rv, rsc, regl);
    bf16x8 Sb[4];
#pragma unroll
    for (int ks = 0; ks < 4; ks++) Sb[ks] = pack8(S[2 * ks], S[2 * ks + 1]);
    f32x4 vn[4];
    f32x4 oq[4];
#pragma unroll
    for (int mt = 0; mt < 4; mt++) oq[mt] = f32x4{0.f, 0.f, 0.f, 0.f};
    if (MIXER == 0) {
      f32x4 P[4];
      bf16x8 aai[2][4];
#pragma unroll
      for (int ks = 0; ks < 2; ks++)
#pragma unroll
        for (int mt = 0; mt < 4; mt++) aai[ks][mt] = ld_perm(sAI + (mt * 16 + fr) * 144, ks * 32 + fq * 4);
#pragma unroll
      for (int mt = 0; mt < 4; mt++) P[mt] = f32x4{0.f, 0.f, 0.f, 0.f};
#pragma unroll
      for (int ks = 0; ks < 4; ks++) {
        bf16x8 ak[4], aq[4];
#pragma unroll
        for (int mt = 0; mt < 4; mt++) { ak[mt] = ld_perm(sKm + (mt * 16 + fr) * 272, ks * 32 + fq * 4); aq[mt] = ld_perm(sQm + (mt * 16 + fr) * 272, ks * 32 + fq * 4); }
#pragma unroll
        for (int mt = 0; mt < 4; mt++) P[mt] = mfma16(ak[mt], Sb[ks], P[mt]);
#pragma unroll
        for (int mt = 0; mt < 4; mt++) oq[mt] = mfma16(aq[mt], Sb[ks], oq[mt]);
      }
#pragma unroll
      for (int mt = 0; mt < 4; mt++)
#pragma unroll
        for (int j = 0; j < 4; j++) P[mt][j] = V[mt][j] - sSC[mt * 16 + fq * 4 + j] * P[mt][j];
      bf16x8 rb[2];
#pragma unroll
      for (int ks = 0; ks < 2; ks++) rb[ks] = pack8(P[2 * ks], P[2 * ks + 1]);
#pragma unroll
      for (int mt = 0; mt < 4; mt++) vn[mt] = f32x4{0.f, 0.f, 0.f, 0.f};
#pragma unroll
      for (int ks = 0; ks < 2; ks++) {
#pragma unroll
        for (int mt = 0; mt < 4; mt++) vn[mt] = mfma16(aai[ks][mt], rb[ks], vn[mt]);
      }
    } else {
#pragma unroll
      for (int ks = 0; ks < 4; ks++) {
        bf16x8 aq[4];
#pragma unroll
        for (int mt = 0; mt < 4; mt++) aq[mt] = ld_perm(sQm + (mt * 16 + fr) * 272, ks * 32 + fq * 4);
#pragma unroll
        for (int mt = 0; mt < 4; mt++) oq[mt] = mfma16(aq[mt], Sb[ks], oq[mt]);
      }
#pragma unroll
      for (int mt = 0; mt < 4; mt++) vn[mt] = V[mt];
    }
    bf16x8 vb[2];
#pragma unroll
    for (int ks = 0; ks < 2; ks++) vb[ks] = pack8(vn[2 * ks], vn[2 * ks + 1]);
    if (MIXER != 2) {
#pragma unroll
      for (int mt = 0; mt < 4; mt++)
#pragma unroll
        for (int j = 0; j < 4; j++) oq[mt][j] *= sSC[mt * 16 + fq * 4 + j];
    }
#pragma unroll
    for (int ks = 0; ks < 2; ks++) {
      bf16x8 aa[4];
#pragma unroll
      for (int mt = 0; mt < 4; mt++) aa[mt] = ld_perm(sAT + (mt * 16 + fr) * 144, ks * 32 + fq * 4);
#pragma unroll
      for (int mt = 0; mt < 4; mt++) oq[mt] = mfma16(aa[mt], vb[ks], oq[mt]);
    }
    if (MIXER != 2) {
#pragma unroll
      for (int mt = 0; mt < 4; mt++)
#pragma unroll
        for (int j = 0; j < 4; j++) vn[mt][j] *= sSC[64 + mt * 16 + fq * 4 + j];
#pragma unroll
      for (int ks = 0; ks < 2; ks++) vb[ks] = pack8(vn[2 * ks], vn[2 * ks + 1]);
    }
#pragma unroll
    for (int mt = 0; mt < 8; mt++) {
      if (MIXER == 2) {
#pragma unroll
        for (int j = 0; j < 4; j++) S[mt][j] *= sSC[mt * 16 + fq * 4 + j];
      } else {
#pragma unroll
        for (int j = 0; j < 4; j++) S[mt][j] *= egl;
      }
    }
#pragma unroll
    for (int ks = 0; ks < 2; ks++) {
      bf16x8 at[8];
#pragma unroll
      for (int mt = 0; mt < 8; mt++) at[mt] = ld_tr2(km_tr + (unsigned)((ks * 32) * 272 + mt * 32), km_tr + (unsigned)((ks * 32 + 16) * 272 + mt * 32));
#pragma unroll
      for (int mt = 0; mt < 8; mt++) S[mt] = mfma16(at[mt], vb[ks], S[mt]);
    }
    {
      u16* obase = s.o + (size_t)row0 * 1024;
#pragma unroll
      for (int mt = 0; mt < 4; mt++)
#pragma unroll
        for (int j = 0; j < 4; j++) obase[(unsigned)((mt * 16 + fq * 4 + j) * 1024 + w * 16 + fr)] = f2bf(oq[mt][j]);
    }
    __syncthreads();
  }
}

DI void scan_phase_hg(const Params& p, char* smem) {
  const int WV = p.ph_hi;
  if ((blockIdx.x & 3) == 0 && (blockIdx.x >> 2) < 64) {
    const int u = blockIdx.x >> 2;
    const int dir = u & 1, vg = (u >> 1) & 1, h = (u >> 2) & 7, b = u >> 5;
    ScanDesc s;
    s.q = dir == 0 ? (const u16*)(p.ws + OFF_A) + h * 128 : (const u16*)(p.ws + OFF_B) + h * 128;
    s.qp = dir == 0 ? 4096 : 1024;
    s.k = (const u16*)(p.ws + OFF_A) + 1024 + dir * 1024 + h * 128; s.kp = 4096;
    s.v = (const u16*)(p.ws + OFF_A) + 3072 + h * 128 + vg * 64; s.vp = 4096;
    s.aux = (const u16*)(p.ws + OFF_C) + (size_t)(h * 2 + dir) * 4096; s.aux_cs = 8 * 2 * 4096; s.attn_off = 0; s.ainv_off = 0;
    s.o = (u16*)(p.ws + OFF_D + (dir ? SZ_TOK1K : 0)) + h * 128 + vg * 64;
    s.mixer = 2; s.b = b; s.dir = dir;
    s.sc = (const float*)(p.ws + OFF_HGDEC) + (size_t)(h * 2 + dir) * 128; s.sc_cs = 8 * 2 * 128; s.lam = 0.f;
    scan_unit<2>(s, smem, WV);
  }
}
DI void scan_phase_dnret(const Params& p, int l, char* smem) {
  const int WV = p.ph_hi;
  if ((blockIdx.x & 1) == 0 && (blockIdx.x >> 1) < 128) {
    const int u = blockIdx.x >> 1;
    const int mixer = u & 1, dir = (u >> 1) & 1, vg = (u >> 2) & 3, h = (u >> 4) & 3, b = u >> 6;
    ScanDesc s;
    const u16* base = (const u16*)(p.ws + OFF_A + (mixer ? 2 * SZ_TOK1K : 0));
    s.q = base + h * 128; s.k = base + 512 + h * 128; s.v = base + 1024 + h * 256 + vg * 64;
    s.qp = s.kp = s.vp = 2048;
    s.mixer = mixer; s.b = b; s.dir = dir;
    if (mixer == 0) {
      s.aux = (const u16*)(p.ws + OFF_B) + (size_t)(h * 2 + dir) * 2 * 4096; s.aux_cs = 4 * 4 * 4096; s.ainv_off = 0; s.attn_off = 4096;
      s.sc = (const float*)(p.ws + OFF_DNSC) + (size_t)(h * 2 + dir) * 192; s.sc_cs = 4 * 2 * 192; s.lam = 0.f;
      s.o = (u16*)(dir == 0 ? p.ws + OFF_E : p.ws + OFF_D + SZ_TOK1K) + h * 256 + vg * 64;
      scan_unit<0>(s, smem, WV);
    } else {
      s.aux = (const u16*)(p.ws + OFF_C) + (size_t)(h * 2 + dir) * 4096; s.aux_cs = 4 * 2 * 4096; s.attn_off = 0; s.ainv_off = 0;
      const float rd = p.ret_decay[l * 8 + dir * 4 + h];
      s.lam = fminf(rd, 0.f) - log1pf(__expf(-fabsf(rd)));
      s.sc = nullptr; s.sc_cs = 0;
      s.o = (u16*)(p.ws + OFF_E + (dir == 0 ? SZ_TOK1K : 2 * SZ_TOK1K)) + h * 256 + vg * 64;
      scan_unit<1>(s, smem, WV);
    }
  }
}

DI void onorm_rows(u16* of, const u16* ob, const float* nw, int dv, int unit, int nunits_stride, const int WV) {
  const int lane = tidx() & 63, w = tidx() >> 6;
  float nwr[16];
  {
    const int dcol0 = (lane * 16) % dv;
#pragma unroll
    for (int e = 0; e < 4; e++) {
      const f32x4 t4 = *(const f32x4*)(nw + dcol0 + 4 * e);
      nwr[4 * e] = t4[0]; nwr[4 * e + 1] = t4[1]; nwr[4 * e + 2] = t4[2]; nwr[4 * e + 3] = t4[3];
    }
  }
  for (int row = unit * 4 + w; row < T_ALL; row += nunits_stride * 4) {
    u16* pf = of + (size_t)row * 1024 + lane * 16;
    const u16* pb = ob + (size_t)row * 1024 + lane * 16;
    float v[16];
#pragma unroll
    for (int hv = 0; hv < 2; hv++) {
      const uint4 a = *(const uint4*)(pf + hv * 8), b = *(const uint4*)(pb + hv * 8);
      const unsigned aa[4] = {a.x, a.y, a.z, a.w}, bb[4] = {b.x, b.y, b.z, b.w};
#pragma unroll
      for (int e = 0; e < 4; e++) {
        v[hv * 8 + e * 2] = bf2f((u16)(aa[e] & 0xffff)) + bf2f((u16)(bb[e] & 0xffff));
        v[hv * 8 + e * 2 + 1] = bf2f((u16)(aa[e] >> 16)) + bf2f((u16)(bb[e] >> 16));
      }
    }
    float ss = 0.f;
#pragma unroll
    for (int e = 0; e < 16; e++) ss += v[e] * v[e];
    ss = dv == 256 ? gsum(ss, 16) : gsum(ss, 8);
    const float rstd = rsqrtf(ss / (float)dv + 1e-6f);
    unsigned o8[8];
#pragma unroll
    for (int e = 0; e < 8; e++) o8[e] = pack2(v[2 * e] * rstd * nwr[2 * e], v[2 * e + 1] * rstd * nwr[2 * e + 1]);
    *(uint4*)pf = uint4{o8[0], o8[1], o8[2], o8[3]};
    *(uint4*)(pf + 8) = uint4{o8[4], o8[5], o8[6], o8[7]};
  }
}

DI void final_norm(const Params& p) {
  const int WV = p.ph_hi;
  const int lane = tidx() & 63, w = tidx() >> 6;
  for (int row = blockIdx.x * 4 + w; row < T_LAT; row += gridDim.x * 4) {
    float* xr = p.out + (size_t)row * 1024;
    f32x4 xv[4];
    float ss = 0.f;
#pragma unroll
    for (int i = 0; i < 4; i++) {
      xv[i] = *(const f32x4*)(xr + i * 256 + lane * 4);
      ss += xv[i][0] * xv[i][0] + xv[i][1] * xv[i][1] + xv[i][2] * xv[i][2] + xv[i][3] * xv[i][3];
    }
    ss = wsum(ss);
    const float rstd = rsqrtf(ss * (1.f / 1024.f) + 1e-6f);
#pragma unroll
    for (int i = 0; i < 4; i++) {
      const f32x4 wv = *(const f32x4*)(p.final_norm_w + i * 256 + lane * 4);
      f32x4 r;
#pragma unroll
      for (int j = 0; j < 4; j++) r[j] = xv[i][j] * rstd * wv[j];
      *(f32x4*)(xr + i * 256 + lane * 4) = r;
    }
  }
}

DI void run_phase(const Params& p, int ph, char* smem) {
  const int WV = p.ph_hi;
  const int G = gridDim.x, B = blockIdx.x;
  if (ph == 0) { if (QSEL(11)) phase_pro(p, smem); return; }
  if (ph == 23) { if (QSEL(12)) final_norm(p); return; }
  const int l = (ph - 1) / 11, q = (ph - 1) % 11;
  const bool last = l == 1;
  switch (q) {
    case 0: if (!QSEL(0)) break;
      if (l == 1) for (int u = B; u < WCONV_UNITS; u += G) wconv_unit(p, 1, u, smem);
      phase_norm(p, l, smem);
      break;
    case 1: if (!QSEL(1)) break;
      for (int t = B; t < 128 * 16; t += G) {
        const int tn = t + G;
        const bool more = tn < 128 * 16;
        gemm_tile<EPI_HG, 8>(p, l, t % 128, t / 128, smem, t != B, more ? tn % 128 : -1, more ? tn / 128 : -1);
      }
      for (int t = B; t < 4 * 32; t += G) gemm_tile<EPI_HG, 4>(p, l, 128 + (t & 3), t >> 2, smem);
      break;
    case 2: if (!QSEL(2)) break;
      for (int u = B; u < NCH * 8; u += G) hg_prep_unit(p, l, u >> 3, u & 7, smem);
      break;
    case 3: if (!QSEL(3)) break; scan_phase_hg(p, smem); break;
    case 4: if (!QSEL(4)) break;
      for (int t = B; t < 128 * 16; t += G) {
        const int tn = t + G;
        const bool more = tn < 128 * 16;
        gemm_tile<EPI_DNRET, 8>(p, l, t % 128, t / 128, smem, t != B, more ? tn % 128 : -1, more ? tn / 128 : -1);
      }
      for (int t = B; t < 4 * 32; t += G) gemm_tile<EPI_DNRET, 4>(p, l, 128 + (t & 3), t >> 2, smem);
      break;
    case 5: if (!QSEL(5)) break;
      for (int u = B; u < NCH * 8; u += G) {
        if (u < NCH * 4) dn_prep_unit(p, l, u >> 2, u & 3, smem);
        else ret_prep_unit(p, l, (u - NCH * 4) >> 2, u & 3, smem);
      }
      if (B >= 32) onorm_rows((u16*)(p.ws + OFF_D), (const u16*)(p.ws + OFF_D + SZ_TOK1K), p.hg_norm_w + l * 128, 128, B - 32, G - 32, WV);
      break;
    case 6: if (!QSEL(6)) break; scan_phase_dnret(p, l, smem); break;
    case 7: if (!QSEL(7)) break;
      onorm_rows((u16*)(p.ws + OFF_E), (const u16*)(p.ws + OFF_D + SZ_TOK1K), p.dn_norm_w + l * 256, 256, B, G, WV);
      onorm_rows((u16*)(p.ws + OFF_E + SZ_TOK1K), (const u16*)(p.ws + OFF_E + 2 * SZ_TOK1K), p.ret_norm_w + l * 256, 256, B, G, WV);
      break;
    case 8: if (!QSEL(8)) break; {
      const int nrt = last ? 128 : 132;
      for (int t = B; t < 128 * 12; t += G) {
        const int tn = t + G;
        const bool more = tn < 128 * 12;
        gemm_tile<EPI_GATE, 8>(p, l, t % 128, t / 128, smem, t != B, more ? tn % 128 : -1, more ? tn / 128 : -1);
      }
      if (!last) for (int t = B; t < 4 * 24; t += G) gemm_tile<EPI_GATE, 4>(p, l, 128 + (t & 3), t >> 2, smem);
    } break;
    case 9: if (!QSEL(9)) break; {
      const int nrt = last ? 128 : 132;
      for (int t = B; t < nrt * 8; t += G) {
        const int tn = t + G;
        const bool more = tn < nrt * 8;
        merge_tile(p, t % nrt, t / nrt, smem, t != B, more ? tn % nrt : -1, more ? tn / nrt : -1);
      }
    } break;
    case 10: if (!QSEL(10)) break; {
      const int nrt = last ? 128 : 132;
      for (int t = B; t < 128 * 4; t += G) {
        const int tn = t + G;
        const bool more = tn < 128 * 4;
        gemm_tile<EPI_OUT, 8>(p, l, t % 128, t / 128, smem, t != B, more ? tn % 128 : -1, more ? tn / 128 : -1);
      }
      if (!last) for (int t = B; t < 4 * 8; t += G) gemm_tile<EPI_OUT, 4>(p, l, 128 + (t & 3), t >> 2, smem);
    } break;
  }
}

#define XB_XCNT(j) (64 * (j))
#define XB_XSUB(j) (1024 + 64 * (j))
#define XB_XGEN(j) (2048 + 64 * (j))
#define XB_TOP 3072
#define XB_TOPGEN 3136
DI unsigned xb_ld(unsigned* q) { return __hip_atomic_load(q, __ATOMIC_RELAXED, __HIP_MEMORY_SCOPE_AGENT); }
DI unsigned xb_add(unsigned* q, unsigned v) { return __hip_atomic_fetch_add(q, v, __ATOMIC_RELAXED, __HIP_MEMORY_SCOPE_AGENT); }
DI void grid_barrier(unsigned* bar, volatile unsigned* st) {
  asm volatile("s_waitcnt vmcnt(0) lgkmcnt(0)" ::: "memory");
  __syncthreads();
  if (__builtin_amdgcn_workitem_id_x() == 0) {
    const unsigned nloc = st[0], nx = st[1], x = st[2];
    const unsigned old = xb_add(&bar[XB_XSUB(x)], 1u);
    const unsigned gen = old / nloc;
    if (old + 1u == (gen + 1u) * nloc) {
      __builtin_amdgcn_fence(__ATOMIC_RELEASE, "agent");
      asm volatile("s_waitcnt vmcnt(0)" ::: "memory");
      const unsigned og = xb_add(&bar[XB_TOP], 1u);
      const unsigned tg = og / nx;
      if (og + 1u == (tg + 1u) * nx) xb_add(&bar[XB_TOPGEN], 1u);
      else while (xb_ld(&bar[XB_TOPGEN]) == tg) __builtin_amdgcn_s_sleep(2);
      __builtin_amdgcn_fence(__ATOMIC_ACQUIRE, "agent");
      xb_add(&bar[XB_XGEN(x)], 1u);
      asm volatile("s_waitcnt vmcnt(0)" ::: "memory");
    } else {
      while (xb_ld(&bar[XB_XGEN(x)]) == gen) __builtin_amdgcn_s_sleep(8);
      __builtin_amdgcn_fence(__ATOMIC_ACQUIRE, "agent");
      asm volatile("s_waitcnt vmcnt(0)" ::: "memory");
    }
  }
  __syncthreads();
}

__global__ void __launch_bounds__(256, 2) mk(Params p) {
  extern __shared__ __attribute__((aligned(16))) char smem[];
  p.ph_hi = __builtin_amdgcn_readfirstlane((int)__builtin_amdgcn_workitem_id_x() >> 6);
#if ONE_LAUNCH
  cg::grid_group grid = cg::this_grid();
  unsigned* bar = (unsigned*)(p.ws + OFF_BAR);
  __shared__ uint4 xbw;
  if (__builtin_amdgcn_workitem_id_x() == 0)
    (void)xb_add(&bar[XB_XCNT((unsigned)__builtin_amdgcn_s_getreg((3 << 11) | 20) & 0xFu)], 1u);
#ifdef PROBE_MASK
  long long tacc = 0, t0 = wall_clock64();
#define PTICK(n) { const long long t1 = wall_clock64(); if ((PROBE_MASK >> (n)) & 1) tacc += t1 - t0; t0 = t1; }
#else
#define PTICK(n)
#endif
  run_phase(p, 0, smem);
  grid.sync();
  if (__builtin_amdgcn_workitem_id_x() == 0) {
    const unsigned x = (unsigned)__builtin_amdgcn_s_getreg((3 << 11) | 20) & 0xFu;
    unsigned cnt = 0u, mine = 1u;
#pragma unroll
    for (unsigned j = 0; j < 16; ++j) { const unsigned c = xb_ld(&bar[XB_XCNT(j)]); cnt += c > 0u ? 1u : 0u; mine = j == x ? c : mine; }
    xbw = make_uint4(mine > 0u ? mine : 1u, cnt > 0u ? cnt : 1u, x, 0u);
  }
  __syncthreads();
  volatile unsigned* xst = (volatile unsigned*)&xbw;
  PTICK(0)
#define PH(n) run_phase(p, n, smem); grid_barrier(bar, xst); PTICK(n)
  PH(1) PH(2) PH(3) PH(4) PH(5) PH(6) PH(7) PH(8) PH(9) PH(10) PH(11)
  PH(12) PH(13) PH(14) PH(15) PH(16) PH(17) PH(18) PH(19) PH(20) PH(21) PH(22)
  run_phase(p, 23, smem);
  PTICK(23)
#ifdef PROBE_MASK
  if (blockIdx.x == 0 && __builtin_amdgcn_workitem_id_x() == 0) {
    const long long tend = wall_clock64() + tacc * 4;
    while (wall_clock64() < tend) __builtin_amdgcn_s_sleep(20);
  }
#endif
#else
  run_phase(p, p.ph_lo, smem);
#endif
}

extern "C" void kernel_launch(void* const* d_in, const int* in_sizes, int n_in, void* d_out,
                              int out_size, void* d_ws, size_t ws_size, hipStream_t stream) {
  static int grid_blocks = 0;
  if (!grid_blocks) {
    int dev = 0, cus = 0, per_cu = 0;
    (void)hipGetDevice(&dev);
    (void)hipDeviceGetAttribute(&cus, hipDeviceAttributeMultiprocessorCount, dev);
    (void)hipFuncSetAttribute((const void*)mk, hipFuncAttributeMaxDynamicSharedMemorySize, SMEM_BYTES);
    (void)hipOccupancyMaxActiveBlocksPerMultiprocessor(&per_cu, mk, 256, SMEM_BYTES);
    if (per_cu > 2) per_cu = 2;
    if (per_cu < 1) per_cu = 1;
    grid_blocks = cus * per_cu;
  }
  Params p{};
  const float** f = (const float**)&p;
  for (int i = 0; i < 19; i++) f[i] = (const float*)d_in[i];
  p.out = (float*)d_out;
  p.ws = (char*)d_ws;
#if ONE_LAUNCH
  p.ph_lo = 0; p.ph_hi = 24;
  (void)hipMemsetAsync((char*)d_ws + OFF_BAR, 0, 16384, stream);
  void* args[] = {&p};
  (void)hipLaunchCooperativeKernel((void*)mk, dim3(grid_blocks), dim3(256), args, SMEM_BYTES, stream);
#else
  for (int ph = 0; ph < 24; ph++) {
    p.ph_lo = ph; p.ph_hi = ph + 1;
    void* args[] = {&p};
    (void)hipLaunchCooperativeKernel((void*)mk, dim3(grid_blocks), dim3(256), args, SMEM_BYTES, stream);
  }
#endif
}
```

```cpp
#include <hip/hip_runtime.h>
#include <hip/hip_cooperative_groups.h>
#include <cstdio>
namespace cg = cooperative_groups;

#ifndef ONE_LAUNCH
#define ONE_LAUNCH 1
#endif
#ifndef ONLY_Q
#define ONLY_Q -1
#endif
#define QSEL(n) (ONLY_Q < 0 || ONLY_Q == (n))

typedef unsigned short u16;
using bf16x8 = __attribute__((ext_vector_type(8))) short;
using bf16x4 = __attribute__((ext_vector_type(4))) short;
using f32x4 = __attribute__((ext_vector_type(4))) float;
using u32x4 = __attribute__((ext_vector_type(4))) unsigned;
#define DI __device__ __forceinline__

constexpr int T_LAT = 16384, T_ALL = 16896, NCH = 264;
constexpr int WROWS = 18448;
constexpr int W_BR = 14352, W_OUT = 17424;
constexpr size_t al(size_t x) { return (x + 255) & ~(size_t)255; }
constexpr size_t SZ_WT = (size_t)WROWS * 1024 * 2;
constexpr size_t SZ_TOK1K = (size_t)T_ALL * 1024 * 2;
constexpr size_t OFF_WT = 0;
constexpr size_t OFF_H = OFF_WT + al(SZ_WT);
constexpr size_t OFF_MOD = OFF_H + al(SZ_TOK1K);
constexpr size_t OFF_ROT = OFF_MOD + al(2 * 3 * 3072 * 4);
constexpr size_t OFF_GB = OFF_ROT + al(128 * 32 * 2 * 4);
constexpr size_t OFF_CTX1 = OFF_GB + al((size_t)T_ALL * 16 * 4);
constexpr size_t OFF_HALO = OFF_CTX1 + al(512 * 1024 * 4);
constexpr size_t OFF_DNSC = OFF_HALO + al((size_t)NCH * 4 * 2048 * 2);
constexpr size_t OFF_HGDEC = OFF_DNSC + al((size_t)NCH * 4 * 2 * 192 * 4);
constexpr size_t OFF_BAR = OFF_HGDEC + al((size_t)NCH * 8 * 2 * 128 * 4);
constexpr size_t OFF_A = OFF_BAR + 16384;
constexpr size_t OFF_B = OFF_A + 4 * SZ_TOK1K;
constexpr size_t OFF_C = OFF_B + SZ_TOK1K;
constexpr size_t OFF_D = OFF_C + SZ_TOK1K;
constexpr size_t OFF_E = OFF_D + 2 * SZ_TOK1K;
constexpr size_t WS_TOTAL = OFF_E + 3 * SZ_TOK1K;
static_assert(WS_TOTAL <= 470286336ull, "workspace too large");

constexpr int SMEM_BYTES = 72960;

struct Params {
  const float *x, *c, *ctx, *c_ctx, *norm_w, *ada_w, *ada_b, *w_in, *dn_conv, *dn_a_log, *dn_dt_bias, *dn_norm_w,
      *ret_decay, *ret_norm_w, *hg_lb, *hg_norm_w, *w_branch, *w_out, *final_norm_w;
  float* out;
  char* ws;
  int ph_lo, ph_hi;
};

DI int laneid_v() { int t; asm volatile("v_mbcnt_lo_u32_b32 %0, -1, 0\n\tv_mbcnt_hi_u32_b32 %0, -1, %0" : "=v"(t)); return t; }
#define tidx() (WV * 64 + laneid_v())
typedef __bf16 hwbf2 __attribute__((ext_vector_type(2)));
DI u16 f2bf(float f) { __bf16 b = (__bf16)f; return __builtin_bit_cast(u16, b); }
DI float bf2f(u16 h) { return __uint_as_float(((unsigned)h) << 16); }
DI unsigned pack2(float a, float b) { hwbf2 v = {(__bf16)a, (__bf16)b}; return __builtin_bit_cast(unsigned, v); }
DI float sigm(float x) { return 1.f / (1.f + __expf(-x)); }
DI float silu(float x) { return x / (1.f + __expf(-x)); }
DI float dpp_f(float v, const int ctrl_sel) {
  const int iv = __float_as_int(v);
  int r;
  if (ctrl_sel == 0) r = __builtin_amdgcn_update_dpp(0, iv, 0xB1, 0xF, 0xF, false);
  else if (ctrl_sel == 1) r = __builtin_amdgcn_update_dpp(0, iv, 0x4E, 0xF, 0xF, false);
  else if (ctrl_sel == 2) r = __builtin_amdgcn_update_dpp(0, iv, 0x141, 0xF, 0xF, false);
  else r = __builtin_amdgcn_update_dpp(0, iv, 0x140, 0xF, 0xF, false);
  return __int_as_float(r);
}
DI float gsum(float v, const int n) {
  v += dpp_f(v, 0);
  v += dpp_f(v, 1);
  v += dpp_f(v, 2);
  if (n == 16) v += dpp_f(v, 3);
  return v;
}
DI float wsum(float v) {
  v = gsum(v, 16);
  v += __int_as_float(__builtin_amdgcn_update_dpp(0, __float_as_int(v), 0x142, 0xA, 0xF, false));
  v += __int_as_float(__builtin_amdgcn_update_dpp(0, __float_as_int(v), 0x143, 0xC, 0xF, false));
  return __int_as_float(__builtin_amdgcn_readlane(__float_as_int(v), 63));
}
DI f32x4 mfma16(bf16x8 a, bf16x8 b, f32x4 c) { return __builtin_amdgcn_mfma_f32_16x16x32_bf16(a, b, c, 0, 0, 0); }
DI bf16x8 pack8(f32x4 lo, f32x4 hi) {
  u32x4 r = {pack2(lo[0], lo[1]), pack2(lo[2], lo[3]), pack2(hi[0], hi[1]), pack2(hi[2], hi[3])};
  return __builtin_bit_cast(bf16x8, r);
}
typedef __attribute__((address_space(3))) bf16x4* lds_v4p;
DI bf16x8 ld_tr2(unsigned a_lo, unsigned a_hi) {
  const bf16x4 lo = __builtin_amdgcn_ds_read_tr16_b64_v4i16((lds_v4p)(size_t)a_lo);
  const bf16x4 hi = __builtin_amdgcn_ds_read_tr16_b64_v4i16((lds_v4p)(size_t)a_hi);
  bf16x8 r;
  r[0] = lo[0]; r[1] = lo[1]; r[2] = lo[2]; r[3] = lo[3]; r[4] = hi[0]; r[5] = hi[1]; r[6] = hi[2]; r[7] = hi[3];
  return r;
}
DI bf16x8 ld_perm(const char* rowp, int c0) {
  bf16x4 lo = *(const bf16x4*)(rowp + c0 * 2);
  bf16x4 hi = *(const bf16x4*)(rowp + c0 * 2 + 32);
  bf16x8 r;
  r[0] = lo[0]; r[1] = lo[1]; r[2] = lo[2]; r[3] = lo[3]; r[4] = hi[0]; r[5] = hi[1]; r[6] = hi[2]; r[7] = hi[3];
  return r;
}

DI int swz(int row, int ch) { return row * 128 + ((ch ^ (row & 7)) << 4); }

template <bool DEEP>
DI void gemm_kloop_t(const u16* __restrict__ A, const u16* __restrict__ W, f32x4 (&acc)[4][4], char* smem, const int WV) {
  const int tid = tidx(), lane = tid & 63, wid = tid >> 6, wn = wid >> 1, wt = wid & 1;
  const int fr = lane & 15, fq = lane >> 4;
  const int lrow = tid >> 3, lch = tid & 7;
  const u16* Ap = A + (size_t)lrow * 1024 + lch * 8;
  const u16* Wp = W + (size_t)lrow * 1024 + lch * 8;
  u32x4 ra0[4], rw0[4], ra1[4], rw1[4];
#define G_LOAD(RA, RW, KT) _Pragma("unroll") for (int i = 0; i < 4; i++) { \
    RA[i] = *(const u32x4*)(Ap + (size_t)i * 32 * 1024 + (KT) * 64); RW[i] = *(const u32x4*)(Wp + (size_t)i * 32 * 1024 + (KT) * 64); }
#define G_STORE(RA, RW, BUF) { char* dW = smem + (BUF) * 32768; _Pragma("unroll") for (int i = 0; i < 4; i++) { \
    *(u32x4*)(dW + swz(lrow + i * 32, lch)) = RW[i]; *(u32x4*)(dW + 16384 + swz(lrow + i * 32, lch)) = RA[i]; } }
#define G_COMPUTE(BUF) { const char* sW = smem + (BUF) * 32768; const char* sA = sW + 16384; \
    _Pragma("unroll") for (int ks = 0; ks < 2; ks++) { bf16x8 fw[4], fa[4]; \
      _Pragma("unroll") for (int i = 0; i < 4; i++) { \
        fw[i] = *(const bf16x8*)(sW + swz(wn * 64 + i * 16 + fr, ks * 4 + fq)); \
        fa[i] = *(const bf16x8*)(sA + swz(wt * 64 + i * 16 + fr, ks * 4 + fq)); } \
      _Pragma("unroll") for (int ni = 0; ni < 4; ni++) _Pragma("unroll") for (int ti = 0; ti < 4; ti++) \
        acc[ni][ti] = mfma16(fw[ni], fa[ti], acc[ni][ti]); } }
  G_LOAD(ra0, rw0, 0)
  G_STORE(ra0, rw0, 0)
  if (DEEP) { G_LOAD(ra1, rw1, 1) }
  __syncthreads();
  if (DEEP) {
    for (int kt = 0; kt < 16; kt += 2) {
      if (kt + 2 < 16) { G_LOAD(ra0, rw0, kt + 2) }
      G_COMPUTE(0)
      G_STORE(ra1, rw1, 1)
      __syncthreads();
      if (kt + 3 < 16) { G_LOAD(ra1, rw1, kt + 3) }
      G_COMPUTE(1)
      if (kt + 2 < 16) { G_STORE(ra0, rw0, 0) }
      __syncthreads();
    }
  } else {
    for (int kt = 0; kt < 16; kt++) {
      if (kt < 15) { G_LOAD(ra0, rw0, kt + 1) }
      G_COMPUTE(kt & 1)
      if (kt < 15) { G_STORE(ra0, rw0, (kt + 1) & 1) }
      __syncthreads();
    }
  }
#undef G_LOAD
#undef G_STORE
#undef G_COMPUTE
}
DI void gemm_kloop(const u16* __restrict__ A, const u16* __restrict__ W, f32x4 (&acc)[4][4], char* smem, const int WV,
                   const bool have0 = false, const u16* __restrict__ nA = nullptr, const u16* __restrict__ nW = nullptr) {
  const int tid = tidx(), lane = tid & 63, wid = tid >> 6, wn = wid >> 1, wt = wid & 1;
  const int fr = lane & 15, fq = lane >> 4;
  const int r8 = lane >> 3, chs = (lane & 7) ^ r8;
  const size_t loff = (size_t)(wid * 32 + r8) * 1024 + chs * 8;
  const u16* Asrc = A + loff;
  const u16* Wsrc = W + loff;
  char* ldsw = smem + wid * 4096;
#define G_STAGE_P(AS, WS, BUF, KT) _Pragma("unroll") for (int i = 0; i < 4; i++) { \
    __builtin_amdgcn_global_load_lds((const unsigned*)((WS) + (size_t)i * 8 * 1024 + (KT) * 64), (unsigned*)(ldsw + (BUF) * 32768 + i * 1024), 16, 0, 0); \
    __builtin_amdgcn_global_load_lds((const unsigned*)((AS) + (size_t)i * 8 * 1024 + (KT) * 64), (unsigned*)(ldsw + (BUF) * 32768 + 16384 + i * 1024), 16, 0, 0); }
#define G_COMPUTE(BUF) { const char* sW = smem + (BUF) * 32768; const char* sA = sW + 16384; \
    _Pragma("unroll") for (int ks = 0; ks < 2; ks++) { bf16x8 fw[4], fa[4]; \
      _Pragma("unroll") for (int i = 0; i < 4; i++) { \
        fw[i] = *(const bf16x8*)(sW + swz(wn * 64 + i * 16 + fr, ks * 4 + fq)); \
        fa[i] = *(const bf16x8*)(sA + swz(wt * 64 + i * 16 + fr, ks * 4 + fq)); } \
      __builtin_amdgcn_s_setprio(1); \
      _Pragma("unroll") for (int ni = 0; ni < 4; ni++) _Pragma("unroll") for (int ti = 0; ti < 4; ti++) \
        acc[ni][ti] = mfma16(fw[ni], fa[ti], acc[ni][ti]); \
      __builtin_amdgcn_s_setprio(0); } }
  if (!have0) {
    G_STAGE_P(Asrc, Wsrc, 0, 0)
    asm volatile("s_waitcnt vmcnt(0)" ::: "memory");
    __syncthreads();
  }
  for (int kt = 0; kt < 16; kt++) {
    if (kt < 15) { G_STAGE_P(Asrc, Wsrc, (kt + 1) & 1, kt + 1) }
    else if (nA != nullptr) { const u16* nAs = nA + loff; const u16* nWs = nW + loff; G_STAGE_P(nAs, nWs, 0, 0) }
    G_COMPUTE(kt & 1)
    asm volatile("s_waitcnt vmcnt(0)" ::: "memory");
    __syncthreads();
  }
#undef G_STAGE_P
#undef G_COMPUTE
}

DI void gemm_kloop256(const u16* __restrict__ A, const u16* __restrict__ W, f32x4 (&acc)[8][4], char* smem, const int WV,
                      const bool have0 = false, const u16* __restrict__ nA = nullptr, const u16* __restrict__ nW = nullptr) {
  const int tid = tidx(), lane = tid & 63, wid = tid >> 6, wn = wid >> 1, wt = wid & 1;
  const int fr = lane & 15, fq = lane >> 4;
  const int r16 = lane >> 2, chs = (lane & 3) ^ ((0 - (r16 >> 2)) & 3);
  const u16* Wsrc = W + (size_t)(wid * 64 + r16) * 1024 + chs * 8;
  const u16* Asrc = A + (size_t)(wid * 32 + r16) * 1024 + chs * 8;
  const int fpos = (fq ^ ((0 - (fr >> 2)) & 3)) << 4;
#define G_STAGE(BUF, KT) { _Pragma("unroll") for (int i = 0; i < 4; i++) \
      __builtin_amdgcn_global_load_lds((const unsigned*)(Wsrc + (size_t)i * 16 * 1024 + (KT) * 32), (unsigned*)(smem + (BUF) * 24576 + (wid * 4 + i) * 1024), 16, 0, 0); \
    _Pragma("unroll") for (int i = 0; i < 2; i++) \
      __builtin_amdgcn_global_load_lds((const unsigned*)(Asrc + (size_t)i * 16 * 1024 + (KT) * 32), (unsigned*)(smem + (BUF) * 24576 + 16384 + (wid * 2 + i) * 1024), 16, 0, 0); }
#define G_COMPUTE(BUF) { const char* sW = smem + (BUF) * 24576; const char* sA = sW + 16384; bf16x8 fw[8], fa[4]; \
    _Pragma("unroll") for (int i = 0; i < 8; i++) fw[i] = *(const bf16x8*)(sW + (wn * 128 + i * 16 + fr) * 64 + fpos); \
    _Pragma("unroll") for (int i = 0; i < 4; i++) fa[i] = *(const bf16x8*)(sA + (wt * 64 + i * 16 + fr) * 64 + fpos); \
    __builtin_amdgcn_s_setprio(1); \
    _Pragma("unroll") for (int ni = 0; ni < 8; ni++) _Pragma("unroll") for (int ti = 0; ti < 4; ti++) \
      acc[ni][ti] = mfma16(fw[ni], fa[ti], acc[ni][ti]); \
    __builtin_amdgcn_s_setprio(0); }
  if (!have0) { G_STAGE(0, 0) }
  asm volatile("s_waitcnt vmcnt(0)" ::: "memory");
  __syncthreads();
  for (int kt = 0; kt < 31; kt++) {
    G_STAGE((kt + 1) & 1, kt + 1)
    G_COMPUTE(kt & 1)
    asm volatile("s_waitcnt vmcnt(0)" ::: "memory");
    __syncthreads();
  }
  if (nA != nullptr) {
    const u16* Wn = nW + (size_t)(wid * 64 + r16) * 1024 + chs * 8;
    const u16* An = nA + (size_t)(wid * 32 + r16) * 1024 + chs * 8;
#pragma unroll
    for (int i = 0; i < 4; i++)
      __builtin_amdgcn_global_load_lds((const unsigned*)(Wn + (size_t)i * 16 * 1024), (unsigned*)(smem + (wid * 4 + i) * 1024), 16, 0, 0);
#pragma unroll
    for (int i = 0; i < 2; i++)
      __builtin_amdgcn_global_load_lds((const unsigned*)(An + (size_t)i * 16 * 1024), (unsigned*)(smem + 16384 + (wid * 2 + i) * 1024), 16, 0, 0);
  }
  G_COMPUTE(1)
  asm volatile("s_waitcnt lgkmcnt(0)\n\ts_barrier" ::: "memory");
#undef G_STAGE
#undef G_COMPUTE
}

enum { EPI_HG = 0, EPI_DNRET = 1, EPI_GATE = 2, EPI_OUT = 3 };

template <int EPI, int NI>
DI const u16* gemm_wptr(const Params& p, int nti) {
  constexpr int NW = NI * 32;
  const u16* WT = (const u16*)(p.ws + OFF_WT);
  int wrow;
  if (EPI == EPI_HG) wrow = 6160 + nti * NW;
  else if (EPI == EPI_DNRET) { const int mx = nti / (2048 / NW); wrow = (mx ? 3088 : 0) + (nti % (2048 / NW)) * NW; }
  else if (EPI == EPI_GATE) { const int mx = nti / (1024 / NW); wrow = (mx == 0 ? 2048 : (mx == 1 ? 5136 : 10256)) + (nti % (1024 / NW)) * NW; }
  else wrow = W_OUT + nti * NW;
  return WT + (size_t)wrow * 1024;
}
template <int EPI, int NI>
DI void gemm_tile(const Params& p, int l, int rt, int nti, char* smem, const bool have0 = false, const int nrt = -1, const int nnti = -1) {
  const int WV = p.ph_hi;
  const int tid = tidx(), lane = tid & 63, wid = tid >> 6, wn = wid >> 1, wt = wid & 1;
  const int fr = lane & 15, fq = lane >> 4;
  const int row0 = rt * 128;
  constexpr int NW = NI * 32;
  const u16* WT = (const u16*)(p.ws + OFF_WT);
  const u16* A;
  int wrow, n0, mixer = 0;
  if (EPI == EPI_HG) { A = (const u16*)(p.ws + OFF_H); n0 = nti * NW; wrow = 6160 + n0; }
  else if (EPI == EPI_DNRET) { A = (const u16*)(p.ws + OFF_H); mixer = nti / (2048 / NW); n0 = (nti % (2048 / NW)) * NW; wrow = (mixer ? 3088 : 0) + n0; }
  else if (EPI == EPI_GATE) { A = (const u16*)(p.ws + OFF_H); mixer = nti / (1024 / NW); n0 = (nti % (1024 / NW)) * NW; wrow = (mixer == 0 ? 2048 : (mixer == 1 ? 5136 : 10256)) + n0; }
  else { A = (const u16*)(p.ws + OFF_B); n0 = nti * NW; wrow = W_OUT + n0; }
  f32x4 acc[NI][4];
#pragma unroll
  for (int i = 0; i < NI; i++)
#pragma unroll
    for (int j = 0; j < 4; j++) acc[i][j] = f32x4{0.f, 0.f, 0.f, 0.f};
  if constexpr (NI == 4) gemm_kloop(A + (size_t)row0 * 1024, WT + (size_t)wrow * 1024, acc, smem, WV);
  else gemm_kloop256(A + (size_t)row0 * 1024, WT + (size_t)wrow * 1024, acc, smem, WV, have0,
                     nrt >= 0 ? A + (size_t)nrt * 128 * 1024 : nullptr, nrt >= 0 ? gemm_wptr<EPI, NI>(p, nnti) : nullptr);

  const float* ROT = (const float*)(p.ws + OFF_ROT);
  const float* MOD = (const float*)(p.ws + OFF_MOD);
#pragma unroll
  for (int ti = 0; ti < 4; ti++) {
    const int token = row0 + wt * 64 + ti * 16 + fr;
#pragma unroll
    for (int ni = 0; ni < NI; ni++) {
      const int nl = n0 + wn * (NI * 16) + ni * 16 + fq * 4;
      f32x4 v = acc[ni][ti];
      if (EPI == EPI_HG) {
        if (nl < 1024) { v[0] = silu(v[0]); v[1] = silu(v[1]); v[2] = silu(v[2]); v[3] = silu(v[3]); }
        u16* dst = (u16*)(p.ws + OFF_A) + (size_t)token * 4096 + nl;
        *(uint2*)dst = uint2{pack2(v[0], v[1]), pack2(v[2], v[3])};
      } else if (EPI == EPI_DNRET) {
        if (mixer == 0) {
          uint2 pk = uint2{pack2(v[0], v[1]), pack2(v[2], v[3])};
          u16* dst = (u16*)(p.ws + OFF_A) + (size_t)token * 2048 + nl;
          *(uint2*)dst = pk;
          const int tm = token & 63;
          if (tm < 2 || tm >= 62) {
            const int slot = tm < 2 ? tm : tm - 60;
            u16* hd = (u16*)(p.ws + OFF_HALO) + ((size_t)(token >> 6) * 4 + slot) * 2048 + nl;
            *(uint2*)hd = pk;
          }
        } else {
          if (nl < 1024) {
            if (token < T_LAT) {
              const int t = token & 8191, ri = t >> 6, ci = t & 63;
              const int d = nl & 127;
#pragma unroll
              for (int pp = 0; pp < 2; pp++) {
                const int pidx = (d >> 1) + pp;
                const float* rp = pidx < 32 ? ROT + (ri * 32 + pidx) * 2 : ROT + (ci * 32 + (pidx - 32)) * 2;
                const float cs = rp[0], sn = rp[1];
                const float x1 = v[2 * pp], x2 = v[2 * pp + 1];
                v[2 * pp] = x1 * cs - x2 * sn;
                v[2 * pp + 1] = x1 * sn + x2 * cs;
              }
            }
            if (nl >= 512) { const float s = 0.08838834764831845f; v[0] *= s; v[1] *= s; v[2] *= s; v[3] *= s; }
          }
          u16* dst = (u16*)(p.ws + OFF_A + 2 * SZ_TOK1K) + (size_t)token * 2048 + nl;
          *(uint2*)dst = uint2{pack2(v[0], v[1]), pack2(v[2], v[3])};
        }
      } else if (EPI == EPI_GATE) {
        char* base = mixer == 0 ? p.ws + OFF_E : (mixer == 1 ? p.ws + OFF_E + SZ_TOK1K : p.ws + OFF_D);
        u16* dst = (u16*)base + (size_t)token * 1024 + nl;
        uint2 on = *(const uint2*)dst;
        float o0 = bf2f((u16)(on.x & 0xffff)), o1 = bf2f((u16)(on.x >> 16)), o2 = bf2f((u16)(on.y & 0xffff)), o3 = bf2f((u16)(on.y >> 16));
        *(uint2*)dst = uint2{pack2(o0 * silu(v[0]), o1 * silu(v[1])), pack2(o2 * silu(v[2]), o3 * silu(v[3]))};
      } else {
        const int vec = token < T_LAT ? (token >> 13) : 2;
        const f32x4 gt = *(const f32x4*)(MOD + ((size_t)l * 3 + vec) * 3072 + 2048 + nl);
        const float* src;
        float* dst;
        if (token < T_LAT) {
          src = (l == 0 ? p.x : (const float*)p.out) + (size_t)token * 1024 + nl;
          dst = p.out + (size_t)token * 1024 + nl;
        } else {
          src = p.ctx + (size_t)(token - T_LAT) * 1024 + nl;
          dst = (float*)(p.ws + OFF_CTX1) + (size_t)(token - T_LAT) * 1024 + nl;
        }
        f32x4 xi = *(const f32x4*)src;
        f32x4 r;
        r[0] = xi[0] + gt[0] * v[0]; r[1] = xi[1] + gt[1] * v[1]; r[2] = xi[2] + gt[2] * v[2]; r[3] = xi[3] + gt[3] * v[3];
        *(f32x4*)dst = r;
      }
    }
  }
}

DI void merge_tile(const Params& p, int rt, int nti, char* smem, const bool have0 = false, const int nrt = -1, const int nnti = -1) {
  const int WV = p.ph_hi;
  const int tid = tidx(), lane = tid & 63, wid = tid >> 6, wn = wid >> 1, wt = wid & 1;
  const int fr = lane & 15, fq = lane >> 4;
  const int row0 = rt * 128, n0 = nti * 128;
  const u16* WT = (const u16*)(p.ws + OFF_WT);
  const u16* H = (const u16*)(p.ws + OFF_H) + (size_t)row0 * 1024;
  uint2 y[4][4];
#pragma unroll
  for (int i = 0; i < 4; i++)
#pragma unroll
    for (int j = 0; j < 4; j++) y[i][j] = uint2{0u, 0u};
  for (int m = 0; m < 3; m++) {
    uint2 sg[4][4];
    {
      f32x4 acc[4][4];
#pragma unroll
      for (int i = 0; i < 4; i++)
#pragma unroll
        for (int j = 0; j < 4; j++) acc[i][j] = f32x4{0.f, 0.f, 0.f, 0.f};
      const char* baseb = m == 0 ? p.ws + OFF_E : (m == 1 ? p.ws + OFF_E + SZ_TOK1K : p.ws + OFF_D);
      gemm_kloop(H, WT + (size_t)(11280 + m * 1024 + n0) * 1024, acc, smem, WV, have0 || m > 0,
                 (const u16*)baseb + (size_t)row0 * 1024, WT + (size_t)(W_BR + m * 1024 + n0) * 1024);
#pragma unroll
      for (int i = 0; i < 4; i++)
#pragma unroll
        for (int j = 0; j < 4; j++)
          sg[i][j] = uint2{pack2(sigm(acc[i][j][0]), sigm(acc[i][j][1])), pack2(sigm(acc[i][j][2]), sigm(acc[i][j][3]))};
    }
    {
      const char* base = m == 0 ? p.ws + OFF_E : (m == 1 ? p.ws + OFF_E + SZ_TOK1K : p.ws + OFF_D);
      f32x4 acc[4][4];
#pragma unroll
      for (int i = 0; i < 4; i++)
#pragma unroll
        for (int j = 0; j < 4; j++) acc[i][j] = f32x4{0.f, 0.f, 0.f, 0.f};
      const u16* nA = m < 2 ? H : (nrt >= 0 ? (const u16*)(p.ws + OFF_H) + (size_t)nrt * 128 * 1024 : nullptr);
      const u16* nW = m < 2 ? WT + (size_t)(11280 + (m + 1) * 1024 + n0) * 1024 : (nrt >= 0 ? WT + (size_t)(11280 + nnti * 128) * 1024 : nullptr);
      gemm_kloop((const u16*)base + (size_t)row0 * 1024, WT + (size_t)(W_BR + m * 1024 + n0) * 1024, acc, smem, WV, true, nA, nW);
#pragma unroll
      for (int i = 0; i < 4; i++)
#pragma unroll
        for (int j = 0; j < 4; j++) {
          const float y0 = bf2f((u16)(y[i][j].x & 0xffff)) + acc[i][j][0] * bf2f((u16)(sg[i][j].x & 0xffff));
          const float y1 = bf2f((u16)(y[i][j].x >> 16)) + acc[i][j][1] * bf2f((u16)(sg[i][j].x >> 16));
          const float y2 = bf2f((u16)(y[i][j].y & 0xffff)) + acc[i][j][2] * bf2f((u16)(sg[i][j].y & 0xffff));
          const float y3 = bf2f((u16)(y[i][j].y >> 16)) + acc[i][j][3] * bf2f((u16)(sg[i][j].y >> 16));
          y[i][j] = uint2{pack2(y0, y1), pack2(y2, y3)};
        }
    }
  }
  u16* Y = (u16*)(p.ws + OFF_B);
#pragma unroll
  for (int ti = 0; ti < 4; ti++) {
    const int token = row0 + wt * 64 + ti * 16 + fr;
#pragma unroll
    for (int ni = 0; ni < 4; ni++) {
      const int nl = n0 + wn * 64 + ni * 16 + fq * 4;
      *(uint2*)(Y + (size_t)token * 1024 + nl) = y[ni][ti];
    }
  }
}

DI void wconv_tile(const float* __restrict__ src, int N, int kt, int ntile, u16* __restrict__ dst, char* smem, const int WV) {
  float* s = (float*)smem;
  const int tid = tidx();
  const int k0 = kt * 64, n0 = ntile * 64;
#pragma unroll
  for (int i = 0; i < 4; i++) {
    const int r = (tid >> 4) + i * 16, c4 = (tid & 15) * 4;
    if (n0 + c4 < N) {
      f32x4 v = *(const f32x4*)(src + (size_t)(k0 + r) * N + n0 + c4);
      s[r * 65 + c4] = v[0]; s[r * 65 + c4 + 1] = v[1]; s[r * 65 + c4 + 2] = v[2]; s[r * 65 + c4 + 3] = v[3];
    }
  }
  __syncthreads();
#pragma unroll
  for (int i = 0; i < 2; i++) {
    const int id = tid + i * 256, n = id >> 3, kc = (id & 7) * 8;
    if (n0 + n < N) {
      uint4 o;
      o.x = pack2(s[(kc + 0) * 65 + n], s[(kc + 1) * 65 + n]);
      o.y = pack2(s[(kc + 2) * 65 + n], s[(kc + 3) * 65 + n]);
      o.z = pack2(s[(kc + 4) * 65 + n], s[(kc + 5) * 65 + n]);
      o.w = pack2(s[(kc + 6) * 65 + n], s[(kc + 7) * 65 + n]);
      *(uint4*)(dst + (size_t)(n0 + n) * 1024 + k0 + kc) = o;
    }
  }
  __syncthreads();
}
constexpr int WCONV_UNITS = 16 * 225 + 3 * 256 + 256;
DI void wconv_unit(const Params& p, int l, int u, char* smem) {
  const int WV = p.ph_hi;
  u16* WT = (u16*)(p.ws + OFF_WT);
  if (u < 16 * 225) wconv_tile(p.w_in + (size_t)l * 1024 * 14352, 14352, u / 225, u % 225, WT, smem, WV);
  else if (u < 16 * 225 + 768) {
    const int v = u - 16 * 225, m = v >> 8, r = v & 255;
    wconv_tile(p.w_branch + ((size_t)l * 3 + m) * 1024 * 1024, 1024, r >> 4, r & 15, WT + (size_t)(W_BR + m * 1024) * 1024, smem, WV);
  } else {
    const int r = u - 16 * 225 - 768;
    wconv_tile(p.w_out + (size_t)l * 1024 * 1024, 1024, r >> 4, r & 15, WT + (size_t)W_OUT * 1024, smem, WV);
  }
}

DI void adaln_unit(const Params& p, int u, char* smem) {
  const int WV = p.ph_hi;
  const int l = u / 48, ng = u % 48;
  const int tid = tidx(), lane = tid & 63, w = tid >> 6;
  const int n = ng * 64 + lane;
  const float* W = p.ada_w + (size_t)l * 1024 * 3072;
  float* ssc = (float*)smem + 1024;
  for (int i = tid; i < 3072; i += 256) {
    const float cv = i < 2048 ? p.c[i] : p.c_ctx[i - 2048];
    ssc[i] = silu(cv);
  }
  __syncthreads();
  float a0 = 0.f, a1 = 0.f, a2 = 0.f;
#pragma unroll 8
  for (int k = w * 256; k < w * 256 + 256; k++) {
    const float wv = W[(size_t)k * 3072 + n];
    a0 += ssc[k] * wv; a1 += ssc[1024 + k] * wv; a2 += ssc[2048 + k] * wv;
  }
  float* red = (float*)smem;
  red[(w * 3 + 0) * 64 + lane] = a0; red[(w * 3 + 1) * 64 + lane] = a1; red[(w * 3 + 2) * 64 + lane] = a2;
  __syncthreads();
  if (tid < 192) {
    const int vec = tid >> 6, ln = tid & 63;
    float s = red[(0 * 3 + vec) * 64 + ln] + red[(1 * 3 + vec) * 64 + ln] + red[(2 * 3 + vec) * 64 + ln] + red[(3 * 3 + vec) * 64 + ln];
    const int nn = ng * 64 + ln;
    ((float*)(p.ws + OFF_MOD))[((size_t)l * 3 + vec) * 3072 + nn] = s + p.ada_b[(size_t)l * 3072 + nn];
  }
  __syncthreads();
}

DI void phase_pro(const Params& p, char* smem) {
  const int WV = p.ph_hi;
  const int total = 96 + 16 + WCONV_UNITS;
  for (int u = blockIdx.x; u < total; u += gridDim.x) {
    if (u < 96) adaln_unit(p, u, smem);
    else if (u < 112) {
      const int id = (u - 96) * 256 + tidx();
      const int pos = id >> 5, m = id & 31;
      const float inv = powf(10000.f, -(float)(2 * m) / 64.f);
      float s, c;
      sincosf((float)pos * inv, &s, &c);
      float* ROT = (float*)(p.ws + OFF_ROT);
      ROT[id * 2] = c; ROT[id * 2 + 1] = s;
    } else wconv_unit(p, 0, u - 112, smem);
  }
}

DI void phase_norm(const Params& p, int l, char* smem) {
  const int WV = p.ph_hi;
  const int tid = tidx(), lane = tid & 63, w = tid >> 6;
  float* sW = (float*)smem;
  const float* win = p.w_in + (size_t)l * 1024 * 14352;
  for (int i = tid; i < 16 * 1024; i += 256) {
    const int k = i >> 4, cc = i & 15;
    sW[cc * 1024 + k] = win[(size_t)k * 14352 + 3072 + cc];
  }
  __syncthreads();
  const float* MOD = (const float*)(p.ws + OFF_MOD);
  const float* nw = p.norm_w + (size_t)l * 1024;
  u16* H = (u16*)(p.ws + OFF_H);
  float* GB = (float*)(p.ws + OFF_GB);
  for (int row = blockIdx.x * 4 + w; row < T_ALL; row += gridDim.x * 4) {
    const float* xr;
    int vec;
    if (row < T_LAT) { xr = (l == 0 ? p.x : (const float*)p.out) + (size_t)row * 1024; vec = row >> 13; }
    else { xr = (l == 0 ? p.ctx : (const float*)(p.ws + OFF_CTX1)) + (size_t)(row - T_LAT) * 1024; vec = 2; }
    const float* md = MOD + ((size_t)l * 3 + vec) * 3072;
    f32x4 xv[4];
    float ss = 0.f;
#pragma unroll
    for (int i = 0; i < 4; i++) {
      xv[i] = *(const f32x4*)(xr + i * 256 + lane * 4);
      ss += xv[i][0] * xv[i][0] + xv[i][1] * xv[i][1] + xv[i][2] * xv[i][2] + xv[i][3] * xv[i][3];
    }
    ss = wsum(ss);
    const float rstd = rsqrtf(ss * (1.f / 1024.f) + 1e-6f);
    float ab[16];
#pragma unroll
    for (int cc = 0; cc < 16; cc++) ab[cc] = 0.f;
#pragma unroll
    for (int i = 0; i < 4; i++) {
      const int k = i * 256 + lane * 4;
      const f32x4 wv = *(const f32x4*)(nw + k);
      const f32x4 sh = *(const f32x4*)(md + k);
      const f32x4 sc = *(const f32x4*)(md + 1024 + k);
      f32x4 h;
#pragma unroll
      for (int j = 0; j < 4; j++) h[j] = xv[i][j] * rstd * wv[j] * (1.f + sc[j]) + sh[j];
      *(uint2*)(H + (size_t)row * 1024 + k) = uint2{pack2(h[0], h[1]), pack2(h[2], h[3])};
      asm volatile("" ::: "memory");
#pragma unroll
      for (int cc = 0; cc < 16; cc++) {
        const f32x4 ww = *(const f32x4*)(sW + cc * 1024 + k);
        ab[cc] += h[0] * ww[0] + h[1] * ww[1] + h[2] * ww[2] + h[3] * ww[3];
      }
    }
#pragma unroll
    for (int cc = 0; cc < 16; cc++) ab[cc] = wsum(ab[cc]);
    if (lane < 16) {
      float v = 0.f;
#pragma unroll
      for (int cc = 0; cc < 16; cc++) if (lane == cc) v = ab[cc];
      float r;
      if (lane < 8) {
        const float A = __expf(p.dn_a_log[l * 8 + lane]);
        const float z = v + p.dn_dt_bias[l * 8 + lane];
        const float sp = z > 20.f ? z : log1pf(__expf(z));
        r = -A * sp;
      } else r = sigm(v);
      GB[(size_t)row * 16 + lane] = r;
    }
  }
  __syncthreads();
}

DI void xyT(const char* sX, const char* sY, int it, f32x4 (&acc)[4], const int WV) {
  const int lane = tidx() & 63, fr = lane & 15, fq = lane >> 4;
#pragma unroll
  for (int j = 0; j < 4; j++) acc[j] = f32x4{0.f, 0.f, 0.f, 0.f};
#pragma unroll
  for (int ks = 0; ks < 4; ks++) {
    const bf16x8 a = *(const bf16x8*)(sX + (it * 16 + fr) * 272 + (ks * 32 + fq * 8) * 2);
#pragma unroll
    for (int jt = 0; jt < 4; jt++) {
      const bf16x8 b = *(const bf16x8*)(sY + (jt * 16 + fr) * 272 + (ks * 32 + fq * 8) * 2);
      acc[jt] = mfma16(a, b, acc[jt]);
    }
  }
}

DI void dn_prep_unit(const Params& p, int l, int c, int h, char* smem) {
  const int WV = p.ph_hi;
  const int tid = tidx(), lane = tid & 63, w = tid >> 6;
  u16* QKV = (u16*)(p.ws + OFF_A);
  const u16* HALO = (const u16*)(p.ws + OFF_HALO);
  char* sQ = smem;
  char* sK = smem + 17408;
  float* sKK = (float*)(smem + 34816);
  float* sQK = (float*)(smem + 34816 + 16384);
  float* sGC = (float*)(smem + 34816 + 32768);
  float* sBT = sGC + 128;
  const int row0 = c * 64;
  {
    const int u = tid * 2;
    const int gcol = u < 128 ? h * 128 + u : (u < 256 ? 512 + h * 128 + (u - 128) : 1024 + h * 256 + (u - 256));
    bool first, last;
    if (c < 256) { first = (c & 127) == 0; last = (c & 127) == 127; }
    else { first = ((c - 256) & 3) == 0; last = ((c - 256) & 3) == 3; }
    const float* cw = p.dn_conv + (size_t)l * 5 * 2048 + gcol;
    float cw0[5], cw1[5];
#pragma unroll
    for (int j = 0; j < 5; j++) { cw0[j] = cw[j * 2048]; cw1[j] = cw[j * 2048 + 1]; }
    const u16* own = QKV + (size_t)row0 * 2048 + gcol;
    const u16* hl = first ? own : HALO + ((size_t)(c - 1) * 4 + 2) * 2048 + gcol;
    const u16* hr = last ? own : HALO + ((size_t)(c + 1) * 4) * 2048 + gcol;
    unsigned cat[12], nxt[8], nx2[8];
    {
      const unsigned a = *(const unsigned*)hl, b = *(const unsigned*)(hl + 2048);
      cat[0] = first ? 0u : a; cat[1] = first ? 0u : b;
      cat[2] = *(const unsigned*)own; cat[3] = *(const unsigned*)(own + 2048);
    }
#pragma unroll
    for (int i = 0; i < 8; i++) nxt[i] = *(const unsigned*)(own + (size_t)(2 + i) * 2048);
#pragma unroll
    for (int i = 0; i < 8; i++) nx2[i] = *(const unsigned*)(own + (size_t)(10 + i) * 2048);
    for (int tb = 0; tb < 8; tb++) {
#pragma unroll
      for (int i = 0; i < 8; i++) { cat[4 + i] = nxt[i]; nxt[i] = nx2[i]; }
      if (tb < 6) {
        const bool lastb = tb == 5;
#pragma unroll
        for (int i = 0; i < 8; i++) {
          const u16* pp = (lastb && i >= 6) ? hr + (size_t)(i - 6) * 2048 : own + (size_t)(2 + (tb + 2) * 8 + i) * 2048;
          const unsigned v = *(const unsigned*)pp;
          nx2[i] = (lastb && i >= 6 && last) ? 0u : v;
        }
      }
#pragma unroll
      for (int i = 0; i < 8; i++) {
        const int t = tb * 8 + i;
        float y0 = 0.f, y1 = 0.f;
#pragma unroll
        for (int j = 0; j < 5; j++) {
          y0 += cw0[j] * bf2f((u16)(cat[i + j] & 0xffff));
          y1 += cw1[j] * bf2f((u16)(cat[i + j] >> 16));
        }
        y0 = silu(y0); y1 = silu(y1);
        if (w < 2) {
          const float ss = wsum(y0 * y0 + y1 * y1);
          float rs = rsqrtf(ss + 1e-6f);
          if (w == 0) rs *= 0.08838834764831845f;
          y0 *= rs; y1 *= rs;
          const unsigned pk = pack2(y0, y1);
          *(unsigned*)((w == 0 ? sQ : sK) + t * 272 + (u & 127) * 2) = pk;
          *(unsigned*)(QKV + (size_t)(row0 + t) * 2048 + gcol) = pk;
        } else {
          *(unsigned*)(QKV + (size_t)(row0 + t) * 2048 + gcol) = pack2(y0, y1);
        }
      }
#pragma unroll
      for (int i = 0; i < 4; i++) cat[i] = cat[8 + i];
    }
  }
  if (w < 2) {
    const float* GB = (const float*)(p.ws + OFF_GB);
    const float g = GB[(size_t)(row0 + lane) * 16 + w * 4 + h];
    const float bt = GB[(size_t)(row0 + lane) * 16 + 8 + w * 4 + h];
    float s = g;
    if (w == 0) {
#pragma unroll
      for (int o = 1; o < 64; o <<= 1) { const float t = __shfl_up(s, o, 64); if (lane >= o) s += t; }
    } else {
#pragma unroll
      for (int o = 1; o < 64; o <<= 1) { const float t = __shfl_down(s, o, 64); if (lane + o < 64) s += t; }
    }
    const float gl = __shfl(s, w == 0 ? 63 : 0, 64);
    sGC[w * 64 + lane] = s;
    sBT[w * 64 + lane] = bt;
    float* SC = (float*)(p.ws + OFF_DNSC) + ((size_t)(c * 4 + h) * 2 + w) * 192;
    SC[lane] = __expf(s);
    SC[64 + lane] = __expf(gl - s);
    if (lane == 0) SC[128] = __expf(gl);
  }
  __syncthreads();
  {
    const int fr = lane & 15, fq = lane >> 4;
    f32x4 acc[4];
    xyT(sK, sK, w, acc, WV);
#pragma unroll
    for (int jt = 0; jt < 4; jt++)
#pragma unroll
      for (int j = 0; j < 4; j++) sKK[(w * 16 + fq * 4 + j) * 64 + jt * 16 + fr] = acc[jt][j];
    xyT(sQ, sK, w, acc, WV);
#pragma unroll
    for (int jt = 0; jt < 4; jt++)
#pragma unroll
      for (int j = 0; j < 4; j++) sQK[(w * 16 + fq * 4 + j) * 64 + jt * 16 + fr] = acc[jt][j];
  }
  __syncthreads();
  u16* AUX = (u16*)(p.ws + OFF_B) + (size_t)(c * 4 + h) * 4 * 4096;
#pragma unroll 2
  for (int e = 0; e < 32; e++) {
    const int id = tid + e * 256, dir = id >> 12, i = (id >> 6) & 63, j = id & 63;
    const bool valid = dir == 0 ? (j <= i) : (j >= i);
    float v = 0.f;
    if (valid) v = sQK[i * 64 + j] * __expf(sGC[dir * 64 + i] - sGC[dir * 64 + j]);
    AUX[(size_t)(dir * 2 + 1) * 4096 + i * 64 + j] = f2bf(v);
  }
  __syncthreads();
  float* sL0 = sQK;
  float* sL1 = (float*)smem;
#pragma unroll 2
  for (int e = 0; e < 32; e++) {
    const int id = tid + e * 256, dir = id >> 12, ip = (id >> 6) & 63, jp = id & 63;
    const int i = dir ? 63 - ip : ip, j = dir ? 63 - jp : jp;
    float v = 0.f;
    if (jp < ip) v = sBT[dir * 64 + i] * sKK[i * 64 + j] * __expf(sGC[dir * 64 + i] - sGC[dir * 64 + j]);
    (dir ? sL1 : sL0)[ip * 64 + jp] = v;
  }
  __syncthreads();
  if (w < 2) {
    const float* L = w ? sL1 : sL0;
    const int cn = w ? 63 - lane : lane;
    const float bc = sBT[w * 64 + cn];
    f32x4 Lb[2][16];
    float T[64];
#pragma unroll
    for (int i = 0; i < 64; i++) {
      if (i + 1 < 64) {
#pragma unroll
        for (int b4 = 0; b4 < (i + 1 + 3) / 4; b4++) Lb[(i + 1) & 1][b4] = *(const f32x4*)(L + (i + 1) * 64 + 4 * b4);
      }
      asm volatile("" ::: "memory");
      float a0 = (i == lane) ? 1.f : 0.f, a1 = 0.f, a2 = 0.f, a3 = 0.f;
#pragma unroll
      for (int r = 0; r < i; r++) {
        const float lv = Lb[i & 1][r >> 2][r & 3];
        if ((r & 3) == 0) a0 -= lv * T[r];
        else if ((r & 3) == 1) a1 -= lv * T[r];
        else if ((r & 3) == 2) a2 -= lv * T[r];
        else a3 -= lv * T[r];
      }
      T[i] = (a0 + a1) + (a2 + a3);
    }
#pragma unroll
    for (int ip = 0; ip < 64; ip++) {
      const int i = w ? 63 - ip : ip;
      AUX[(size_t)(w * 2 + 0) * 4096 + i * 64 + cn] = f2bf(T[ip] * bc);
    }
  }
  __syncthreads();
}

DI void ret_prep_unit(const Params& p, int l, int c, int h, char* smem) {
  const int WV = p.ph_hi;
  const int tid = tidx(), lane = tid & 63, w = tid >> 6;
  const u16* QKV = (const u16*)(p.ws + OFF_A + 2 * SZ_TOK1K);
  char* sQ = smem;
  char* sK = smem + 17408;
  const int row0 = c * 64;
#pragma unroll
  for (int i = 0; i < 4; i++) {
    const int id = tid + i * 256, r = id >> 4, ch = id & 15;
    *(uint4*)(sQ + r * 272 + ch * 16) = *(const uint4*)(QKV + (size_t)(row0 + r) * 2048 + h * 128 + ch * 8);
    *(uint4*)(sK + r * 272 + ch * 16) = *(const uint4*)(QKV + (size_t)(row0 + r) * 2048 + 512 + h * 128 + ch * 8);
  }
  __syncthreads();
  f32x4 acc[4];
  xyT(sQ, sK, w, acc, WV);
  const int fr = lane & 15, fq = lane >> 4;
  u16* AUX = (u16*)(p.ws + OFF_C) + (size_t)(c * 4 + h) * 2 * 4096;
#pragma unroll
  for (int dir = 0; dir < 2; dir++) {
    const float rd = p.ret_decay[l * 8 + dir * 4 + h];
    const float lam = fminf(rd, 0.f) - log1pf(__expf(-fabsf(rd)));
#pragma unroll
    for (int jt = 0; jt < 4; jt++)
#pragma unroll
      for (int j = 0; j < 4; j++) {
        const int i = w * 16 + fq * 4 + j, jj = jt * 16 + fr;
        const int dd = dir == 0 ? i - jj : jj - i;
        const float v = dd >= 0 ? acc[jt][j] * __expf(lam * (float)dd) : 0.f;
        AUX[(size_t)dir * 4096 + i * 64 + jj] = f2bf(v);
      }
  }
  __syncthreads();
}

DI void hg_prep_unit(const Params& p, int l, int c, int h, char* smem) {
  const int WV = p.ph_hi;
  const int tid = tidx();
  u16* QFI = (u16*)(p.ws + OFF_A);
  u16* HGX = (u16*)(p.ws + OFF_B);
  float* sG = (float*)smem;
  u16* sQ = (u16*)(smem + 33280);
  u16* sK = (u16*)(smem + 50176);
  float* sTot = (float*)(smem + 67072);
  const int row0 = c * 64;
#pragma unroll
  for (int i = 0; i < 4; i++) {
    const int id = tid + i * 256, r = id >> 4, ch = id & 15;
    const uint4 v = *(const uint4*)(QFI + (size_t)(row0 + r) * 4096 + h * 128 + ch * 8);
    const unsigned vv[4] = {v.x, v.y, v.z, v.w};
#pragma unroll
    for (int e = 0; e < 4; e++) {
      sQ[(ch * 8 + e * 2) * 66 + r] = (u16)(vv[e] & 0xffff);
      sQ[(ch * 8 + e * 2 + 1) * 66 + r] = (u16)(vv[e] >> 16);
    }
  }
  __syncthreads();
  const int half = tid >> 7, d = tid & 127;
#pragma unroll 1
  for (int dir = 1; dir >= 0; dir--) {
    float lo = 0.f;
    if (l == 1) {
      const float b0 = p.hg_lb[dir * 1024 + h * 128 + d], b1 = p.hg_lb[2048 + dir * 1024 + h * 128 + d];
      lo = sigm(b1 - b0);
    }
    float run = 0.f;
    {
      const u16* xs = QFI + (size_t)row0 * 4096 + 1024 + dir * 1024 + h * 128 + d;
      float xv[32];
#pragma unroll
      for (int i = 0; i < 32; i++) xv[i] = bf2f(xs[(size_t)(half * 32 + (dir == 0 ? i : 31 - i)) * 4096]);
#pragma unroll
      for (int i = 0; i < 32; i++) {
        const int ii = dir == 0 ? i : 31 - i;
        const int t = half * 32 + ii;
        const float x = xv[i];
        const float sg = sigm(x);
        const float f = lo + (1.f - lo) * sg;
        const float omf = (1.f - lo) * (1.f - sg);
        run += __log2f(f);
        sG[d * 65 + t] = run;
        sK[d * 66 + t] = f2bf(omf);
      }
      sTot[half * 128 + d] = run;
    }
    __syncthreads();
    {
      const float t0 = sTot[d], t1 = sTot[128 + d];
      const float gtot = t0 + t1;
      const float add = dir == 0 ? (half == 1 ? t0 : 0.f) : (half == 0 ? t1 : 0.f);
      u16* qdst = dir == 0 ? QFI + (size_t)row0 * 4096 + h * 128 + d : HGX + (size_t)row0 * 1024 + h * 128 + d;
      const size_t qp = dir == 0 ? 4096 : 1024;
      u16* kdst = QFI + (size_t)row0 * 4096 + 1024 + dir * 1024 + h * 128 + d;
#pragma unroll 8
      for (int i = 0; i < 32; i++) {
        const int t = half * 32 + i;
        const float G = sG[d * 65 + t] + add;
        sG[d * 65 + t] = G;
        qdst[(size_t)t * qp] = f2bf(bf2f(sQ[d * 66 + t]) * __builtin_amdgcn_exp2f(G));
        kdst[(size_t)t * 4096] = f2bf(bf2f(sK[d * 66 + t]) * __builtin_amdgcn_exp2f(gtot - G));
      }
      if (half == 0) ((float*)(p.ws + OFF_HGDEC))[((size_t)(c * 8 + h) * 2 + dir) * 128 + d] = __builtin_amdgcn_exp2f(gtot);
    }
    __syncthreads();
    {
      const int lane = tid & 63, I = tid >> 6, fr = lane & 15, fq = lane >> 4;
      const int rt = dir == 0 ? I * 16 - 1 : I * 16 + 16;
      const bool hasref = dir == 0 ? (I > 0) : (I < 3);
      bf16x8 af[4];
#pragma unroll
      for (int ks = 0; ks < 4; ks++) {
        asm volatile("" ::: "memory");
#pragma unroll
        for (int j = 0; j < 8; j++) {
          const int dd = ks * 32 + fq * 8 + j;
          const float R = hasref ? sG[dd * 65 + rt] : 0.f;
          const float e = __builtin_amdgcn_exp2f(fmaxf(sG[dd * 65 + I * 16 + fr] - R, -120.f));
          af[ks][j] = (short)f2bf(bf2f(sQ[dd * 66 + I * 16 + fr]) * e);
        }
      }
      u16* AUX = (u16*)(p.ws + OFF_C) + ((size_t)(c * 8 + h) * 2 + dir) * 4096;
#pragma unroll 1
      for (int J = 0; J < 4; J++) {
        const bool actv = dir == 0 ? (J <= I) : (J >= I);
        f32x4 acc = f32x4{0.f, 0.f, 0.f, 0.f};
        if (actv) {
#pragma unroll
          for (int ks = 0; ks < 4; ks++) {
            asm volatile("" ::: "memory");
            bf16x8 bfr;
#pragma unroll
            for (int j = 0; j < 8; j++) {
              const int dd = ks * 32 + fq * 8 + j;
              const float R = hasref ? sG[dd * 65 + rt] : 0.f;
              const float e = __builtin_amdgcn_exp2f(fminf(R - sG[dd * 65 + J * 16 + fr], 120.f));
              bfr[j] = (short)f2bf(bf2f(sK[dd * 66 + J * 16 + fr]) * e);
            }
            acc = mfma16(af[ks], bfr, acc);
          }
        }
#pragma unroll
        for (int jj = 0; jj < 4; jj++) {
          const int i = I * 16 + fq * 4 + jj, j = J * 16 + fr;
          const bool valid = actv && (dir == 0 ? (j <= i) : (j >= i));
          AUX[i * 64 + j] = f2bf(valid ? acc[jj] : 0.f);
        }
      }
    }
    __syncthreads();
  }
}

struct ScanDesc {
  const u16 *q, *k, *v;
  int qp, kp, vp;
  const u16* aux;
  size_t aux_cs;
  int attn_off, ainv_off;
  u16* o;
  int mixer, b, dir;
  const float* sc;
  size_t sc_cs;
  float lam;
};

DI int scan_chunk_of(int dir, int b, int step) {
  if (dir == 0) return step < 4 ? 256 + 4 * b + step : 128 * b + (step - 4);
  return step < 4 ? 256 + 4 * b + (3 - step) : 128 * b + (131 - step);
}
template <int MIXER>
DI void scan_prefetch(const u16* sq, const u16* sk, const u16* sv, int qp, int kp, int vp, const u16* saux, size_t aux_cs, int attn_off, int ainv_off,
                      const float* ssc, size_t sc_cs, int c, int tid, int w, int fr, int fq, u32x4 (&rq)[4], u32x4 (&rk)[4], u32x4 (&rat)[2], u32x4 (&rai)[2],
                      unsigned (&rv)[8], float& rsc, float& regl) {
  struct { const u16 *q, *k, *v; int qp, kp, vp; const u16* aux; size_t aux_cs; int attn_off, ainv_off; const float* sc; size_t sc_cs; } s =
      {sq, sk, sv, qp, kp, vp, saux, aux_cs, attn_off, ainv_off, ssc, sc_cs};
  const int row0 = c * 64;
  const u16* qbase = s.q + (size_t)row0 * s.qp;
  const u16* kbase = s.k + (size_t)row0 * s.kp;
  const u16* vbase = s.v + (size_t)row0 * s.vp;
  const unsigned qoff = (unsigned)((tid >> 4) * s.qp + (tid & 15) * 8);
  const unsigned koff = (unsigned)((tid >> 4) * s.kp + (tid & 15) * 8);
#pragma unroll
  for (int i = 0; i < 4; i++) {
    rq[i] = *(const u32x4*)(qbase + (size_t)(i * 16) * s.qp + qoff);
    rk[i] = *(const u32x4*)(kbase + (size_t)(i * 16) * s.kp + koff);
  }
  const u16* ab = s.aux + (size_t)c * s.aux_cs;
  const unsigned aoff = (unsigned)((tid >> 3) * 64 + (tid & 7) * 8);
#pragma unroll
  for (int i = 0; i < 2; i++) {
    rat[i] = *(const u32x4*)(ab + s.attn_off + i * 32 * 64 + aoff);
    if (MIXER == 0) rai[i] = *(const u32x4*)(ab + s.ainv_off + i * 32 * 64 + aoff);
  }
  if (MIXER == 0) {
    const float* sc = s.sc + (size_t)c * s.sc_cs;
    if (tid < 128) rsc = sc[tid];
    regl = sc[128];
  } else if (MIXER == 2) {
    if (tid < 128) rsc = s.sc[(size_t)c * s.sc_cs + tid];
  }
  const unsigned voff = (unsigned)(fq * 4 * s.vp + w * 16 + fr);
#pragma unroll
  for (int mt = 0; mt < 4; mt++)
#pragma unroll
    for (int jp = 0; jp < 2; jp++) {
      const unsigned lo = (vbase + (size_t)(mt * 16 + jp * 2) * s.vp)[voff];
      const unsigned hi = (vbase + (size_t)(mt * 16 + jp * 2 + 1) * s.vp)[voff];
      rv[mt * 2 + jp] = lo | (hi << 16);
    }
}

template <int MIXER>
DI void scan_unit(const ScanDesc& s, char* smem, const int WV) {
  const int tid = tidx(), lane = tid & 63, w = tid >> 6;
  const int fr = lane & 15, fq = lane >> 4;
  char* sQm = smem;
  char* sKm = smem + 17408;
  const unsigned km_tr = (unsigned)(size_t)sKm + (unsigned)((fq * 4 + ((lane & 15) >> 2)) * 272 + (lane & 3) * 8);
  char* sAT = smem + 53248;
  char* sAI = smem + 62464;
  float* sSC = (float*)(smem + 71680);
  f32x4 S[8];
#pragma unroll
  for (int i = 0; i < 8; i++) S[i] = f32x4{0.f, 0.f, 0.f, 0.f};
  u32x4 rq[4], rk[4], rat[2], rai[2];
  rai[0] = u32x4{0u, 0u, 0u, 0u}; rai[1] = rai[0];
  unsigned rv[8];
  float rsc = 0.f, regl = 1.f;
  scan_prefetch<MIXER>(s.q, s.k, s.v, s.qp, s.kp, s.vp, s.aux, s.aux_cs, s.attn_off, s.ainv_off, s.sc, s.sc_cs, scan_chunk_of(s.dir, s.b, 0), tid, w, fr, fq, rq, rk, rat, rai, rv, rsc, regl);
  for (int step = 0; step < 132; step++) {
    const int c = scan_chunk_of(s.dir, s.b, step);
    const int row0 = c * 64;
#pragma unroll
    for (int i = 0; i < 4; i++) {
      const int id = tid + i * 256, r = id >> 4, ch = id & 15;
      *(u32x4*)(sQm + r * 272 + ch * 16) = rq[i];
      *(u32x4*)(sKm + r * 272 + ch * 16) = rk[i];
    }
#pragma unroll
    for (int i = 0; i < 2; i++) {
      const int id = tid + i * 256, r = id >> 3, ch = id & 7;
      *(u32x4*)(sAT + r * 144 + ch * 16) = rat[i];
      if (MIXER == 0) *(u32x4*)(sAI + r * 144 + ch * 16) = rai[i];
    }
    float egl = 1.f;
    if (MIXER == 0) {
      if (tid < 128) sSC[tid] = rsc;
      egl = regl;
    } else if (MIXER == 1) {
      if (tid < 64) {
        const float e1 = s.dir == 0 ? (float)(tid + 1) : (float)(64 - tid);
        sSC[tid] = __expf(s.lam * e1);
        sSC[64 + tid] = __expf(s.lam * (64.f - e1));
      }
      egl = __expf(s.lam * 64.f);
    } else {
      if (tid < 128) sSC[tid] = rsc;
    }
    f32x4 V[4];
#pragma unroll
    for (int mt = 0; mt < 4; mt++) {
      V[mt][0] = bf2f((u16)(rv[mt * 2] & 0xffff)); V[mt][1] = bf2f((u16)(rv[mt * 2] >> 16));
      V[mt][2] = bf2f((u16)(rv[mt * 2 + 1] & 0xffff)); V[mt][3] = bf2f((u16)(rv[mt * 2 + 1] >> 16));
    }
    __syncthreads();
    if (step + 1 < 132) scan_prefetch<MIXER>(s.q, s.k, s.v, s.qp, s.kp, s.vp, s.aux, s.aux_cs, s.attn_off, s.ainv_off, s.sc, s.sc_cs, scan_chunk_of(s.dir, s.b, step + 1), tid, w, fr, fq, rq, rk, rat, rai, rv, rsc, regl);
    bf16x8 Sb[4];
#pragma unroll
    for (int ks = 0; ks < 4; ks++) Sb[ks] = pack8(S[2 * ks], S[2 * ks + 1]);
    f32x4 vn[4];
    f32x4 oq[4];
#pragma unroll
    for (int mt = 0; mt < 4; mt++) oq[mt] = f32x4{0.f, 0.f, 0.f, 0.f};
    if (MIXER == 0) {
      f32x4 P[4];
      bf16x8 aai[2][4];
#pragma unroll
      for (int ks = 0; ks < 2; ks++)
#pragma unroll
        for (int mt = 0; mt < 4; mt++) aai[ks][mt] = ld_perm(sAI + (mt * 16 + fr) * 144, ks * 32 + fq * 4);
#pragma unroll
      for (int mt = 0; mt < 4; mt++) P[mt] = f32x4{0.f, 0.f, 0.f, 0.f};
#pragma unroll
      for (int ks = 0; ks < 4; ks++) {
        bf16x8 ak[4], aq[4];
#pragma unroll
        for (int mt = 0; mt < 4; mt++) { ak[mt] = ld_perm(sKm + (mt * 16 + fr) * 272, ks * 32 + fq * 4); aq[mt] = ld_perm(sQm + (mt * 16 + fr) * 272, ks * 32 + fq * 4); }
#pragma unroll
        for (int mt = 0; mt < 4; mt++) P[mt] = mfma16(ak[mt], Sb[ks], P[mt]);
#pragma unroll
        for (int mt = 0; mt < 4; mt++) oq[mt] = mfma16(aq[mt], Sb[ks], oq[mt]);
      }
#pragma unroll
      for (int mt = 0; mt < 4; mt++)
#pragma unroll
        for (int j = 0; j < 4; j++) P[mt][j] = V[mt][j] - sSC[mt * 16 + fq * 4 + j] * P[mt][j];
      bf16x8 rb[2];
#pragma unroll
      for (int ks = 0; ks < 2; ks++) rb[ks] = pack8(P[2 * ks], P[2 * ks + 1]);
#pragma unroll
      for (int mt = 0; mt < 4; mt++) vn[mt] = f32x4{0.f, 0.f, 0.f, 0.f};
#pragma unroll
      for (int ks = 0; ks < 2; ks++) {
#pragma unroll
        for (int mt = 0; mt < 4; mt++) vn[mt] = mfma16(aai[ks][mt], rb[ks], vn[mt]);
      }
    } else {
#pragma unroll
      for (int ks = 0; ks < 4; ks++) {
        bf16x8 aq[4];
#pragma unroll
        for (int mt = 0; mt < 4; mt++) aq[mt] = ld_perm(sQm + (mt * 16 + fr) * 272, ks * 32 + fq * 4);
#pragma unroll
        for (int mt = 0; mt < 4; mt++) oq[mt] = mfma16(aq[mt], Sb[ks], oq[mt]);
      }
#pragma unroll
      for (int mt = 0; mt < 4; mt++) vn[mt] = V[mt];
    }
    bf16x8 vb[2];
#pragma unroll
    for (int ks = 0; ks < 2; ks++) vb[ks] = pack8(vn[2 * ks], vn[2 * ks + 1]);
    if (MIXER != 2) {
#pragma unroll
      for (int mt = 0; mt < 4; mt++)
#pragma unroll
        for (int j = 0; j < 4; j++) oq[mt][j] *= sSC[mt * 16 + fq * 4 + j];
    }
#pragma unroll
    for (int ks = 0; ks < 2; ks++) {
      bf16x8 aa[4];
#pragma unroll
      for (int mt = 0; mt < 4; mt++) aa[mt] = ld_perm(sAT + (mt * 16 + fr) * 144, ks * 32 + fq * 4);
#pragma unroll
      for (int mt = 0; mt < 4; mt++) oq[mt] = mfma16(aa[mt], vb[ks], oq[mt]);
    }
    if (MIXER != 2) {
#pragma unroll
      for (int mt = 0; mt < 4; mt++)
#pragma unroll
        for (int j = 0; j < 4; j++) vn[mt][j] *= sSC[64 + mt * 16 + fq * 4 + j];
#pragma unroll
      for (int ks = 0; ks < 2; ks++) vb[ks] = pack8(vn[2 * ks], vn[2 * ks + 1]);
    }
#pragma unroll
    for (int mt = 0; mt < 8; mt++) {
      if (MIXER == 2) {
#pragma unroll
        for (int j = 0; j < 4; j++) S[mt][j] *= sSC[mt * 16 + fq * 4 + j];
      } else {
#pragma unroll
        for (int j = 0; j < 4; j++) S[mt][j] *= egl;
      }
    }
#pragma unroll
    for (int ks = 0; ks < 2; ks++) {
      bf16x8 at[8];
#pragma unroll
      for (int mt = 0; mt < 8; mt++) at[mt] = ld_tr2(km_tr + (unsigned)((ks * 32) * 272 + mt * 32), km_tr + (unsigned)((ks * 32 + 16) * 272 + mt * 32));
#pragma unroll
      for (int mt = 0; mt < 8; mt++) S[mt] = mfma16(at[mt], vb[ks], S[mt]);
    }
    {
      u16* obase = s.o + (size_t)row0 * 1024;
#pragma unroll
      for (int mt = 0; mt < 4; mt++)
#pragma unroll
        for (int j = 0; j < 4; j++) obase[(unsigned)((mt * 16 + fq * 4 + j) * 1024 + w * 16 + fr)] = f2bf(oq[mt][j]);
    }
    __syncthreads();
  }
}

DI void scan_phase_hg(const Params& p, char* smem) {
  const int WV = p.ph_hi;
  if ((blockIdx.x & 3) == 0 && (blockIdx.x >> 2) < 64) {
    const int u = blockIdx.x >> 2;
    const int dir = u & 1, vg = (u >> 1) & 1, h = (u >> 2) & 7, b = u >> 5;
    ScanDesc s;
    s.q = dir == 0 ? (const u16*)(p.ws + OFF_A) + h * 128 : (const u16*)(p.ws + OFF_B) + h * 128;
    s.qp = dir == 0 ? 4096 : 1024;
    s.k = (const u16*)(p.ws + OFF_A) + 1024 + dir * 1024 + h * 128; s.kp = 4096;
    s.v = (const u16*)(p.ws + OFF_A) + 3072 + h * 128 + vg * 64; s.vp = 4096;
    s.aux = (const u16*)(p.ws + OFF_C) + (size_t)(h * 2 + dir) * 4096; s.aux_cs = 8 * 2 * 4096; s.attn_off = 0; s.ainv_off = 0;
    s.o = (u16*)(p.ws + OFF_D + (dir ? SZ_TOK1K : 0)) + h * 128 + vg * 64;
    s.mixer = 2; s.b = b; s.dir = dir;
    s.sc = (const float*)(p.ws + OFF_HGDEC) + (size_t)(h * 2 + dir) * 128; s.sc_cs = 8 * 2 * 128; s.lam = 0.f;
    scan_unit<2>(s, smem, WV);
  }
}
DI void scan_phase_dnret(const Params& p, int l, char* smem) {
  const int WV = p.ph_hi;
  if ((blockIdx.x & 1) == 0 && (blockIdx.x >> 1) < 128) {
    const int u = blockIdx.x >> 1;
    const int mixer = u & 1, dir = (u >> 1) & 1, vg = (u >> 2) & 3, h = (u >> 4) & 3, b = u >> 6;
    ScanDesc s;
    const u16* base = (const u16*)(p.ws + OFF_A + (mixer ? 2 * SZ_TOK1K : 0));
    s.q = base + h * 128; s.k = base + 512 + h * 128; s.v = base + 1024 + h * 256 + vg * 64;
    s.qp = s.kp = s.vp = 2048;
    s.mixer = mixer; s.b = b; s.dir = dir;
    if (mixer == 0) {
      s.aux = (const u16*)(p.ws + OFF_B) + (size_t)(h * 2 + dir) * 2 * 4096; s.aux_cs = 4 * 4 * 4096; s.ainv_off = 0; s.attn_off = 4096;
      s.sc = (const float*)(p.ws + OFF_DNSC) + (size_t)(h * 2 + dir) * 192; s.sc_cs = 4 * 2 * 192; s.lam = 0.f;
      s.o = (u16*)(dir == 0 ? p.ws + OFF_E : p.ws + OFF_D + SZ_TOK1K) + h * 256 + vg * 64;
      scan_unit<0>(s, smem, WV);
    } else {
      s.aux = (const u16*)(p.ws + OFF_C) + (size_t)(h * 2 + dir) * 4096; s.aux_cs = 4 * 2 * 4096; s.attn_off = 0; s.ainv_off = 0;
      const float rd = p.ret_decay[l * 8 + dir * 4 + h];
      s.lam = fminf(rd, 0.f) - log1pf(__expf(-fabsf(rd)));
      s.sc = nullptr; s.sc_cs = 0;
      s.o = (u16*)(p.ws + OFF_E + (dir == 0 ? SZ_TOK1K : 2 * SZ_TOK1K)) + h * 256 + vg * 64;
      scan_unit<1>(s, smem, WV);
    }
  }
}

DI void onorm_rows(u16* of, const u16* ob, const float* nw, int dv, int unit, int nunits_stride, const int WV) {
  const int lane = tidx() & 63, w = tidx() >> 6;
  float nwr[16];
  {
    const int dcol0 = (lane * 16) % dv;
#pragma unroll
    for (int e = 0; e < 4; e++) {
      const f32x4 t4 = *(const f32x4*)(nw + dcol0 + 4 * e);
      nwr[4 * e] = t4[0]; nwr[4 * e + 1] = t4[1]; nwr[4 * e + 2] = t4[2]; nwr[4 * e + 3] = t4[3];
    }
  }
  for (int row = unit * 4 + w; row < T_ALL; row += nunits_stride * 4) {
    u16* pf = of + (size_t)row * 1024 + lane * 16;
    const u16* pb = ob + (size_t)row * 1024 + lane * 16;
    float v[16];
#pragma unroll
    for (int hv = 0; hv < 2; hv++) {
      const uint4 a = *(const uint4*)(pf + hv * 8), b = *(const uint4*)(pb + hv * 8);
      const unsigned aa[4] = {a.x, a.y, a.z, a.w}, bb[4] = {b.x, b.y, b.z, b.w};
#pragma unroll
      for (int e = 0; e < 4; e++) {
        v[hv * 8 + e * 2] = bf2f((u16)(aa[e] & 0xffff)) + bf2f((u16)(bb[e] & 0xffff));
        v[hv * 8 + e * 2 + 1] = bf2f((u16)(aa[e] >> 16)) + bf2f((u16)(bb[e] >> 16));
      }
    }
    float ss = 0.f;
#pragma unroll
    for (int e = 0; e < 16; e++) ss += v[e] * v[e];
    ss = dv == 256 ? gsum(ss, 16) : gsum(ss, 8);
    const float rstd = rsqrtf(ss / (float)dv + 1e-6f);
    unsigned o8[8];
#pragma unroll
    for (int e = 0; e < 8; e++) o8[e] = pack2(v[2 * e] * rstd * nwr[2 * e], v[2 * e + 1] * rstd * nwr[2 * e + 1]);
    *(uint4*)pf = uint4{o8[0], o8[1], o8[2], o8[3]};
    *(uint4*)(pf + 8) = uint4{o8[4], o8[5], o8[6], o8[7]};
  }
}

DI void final_norm(const Params& p) {
  const int WV = p.ph_hi;
  const int lane = tidx() & 63, w = tidx() >> 6;
  for (int row = blockIdx.x * 4 + w; row < T_LAT; row += gridDim.x * 4) {
    float* xr = p.out + (size_t)row * 1024;
    f32x4 xv[4];
    float ss = 0.f;
#pragma unroll
    for (int i = 0; i < 4; i++) {
      xv[i] = *(const f32x4*)(xr + i * 256 + lane * 4);
      ss += xv[i][0] * xv[i][0] + xv[i][1] * xv[i][1] + xv[i][2] * xv[i][2] + xv[i][3] * xv[i][3];
    }
    ss = wsum(ss);
    const float rstd = rsqrtf(ss * (1.f / 1024.f) + 1e-6f);
#pragma unroll
    for (int i = 0; i < 4; i++) {
      const f32x4 wv = *(const f32x4*)(p.final_norm_w + i * 256 + lane * 4);
      f32x4 r;
#pragma unroll
      for (int j = 0; j < 4; j++) r[j] = xv[i][j] * rstd * wv[j];
      *(f32x4*)(xr + i * 256 + lane * 4) = r;
    }
  }
}

DI void run_phase(const Params& p, int ph, char* smem) {
  const int WV = p.ph_hi;
  const int G = gridDim.x, B = blockIdx.x;
  if (ph == 0) { if (QSEL(11)) phase_pro(p, smem); return; }
  if (ph == 23) { if (QSEL(12)) final_norm(p); return; }
  const int l = (ph - 1) / 11, q = (ph - 1) % 11;
  const bool last = l == 1;
  switch (q) {
    case 0: if (!QSEL(0)) break;
      if (l == 1) for (int u = B; u < WCONV_UNITS; u += G) wconv_unit(p, 1, u, smem);
      phase_norm(p, l, smem);
      break;
    case 1: if (!QSEL(1)) break;
      for (int t = B; t < 128 * 16; t += G) {
        const int tn = t + G;
        const bool more = tn < 128 * 16;
        gemm_tile<EPI_HG, 8>(p, l, t % 128, t / 128, smem, t != B, more ? tn % 128 : -1, more ? tn / 128 : -1);
      }
      for (int t = B; t < 4 * 32; t += G) gemm_tile<EPI_HG, 4>(p, l, 128 + (t & 3), t >> 2, smem);
      break;
    case 2: if (!QSEL(2)) break;
      for (int u = B; u < NCH * 8; u += G) hg_prep_unit(p, l, u >> 3, u & 7, smem);
      break;
    case 3: if (!QSEL(3)) break; scan_phase_hg(p, smem); break;
    case 4: if (!QSEL(4)) break;
      for (int t = B; t < 128 * 16; t += G) {
        const int tn = t + G;
        const bool more = tn < 128 * 16;
        gemm_tile<EPI_DNRET, 8>(p, l, t % 128, t / 128, smem, t != B, more ? tn % 128 : -1, more ? tn / 128 : -1);
      }
      for (int t = B; t < 4 * 32; t += G) gemm_tile<EPI_DNRET, 4>(p, l, 128 + (t & 3), t >> 2, smem);
      break;
    case 5: if (!QSEL(5)) break;
      for (int u = B; u < NCH * 8; u += G) {
        if (u < NCH * 4) dn_prep_unit(p, l, u >> 2, u & 3, smem);
        else ret_prep_unit(p, l, (u - NCH * 4) >> 2, u & 3, smem);
      }
      if (B >= 32) onorm_rows((u16*)(p.ws + OFF_D), (const u16*)(p.ws + OFF_D + SZ_TOK1K), p.hg_norm_w + l * 128, 128, B - 32, G - 32, WV);
      break;
    case 6: if (!QSEL(6)) break; scan_phase_dnret(p, l, smem); break;
    case 7: if (!QSEL(7)) break;
      onorm_rows((u16*)(p.ws + OFF_E), (const u16*)(p.ws + OFF_D + SZ_TOK1K), p.dn_norm_w + l * 256, 256, B, G, WV);
      onorm_rows((u16*)(p.ws + OFF_E + SZ_TOK1K), (const u16*)(p.ws + OFF_E + 2 * SZ_TOK1K), p.ret_norm_w + l * 256, 256, B, G, WV);
      break;
    case 8: if (!QSEL(8)) break; {
      const int nrt = last ? 128 : 132;
      for (int t = B; t < 128 * 12; t += G) {
        const int tn = t + G;
        const bool more = tn < 128 * 12;
        gemm_tile<EPI_GATE, 8>(p, l, t % 128, t / 128, smem, t != B, more ? tn % 128 : -1, more ? tn / 128 : -1);
      }
      if (!last) for (int t = B; t < 4 * 24; t += G) gemm_tile<EPI_GATE, 4>(p, l, 128 + (t & 3), t >> 2, smem);
    } break;
    case 9: if (!QSEL(9)) break; {
      const int nrt = last ? 128 : 132;
      for (int t = B; t < nrt * 8; t += G) {
        const int tn = t + G;
        const bool more = tn < nrt * 8;
        merge_tile(p, t % nrt, t / nrt, smem, t != B, more ? tn % nrt : -1, more ? tn / nrt : -1);
      }
    } break;
    case 10: if (!QSEL(10)) break; {
      const int nrt = last ? 128 : 132;
      for (int t = B; t < 128 * 4; t += G) {
        const int tn = t + G;
        const bool more = tn < 128 * 4;
        gemm_tile<EPI_OUT, 8>(p, l, t % 128, t / 128, smem, t != B, more ? tn % 128 : -1, more ? tn / 128 : -1);
      }
      if (!last) for (int t = B; t < 4 * 8; t += G) gemm_tile<EPI_OUT, 4>(p, l, 128 + (t & 3), t >> 2, smem);
    } break;
  }
}

#define XB_XCNT(j) (64 * (j))
#define XB_XSUB(j) (1024 + 64 * (j))
#define XB_XGEN(j) (2048 + 64 * (j))
#define XB_TOP 3072
#define XB_TOPGEN 3136
DI unsigned xb_ld(unsigned* q) { return __hip_atomic_load(q, __ATOMIC_RELAXED, __HIP_MEMORY_SCOPE_AGENT); }
DI unsigned xb_add(unsigned* q, unsigned v) { return __hip_atomic_fetch_add(q, v, __ATOMIC_RELAXED, __HIP_MEMORY_SCOPE_AGENT); }
DI void grid_barrier(unsigned* bar, volatile unsigned* st) {
  asm volatile("s_waitcnt vmcnt(0) lgkmcnt(0)" ::: "memory");
  __syncthreads();
  if (__builtin_amdgcn_workitem_id_x() == 0) {
    const unsigned nloc = st[0], nx = st[1], x = st[2];
    const unsigned old = xb_add(&bar[XB_XSUB(x)], 1u);
    const unsigned gen = old / nloc;
    if (old + 1u == (gen + 1u) * nloc) {
      __builtin_amdgcn_fence(__ATOMIC_RELEASE, "agent");
      asm volatile("s_waitcnt vmcnt(0)" ::: "memory");
      const unsigned og = xb_add(&bar[XB_TOP], 1u);
      const unsigned tg = og / nx;
      if (og + 1u == (tg + 1u) * nx) xb_add(&bar[XB_TOPGEN], 1u);
      else while (xb_ld(&bar[XB_TOPGEN]) == tg) __builtin_amdgcn_s_sleep(2);
      __builtin_amdgcn_fence(__ATOMIC_ACQUIRE, "agent");
      xb_add(&bar[XB_XGEN(x)], 1u);
      asm volatile("s_waitcnt vmcnt(0)" ::: "memory");
    } else {
      while (xb_ld(&bar[XB_XGEN(x)]) == gen) __builtin_amdgcn_s_sleep(8);
      __builtin_amdgcn_fence(__ATOMIC_ACQUIRE, "agent");
      asm volatile("s_waitcnt vmcnt(0)" ::: "memory");
    }
  }
  __syncthreads();
}

__global__ void __launch_bounds__(256, 2) mk(Params p) {
  extern __shared__ __attribute__((aligned(16))) char smem[];
  p.ph_hi = __builtin_amdgcn_readfirstlane((int)__builtin_amdgcn_workitem_id_x() >> 6);
#if ONE_LAUNCH
  cg::grid_group grid = cg::this_grid();
  unsigned* bar = (unsigned*)(p.ws + OFF_BAR);
  __shared__ uint4 xbw;
  if (__builtin_amdgcn_workitem_id_x() == 0)
    (void)xb_add(&bar[XB_XCNT((unsigned)__builtin_amdgcn_s_getreg((3 << 11) | 20) & 0xFu)], 1u);
#ifdef PROBE_MASK
  long long tacc = 0, t0 = wall_clock64();
#define PTICK(n) { const long long t1 = wall_clock64(); if ((PROBE_MASK >> (n)) & 1) tacc += t1 - t0; t0 = t1; }
#else
#define PTICK(n)
#endif
  run_phase(p, 0, smem);
  grid.sync();
  if (__builtin_amdgcn_workitem_id_x() == 0) {
    const unsigned x = (unsigned)__builtin_amdgcn_s_getreg((3 << 11) | 20) & 0xFu;
    unsigned cnt = 0u, mine = 1u;
#pragma unroll
    for (unsigned j = 0; j < 16; ++j) { const unsigned c = xb_ld(&bar[XB_XCNT(j)]); cnt += c > 0u ? 1u : 0u; mine = j == x ? c : mine; }
    xbw = make_uint4(mine > 0u ? mine : 1u, cnt > 0u ? cnt : 1u, x, 0u);
  }
  __syncthreads();
  volatile unsigned* xst = (volatile unsigned*)&xbw;
  PTICK(0)
#define PH(n) run_phase(p, n, smem); grid_barrier(bar, xst); PTICK(n)
  PH(1) PH(2) PH(3) PH(4) PH(5) PH(6) PH(7) PH(8) PH(9) PH(10) PH(11)
  PH(12) PH(13) PH(14) PH(15) PH(16) PH(17) PH(18) PH(19) PH(20) PH(21) PH(22)
  run_phase(p, 23, smem);
  PTICK(23)
#ifdef PROBE_MASK
  if (blockIdx.x == 0 && __builtin_amdgcn_workitem_id_x() == 0) {
    const long long tend = wall_clock64() + tacc * 4;
    while (wall_clock64() < tend) __builtin_amdgcn_s_sleep(20);
  }
#endif
#else
  run_phase(p, p.ph_lo, smem);
#endif
}

extern "C" void kernel_launch(void* const* d_in, const int* in_sizes, int n_in, void* d_out,
                              int out_size, void* d_ws, size_t ws_size, hipStream_t stream) {
  static int grid_blocks = 0;
  if (!grid_blocks) {
    int dev = 0, cus = 0, per_cu = 0;
    (void)hipGetDevice(&dev);
    (void)hipDeviceGetAttribute(&cus, hipDeviceAttributeMultiprocessorCount, dev);
    (void)hipFuncSetAttribute((const void*)mk, hipFuncAttributeMaxDynamicSharedMemorySize, SMEM_BYTES);
    (void)hipOccupancyMaxActiveBlocksPerMultiprocessor(&per_cu, mk, 256, SMEM_BYTES);
    if (per_cu > 2) per_cu = 2;
    if (per_cu < 1) per_cu = 1;
    grid_blocks = cus * per_cu;
  }
  Params p{};
  const float** f = (const float**)&p;
  for (int i = 0; i < 19; i++) f[i] = (const float*)d_in[i];
  p.out = (float*)d_out;
  p.ws = (char*)d_ws;
#if ONE_LAUNCH
  p.ph_lo = 0; p.ph_hi = 24;
  (void)hipMemsetAsync((char*)d_ws + OFF_BAR, 0, 16384, stream);
  void* args[] = {&p};
  (void)hipLaunchCooperativeKernel((void*)mk, dim3(grid_blocks), dim3(256), args, SMEM_BYTES, stream);
#else
  for (int ph = 0; ph < 24; ph++) {
    p.ph_lo = ph; p.ph_hi = ph + 1;
    void* args[] = {&p};
    (void)hipLaunchCooperativeKernel((void*)mk, dim3(grid_blocks), dim3(256), args, SMEM_BYTES, stream);
  }
#endif
}
```
